# Optimizing an MI355X kernel written in HIP

```python
import math
import numpy as np
import jax
import jax.numpy as jnp
from jax import lax

D_MODEL = 1024
BATCH = 4
SEQ = 8192
DEPTH = 2

GRID_W = 64
CTX_LEN = 256
N_EVEN = (DEPTH + 1) // 2
N_ODD = DEPTH // 2
N_MOD = 9
DN_ALPHA = float((2 * DEPTH) ** 0.25)
DN_BETA = float((8 * DEPTH) ** -0.25)
LN_EPS = 1e-6
RMS_EPS = 1e-6
SUBLN_EPS = 1e-5
ROPE_BASE = 10000.0
Q_BLOCK = 128
NEG_INF = -1e30

D_FF = 2816

A_HEADS = 8
A_NOPE = 64
A_ROPE = 32
A_V = 64
A_Q_RANK = 256
A_KV_RANK = 128
A_SCALE = float((A_NOPE + A_ROPE) ** -0.5)
A_WIDTH = A_HEADS * A_V

B_HEADS = 4
B_HD = 64
B_SCALE = float(B_HD ** -0.5)
B_QK = B_HEADS * 2 * B_HD
B_WIDTH = B_HEADS * 2 * B_HD

C_GROUPS = 4
C_WINDOWS = (2, 4, 8, 16)
C_GW = 128
C_WIDTH = C_GROUPS * C_GW

D_HEADS = 8
D_HD = 64
D_SCALE = float(D_HD ** -0.5)
D_WIDTH = D_HEADS * D_HD
NA_ROWS = 8
NA_COLS = 16

EV_Q_COLS = A_Q_RANK + B_QK
EV_KV_COLS = A_KV_RANK + A_ROPE + B_QK + B_QK
EV_COLS = EV_Q_COLS + EV_KV_COLS
EV_MIX = A_WIDTH + B_WIDTH
OD_Q_COLS = C_WIDTH + D_WIDTH
OD_COLS = OD_Q_COLS + 2 * D_WIDTH
OD_MIX = C_WIDTH + D_WIDTH

kernel_name = 'hybrid_mla_diff_pool_natten_prefix_trunk'


def layer_norm(x, g, b):
    xf = x.astype(jnp.float32)
    mu = jnp.mean(xf, -1, keepdims=True)
    var = jnp.mean(jnp.square(xf - mu), -1, keepdims=True)
    y = (xf - mu) * lax.rsqrt(var + LN_EPS)
    return (y * g.astype(jnp.float32) + b.astype(jnp.float32)).astype(x.dtype)


def rms_norm(x, g, eps=RMS_EPS):
    xf = x.astype(jnp.float32)
    y = xf * lax.rsqrt(jnp.mean(jnp.square(xf), -1, keepdims=True) + eps)
    return (y * g.astype(jnp.float32)).astype(x.dtype)


def modulate(x, shift, scale):
    return x * (1 + scale) + shift


def post_norm(x, y, g, b):
    return layer_norm(DN_ALPHA * x + y, g, b)


def swiglu(h, w_gate, w_up, w_down):
    return (jax.nn.silu(h @ w_gate) * (h @ w_up)) @ w_down


def axial_rope_tables(n, rot_dim):
    t = jnp.arange(n, dtype=jnp.int32)
    row = (t // GRID_W).astype(jnp.float32)
    col = (t % GRID_W).astype(jnp.float32)
    quarter = rot_dim // 4
    inv = ROPE_BASE ** (-jnp.arange(quarter, dtype=jnp.float32) / quarter)
    ang_r = row[:, None] * inv[None, :]
    ang_c = col[:, None] * inv[None, :]
    ang = jnp.concatenate([ang_r, ang_r, ang_c, ang_c], -1)
    return jnp.cos(ang), jnp.sin(ang)


def maybe_rope(x, tables):
    if tables is None:
        return x
    cos, sin = tables
    if x.ndim == 4:
        cos, sin = cos[:, None, :], sin[:, None, :]
    xf = x.astype(jnp.float32)
    x1, x2, x3, x4 = jnp.split(xf, 4, axis=-1)
    rot = jnp.concatenate([-x2, x1, -x4, x3], -1)
    return (xf * cos + rot * sin).astype(x.dtype)


def softmax_f32(s, scale):
    return jax.nn.softmax(s.astype(jnp.float32) * scale, axis=-1)


def softmax_attend(q, k, v, scale):
    p = softmax_f32(jnp.einsum('bqhd,bkhd->bhqk', q, k), scale)
    return jnp.einsum('bhqk,bkhd->bqhd', p.astype(v.dtype), v)


def mla_attend(q_nope, q_pe, k_nope, k_pe, v):
    s = jnp.einsum('bqhd,bkhd->bhqk', q_nope, k_nope) + jnp.einsum('bqhr,bkr->bhqk', q_pe, k_pe)
    p = softmax_f32(s, A_SCALE)
    return jnp.einsum('bhqk,bkhd->bqhd', p.astype(v.dtype), v)


def diff_attend(q1, q2, k1, k2, v, lam, lam_init, g_sub):
    p1 = softmax_f32(jnp.einsum('bqhd,bkhd->bhqk', q1, k1), B_SCALE)
    p2 = softmax_f32(jnp.einsum('bqhd,bkhd->bhqk', q2, k2), B_SCALE)
    o = jnp.einsum('bhqk,bkhd->bqhd', (p1 - lam * p2).astype(v.dtype), v)
    return rms_norm(o, g_sub, SUBLN_EPS) * (1.0 - lam_init)


def sweep_query_blocks(fn, *qs):
    b, n = qs[0].shape[:2]
    nb = n // Q_BLOCK
    blocks = tuple(jnp.moveaxis(q.reshape((b, nb, Q_BLOCK) + q.shape[2:]), 1, 0) for q in qs)
    out = lax.map(lambda blk: fn(*blk), blocks)
    out = jnp.moveaxis(out, 0, 1)
    return out.reshape((b, n) + out.shape[3:])


def even_queries(qp, g_qlat, w_uq, rope_a, rope_b):
    b, n, _ = qp.shape
    q = (rms_norm(qp[..., :A_Q_RANK], g_qlat) @ w_uq).reshape(b, n, A_HEADS, A_NOPE + A_ROPE)
    bq = qp[..., A_Q_RANK:].reshape(b, n, B_HEADS, 2, B_HD)
    return (q[..., :A_NOPE], maybe_rope(q[..., A_NOPE:], rope_a),
            maybe_rope(bq[..., 0, :], rope_b), maybe_rope(bq[..., 1, :], rope_b))


def even_keys(kp, g_kvlat, w_ukv, rope_a, rope_b):
    b, n, _ = kp.shape
    kv = (rms_norm(kp[..., :A_KV_RANK], g_kvlat) @ w_ukv).reshape(b, n, A_HEADS, A_NOPE + A_V)
    k_pe = maybe_rope(kp[..., A_KV_RANK:A_KV_RANK + A_ROPE], rope_a)
    o = A_KV_RANK + A_ROPE
    bk = kp[..., o:o + B_QK].reshape(b, n, B_HEADS, 2, B_HD)
    v_b = kp[..., o + B_QK:].reshape(b, n, B_HEADS, 2 * B_HD)
    return (kv[..., :A_NOPE], k_pe, kv[..., A_NOPE:],
            maybe_rope(bk[..., 0, :], rope_b), maybe_rope(bk[..., 1, :], rope_b), v_b)


def even_mixer(h, hc, w_in, w_out, g_qlat, g_kvlat, w_uq, w_ukv, lam_vec, g_sub, lam_init, ctx_out):
    b, n, _ = h.shape
    m = hc.shape[1]
    rope_a = axial_rope_tables(n, A_ROPE)
    rope_b = axial_rope_tables(n, B_HD)
    lv = lam_vec.astype(jnp.float32)
    lam = jnp.exp(jnp.sum(lv[0] * lv[1])) - jnp.exp(jnp.sum(lv[2] * lv[3])) + lam_init
    p = h @ w_in
    pc = hc @ (w_in if ctx_out else w_in[:, EV_Q_COLS:])
    keys_ctx = even_keys(pc[..., -EV_KV_COLS:], g_kvlat, w_ukv, None, None)
    keys_lat = even_keys(p[..., EV_Q_COLS:], g_kvlat, w_ukv, rope_a, rope_b)
    kn, kpe, va, k1, k2, vb = [jnp.concatenate([kl, kc], axis=1) for kl, kc in zip(keys_lat, keys_ctx)]

    def block(qn, qpe, q1, q2):
        bq = qn.shape[1]
        oa = mla_attend(qn, qpe, kn, kpe, va).reshape(b, bq, A_WIDTH)
        ob = diff_attend(q1, q2, k1, k2, vb, lam, lam_init, g_sub).reshape(b, bq, B_WIDTH)
        return jnp.concatenate([oa, ob], -1)

    y = sweep_query_blocks(block, *even_queries(p[..., :EV_Q_COLS], g_qlat, w_uq, rope_a, rope_b)) @ w_out
    if not ctx_out:
        return y, None
    kn_c, kpe_c, va_c, k1_c, k2_c, vb_c = keys_ctx
    qn_c, qpe_c, q1_c, q2_c = even_queries(pc[..., :EV_Q_COLS], g_qlat, w_uq, None, None)
    oa_c = mla_attend(qn_c, qpe_c, kn_c, kpe_c, va_c).reshape(b, m, A_WIDTH)
    ob_c = diff_attend(q1_c, q2_c, k1_c, k2_c, vb_c, lam, lam_init, g_sub).reshape(b, m, B_WIDTH)
    yc = jnp.concatenate([oa_c, ob_c], -1) @ w_out
    return y, yc


def window_mean(u, w):
    n = u.shape[1]
    left = w // 2
    right = w - 1 - left
    t = np.arange(n)
    lo = np.clip(t - left, 0, n)
    hi = np.clip(t + right + 1, 0, n)
    uf = u.astype(jnp.float32)
    csum = jnp.concatenate([jnp.zeros_like(uf[:, :1]), jnp.cumsum(uf, axis=1)], axis=1)
    cnt = jnp.asarray(hi - lo, jnp.float32)
    return ((csum[:, hi] - csum[:, lo]) / cnt[None, :, None]).astype(u.dtype)


def multiscale_pool(u, w_pool, pool_scale):
    b, n, _ = u.shape
    ug = u.reshape(b, n, C_GROUPS, C_GW)
    pooled = jnp.stack([window_mean(ug[:, :, g], w) for g, w in enumerate(C_WINDOWS)], axis=2) - ug
    return jnp.einsum('bngc,gcd->bngd', pooled, w_pool).reshape(b, n, C_WIDTH) * pool_scale


def neighbourhood_attend(q, k, v, k_ctx, v_ctx, rpb):
    b, n, h, d = q.shape
    rows = n // GRID_W
    wr = min(NA_ROWS, rows)
    rs = np.clip(np.arange(rows) - wr // 2, 0, rows - wr)
    j = np.arange(GRID_W)
    cs = np.clip(j - NA_COLS // 2, 0, GRID_W - NA_COLS)
    col_valid = (j[None, :] >= cs[:, None]) & (j[None, :] < cs[:, None] + NA_COLS)
    col_idx = np.clip(j[None, :] - j[:, None] + NA_COLS - 1, 0, 2 * NA_COLS - 2)
    q_rows = jnp.moveaxis(q.reshape(b, rows, GRID_W, h, d), 1, 0)
    k_grid = k.reshape(b, rows, GRID_W, h, d)
    v_grid = v.reshape(b, rows, GRID_W, h, d)
    nk = wr * GRID_W

    def row_fn(args):
        q_r, r, r0 = args
        k_blk = lax.dynamic_slice_in_dim(k_grid, r0, wr, axis=1).reshape(b, nk, h, d)
        v_blk = lax.dynamic_slice_in_dim(v_grid, r0, wr, axis=1).reshape(b, nk, h, d)
        row_off = r0 + jnp.arange(wr, dtype=jnp.int32) - r + NA_ROWS - 1
        bias = rpb[:, row_off[:, None, None], col_idx[None]].astype(jnp.float32)
        bias = jnp.where(col_valid[None, None], bias, NEG_INF)
        bias = bias.transpose(0, 2, 1, 3).reshape(h, GRID_W, nk)
        s_nb = jnp.einsum('bqhd,bkhd->bhqk', q_r, k_blk).astype(jnp.float32) * D_SCALE + bias
        s_cx = jnp.einsum('bqhd,bkhd->bhqk', q_r, k_ctx).astype(jnp.float32) * D_SCALE
        p = jax.nn.softmax(jnp.concatenate([s_nb, s_cx], -1), axis=-1).astype(v.dtype)
        return (jnp.einsum('bhqk,bkhd->bqhd', p[..., :nk], v_blk)
                + jnp.einsum('bhqk,bkhd->bqhd', p[..., nk:], v_ctx))

    out = lax.map(row_fn, (q_rows, jnp.arange(rows, dtype=jnp.int32), jnp.asarray(rs, jnp.int32)))
    return jnp.moveaxis(out, 0, 1).reshape(b, n, h, d)


def odd_mixer(h, hc, w_in, w_out, w_pool, pool_scale, rpb, ctx_out):
    b, n, _ = h.shape
    m = hc.shape[1]
    p = h @ w_in
    pc = hc @ (w_in if ctx_out else w_in[:, OD_Q_COLS:])
    q = p[..., C_WIDTH:OD_Q_COLS].reshape(b, n, D_HEADS, D_HD)
    k = p[..., OD_Q_COLS:OD_Q_COLS + D_WIDTH].reshape(b, n, D_HEADS, D_HD)
    v = p[..., OD_Q_COLS + D_WIDTH:].reshape(b, n, D_HEADS, D_HD)
    k_c = pc[..., -2 * D_WIDTH:-D_WIDTH].reshape(b, m, D_HEADS, D_HD)
    v_c = pc[..., -D_WIDTH:].reshape(b, m, D_HEADS, D_HD)
    y_pool = multiscale_pool(p[..., :C_WIDTH], w_pool, pool_scale)
    y_na = neighbourhood_attend(q, k, v, k_c, v_c, rpb).reshape(b, n, D_WIDTH)
    y = jnp.concatenate([y_pool, y_na], -1) @ w_out
    if not ctx_out:
        return y, None
    q_c = pc[..., C_WIDTH:OD_Q_COLS].reshape(b, m, D_HEADS, D_HD)
    yc_pool = multiscale_pool(pc[..., :C_WIDTH], w_pool, pool_scale)
    yc_att = softmax_attend(q_c, k_c, v_c, D_SCALE).reshape(b, m, D_WIDTH)
    yc = jnp.concatenate([yc_pool, yc_att], -1) @ w_out
    return y, yc


def setup_inputs(seed: int = 0) -> dict:
    key = jax.random.key(seed)
    ks = jax.random.split(key, 26)

    def nrm(k, shape, s):
        return jax.random.normal(k, shape, jnp.float32) * s

    return {
        'x': nrm(ks[0], (BATCH, SEQ, D_MODEL), 1.0),
        'c': nrm(ks[1], (BATCH, D_MODEL), 1.0),
        'ctx': nrm(ks[2], (BATCH, CTX_LEN, D_MODEL), 1.0),
        'c_ctx': nrm(ks[3], (D_MODEL,), 1.0),
        'ada_w': nrm(ks[4], (DEPTH, D_MODEL, N_MOD * D_MODEL), 0.5 * D_MODEL ** -0.5),
        'ada_b': nrm(ks[5], (DEPTH, N_MOD * D_MODEL), 0.02),
        'ln_g': 1.0 + nrm(ks[6], (DEPTH, 3, D_MODEL), 0.02),
        'ln_b': nrm(ks[7], (DEPTH, 3, D_MODEL), 0.02),
        'ffn_w_gate': nrm(ks[8], (DEPTH, 2, D_MODEL, D_FF), D_MODEL ** -0.5),
        'ffn_w_up': nrm(ks[9], (DEPTH, 2, D_MODEL, D_FF), D_MODEL ** -0.5),
        'ffn_w_down': nrm(ks[10], (DEPTH, 2, D_FF, D_MODEL), DN_BETA * D_FF ** -0.5),
        'ev_w_in': nrm(ks[11], (N_EVEN, D_MODEL, EV_COLS), D_MODEL ** -0.5),
        'ev_w_out': nrm(ks[12], (N_EVEN, EV_MIX, D_MODEL), DN_BETA * EV_MIX ** -0.5),
        'ev_g_qlat': 1.0 + nrm(ks[13], (N_EVEN, A_Q_RANK), 0.02),
        'ev_g_kvlat': 1.0 + nrm(ks[14], (N_EVEN, A_KV_RANK), 0.02),
        'ev_w_uq': nrm(ks[15], (N_EVEN, A_Q_RANK, A_HEADS * (A_NOPE + A_ROPE)), A_Q_RANK ** -0.5),
        'ev_w_ukv': nrm(ks[16], (N_EVEN, A_KV_RANK, A_HEADS * (A_NOPE + A_V)), A_KV_RANK ** -0.5),
        'ev_lam': nrm(ks[17], (N_EVEN, 4, B_HD), 0.1),
        'ev_g_sub': 1.0 + nrm(ks[18], (N_EVEN, 2 * B_HD), 0.02),
        'od_w_in': nrm(ks[19], (N_ODD, D_MODEL, OD_COLS), D_MODEL ** -0.5),
        'od_w_out': nrm(ks[20], (N_ODD, OD_MIX, D_MODEL), DN_BETA * OD_MIX ** -0.5),
        'od_w_pool': nrm(ks[21], (N_ODD, C_GROUPS, C_GW, C_GW), C_GW ** -0.5),
        'od_pool_scale': 1.0 + nrm(ks[22], (N_ODD, C_WIDTH), 0.02),
        'od_rpb': nrm(ks[23], (N_ODD, D_HEADS, 2 * NA_ROWS - 1, 2 * NA_COLS - 1), 0.02),
    }


def reference(x, c, ctx, c_ctx, ada_w, ada_b, ln_g, ln_b, ffn_w_gate, ffn_w_up, ffn_w_down,
              ev_w_in, ev_w_out, ev_g_qlat, ev_g_kvlat, ev_w_uq, ev_w_ukv, ev_lam, ev_g_sub,
              od_w_in, od_w_out, od_w_pool, od_pool_scale, od_rpb):
    bsz = x.shape[0]
    sc = jax.nn.silu(c)
    sc_ctx = jax.nn.silu(c_ctx)
    h, hc = x, ctx
    for l in range(DEPTH):
        last = l == DEPTH - 1
        mod = (sc @ ada_w[l] + ada_b[l]).reshape(bsz, N_MOD, 1, D_MODEL)
        mod_c = (sc_ctx @ ada_w[l] + ada_b[l]).reshape(N_MOD, D_MODEL)

        h = post_norm(h, 0.5 * mod[:, 2] * swiglu(modulate(h, mod[:, 0], mod[:, 1]),
                                                   ffn_w_gate[l, 0], ffn_w_up[l, 0], ffn_w_down[l, 0]),
                      ln_g[l, 0], ln_b[l, 0])
        hc = post_norm(hc, 0.5 * mod_c[2] * swiglu(modulate(hc, mod_c[0], mod_c[1]),
                                                    ffn_w_gate[l, 0], ffn_w_up[l, 0], ffn_w_down[l, 0]),
                       ln_g[l, 0], ln_b[l, 0])

        hm = modulate(h, mod[:, 3], mod[:, 4])
        hcm = modulate(hc, mod_c[3], mod_c[4])
        if l % 2 == 0:
            e = l // 2
            lam_init = 0.8 - 0.6 * math.exp(-0.3 * l)
            y, yc = even_mixer(hm, hcm, ev_w_in[e], ev_w_out[e], ev_g_qlat[e], ev_g_kvlat[e],
                               ev_w_uq[e], ev_w_ukv[e], ev_lam[e], ev_g_sub[e], lam_init, not last)
        else:
            o = l // 2
            y, yc = odd_mixer(hm, hcm, od_w_in[o], od_w_out[o], od_w_pool[o], od_pool_scale[o],
                              od_rpb[o], not last)
        h = post_norm(h, mod[:, 5] * y, ln_g[l, 1], ln_b[l, 1])

        h = post_norm(h, 0.5 * mod[:, 8] * swiglu(modulate(h, mod[:, 6], mod[:, 7]),
                                                   ffn_w_gate[l, 1], ffn_w_up[l, 1], ffn_w_down[l, 1]),
                      ln_g[l, 2], ln_b[l, 2])
        if not last:
            hc = post_norm(hc, mod_c[5] * yc, ln_g[l, 1], ln_b[l, 1])
            hc = post_norm(hc, 0.5 * mod_c[8] * swiglu(modulate(hc, mod_c[6], mod_c[7]),
                                                        ffn_w_gate[l, 1], ffn_w_up[l, 1], ffn_w_down[l, 1]),
                           ln_g[l, 2], ln_b[l, 2])
    return h
```

```cpp
#include <hip/hip_runtime.h>
#include <hip/hip_cooperative_groups.h>
#include <cstdio>
#include <cstdint>
namespace cg = cooperative_groups;

#ifndef COOP
#define COOP 1
#endif

#define DI __device__ __forceinline__
typedef unsigned short bf16_t;
typedef short bf16x8 __attribute__((ext_vector_type(8)));
typedef short s16x4 __attribute__((ext_vector_type(4)));
typedef __bf16 bfx4 __attribute__((ext_vector_type(4)));
typedef __bf16 bfx2 __attribute__((ext_vector_type(2)));
typedef float f32x2 __attribute__((ext_vector_type(2)));
typedef float f32x4 __attribute__((ext_vector_type(4)));
typedef float f32x16 __attribute__((ext_vector_type(16)));
typedef unsigned u32x2 __attribute__((ext_vector_type(2)));
typedef unsigned u32x4 __attribute__((ext_vector_type(4)));
#define LDS_AS __attribute__((address_space(3)))

constexpr int DM = 1024, NB = 4, SEQ = 8192, CTX = 256, DFF = 2816;
constexpr int RL = NB * SEQ, RC = NB * CTX, RT = RL + RC;
constexpr int NK = SEQ + CTX;
constexpr float ALPHA = 1.41421356237f;
constexpr float LOG2E = 1.4426950408889634f;
constexpr float QA_SCALE = 0.10206207261596575f * LOG2E;
constexpr float QB_SCALE = 0.125f * LOG2E;
constexpr float QD_SCALE = 0.125f * LOG2E;
constexpr int NTHR = 256;

constexpr size_t SZ_WGU = 1024ull * 5632 * 2, SZ_WD = 2816ull * 1024 * 2;
constexpr size_t OFF_WGU = 0;
constexpr size_t OFF_WD = OFF_WGU + 4 * SZ_WGU;
constexpr size_t OFF_EVIN = OFF_WD + 4 * SZ_WD;
constexpr size_t OFF_EVOUT = OFF_EVIN + 1024ull * 2048 * 2;
constexpr size_t OFF_UQ = OFF_EVOUT + 1024ull * 1024 * 2;
constexpr size_t OFF_UKV = OFF_UQ + 256ull * 768 * 2;
constexpr size_t OFF_ODIN = OFF_UKV + 128ull * 1024 * 2;
constexpr size_t OFF_ODOUT = OFF_ODIN + 1024ull * 2048 * 2;
constexpr size_t OFF_POOL = OFF_ODOUT + 1024ull * 1024 * 2;
constexpr size_t OFF_MOD = OFF_POOL + 4ull * 128 * 128 * 2;
constexpr size_t OFF_TAR = OFF_MOD + 2ull * 5 * 9216 * 4;
constexpr size_t OFF_TAC = OFF_TAR + 128 * 8 * 8;
constexpr size_t OFF_TBR = OFF_TAC + 64 * 8 * 8;
constexpr size_t OFF_TBC = OFF_TBR + 128 * 16 * 8;
constexpr size_t OFF_LAM = OFF_TBC + 64 * 16 * 8;
constexpr size_t OFF_X = OFF_LAM + 256;
constexpr size_t OFF_XM = OFF_X + (size_t)RT * 1024 * 4;
constexpr size_t OFF_HID = OFF_XM + (size_t)RT * 1024 * 2;
constexpr size_t WS_NEED = OFF_HID + (size_t)RT * DFF * 2;
constexpr size_t SZ_H96 = (size_t)NB * 8 * NK * 96 * 2, SZ_H64 = (size_t)NB * 8 * NK * 64 * 2;
constexpr size_t HOFF_QA = 0, HOFF_KA = SZ_H96, HOFF_VA = 2 * SZ_H96, HOFF_QB = HOFF_VA + SZ_H64, HOFF_QN = HOFF_QB + SZ_H64;
static_assert(HOFF_QN + (size_t)RT * 256 * 2 <= (size_t)RT * DFF * 2, "HID region overflow");
constexpr size_t HOFF_U = 0, HOFF_PL = SZ_H64, HOFF_QD = 2 * SZ_H64, HOFF_KD = 3 * SZ_H64, HOFF_VD = 4 * SZ_H64;
constexpr size_t OOFF_KB = 0, OOFF_VB = SZ_H64, OOFF_KVN = 2 * SZ_H64;
static_assert(OOFF_KVN + (size_t)RT * 128 * 2 <= (size_t)RL * 1024 * 4, "d_out region overflow");

struct Params {
    const float* in[24];
    float* out;
    char* ws;
};

DI int ltid() { int t = threadIdx.x; asm volatile("" : "+v"(t)); return t; }
DI int lbid() { int t = blockIdx.x; asm volatile("" : "+s"(t)); return t; }
DI unsigned pk2(float a, float b) { f32x2 v = {a, b}; bfx2 r = __builtin_convertvector(v, bfx2); return __builtin_bit_cast(unsigned, r); }
DI float bf2f(unsigned short u) { return __uint_as_float(((unsigned)u) << 16); }
DI float bflo(unsigned u) { return __uint_as_float(u << 16); }
DI float bfhi(unsigned u) { return __uint_as_float(u & 0xffff0000u); }
DI float silu_f(float x) { return x * __builtin_amdgcn_rcpf(1.f + __expf(-x)); }
DI f32x16 mfma32(bf16x8 a, bf16x8 b, f32x16 c) { return __builtin_amdgcn_mfma_f32_32x32x16_bf16(a, b, c, 0, 0, 0); }
DI s16x4 tr_read(const char* p) { bfx4 r = __builtin_amdgcn_ds_read_tr16_b64_v4bf16((LDS_AS bfx4*)p); return __builtin_bit_cast(s16x4, r); }
DI bf16x8 cat8(s16x4 lo, s16x4 hi) { return __builtin_shufflevector(lo, hi, 0, 1, 2, 3, 4, 5, 6, 7); }

struct RowInfo { int b, j, s; bool lat; };
DI RowInfo rowinfo(int row) {
    RowInfo r;
    if (row < RL) { r.b = row >> 13; r.j = row & 8191; r.s = r.b; r.lat = true; }
    else { int rc = row - RL; r.b = rc >> 8; r.j = 8192 + (rc & 255); r.s = 4; r.lat = false; }
    return r;
}
DI void store16(bf16_t* dst32, const f32x16& v, float sc, int hh) {
#pragma unroll
    for (int q4 = 0; q4 < 4; ++q4) {
        u32x2 w; w.x = pk2(v[4 * q4] * sc, v[4 * q4 + 1] * sc); w.y = pk2(v[4 * q4 + 2] * sc, v[4 * q4 + 3] * sc);
        *(u32x2*)(dst32 + 8 * q4 + 4 * hh) = w;
    }
}
DI f32x16 ropeB(const f32x16& v, const f32x2* tab, int hh) {
    f32x16 o;
#pragma unroll
    for (int r = 0; r < 8; ++r) {
        const int i = (r & 3) + 8 * (r >> 2) + 4 * hh;
        const f32x2 cs = tab[i];
        o[r] = v[r] * cs.x - v[r + 8] * cs.y;
        o[r + 8] = v[r + 8] * cs.x + v[r] * cs.y;
    }
    return o;
}
DI f32x16 ropeA(const f32x16& v, const f32x2* tr, const f32x2* tc, int hh) {
    f32x16 o;
#pragma unroll
    for (int r = 0; r < 4; ++r) {
        const int i = 4 * hh + r;
        const f32x2 a = tr[i], c = tc[i];
        o[r] = v[r] * a.x - v[r + 4] * a.y;
        o[r + 4] = v[r + 4] * a.x + v[r] * a.y;
        o[8 + r] = v[8 + r] * c.x - v[12 + r] * c.y;
        o[12 + r] = v[12 + r] * c.x + v[8 + r] * c.y;
    }
    return o;
}

constexpr int GA_S = 144, GB_S = 272;
constexpr int GEMM_LDS = 128 * GA_S + 64 * GB_S;

template <class Epi>
DI void gemm_tile(const bf16_t* __restrict__ A, int lda, const bf16_t* __restrict__ B, int ldb, int K, int row0, int col0, const Epi& epi, char* smem) {
    const int tid = ltid(), lane = tid & 63, wave = tid >> 6, wm = wave >> 1, wn = wave & 1;
    const int l31 = lane & 31, hh = lane >> 5, q = (lane & 15) >> 2, p = lane & 3, nblk = (lane >> 4) & 1;
    char* sA = smem; char* sB = smem + 128 * GA_S;
    f32x16 acc[2][2];
#pragma unroll
    for (int i = 0; i < 2; ++i)
#pragma unroll
        for (int j = 0; j < 2; ++j)
#pragma unroll
            for (int r = 0; r < 16; ++r) acc[i][j][r] = 0.f;
    u32x4 ra[4], rb[4];
    const bf16_t* ag = A + (size_t)(row0 + (tid >> 3)) * lda + (tid & 7) * 8;
    const bf16_t* bg = B + (size_t)(tid >> 4) * ldb + col0 + (tid & 15) * 8;
    const int aw = (tid >> 3) * GA_S + (tid & 7) * 16, bw = (tid >> 4) * GB_S + (tid & 15) * 16;
    const int nk = K >> 6;
#pragma unroll
    for (int i = 0; i < 4; ++i) { ra[i] = *(const u32x4*)(ag + (size_t)(32 * i) * lda); rb[i] = *(const u32x4*)(bg + (size_t)(16 * i) * ldb); }
    const int xoff = (wm * 64 + l31) * GA_S + hh * 16;
    const int woff = (hh * 8 + q) * GB_S + (wn * 64 + nblk * 16 + 4 * p) * 2;
    for (int kt = 0; kt < nk; ++kt) {
        __syncthreads();
#pragma unroll
        for (int i = 0; i < 4; ++i) { *(u32x4*)(sA + aw + 32 * i * GA_S) = ra[i]; *(u32x4*)(sB + bw + 16 * i * GB_S) = rb[i]; }
        __syncthreads();
        if (kt + 1 < nk) {
            const bf16_t* a2 = ag + (size_t)(kt + 1) * 64; const bf16_t* b2 = bg + (size_t)(kt + 1) * 64 * ldb;
#pragma unroll
            for (int i = 0; i < 4; ++i) { ra[i] = *(const u32x4*)(a2 + (size_t)(32 * i) * lda); rb[i] = *(const u32x4*)(b2 + (size_t)(16 * i) * ldb); }
        }
#pragma unroll
        for (int s = 0; s < 4; ++s) {
            bf16x8 xf[2], wf[2];
#pragma unroll
            for (int mi = 0; mi < 2; ++mi) xf[mi] = *(const bf16x8*)(sA + xoff + mi * 32 * GA_S + s * 32);
#pragma unroll
            for (int ni = 0; ni < 2; ++ni) {
                const char* wp = sB + woff + s * 16 * GB_S + ni * 64;
                wf[ni] = cat8(tr_read(wp), tr_read(wp + 4 * GB_S));
            }
#pragma unroll
            for (int mi = 0; mi < 2; ++mi)
#pragma unroll
                for (int ni = 0; ni < 2; ++ni) acc[mi][ni] = mfma32(wf[ni], xf[mi], acc[mi][ni]);
        }
    }
    epi(acc, row0 + wm * 64, col0 + wn * 64, lane);
}

template <class Epi>
DI void gemm_phase(const bf16_t* A, int lda, const bf16_t* B, int ldb, int M, int N, int K, const Epi& epi, char* smem, int blk0 = 0) {
    const int nt = N >> 7, tiles = (M >> 7) * nt;
    int start = (int)lbid() - blk0; if (start < 0) start += gridDim.x;
    for (int t = start; t < tiles; t += gridDim.x) gemm_tile(A, lda, B, ldb, K, (t / nt) * 128, (t % nt) * 128, epi, smem);
}

struct EpiSwiglu {
    bf16_t* hid;
    DI void operator()(const f32x16 (&acc)[2][2], int rbase, int cbase, int lane) const {
        const int l31 = lane & 31, hh = lane >> 5;
#pragma unroll
        for (int mi = 0; mi < 2; ++mi) {
            const int row = rbase + mi * 32 + l31;
            bf16_t* dst = hid + (size_t)row * DFF + (cbase >> 1) + 4 * hh;
#pragma unroll
            for (int q4 = 0; q4 < 4; ++q4) {
                float h[4];
#pragma unroll
                for (int j = 0; j < 4; ++j) h[j] = silu_f(acc[mi][0][4 * q4 + j]) * acc[mi][1][4 * q4 + j];
                u32x2 w; w.x = pk2(h[0], h[1]); w.y = pk2(h[2], h[3]);
                *(u32x2*)(dst + 8 * q4) = w;
            }
        }
    }
};
struct EpiResid {
    const float* res_lat; const float* res_ctx; float* X; const float* gate; float coef;
    DI void operator()(const f32x16 (&acc)[2][2], int rbase, int cbase, int lane) const {
        const int l31 = lane & 31, hh = lane >> 5;
#pragma unroll
        for (int mi = 0; mi < 2; ++mi) {
            const int row = rbase + mi * 32 + l31;
            const int s = row < RL ? (row >> 13) : 4;
            const float* rp = row < RL ? res_lat + (size_t)row * 1024 : res_ctx + (size_t)(row - RL) * 1024;
            const float* gp = gate + s * 9216;
            float* xp = X + (size_t)row * 1024;
#pragma unroll
            for (int ni = 0; ni < 2; ++ni)
#pragma unroll
                for (int q4 = 0; q4 < 4; ++q4) {
                    const int c = cbase + ni * 32 + 8 * q4 + 4 * hh;
                    const f32x4 r = *(const f32x4*)(rp + c), g = *(const f32x4*)(gp + c);
                    f32x4 z;
#pragma unroll
                    for (int j = 0; j < 4; ++j) z[j] = ALPHA * r[j] + coef * g[j] * acc[mi][ni][4 * q4 + j];
                    *(f32x4*)(xp + c) = z;
                }
        }
    }
};
struct EpiEvIn {
    bf16_t *QN, *QB, *KVN, *KA, *KB, *VB; const f32x2 *tAr, *tAc, *tBr, *tBc;
    DI void operator()(const f32x16 (&acc)[2][2], int rbase, int cbase, int lane) const {
        const int l31 = lane & 31, hh = lane >> 5;
#pragma unroll
        for (int mi = 0; mi < 2; ++mi) {
            const int row = rbase + mi * 32 + l31;
            const RowInfo ri = rowinfo(row);
            const int gr = (ri.j >> 6) & 127, gc = ri.j & 63;
#pragma unroll
            for (int ni = 0; ni < 2; ++ni) {
                const int g = (cbase >> 5) + ni;
                const f32x16& v = acc[mi][ni];
                if (g < 8) store16(QN + (size_t)row * 256 + g * 32, v, 1.f, hh);
                else if (g < 24) {
                    const int hv = (g - 8) >> 1, half = (g - 8) & 1;
                    f32x16 w = v; if (ri.lat) w = ropeB(v, half ? tBc + gc * 16 : tBr + gr * 16, hh);
                    store16(QB + ((size_t)(ri.b * 8 + hv) * NK + ri.j) * 64 + half * 32, w, QB_SCALE, hh);
                } else if (g < 28) store16(KVN + (size_t)row * 128 + (g - 24) * 32, v, 1.f, hh);
                else if (g == 28) {
                    f32x16 w = v; if (ri.lat) w = ropeA(v, tAr + gr * 8, tAc + gc * 8, hh);
                    for (int h = 0; h < 8; ++h) store16(KA + ((size_t)(ri.b * 8 + h) * NK + ri.j) * 96 + 64, w, 1.f, hh);
                } else if (g < 45) {
                    const int hv = (g - 29) >> 1, half = (g - 29) & 1;
                    f32x16 w = v; if (ri.lat) w = ropeB(v, half ? tBc + gc * 16 : tBr + gr * 16, hh);
                    store16(KB + ((size_t)(ri.b * 8 + hv) * NK + ri.j) * 64 + half * 32, w, 1.f, hh);
                } else if (g < 61) {
                    const int idx = g - 45, h = idx >> 2, part = idx & 3;
                    store16(VB + ((size_t)(ri.b * 4 + h) * NK + ri.j) * 128 + part * 32, v, 1.f, hh);
                }
            }
        }
    }
};
struct EpiUQ {
    bf16_t* QA; const f32x2 *tAr, *tAc;
    DI void operator()(const f32x16 (&acc)[2][2], int rbase, int cbase, int lane) const {
        const int l31 = lane & 31, hh = lane >> 5;
#pragma unroll
        for (int mi = 0; mi < 2; ++mi) {
            const int row = rbase + mi * 32 + l31;
            const RowInfo ri = rowinfo(row);
            const int gr = (ri.j >> 6) & 127, gc = ri.j & 63;
#pragma unroll
            for (int ni = 0; ni < 2; ++ni) {
                const int g = (cbase >> 5) + ni, h = g / 3, part = g - 3 * h;
                f32x16 w = acc[mi][ni];
                if (part == 2 && ri.lat) w = ropeA(acc[mi][ni], tAr + gr * 8, tAc + gc * 8, hh);
                store16(QA + ((size_t)(ri.b * 8 + h) * NK + ri.j) * 96 + part * 32, w, QA_SCALE, hh);
            }
        }
    }
};
struct EpiUKV {
    bf16_t *KA, *VA;
    DI void operator()(const f32x16 (&acc)[2][2], int rbase, int cbase, int lane) const {
        const int l31 = lane & 31, hh = lane >> 5;
#pragma unroll
        for (int mi = 0; mi < 2; ++mi) {
            const int row = rbase + mi * 32 + l31;
            const RowInfo ri = rowinfo(row);
#pragma unroll
            for (int ni = 0; ni < 2; ++ni) {
                const int g = (cbase >> 5) + ni, h = g >> 2, part = g & 3;
                const size_t tk = (size_t)(ri.b * 8 + h) * NK + ri.j;
                if (part < 2) store16(KA + tk * 96 + part * 32, acc[mi][ni], 1.f, hh);
                else store16(VA + tk * 64 + (part - 2) * 32, acc[mi][ni], 1.f, hh);
            }
        }
    }
};
struct EpiOdIn {
    bf16_t *U, *QD, *KD, *VD;
    DI void operator()(const f32x16 (&acc)[2][2], int rbase, int cbase, int lane) const {
        const int l31 = lane & 31, hh = lane >> 5;
#pragma unroll
        for (int mi = 0; mi < 2; ++mi) {
            const int row = rbase + mi * 32 + l31;
            const RowInfo ri = rowinfo(row);
#pragma unroll
            for (int ni = 0; ni < 2; ++ni) {
                const int g = (cbase >> 5) + ni;
                if (g < 16) store16(U + (size_t)row * 512 + g * 32, acc[mi][ni], 1.f, hh);
                else {
                    const int gg = (g - 16) & 15, h = gg >> 1, half = gg & 1;
                    const size_t off = ((size_t)(ri.b * 8 + h) * NK + ri.j) * 64 + half * 32;
                    if (g < 32) store16(QD + off, acc[mi][ni], QD_SCALE, hh);
                    else if (g < 48) store16(KD + off, acc[mi][ni], 1.f, hh);
                    else store16(VD + off, acc[mi][ni], 1.f, hh);
                }
            }
        }
    }
};
struct EpiPool {
    bf16_t* CC; const float* pscale; int gidx;
    DI void operator()(const f32x16 (&acc)[2][2], int rbase, int cbase, int lane) const {
        const int l31 = lane & 31, hh = lane >> 5;
#pragma unroll
        for (int mi = 0; mi < 2; ++mi) {
            const int row = rbase + mi * 32 + l31;
#pragma unroll
            for (int ni = 0; ni < 2; ++ni)
#pragma unroll
                for (int q4 = 0; q4 < 4; ++q4) {
                    const int c = gidx * 128 + cbase + ni * 32 + 8 * q4 + 4 * hh;
                    const f32x4 s = *(const f32x4*)(pscale + c);
                    u32x2 w; w.x = pk2(acc[mi][ni][4 * q4] * s[0], acc[mi][ni][4 * q4 + 1] * s[1]); w.y = pk2(acc[mi][ni][4 * q4 + 2] * s[2], acc[mi][ni][4 * q4 + 3] * s[3]);
                    *(u32x2*)(CC + (size_t)row * 1024 + c) = w;
                }
        }
    }
};

constexpr int ATT_LDS = 64 * (96 + 8) * 2 + 64 * (128 + 8) * 2;
constexpr int RPB_OFF = ATT_LDS;
constexpr int SMEM_BYTES = GEMM_LDS > (ATT_LDS + 2048) ? GEMM_LDS : (ATT_LDS + 2048);

struct NAInfo { int qr; int kstart; };

template <int DQK, int DV, bool NA>
DI void attend(const bf16_t* __restrict__ Q, int q0, const bf16_t* __restrict__ Kb, const bf16_t* __restrict__ Vb,
               int s0, int n0, int s1, int n1, f32x16 (&o)[DV / 32], char* smem, NAInfo na) {
    constexpr int KS = (DQK + 8) * 2, VS = (DV + 8) * 2;
    constexpr int KCH = DQK / 8, KN = 64 * KCH / NTHR, VCH = DV / 8, VN = 64 * VCH / NTHR;
    constexpr int NS = DQK / 16, NDT = DV / 32;
    const int tid = ltid(), lane = tid & 63, wave = tid >> 6;
    const int l31 = lane & 31, hh = lane >> 5, q = (lane & 15) >> 2, p = lane & 3, dblk = (lane >> 4) & 1;
    char* sK = smem; char* sV = smem + 64 * KS;
    bf16x8 qf[NS];
    {
        const bf16_t* qp = Q + (size_t)(q0 + wave * 32 + l31) * DQK + hh * 8;
#pragma unroll
        for (int s = 0; s < NS; ++s) qf[s] = *(const bf16x8*)(qp + s * 16);
    }
#pragma unroll
    for (int d = 0; d < NDT; ++d)
#pragma unroll
        for (int r = 0; r < 16; ++r) o[d][r] = 0.f;
    float m = -INFINITY, l = 0.f;
    u32x4 rk[KN], rv[VN];
    const int nt = n0 + n1;
    auto gload = [&](int t) {
        const int j0 = t < n0 ? s0 + t * 64 : s1 + (t - n0) * 64;
#pragma unroll
        for (int i = 0; i < KN; ++i) { const int id = tid + NTHR * i, row = id / KCH, ch = id - row * KCH; rk[i] = *(const u32x4*)(Kb + (size_t)(j0 + row) * DQK + ch * 8); }
#pragma unroll
        for (int i = 0; i < VN; ++i) { const int id = tid + NTHR * i, row = id / VCH, ch = id - row * VCH; rv[i] = *(const u32x4*)(Vb + (size_t)(j0 + row) * DV + ch * 8); }
    };
    gload(0);
    int qc = 0, cs = 0, rs = 0;
    if (NA) { qc = (wave & 1) * 32 + l31; cs = min(max(qc - 8, 0), 48); rs = min(max(na.qr - 4, 0), 120); }
    const float* rpb = (const float*)(smem + RPB_OFF);
    for (int t = 0; t < nt; ++t) {
        __syncthreads();
#pragma unroll
        for (int i = 0; i < KN; ++i) { const int id = tid + NTHR * i, row = id / KCH, ch = id - row * KCH; *(u32x4*)(sK + row * KS + ch * 16) = rk[i]; }
#pragma unroll
        for (int i = 0; i < VN; ++i) { const int id = tid + NTHR * i, row = id / VCH, ch = id - row * VCH; *(u32x4*)(sV + row * VS + ch * 16) = rv[i]; }
        __syncthreads();
        if (t + 1 < nt) gload(t + 1);
        bool active = true; int kr = 0;
        if (NA && t < n0) { kr = na.kstart + t; active = (kr >= rs) && (kr < rs + 8); }
        if (active) {
#pragma unroll 1
            for (int sub = 0; sub < 2; ++sub) {
                f32x16 st;
#pragma unroll
                for (int r = 0; r < 16; ++r) st[r] = 0.f;
#pragma unroll
                for (int s = 0; s < NS; ++s) {
                    const bf16x8 kf = *(const bf16x8*)(sK + (sub * 32 + l31) * KS + (s * 16 + hh * 8) * 2);
                    st = mfma32(kf, qf[s], st);
                }
                if (NA && t < n0) {
                    const float* brow = rpb + (kr - na.qr + 7) * 31 + 15 - qc;
#pragma unroll
                    for (int r = 0; r < 16; ++r) {
                        const int kc = sub * 32 + (r & 3) + 8 * (r >> 2) + 4 * hh;
                        const bool valid = (kc >= cs) && (kc < cs + 16);
                        const int bi = valid ? kc : cs;
                        const float bias = brow[bi];
                        st[r] = valid ? st[r] + bias : -INFINITY;
                    }
                }
                float mx = st[0];
#pragma unroll
                for (int r = 1; r < 16; ++r) mx = fmaxf(mx, st[r]);
                mx = fmaxf(mx, __shfl_xor(mx, 32));
                const float mnew = fmaxf(m, mx);
                const float muse = (mnew == -INFINITY) ? 0.f : mnew;
                const float alpha = __builtin_amdgcn_exp2f(m - muse);
                m = mnew;
                float rsum = 0.f;
#pragma unroll
                for (int r = 0; r < 16; ++r) { st[r] = __builtin_amdgcn_exp2f(st[r] - muse); rsum += st[r]; }
                l = l * alpha + rsum;
#pragma unroll
                for (int d = 0; d < NDT; ++d)
#pragma unroll
                    for (int r = 0; r < 16; ++r) o[d][r] *= alpha;
                bf16x8 pf[2];
#pragma unroll
                for (int s2 = 0; s2 < 2; ++s2) {
                    u32x4 w;
                    w.x = pk2(st[8 * s2], st[8 * s2 + 1]); w.y = pk2(st[8 * s2 + 2], st[8 * s2 + 3]);
                    w.z = pk2(st[8 * s2 + 4], st[8 * s2 + 5]); w.w = pk2(st[8 * s2 + 6], st[8 * s2 + 7]);
                    pf[s2] = __builtin_bit_cast(bf16x8, w);
                }
#pragma unroll
                for (int d = 0; d < NDT; ++d)
#pragma unroll
                    for (int s2 = 0; s2 < 2; ++s2) {
                        const char* vp = sV + (sub * 32 + 16 * s2 + 4 * hh + q) * VS + (d * 32 + dblk * 16 + 4 * p) * 2;
                        const bf16x8 vf = cat8(tr_read(vp), tr_read(vp + 8 * VS));
                        o[d] = mfma32(vf, pf[s2], o[d]);
                    }
            }
        }
    }
    l += __shfl_xor(l, 32);
    const float inv = 1.f / l;
#pragma unroll
    for (int d = 0; d < NDT; ++d)
#pragma unroll
        for (int r = 0; r < 16; ++r) o[d][r] *= inv;
}

DI int qrow_of(int b, int j) { return j < SEQ ? b * SEQ + j : RL + b * CTX + (j - SEQ); }

DI void even_attention_phase(const Params& P, char* smem) {
    char* ws = P.ws; char* hid = ws + OFF_HID; char* ob = (char*)P.out;
    const bf16_t* QA = (const bf16_t*)(hid + HOFF_QA); const bf16_t* KA = (const bf16_t*)(hid + HOFF_KA); const bf16_t* VA = (const bf16_t*)(hid + HOFF_VA);
    const bf16_t* QB = (const bf16_t*)(hid + HOFF_QB); const bf16_t* KB = (const bf16_t*)(ob + OOFF_KB); const bf16_t* VB = (const bf16_t*)(ob + OOFF_VB);
    bf16_t* CC = (bf16_t*)(ws + OFF_XM);
    const float lam = *(const float*)(ws + OFF_LAM);
    const float* gsub = P.in[18];
    const int lane = ltid() & 63, wave = ltid() >> 6, l31 = lane & 31, hh = lane >> 5;
    constexpr int NQT = 66, NDIFF = NB * 4 * NQT, NMLA = NB * 8 * NQT;
    NAInfo na; na.qr = 0; na.kstart = 0;
    for (int u = lbid(); u < NDIFF + NMLA; u += gridDim.x) {
        if (u < NDIFF) {
            const int qt = u % NQT, bh = u / NQT, h = bh & 3, b = bh >> 2;
            const int q0 = qt < 64 ? qt * 128 : SEQ + (qt - 64) * 128;
            const int s0 = qt < 64 ? 0 : SEQ, n0 = qt < 64 ? NK / 64 : CTX / 64;
            const bf16_t* V = VB + (size_t)(b * 4 + h) * NK * 128;
            f32x16 o[4];
            attend<64, 128, false>(QB + (size_t)(b * 8 + 2 * h) * NK * 64, q0, KB + (size_t)(b * 8 + 2 * h) * NK * 64, V, s0, n0, 0, 0, o, smem, na);
            const int row = qrow_of(b, q0 + wave * 32 + l31);
            bf16_t* dst = CC + (size_t)row * 1024 + 512 + h * 128;
#pragma unroll
            for (int d = 0; d < 4; ++d) store16(dst + d * 32, o[d], 1.f, hh);
            f32x16 o2[4];
            attend<64, 128, false>(QB + (size_t)(b * 8 + 2 * h + 1) * NK * 64, q0, KB + (size_t)(b * 8 + 2 * h + 1) * NK * 64, V, s0, n0, 0, 0, o2, smem, na);
            float ss = 0.f;
#pragma unroll
            for (int d = 0; d < 4; ++d)
#pragma unroll
                for (int q4 = 0; q4 < 4; ++q4) {
                    const u32x2 w = *(const volatile u32x2*)(dst + d * 32 + 8 * q4 + 4 * hh);
                    const float a0 = bflo(w.x) - lam * o2[d][4 * q4], a1 = bfhi(w.x) - lam * o2[d][4 * q4 + 1], a2 = bflo(w.y) - lam * o2[d][4 * q4 + 2], a3 = bfhi(w.y) - lam * o2[d][4 * q4 + 3];
                    o[d][4 * q4] = a0; o[d][4 * q4 + 1] = a1; o[d][4 * q4 + 2] = a2; o[d][4 * q4 + 3] = a3;
                    ss += (a0 * a0 + a1 * a1) + (a2 * a2 + a3 * a3);
                }
            ss += __shfl_xor(ss, 32);
            const float rn = rsqrtf(ss * (1.f / 128.f) + 1e-5f) * 0.8f;
#pragma unroll
            for (int d = 0; d < 4; ++d)
#pragma unroll
                for (int q4 = 0; q4 < 4; ++q4) {
                    const int c = d * 32 + 8 * q4 + 4 * hh;
                    const f32x4 g = *(const f32x4*)(gsub + c);
                    u32x2 w; w.x = pk2(o[d][4 * q4] * rn * g[0], o[d][4 * q4 + 1] * rn * g[1]); w.y = pk2(o[d][4 * q4 + 2] * rn * g[2], o[d][4 * q4 + 3] * rn * g[3]);
                    *(u32x2*)(dst + c) = w;
                }
        } else {
            const int v = u - NDIFF, qt = v % NQT, bh = v / NQT, h = bh & 7, b = bh >> 3;
            const int q0 = qt < 64 ? qt * 128 : SEQ + (qt - 64) * 128;
            const int s0 = qt < 64 ? 0 : SEQ, n0 = qt < 64 ? NK / 64 : CTX / 64;
            f32x16 o[2];
            attend<96, 64, false>(QA + (size_t)(b * 8 + h) * NK * 96, q0, KA + (size_t)(b * 8 + h) * NK * 96, VA + (size_t)(b * 8 + h) * NK * 64, s0, n0, 0, 0, o, smem, na);
            const int row = qrow_of(b, q0 + wave * 32 + l31);
            bf16_t* dst = CC + (size_t)row * 1024 + h * 64;
#pragma unroll
            for (int d = 0; d < 2; ++d) store16(dst + d * 32, o[d], 1.f, hh);
        }
    }
}

DI void odd_attention_phase(const Params& P, char* smem) {
    char* ws = P.ws; char* hid = ws + OFF_HID;
    const bf16_t* QD = (const bf16_t*)(hid + HOFF_QD); const bf16_t* KD = (const bf16_t*)(hid + HOFF_KD); const bf16_t* VD = (const bf16_t*)(hid + HOFF_VD);
    bf16_t* CC = (bf16_t*)(ws + OFF_XM);
    const float* rpbg = P.in[23];
    const int lane = ltid() & 63, wave = ltid() >> 6, l31 = lane & 31, hh = lane >> 5;
    float* rpbl = (float*)(smem + RPB_OFF);
    constexpr int NU = NB * 8 * 64;
    for (int u = lbid(); u < NU; u += gridDim.x) {
        const int rp = u & 63, bh = u >> 6, h = bh & 7, b = bh >> 3;
        __syncthreads();
        for (int i = ltid(); i < 465; i += NTHR) rpbl[i] = rpbg[h * 465 + i] * LOG2E;
        const int r0 = rp * 2;
        NAInfo na; na.qr = r0 + (wave >> 1);
        const int rs0 = min(max(r0 - 4, 0), 120);
        na.kstart = min(rs0, 119);
        f32x16 o[2];
        const size_t hb = (size_t)(b * 8 + h) * NK * 64;
        attend<64, 64, true>(QD + hb, r0 * 64, KD + hb, VD + hb, na.kstart * 64, 9, SEQ, CTX / 64, o, smem, na);
        const int row = b * SEQ + r0 * 64 + wave * 32 + l31;
        bf16_t* dst = CC + (size_t)row * 1024 + 512 + h * 64;
#pragma unroll
        for (int d = 0; d < 2; ++d) store16(dst + d * 32, o[d], 1.f, hh);
    }
}

DI void cvt8(bf16_t* dst, const float* src, float sc) {
    const f32x4 a = *(const f32x4*)src, b = *(const f32x4*)(src + 4);
    u32x4 w; w.x = pk2(a[0] * sc, a[1] * sc); w.y = pk2(a[2] * sc, a[3] * sc); w.z = pk2(b[0] * sc, b[1] * sc); w.w = pk2(b[2] * sc, b[3] * sc);
    *(u32x4*)dst = w;
}
DI void cvt_rows(bf16_t* dst, int ldd, const float* src, int lds_, int rows, int cols_src, const float* rowscale, size_t gtid, size_t gstride) {
    const int c8 = ldd >> 3; const size_t n = (size_t)rows * c8;
    for (size_t i = gtid; i < n; i += gstride) {
        const int k = (int)(i / c8), c = (int)(i % c8) * 8;
        if (c < cols_src) cvt8(dst + (size_t)k * ldd + c, src + (size_t)k * lds_ + c, rowscale ? rowscale[k] : 1.f);
        else { u32x4 z = {0u, 0u, 0u, 0u}; *(u32x4*)(dst + (size_t)k * ldd + c) = z; }
    }
}

DI void phase_pro_a(const Params& P, char* smem) {
    char* ws = P.ws;
    const size_t gtid = (size_t)lbid() * NTHR + ltid(), gstride = (size_t)gridDim.x * NTHR;
    for (int lf = 0; lf < 4; ++lf) {
        const float* sg = P.in[8] + (size_t)lf * 1024 * DFF; const float* su = P.in[9] + (size_t)lf * 1024 * DFF;
        bf16_t* dst = (bf16_t*)(ws + OFF_WGU + lf * SZ_WGU);
        for (size_t i = gtid; i < 1024ull * 704; i += gstride) {
            const int k = (int)(i / 704), n = (int)(i % 704) * 8, grp = n >> 6, w = n & 63;
            const float* src = ((w < 32) ? sg : su) + (size_t)k * DFF + grp * 32 + (w & 31);
            cvt8(dst + (size_t)k * 5632 + n, src, 1.f);
        }
        cvt_rows((bf16_t*)(ws + OFF_WD + lf * SZ_WD), 1024, P.in[10] + (size_t)lf * DFF * 1024, 1024, DFF, 1024, nullptr, gtid, gstride);
    }
    cvt_rows((bf16_t*)(ws + OFF_EVIN), 2048, P.in[11], 1952, 1024, 1952, nullptr, gtid, gstride);
    cvt_rows((bf16_t*)(ws + OFF_EVOUT), 1024, P.in[12], 1024, 1024, 1024, nullptr, gtid, gstride);
    cvt_rows((bf16_t*)(ws + OFF_UQ), 768, P.in[15], 768, 256, 768, P.in[13], gtid, gstride);
    cvt_rows((bf16_t*)(ws + OFF_UKV), 1024, P.in[16], 1024, 128, 1024, P.in[14], gtid, gstride);
    cvt_rows((bf16_t*)(ws + OFF_ODIN), 2048, P.in[19], 2048, 1024, 2048, nullptr, gtid, gstride);
    cvt_rows((bf16_t*)(ws + OFF_ODOUT), 1024, P.in[20], 1024, 1024, 1024, nullptr, gtid, gstride);
    cvt_rows((bf16_t*)(ws + OFF_POOL), 128, P.in[21], 128, 512, 128, nullptr, gtid, gstride);
    if (gtid < 128 * 8) { const int r = (int)gtid >> 3, i = (int)gtid & 7; const float inv = exp2f(-(float)i * (13.287712379549449f / 8.f)); float rev = (float)r * inv * 0.15915494309189535f; rev -= floorf(rev);
        f32x2 v = {__builtin_amdgcn_cosf(rev), __builtin_amdgcn_sinf(rev)}; ((f32x2*)(ws + OFF_TAR))[gtid] = v; if (r < 64) ((f32x2*)(ws + OFF_TAC))[gtid] = v; }
    if (gtid < 128 * 16) { const int r = (int)gtid >> 4, i = (int)gtid & 15; const float inv = exp2f(-(float)i * (13.287712379549449f / 16.f)); float rev = (float)r * inv * 0.15915494309189535f; rev -= floorf(rev);
        f32x2 v = {__builtin_amdgcn_cosf(rev), __builtin_amdgcn_sinf(rev)}; ((f32x2*)(ws + OFF_TBR))[gtid] = v; if (r < 64) ((f32x2*)(ws + OFF_TBC))[gtid] = v; }
    if (gtid == 0) {
        const float* lv = P.in[17]; float a = 0.f, b = 0.f;
        for (int i = 0; i < 64; ++i) { a += lv[i] * lv[64 + i]; b += lv[128 + i] * lv[192 + i]; }
        *(float*)(ws + OFF_LAM) = expf(a) - expf(b) + 0.2f;
    }
    float* sc = (float*)smem;
    float* red = sc + 5 * 1024;
    const int tid = ltid(), jj = tid & 63, ig = tid >> 6;
    for (int u = lbid(); u < 288; u += gridDim.x) {
        const int l = u / 144, j0 = (u % 144) * 64;
        __syncthreads();
        for (int i = tid; i < 5 * 1024; i += NTHR) { const float v = i < 4096 ? P.in[1][i] : P.in[3][i - 4096]; sc[i] = v / (1.f + expf(-v)); }
        __syncthreads();
        float a[5] = {0.f, 0.f, 0.f, 0.f, 0.f};
        const float* w = P.in[4] + (size_t)l * 1024 * 9216 + j0 + jj;
        for (int i = ig * 256; i < ig * 256 + 256; ++i) {
            const float wv = w[(size_t)i * 9216];
#pragma unroll
            for (int s = 0; s < 5; ++s) a[s] += sc[s * 1024 + i] * wv;
        }
#pragma unroll
        for (int s = 0; s < 5; ++s) red[(ig * 5 + s) * 64 + jj] = a[s];
        __syncthreads();
        for (int o = tid; o < 320; o += NTHR) {
            const int s = o >> 6, j = o & 63;
            const float v = red[(0 * 5 + s) * 64 + j] + red[(1 * 5 + s) * 64 + j] + red[(2 * 5 + s) * 64 + j] + red[(3 * 5 + s) * 64 + j] + P.in[5][l * 9216 + j0 + j];
            ((float*)(ws + OFF_MOD))[(size_t)(l * 5 + s) * 9216 + j0 + j] = v;
        }
    }
}

DI void phase_pro_b(const Params& P) {
    char* ws = P.ws; bf16_t* XM = (bf16_t*)(ws + OFF_XM); const float* MOD = (const float*)(ws + OFF_MOD);
    const size_t gtid = (size_t)lbid() * NTHR + ltid(), gstride = (size_t)gridDim.x * NTHR;
    for (size_t i = gtid; i < (size_t)RT * 128; i += gstride) {
        const int row = (int)(i >> 7), c = (int)(i & 127) * 8;
        const float* src = row < RL ? P.in[0] + (size_t)row * 1024 + c : P.in[2] + (size_t)(row - RL) * 1024 + c;
        const int s = row < RL ? (row >> 13) : 4;
        const float* sh = MOD + (size_t)s * 9216 + c; const float* scl = sh + 1024;
        unsigned w[4];
#pragma unroll
        for (int hf = 0; hf < 2; ++hf) {
            const f32x4 x = *(const f32x4*)(src + 4 * hf), a = *(const f32x4*)(sh + 4 * hf), g = *(const f32x4*)(scl + 4 * hf);
            w[2 * hf] = pk2(x[0] * (1.f + g[0]) + a[0], x[1] * (1.f + g[1]) + a[1]);
            w[2 * hf + 1] = pk2(x[2] * (1.f + g[2]) + a[2], x[3] * (1.f + g[3]) + a[3]);
        }
        u32x4 o = {w[0], w[1], w[2], w[3]};
        *(u32x4*)(XM + (size_t)row * 1024 + c) = o;
    }
}

DI void phase_ln(const Params& P, int l, int which, int lnext, int mshift, bool final_) {
    char* ws = P.ws; float* X = (float*)(ws + OFF_X); bf16_t* XM = (bf16_t*)(ws + OFF_XM); const float* MOD = (const float*)(ws + OFF_MOD);
    const float* g = P.in[6] + (l * 3 + which) * 1024; const float* bb = P.in[7] + (l * 3 + which) * 1024;
    const int lane = ltid() & 63, wave = ltid() >> 6;
    const int nrows = final_ ? RL : RT;
    for (int row = lbid() * 4 + wave; row < nrows; row += gridDim.x * 4) {
        float* xp = X + (size_t)row * 1024;
        f32x4 v[4]; float s = 0.f;
#pragma unroll
        for (int i = 0; i < 4; ++i) { v[i] = *(const f32x4*)(xp + (i * 64 + lane) * 4); s += (v[i][0] + v[i][1]) + (v[i][2] + v[i][3]); }
#pragma unroll
        for (int o = 32; o >= 1; o >>= 1) s += __shfl_xor(s, o);
        const float mu = s * (1.f / 1024.f);
        float qv = 0.f;
#pragma unroll
        for (int i = 0; i < 4; ++i)
#pragma unroll
            for (int j = 0; j < 4; ++j) { const float d = v[i][j] - mu; qv += d * d; }
#pragma unroll
        for (int o = 32; o >= 1; o >>= 1) qv += __shfl_xor(qv, o);
        const float rstd = rsqrtf(qv * (1.f / 1024.f) + 1e-6f);
        const int sidx = row < RL ? (row >> 13) : 4;
        const float* sh = MOD + (size_t)(lnext * 5 + sidx) * 9216 + mshift * 1024; const float* scl = sh + 1024;
#pragma unroll
        for (int i = 0; i < 4; ++i) {
            const int c = (i * 64 + lane) * 4;
            const f32x4 gg = *(const f32x4*)(g + c), b4 = *(const f32x4*)(bb + c);
            f32x4 y;
#pragma unroll
            for (int j = 0; j < 4; ++j) y[j] = (v[i][j] - mu) * rstd * gg[j] + b4[j];
            if (final_) { *(f32x4*)(P.out + (size_t)row * 1024 + c) = y; }
            else {
                *(f32x4*)(xp + c) = y;
                const f32x4 a = *(const f32x4*)(sh + c), sg = *(const f32x4*)(scl + c);
                u32x2 w; w.x = pk2(y[0] * (1.f + sg[0]) + a[0], y[1] * (1.f + sg[1]) + a[1]); w.y = pk2(y[2] * (1.f + sg[2]) + a[2], y[3] * (1.f + sg[3]) + a[3]);
                *(u32x2*)(XM + (size_t)row * 1024 + c) = w;
            }
        }
    }
}

DI void phase_ev_rms(const Params& P) {
    char* ws = P.ws; bf16_t* QN = (bf16_t*)(ws + OFF_HID + HOFF_QN); bf16_t* KVN = (bf16_t*)((char*)P.out + OOFF_KVN);
    const int lane = ltid() & 63, wave = ltid() >> 6;
    for (int row = lbid() * 4 + wave; row < RT; row += gridDim.x * 4) {
        {
            u32x2* p = (u32x2*)(QN + (size_t)row * 256 + lane * 4); const u32x2 w = *p;
            float a = bflo(w.x), b = bfhi(w.x), c = bflo(w.y), d = bfhi(w.y);
            float s = a * a + b * b + c * c + d * d;
#pragma unroll
            for (int o = 32; o >= 1; o >>= 1) s += __shfl_xor(s, o);
            const float r = rsqrtf(s * (1.f / 256.f) + 1e-6f);
            u32x2 o2; o2.x = pk2(a * r, b * r); o2.y = pk2(c * r, d * r); *p = o2;
        }
        {
            unsigned* p = (unsigned*)(KVN + (size_t)row * 128 + lane * 2); const unsigned w = *p;
            float a = bflo(w), b = bfhi(w);
            float s = a * a + b * b;
#pragma unroll
            for (int o = 32; o >= 1; o >>= 1) s += __shfl_xor(s, o);
            const float r = rsqrtf(s * (1.f / 128.f) + 1e-6f);
            *p = pk2(a * r, b * r);
        }
    }
}

DI void phase_od_pool(const Params& P) {
    char* ws = P.ws; const bf16_t* U = (const bf16_t*)(ws + OFF_HID + HOFF_U); bf16_t* PL = (bf16_t*)(ws + OFF_HID + HOFF_PL);
    const size_t gtid = (size_t)lbid() * NTHR + ltid(), gstride = (size_t)gridDim.x * NTHR;
    for (size_t i = gtid; i < (size_t)RT * 64; i += gstride) {
        const int row = (int)(i >> 6), c = (int)(i & 63) * 8, grp = c >> 7;
        const int w = 2 << grp, left = w >> 1, right = w - 1 - left;
        int base, n, t;
        if (row < RL) { base = row & ~8191; n = SEQ; t = row & 8191; } else { const int rc = row - RL; base = RL + (rc & ~255); n = CTX; t = rc & 255; }
        const int lo = max(t - left, 0), hi = min(t + right + 1, n);
        float acc[8] = {0.f, 0.f, 0.f, 0.f, 0.f, 0.f, 0.f, 0.f};
        for (int tt = lo; tt < hi; ++tt) {
            const u32x4 v = *(const u32x4*)(U + (size_t)(base + tt) * 512 + c);
            acc[0] += bflo(v.x); acc[1] += bfhi(v.x); acc[2] += bflo(v.y); acc[3] += bfhi(v.y); acc[4] += bflo(v.z); acc[5] += bfhi(v.z); acc[6] += bflo(v.w); acc[7] += bfhi(v.w);
        }
        const float ic = 1.f / (float)(hi - lo);
        const u32x4 s = *(const u32x4*)(U + (size_t)row * 512 + c);
        u32x4 o;
        o.x = pk2(acc[0] * ic - bflo(s.x), acc[1] * ic - bfhi(s.x)); o.y = pk2(acc[2] * ic - bflo(s.y), acc[3] * ic - bfhi(s.y));
        o.z = pk2(acc[4] * ic - bflo(s.z), acc[5] * ic - bfhi(s.z)); o.w = pk2(acc[6] * ic - bflo(s.w), acc[7] * ic - bfhi(s.w));
        *(u32x4*)(PL + (size_t)row * 512 + c) = o;
    }
}

constexpr int NPHASE = 25;

DI void run_phase(const Params& P, int ph, char* smem) {
    char* ws = P.ws; char* hid = ws + OFF_HID; char* ob = (char*)P.out;
    float* X = (float*)(ws + OFF_X); bf16_t* XM = (bf16_t*)(ws + OFF_XM); bf16_t* HID = (bf16_t*)hid;
    const float* MOD = (const float*)(ws + OFF_MOD);
    if (ph == 0) { phase_pro_a(P, smem); return; }
    if (ph == 1) { phase_pro_b(P); return; }
    int l, op;
    if (ph < 14) { l = 0; op = ph - 2; } else { l = 1; op = ph - 14; if (op >= 6) op += 1; }
    const float* modl = MOD + (size_t)l * 5 * 9216;
    switch (op) {
    case 0: case 9: {
        const int f = op == 0 ? 0 : 1;
        EpiSwiglu e{HID};
        gemm_phase(XM, 1024, (const bf16_t*)(ws + OFF_WGU + (l * 2 + f) * SZ_WGU), 5632, RT, 5632, 1024, e, smem);
    } break;
    case 1: case 10: {
        const int f = op == 1 ? 0 : 1;
        const bool first = (l == 0 && f == 0);
        EpiResid e{first ? P.in[0] : X, first ? P.in[2] : X + (size_t)RL * 1024, X, modl + (f == 0 ? 2 : 8) * 1024, 0.5f};
        gemm_phase(HID, DFF, (const bf16_t*)(ws + OFF_WD + (l * 2 + f) * SZ_WD), 1024, RT, 1024, DFF, e, smem);
    } break;
    case 2: phase_ln(P, l, 0, l, 3, false); break;
    case 3: {
        if (l == 0) {
            EpiEvIn e{(bf16_t*)(hid + HOFF_QN), (bf16_t*)(hid + HOFF_QB), (bf16_t*)(ob + OOFF_KVN), (bf16_t*)(hid + HOFF_KA), (bf16_t*)(ob + OOFF_KB), (bf16_t*)(ob + OOFF_VB),
                      (const f32x2*)(ws + OFF_TAR), (const f32x2*)(ws + OFF_TAC), (const f32x2*)(ws + OFF_TBR), (const f32x2*)(ws + OFF_TBC)};
            gemm_phase(XM, 1024, (const bf16_t*)(ws + OFF_EVIN), 2048, RT, 2048, 1024, e, smem);
        } else {
            EpiOdIn e{(bf16_t*)(hid + HOFF_U), (bf16_t*)(hid + HOFF_QD), (bf16_t*)(hid + HOFF_KD), (bf16_t*)(hid + HOFF_VD)};
            gemm_phase(XM, 1024, (const bf16_t*)(ws + OFF_ODIN), 2048, RT, 2048, 1024, e, smem);
        }
    } break;
    case 4: if (l == 0) phase_ev_rms(P); else phase_od_pool(P); break;
    case 5: {
        if (l == 0) {
            EpiUQ e1{(bf16_t*)(hid + HOFF_QA), (const f32x2*)(ws + OFF_TAR), (const f32x2*)(ws + OFF_TAC)};
            gemm_phase((const bf16_t*)(hid + HOFF_QN), 256, (const bf16_t*)(ws + OFF_UQ), 768, RT, 768, 256, e1, smem);
            EpiUKV e2{(bf16_t*)(hid + HOFF_KA), (bf16_t*)(hid + HOFF_VA)};
            gemm_phase((const bf16_t*)(ob + OOFF_KVN), 128, (const bf16_t*)(ws + OFF_UKV), 1024, RT, 1024, 128, e2, smem);
        } else {
            odd_attention_phase(P, smem);
            for (int g = 0; g < 4; ++g) {
                EpiPool e{XM, P.in[22], g};
                gemm_phase((const bf16_t*)(hid + HOFF_PL) + g * 128, 512, (const bf16_t*)(ws + OFF_POOL) + g * 128 * 128, 128, RT, 128, 128, e, smem);
            }
        }
    } break;
    case 6: even_attention_phase(P, smem); break;
    case 7: {
        EpiResid e{X, X + (size_t)RL * 1024, X, modl + 5 * 1024, 1.f};
        gemm_phase(XM, 1024, (const bf16_t*)(ws + (l == 0 ? OFF_EVOUT : OFF_ODOUT)), 1024, RT, 1024, 1024, e, smem);
    } break;
    case 8: phase_ln(P, l, 1, l, 6, false); break;
    case 11: if (l == 0) phase_ln(P, 0, 2, 1, 0, false); else phase_ln(P, 1, 2, 1, 0, true); break;
    default: break;
    }
}

__global__ void __launch_bounds__(NTHR, 2) mega(Params P, int ph_lo, int ph_hi) {
    __shared__ __attribute__((aligned(16))) char smem[SMEM_BYTES];
    for (int ph = ph_lo; ph < ph_hi; ++ph) {
        run_phase(P, ph, smem);
        if (ph + 1 < ph_hi) cg::this_grid().sync();
    }
}

extern "C" void kernel_launch(void* const* d_in, const int* in_sizes, int n_in, void* d_out, int out_size, void* d_ws, size_t ws_size, hipStream_t stream) {
    if (ws_size < WS_NEED) { fprintf(stderr, "workspace too small: %zu < %zu\n", ws_size, (size_t)WS_NEED); return; }
    Params P{};
    for (int i = 0; i < 24; ++i) P.in[i] = (const float*)d_in[i];
    P.out = (float*)d_out; P.ws = (char*)d_ws;
    static int grid_blocks = 0;
    if (!grid_blocks) {
        int dev = 0, cus = 0, per_cu = 0;
        hipGetDevice(&dev);
        hipDeviceGetAttribute(&cus, hipDeviceAttributeMultiprocessorCount, dev);
        hipOccupancyMaxActiveBlocksPerMultiprocessor(&per_cu, mega, NTHR, 0);
        if (per_cu < 1) per_cu = 1;
        if (per_cu > 2) per_cu = 2;
        grid_blocks = cus * per_cu;
    }
#if COOP
    int lo = 0, hi = NPHASE;
    void* args[] = {&P, &lo, &hi};
    hipError_t e = hipLaunchCooperativeKernel((void*)mega, dim3(grid_blocks), dim3(NTHR), args, 0, stream);
    if (e != hipSuccess) fprintf(stderr, "cooperative launch failed: %s (grid %d)\n", hipGetErrorString(e), grid_blocks);
#else
    for (int ph = 0; ph < NPHASE; ++ph) mega<<<grid_blocks, NTHR, 0, stream>>>(P, ph, ph + 1);
#endif
}
```

```cpp
#include <hip/hip_runtime.h>
#include <hip/hip_cooperative_groups.h>
#include <cstdio>
#include <cstdint>
namespace cg = cooperative_groups;

#ifndef COOP
#define COOP 1
#endif

#define DI __device__ __forceinline__
typedef unsigned short bf16_t;
typedef short bf16x8 __attribute__((ext_vector_type(8)));
typedef short s16x4 __attribute__((ext_vector_type(4)));
typedef __bf16 bfx4 __attribute__((ext_vector_type(4)));
typedef __bf16 bfx2 __attribute__((ext_vector_type(2)));
typedef float f32x2 __attribute__((ext_vector_type(2)));
typedef float f32x4 __attribute__((ext_vector_type(4)));
typedef float f32x16 __attribute__((ext_vector_type(16)));
typedef unsigned u32x2 __attribute__((ext_vector_type(2)));
typedef unsigned u32x4 __attribute__((ext_vector_type(4)));
#define LDS_AS __attribute__((address_space(3)))

constexpr int DM = 1024, NB = 4, SEQ = 8192, CTX = 256, DFF = 2816;
constexpr int RL = NB * SEQ, RC = NB * CTX, RT = RL + RC;
constexpr int NK = SEQ + CTX;
constexpr float ALPHA = 1.41421356237f;
constexpr float LOG2E = 1.4426950408889634f;
constexpr float QA_SCALE = 0.10206207261596575f * LOG2E;
constexpr float QB_SCALE = 0.125f * LOG2E;
constexpr float QD_SCALE = 0.125f * LOG2E;
constexpr int NTHR = 256;

constexpr size_t SZ_WGU = 1024ull * 5632 * 2, SZ_WD = 2816ull * 1024 * 2;
constexpr size_t OFF_WGU = 0;
constexpr size_t OFF_WD = OFF_WGU + 4 * SZ_WGU;
constexpr size_t OFF_EVIN = OFF_WD + 4 * SZ_WD;
constexpr size_t OFF_EVOUT = OFF_EVIN + 1024ull * 2048 * 2;
constexpr size_t OFF_UQ = OFF_EVOUT + 1024ull * 1024 * 2;
constexpr size_t OFF_UKV = OFF_UQ + 256ull * 768 * 2;
constexpr size_t OFF_ODIN = OFF_UKV + 128ull * 1024 * 2;
constexpr size_t OFF_ODOUT = OFF_ODIN + 1024ull * 2048 * 2;
constexpr size_t OFF_POOL = OFF_ODOUT + 1024ull * 1024 * 2;
constexpr size_t OFF_MOD = OFF_POOL + 4ull * 128 * 128 * 2;
constexpr size_t OFF_TAR = OFF_MOD + 2ull * 5 * 9216 * 4;
constexpr size_t OFF_TAC = OFF_TAR + 128 * 8 * 8;
constexpr size_t OFF_TBR = OFF_TAC + 64 * 8 * 8;
constexpr size_t OFF_TBC = OFF_TBR + 128 * 16 * 8;
constexpr size_t OFF_LAM = OFF_TBC + 64 * 16 * 8;
constexpr size_t OFF_BAR = OFF_LAM + 256;
constexpr size_t OFF_X = OFF_BAR + 256;
constexpr size_t OFF_XM = OFF_X + (size_t)RT * 1024 * 4;
constexpr size_t OFF_HID = OFF_XM + (size_t)RT * 1024 * 2;
constexpr size_t WS_NEED = OFF_HID + (size_t)RT * DFF * 2;
constexpr size_t SZ_H96 = (size_t)NB * 8 * NK * 96 * 2, SZ_H64 = (size_t)NB * 8 * NK * 64 * 2;
constexpr size_t HOFF_QA = 0, HOFF_KA = SZ_H96, HOFF_VA = 2 * SZ_H96, HOFF_QB = HOFF_VA + SZ_H64, HOFF_QN = HOFF_QB + SZ_H64;
static_assert(HOFF_QN + (size_t)RT * 256 * 2 <= (size_t)RT * DFF * 2, "HID region overflow");
constexpr size_t HOFF_U = 0, HOFF_PL = SZ_H64, HOFF_QD = 2 * SZ_H64, HOFF_KD = 3 * SZ_H64, HOFF_VD = 4 * SZ_H64;
constexpr size_t OOFF_KB = 0, OOFF_VB = SZ_H64, OOFF_KVN = 2 * SZ_H64;
static_assert(OOFF_KVN + (size_t)RT * 128 * 2 <= (size_t)RL * 1024 * 4, "d_out region overflow");

struct Params {
    const float* in[24];
    float* out;
    char* ws;
};

DI int ltid() { int t = threadIdx.x; asm volatile("" : "+v"(t)); return t; }
DI int lbid() { int t = blockIdx.x; asm volatile("" : "+s"(t)); return t; }
DI unsigned pk2(float a, float b) { f32x2 v = {a, b}; bfx2 r = __builtin_convertvector(v, bfx2); return __builtin_bit_cast(unsigned, r); }
DI float bf2f(unsigned short u) { return __uint_as_float(((unsigned)u) << 16); }
DI float bflo(unsigned u) { return __uint_as_float(u << 16); }
DI float bfhi(unsigned u) { return __uint_as_float(u & 0xffff0000u); }
DI float silu_f(float x) { return x * __builtin_amdgcn_rcpf(1.f + __expf(-x)); }
DI f32x16 mfma32(bf16x8 a, bf16x8 b, f32x16 c) { return __builtin_amdgcn_mfma_f32_32x32x16_bf16(a, b, c, 0, 0, 0); }
DI s16x4 tr_read(const char* p) { bfx4 r = __builtin_amdgcn_ds_read_tr16_b64_v4bf16((LDS_AS bfx4*)p); return __builtin_bit_cast(s16x4, r); }
DI bf16x8 cat8(s16x4 lo, s16x4 hi) { return __builtin_shufflevector(lo, hi, 0, 1, 2, 3, 4, 5, 6, 7); }

struct RowInfo { int b, j, s; bool lat; };
DI RowInfo rowinfo(int row) {
    RowInfo r;
    if (row < RL) { r.b = row >> 13; r.j = row & 8191; r.s = r.b; r.lat = true; }
    else { int rc = row - RL; r.b = rc >> 8; r.j = 8192 + (rc & 255); r.s = 4; r.lat = false; }
    return r;
}
DI void store16(bf16_t* dst32, const f32x16& v, float sc, int hh) {
#pragma unroll
    for (int q4 = 0; q4 < 4; ++q4) {
        u32x2 w; w.x = pk2(v[4 * q4] * sc, v[4 * q4 + 1] * sc); w.y = pk2(v[4 * q4 + 2] * sc, v[4 * q4 + 3] * sc);
        *(u32x2*)(dst32 + 8 * q4 + 4 * hh) = w;
    }
}
DI f32x16 ropeB(const f32x16& v, const f32x2* tab, int hh) {
    f32x16 o;
#pragma unroll
    for (int r = 0; r < 8; ++r) {
        const int i = (r & 3) + 8 * (r >> 2) + 4 * hh;
        const f32x2 cs = tab[i];
        o[r] = v[r] * cs.x - v[r + 8] * cs.y;
        o[r + 8] = v[r + 8] * cs.x + v[r] * cs.y;
    }
    return o;
}
DI f32x16 ropeA(const f32x16& v, const f32x2* tr, const f32x2* tc, int hh) {
    f32x16 o;
#pragma unroll
    for (int r = 0; r < 4; ++r) {
        const int i = 4 * hh + r;
        const f32x2 a = tr[i], c = tc[i];
        o[r] = v[r] * a.x - v[r + 4] * a.y;
        o[r + 4] = v[r + 4] * a.x + v[r] * a.y;
        o[8 + r] = v[8 + r] * c.x - v[12 + r] * c.y;
        o[12 + r] = v[12 + r] * c.x + v[8 + r] * c.y;
    }
    return o;
}

constexpr int GA_S = 144, GB_S = 320;
constexpr int GEMM_LDS = 256 * GA_S + 64 * GB_S;

template <int BM, class Epi>
DI void gemm_tile(const bf16_t* __restrict__ A, int lda, const bf16_t* __restrict__ B, int ldb, int K, int row0, int col0, const Epi& epi, char* smem) {
    constexpr int MI = BM / 64, NA_ = BM / 32;
    const int tid = ltid(), lane = tid & 63, wave = tid >> 6, wm = wave >> 1, wn = wave & 1;
    const int l31 = lane & 31, hh = lane >> 5, q = (lane & 15) >> 2, p = lane & 3, nblk = (lane >> 4) & 1;
    char* sA = smem; char* sB = smem + BM * GA_S;
    f32x16 acc[MI][2];
#pragma unroll
    for (int i = 0; i < MI; ++i)
#pragma unroll
        for (int j = 0; j < 2; ++j)
#pragma unroll
            for (int r = 0; r < 16; ++r) acc[i][j][r] = 0.f;
    u32x4 ra[NA_], rb[4];
    const bf16_t* ag = A + (size_t)(row0 + (tid >> 3)) * lda + (tid & 7) * 8;
    const bf16_t* bg = B + (size_t)(tid >> 4) * ldb + col0 + (tid & 15) * 8;
    const int aw = (tid >> 3) * GA_S + (tid & 7) * 16, bw = (tid >> 4) * GB_S + (tid & 15) * 16;
    const int nk = K >> 6;
#pragma unroll
    for (int i = 0; i < NA_; ++i) ra[i] = *(const u32x4*)(ag + (size_t)(32 * i) * lda);
#pragma unroll
    for (int i = 0; i < 4; ++i) rb[i] = *(const u32x4*)(bg + (size_t)(16 * i) * ldb);
    const int xoff = (wm * (BM / 2) + l31) * GA_S + hh * 16;
    const int woff = (hh * 8 + q) * GB_S + (wn * 64 + nblk * 16 + 4 * p) * 2;
    for (int kt = 0; kt < nk; ++kt) {
        __syncthreads();
#pragma unroll
        for (int i = 0; i < NA_; ++i) *(u32x4*)(sA + aw + 32 * i * GA_S) = ra[i];
#pragma unroll
        for (int i = 0; i < 4; ++i) *(u32x4*)(sB + bw + 16 * i * GB_S) = rb[i];
        __syncthreads();
        if (kt + 1 < nk) {
            const bf16_t* a2 = ag + (size_t)(kt + 1) * 64; const bf16_t* b2 = bg + (size_t)(kt + 1) * 64 * ldb;
#pragma unroll
            for (int i = 0; i < NA_; ++i) ra[i] = *(const u32x4*)(a2 + (size_t)(32 * i) * lda);
#pragma unroll
            for (int i = 0; i < 4; ++i) rb[i] = *(const u32x4*)(b2 + (size_t)(16 * i) * ldb);
        }
        __builtin_amdgcn_sched_barrier(0);
#pragma unroll
        for (int s = 0; s < 4; ++s) {
            bf16x8 xf[MI], wf[2];
#pragma unroll
            for (int mi = 0; mi < MI; ++mi) xf[mi] = *(const bf16x8*)(sA + xoff + mi * 32 * GA_S + s * 32);
#pragma unroll
            for (int ni = 0; ni < 2; ++ni) {
                const char* wp = sB + woff + s * 16 * GB_S + ni * 64;
                wf[ni] = cat8(tr_read(wp), tr_read(wp + 4 * GB_S));
            }
#pragma unroll
            for (int mi = 0; mi < MI; ++mi)
#pragma unroll
                for (int ni = 0; ni < 2; ++ni) acc[mi][ni] = mfma32(wf[ni], xf[mi], acc[mi][ni]);
        }
    }
#pragma unroll
    for (int mi = 0; mi < MI; ++mi) epi(acc[mi][0], acc[mi][1], row0 + wm * (BM / 2) + mi * 32 + l31, col0 + wn * 64, hh);
}

template <class Epi>
DI void gemm_phase(const bf16_t* A, int lda, const bf16_t* B, int ldb, int N, int K, const Epi& epi, char* smem) {
    const int nt = N >> 7, small = (RC / 128) * nt;
    const int bid = lbid(), G = gridDim.x;
    if ((G & 7) == 0) {
        const int xcd = bid & 7, loc = bid >> 3, per = G >> 3, mine = (RL / 256 / 8) * nt;
        for (int i = loc; i < mine; i += per) gemm_tile<256>(A, lda, B, ldb, K, ((i & 15) * 8 + xcd) * 256, (i >> 4) * 128, epi, smem);
    } else {
        const int big = (RL / 256) * nt;
        for (int t = bid; t < big; t += G) gemm_tile<256>(A, lda, B, ldb, K, (t / nt) * 256, (t % nt) * 128, epi, smem);
    }
    for (int u = bid; u < small; u += G) gemm_tile<128>(A, lda, B, ldb, K, RL + (u / nt) * 128, (u % nt) * 128, epi, smem);
}

struct EpiSwiglu {
    bf16_t* hid;
    DI void operator()(const f32x16& a0, const f32x16& a1, int row, int cbase, int hh) const {
        bf16_t* dst = hid + (size_t)row * DFF + (cbase >> 1) + 4 * hh;
#pragma unroll
        for (int q4 = 0; q4 < 4; ++q4) {
            float h[4];
#pragma unroll
            for (int j = 0; j < 4; ++j) h[j] = silu_f(a0[4 * q4 + j]) * a1[4 * q4 + j];
            u32x2 w; w.x = pk2(h[0], h[1]); w.y = pk2(h[2], h[3]);
            *(u32x2*)(dst + 8 * q4) = w;
        }
    }
};
struct EpiResid {
    const float* res_lat; const float* res_ctx; float* X; const float* gate; float coef;
    DI void operator()(const f32x16& a0, const f32x16& a1, int row, int cbase, int hh) const {
        const int s = row < RL ? (row >> 13) : 4;
        const float* rp = row < RL ? res_lat + (size_t)row * 1024 : res_ctx + (size_t)(row - RL) * 1024;
        const float* gp = gate + s * 9216;
        float* xp = X + (size_t)row * 1024;
#pragma unroll
        for (int ni = 0; ni < 2; ++ni)
#pragma unroll
            for (int q4 = 0; q4 < 4; ++q4) {
                const int c = cbase + ni * 32 + 8 * q4 + 4 * hh;
                const f32x4 r = *(const f32x4*)(rp + c), g = *(const f32x4*)(gp + c);
                f32x4 z;
#pragma unroll
                for (int j = 0; j < 4; ++j) z[j] = ALPHA * r[j] + coef * g[j] * (ni ? a1[4 * q4 + j] : a0[4 * q4 + j]);
                *(f32x4*)(xp + c) = z;
            }
    }
};
struct EpiEvIn {
    bf16_t *QN, *QB, *KVN, *KA, *KB, *VB; const f32x2 *tAr, *tAc, *tBr, *tBc;
    DI void operator()(const f32x16& a0, const f32x16& a1, int row, int cbase, int hh) const {
        const RowInfo ri = rowinfo(row);
        const int gr = (ri.j >> 6) & 127, gc = ri.j & 63;
#pragma unroll
        for (int ni = 0; ni < 2; ++ni) {
            const int g = (cbase >> 5) + ni;
            const f32x16& v = ni ? a1 : a0;
            if (g < 8) store16(QN + (size_t)row * 256 + g * 32, v, 1.f, hh);
            else if (g < 24) {
                const int hv = (g - 8) >> 1, half = (g - 8) & 1;
                f32x16 w = v; if (ri.lat) w = ropeB(v, half ? tBc + gc * 16 : tBr + gr * 16, hh);
                store16(QB + ((size_t)(ri.b * 8 + hv) * NK + ri.j) * 64 + half * 32, w, QB_SCALE, hh);
            } else if (g < 28) store16(KVN + (size_t)row * 128 + (g - 24) * 32, v, 1.f, hh);
            else if (g == 28) {
                f32x16 w = v; if (ri.lat) w = ropeA(v, tAr + gr * 8, tAc + gc * 8, hh);
                for (int h = 0; h < 8; ++h) store16(KA + ((size_t)(ri.b * 8 + h) * NK + ri.j) * 96 + 64, w, 1.f, hh);
            } else if (g < 45) {
                const int hv = (g - 29) >> 1, half = (g - 29) & 1;
                f32x16 w = v; if (ri.lat) w = ropeB(v, half ? tBc + gc * 16 : tBr + gr * 16, hh);
                store16(KB + ((size_t)(ri.b * 8 + hv) * NK + ri.j) * 64 + half * 32, w, 1.f, hh);
            } else if (g < 61) {
                const int idx = g - 45, h = idx >> 2, part = idx & 3;
                store16(VB + ((size_t)(ri.b * 4 + h) * NK + ri.j) * 128 + part * 32, v, 1.f, hh);
            }
        }
    }
};
struct EpiUQ {
    bf16_t* QA; const f32x2 *tAr, *tAc;
    DI void operator()(const f32x16& a0, const f32x16& a1, int row, int cbase, int hh) const {
        const RowInfo ri = rowinfo(row);
        const int gr = (ri.j >> 6) & 127, gc = ri.j & 63;
#pragma unroll
        for (int ni = 0; ni < 2; ++ni) {
            const int g = (cbase >> 5) + ni, h = g / 3, part = g - 3 * h;
            f32x16 w = ni ? a1 : a0;
            if (part == 2 && ri.lat) w = ropeA(ni ? a1 : a0, tAr + gr * 8, tAc + gc * 8, hh);
            store16(QA + ((size_t)(ri.b * 8 + h) * NK + ri.j) * 96 + part * 32, w, QA_SCALE, hh);
        }
    }
};
struct EpiUKV {
    bf16_t *KA, *VA;
    DI void operator()(const f32x16& a0, const f32x16& a1, int row, int cbase, int hh) const {
        const RowInfo ri = rowinfo(row);
#pragma unroll
        for (int ni = 0; ni < 2; ++ni) {
            const int g = (cbase >> 5) + ni, h = g >> 2, part = g & 3;
            const size_t tk = (size_t)(ri.b * 8 + h) * NK + ri.j;
            if (part < 2) store16(KA + tk * 96 + part * 32, ni ? a1 : a0, 1.f, hh);
            else store16(VA + tk * 64 + (part - 2) * 32, ni ? a1 : a0, 1.f, hh);
        }
    }
};
struct EpiOdIn {
    bf16_t *U, *QD, *KD, *VD;
    DI void operator()(const f32x16& a0, const f32x16& a1, int row, int cbase, int hh) const {
        const RowInfo ri = rowinfo(row);
#pragma unroll
        for (int ni = 0; ni < 2; ++ni) {
            const int g = (cbase >> 5) + ni;
            const f32x16& v = ni ? a1 : a0;
            if (g < 16) store16(U + (size_t)row * 512 + g * 32, v, 1.f, hh);
            else {
                const int gg = (g - 16) & 15, h = gg >> 1, half = gg & 1;
                const size_t off = ((size_t)(ri.b * 8 + h) * NK + ri.j) * 64 + half * 32;
                if (g < 32) store16(QD + off, v, QD_SCALE, hh);
                else if (g < 48) store16(KD + off, v, 1.f, hh);
                else store16(VD + off, v, 1.f, hh);
            }
        }
    }
};
struct EpiPool {
    bf16_t* CC; const float* pscale; int gidx;
    DI void operator()(const f32x16& a0, const f32x16& a1, int row, int cbase, int hh) const {
#pragma unroll
        for (int ni = 0; ni < 2; ++ni)
#pragma unroll
            for (int q4 = 0; q4 < 4; ++q4) {
                const int c = gidx * 128 + cbase + ni * 32 + 8 * q4 + 4 * hh;
                const f32x4 s = *(const f32x4*)(pscale + c);
                const f32x16& v = ni ? a1 : a0;
                u32x2 w; w.x = pk2(v[4 * q4] * s[0], v[4 * q4 + 1] * s[1]); w.y = pk2(v[4 * q4 + 2] * s[2], v[4 * q4 + 3] * s[3]);
                *(u32x2*)(CC + (size_t)row * 1024 + c) = w;
            }
    }
};

constexpr int ATT_LDS = 64 * (96 + 8) * 2 + 64 * (128 * 2 + 64);
constexpr int RPB_OFF = ATT_LDS;
constexpr int SMEM_BYTES = GEMM_LDS > (ATT_LDS + 2048) ? GEMM_LDS : (ATT_LDS + 2048);

struct NAInfo { int qr; int kstart; };

template <int DQK, int DV, bool NA>
DI void attend(const bf16_t* __restrict__ Q, int q0, const bf16_t* __restrict__ Kb, const bf16_t* __restrict__ Vb,
               int s0, int n0, int s1, int n1, f32x16 (&o)[DV / 32], char* smem, NAInfo na) {
    constexpr int KS = (DQK + 8) * 2, VS = DV * 2 + 64;
    constexpr int KCH = DQK / 8, KN = 64 * KCH / NTHR, VCH = DV / 8, VN = 64 * VCH / NTHR;
    constexpr int NS = DQK / 16, NDT = DV / 32;
    const int tid = ltid(), lane = tid & 63, wave = tid >> 6;
    const int l31 = lane & 31, hh = lane >> 5, q = (lane & 15) >> 2, p = lane & 3, dblk = (lane >> 4) & 1;
    char* sK = smem; char* sV = smem + 64 * KS;
    bf16x8 qf[NS];
    {
        const bf16_t* qp = Q + (size_t)(q0 + wave * 32 + l31) * DQK + hh * 8;
#pragma unroll
        for (int s = 0; s < NS; ++s) qf[s] = *(const bf16x8*)(qp + s * 16);
    }
#pragma unroll
    for (int d = 0; d < NDT; ++d)
#pragma unroll
        for (int r = 0; r < 16; ++r) o[d][r] = 0.f;
    float m = -INFINITY, l = 0.f;
    u32x4 rk[KN], rv[VN];
    const int nt = n0 + n1;
    auto gload = [&](int t) {
        const int j0 = t < n0 ? s0 + t * 64 : s1 + (t - n0) * 64;
#pragma unroll
        for (int i = 0; i < KN; ++i) { const int id = tid + NTHR * i, row = id / KCH, ch = id - row * KCH; rk[i] = *(const u32x4*)(Kb + (size_t)(j0 + row) * DQK + ch * 8); }
#pragma unroll
        for (int i = 0; i < VN; ++i) { const int id = tid + NTHR * i, row = id / VCH, ch = id - row * VCH; rv[i] = *(const u32x4*)(Vb + (size_t)(j0 + row) * DV + ch * 8); }
    };
    gload(0);
    int qc = 0, cs = 0, rs = 0;
    if (NA) { qc = (wave & 1) * 32 + l31; cs = min(max(qc - 8, 0), 48); rs = min(max(na.qr - 4, 0), 120); }
    const float* rpb = (const float*)(smem + RPB_OFF);
    for (int t = 0; t < nt; ++t) {
        __syncthreads();
#pragma unroll
        for (int i = 0; i < KN; ++i) { const int id = tid + NTHR * i, row = id / KCH, ch = id - row * KCH; *(u32x4*)(sK + row * KS + ch * 16) = rk[i]; }
#pragma unroll
        for (int i = 0; i < VN; ++i) { const int id = tid + NTHR * i, row = id / VCH, ch = id - row * VCH; *(u32x4*)(sV + row * VS + ch * 16) = rv[i]; }
        __syncthreads();
        if (t + 1 < nt) gload(t + 1);
        __builtin_amdgcn_sched_barrier(0);
        bool active = true; int kr = 0;
        if (NA && t < n0) { kr = na.kstart + t; active = (kr >= rs) && (kr < rs + 8); }
        if (active) {
#pragma unroll 1
            for (int sub = 0; sub < 2; ++sub) {
                f32x16 st;
#pragma unroll
                for (int r = 0; r < 16; ++r) st[r] = 0.f;
#pragma unroll
                for (int s = 0; s < NS; ++s) {
                    const bf16x8 kf = *(const bf16x8*)(sK + (sub * 32 + l31) * KS + (s * 16 + hh * 8) * 2);
                    st = mfma32(kf, qf[s], st);
                }
                if (NA && t < n0) {
                    const float* brow = rpb + (kr - na.qr + 7) * 31 + 15 - qc;
#pragma unroll
                    for (int r = 0; r < 16; ++r) {
                        const int kc = sub * 32 + (r & 3) + 8 * (r >> 2) + 4 * hh;
                        const bool valid = (kc >= cs) && (kc < cs + 16);
                        const int bi = valid ? kc : cs;
                        const float bias = brow[bi];
                        st[r] = valid ? st[r] + bias : -INFINITY;
                    }
                }
                float mx = st[0];
#pragma unroll
                for (int r = 1; r < 16; ++r) mx = fmaxf(mx, st[r]);
                mx = fmaxf(mx, __shfl_xor(mx, 32));
                float muse;
                if (NA) {
                    const float mnew = fmaxf(m, mx);
                    muse = (mnew == -INFINITY) ? 0.f : mnew;
                    const float alpha = __builtin_amdgcn_exp2f(m - muse);
                    m = mnew;
                    l *= alpha;
#pragma unroll
                    for (int d = 0; d < NDT; ++d)
#pragma unroll
                        for (int r = 0; r < 16; ++r) o[d][r] *= alpha;
                } else {
                    if (__builtin_amdgcn_ballot_w64(mx > m + 8.f) != 0) {
                        const float mnew = fmaxf(m, mx);
                        const float alpha = __builtin_amdgcn_exp2f(m - mnew);
                        m = mnew;
                        l *= alpha;
#pragma unroll
                        for (int d = 0; d < NDT; ++d)
#pragma unroll
                            for (int r = 0; r < 16; ++r) o[d][r] *= alpha;
                    }
                    muse = m;
                }
                float rsum = 0.f;
#pragma unroll
                for (int r = 0; r < 16; ++r) { st[r] = __builtin_amdgcn_exp2f(st[r] - muse); rsum += st[r]; }
                l += rsum;
                bf16x8 pf[2];
#pragma unroll
                for (int s2 = 0; s2 < 2; ++s2) {
                    u32x4 w;
                    w.x = pk2(st[8 * s2], st[8 * s2 + 1]); w.y = pk2(st[8 * s2 + 2], st[8 * s2 + 3]);
                    w.z = pk2(st[8 * s2 + 4], st[8 * s2 + 5]); w.w = pk2(st[8 * s2 + 6], st[8 * s2 + 7]);
                    pf[s2] = __builtin_bit_cast(bf16x8, w);
                }
#pragma unroll
                for (int d = 0; d < NDT; ++d)
#pragma unroll
                    for (int s2 = 0; s2 < 2; ++s2) {
                        const char* vp = sV + (sub * 32 + 16 * s2 + 4 * hh + q) * VS + (d * 32 + dblk * 16 + 4 * p) * 2;
                        const bf16x8 vf = cat8(tr_read(vp), tr_read(vp + 8 * VS));
                        o[d] = mfma32(vf, pf[s2], o[d]);
                    }
            }
        }
    }
    l += __shfl_xor(l, 32);
    const float inv = 1.f / l;
#pragma unroll
    for (int d = 0; d < NDT; ++d)
#pragma unroll
        for (int r = 0; r < 16; ++r) o[d][r] *= inv;
}

DI int qrow_of(int b, int j) { return j < SEQ ? b * SEQ + j : RL + b * CTX + (j - SEQ); }

DI void even_attention_phase(const Params& P, char* smem) {
    char* ws = P.ws; char* hid = ws + OFF_HID; char* ob = (char*)P.out;
    const bf16_t* QA = (const bf16_t*)(hid + HOFF_QA); const bf16_t* KA = (const bf16_t*)(hid + HOFF_KA); const bf16_t* VA = (const bf16_t*)(hid + HOFF_VA);
    const bf16_t* QB = (const bf16_t*)(hid + HOFF_QB); const bf16_t* KB = (const bf16_t*)(ob + OOFF_KB); const bf16_t* VB = (const bf16_t*)(ob + OOFF_VB);
    bf16_t* CC = (bf16_t*)(ws + OFF_XM);
    const float lam = *(const float*)(ws + OFF_LAM);
    const float* gsub = P.in[18];
    const int lane = ltid() & 63, wave = ltid() >> 6, l31 = lane & 31, hh = lane >> 5;
    constexpr int NQT = 66, NDIFF = NB * 4 * NQT, NMLA = NB * 8 * NQT;
    NAInfo na; na.qr = 0; na.kstart = 0;
    unsigned* wq = (unsigned*)(ws + OFF_BAR + 128);
    volatile int* slot = (volatile int*)(smem + 36000);
    for (;;) {
        __syncthreads();
        if (ltid() == 0) *slot = (int)atomicAdd(wq, 1u);
        __syncthreads();
        const int u = *slot;
        if (u >= NDIFF + NMLA) break;
        if (u < NDIFF) {
            const int qt = u % NQT, bh = u / NQT, h = bh & 3, b = bh >> 2;
            const int q0 = qt < 64 ? qt * 128 : SEQ + (qt - 64) * 128;
            const int s0 = qt < 64 ? 0 : SEQ, n0 = qt < 64 ? NK / 64 : CTX / 64;
            const bf16_t* V = VB + (size_t)(b * 4 + h) * NK * 128;
            f32x16 o[4];
            attend<64, 128, false>(QB + (size_t)(b * 8 + 2 * h) * NK * 64, q0, KB + (size_t)(b * 8 + 2 * h) * NK * 64, V, s0, n0, 0, 0, o, smem, na);
            const int row = qrow_of(b, q0 + wave * 32 + l31);
            bf16_t* dst = CC + (size_t)row * 1024 + 512 + h * 128;
#pragma unroll
            for (int d = 0; d < 4; ++d) store16(dst + d * 32, o[d], 1.f, hh);
            f32x16 o2[4];
            attend<64, 128, false>(QB + (size_t)(b * 8 + 2 * h + 1) * NK * 64, q0, KB + (size_t)(b * 8 + 2 * h + 1) * NK * 64, V, s0, n0, 0, 0, o2, smem, na);
            float ss = 0.f;
#pragma unroll
            for (int d = 0; d < 4; ++d)
#pragma unroll
                for (int q4 = 0; q4 < 4; ++q4) {
                    const u32x2 w = *(const volatile u32x2*)(dst + d * 32 + 8 * q4 + 4 * hh);
                    const float a0 = bflo(w.x) - lam * o2[d][4 * q4], a1 = bfhi(w.x) - lam * o2[d][4 * q4 + 1], a2 = bflo(w.y) - lam * o2[d][4 * q4 + 2], a3 = bfhi(w.y) - lam * o2[d][4 * q4 + 3];
                    o[d][4 * q4] = a0; o[d][4 * q4 + 1] = a1; o[d][4 * q4 + 2] = a2; o[d][4 * q4 + 3] = a3;
                    ss += (a0 * a0 + a1 * a1) + (a2 * a2 + a3 * a3);
                }
            ss += __shfl_xor(ss, 32);
            const float rn = rsqrtf(ss * (1.f / 128.f) + 1e-5f) * 0.8f;
#pragma unroll
            for (int d = 0; d < 4; ++d)
#pragma unroll
                for (int q4 = 0; q4 < 4; ++q4) {
                    const int c = d * 32 + 8 * q4 + 4 * hh;
                    const f32x4 g = *(const f32x4*)(gsub + c);
                    u32x2 w; w.x = pk2(o[d][4 * q4] * rn * g[0], o[d][4 * q4 + 1] * rn * g[1]); w.y = pk2(o[d][4 * q4 + 2] * rn * g[2], o[d][4 * q4 + 3] * rn * g[3]);
                    *(u32x2*)(dst + c) = w;
                }
        } else {
            const int v = u - NDIFF, qt = v % NQT, bh = v / NQT, h = bh & 7, b = bh >> 3;
            const int q0 = qt < 64 ? qt * 128 : SEQ + (qt - 64) * 128;
            const int s0 = qt < 64 ? 0 : SEQ, n0 = qt < 64 ? NK / 64 : CTX / 64;
            f32x16 o[2];
            attend<96, 64, false>(QA + (size_t)(b * 8 + h) * NK * 96, q0, KA + (size_t)(b * 8 + h) * NK * 96, VA + (size_t)(b * 8 + h) * NK * 64, s0, n0, 0, 0, o, smem, na);
            const int row = qrow_of(b, q0 + wave * 32 + l31);
            bf16_t* dst = CC + (size_t)row * 1024 + h * 64;
#pragma unroll
            for (int d = 0; d < 2; ++d) store16(dst + d * 32, o[d], 1.f, hh);
        }
    }
}

DI void odd_attention_phase(const Params& P, char* smem) {
    char* ws = P.ws; char* hid = ws + OFF_HID;
    const bf16_t* QD = (const bf16_t*)(hid + HOFF_QD); const bf16_t* KD = (const bf16_t*)(hid + HOFF_KD); const bf16_t* VD = (const bf16_t*)(hid + HOFF_VD);
    bf16_t* CC = (bf16_t*)(ws + OFF_XM);
    const float* rpbg = P.in[23];
    const int lane = ltid() & 63, wave = ltid() >> 6, l31 = lane & 31, hh = lane >> 5;
    float* rpbl = (float*)(smem + RPB_OFF);
    constexpr int NU = NB * 8 * 64;
    for (int u = lbid(); u < NU; u += gridDim.x) {
        const int rp = u & 63, bh = u >> 6, h = bh & 7, b = bh >> 3;
        __syncthreads();
        for (int i = ltid(); i < 465; i += NTHR) rpbl[i] = rpbg[h * 465 + i] * LOG2E;
        const int r0 = rp * 2;
        NAInfo na; na.qr = r0 + (wave >> 1);
        const int rs0 = min(max(r0 - 4, 0), 120);
        na.kstart = min(rs0, 119);
        f32x16 o[2];
        const size_t hb = (size_t)(b * 8 + h) * NK * 64;
        attend<64, 64, true>(QD + hb, r0 * 64, KD + hb, VD + hb, na.kstart * 64, 9, SEQ, CTX / 64, o, smem, na);
        const int row = b * SEQ + r0 * 64 + wave * 32 + l31;
        bf16_t* dst = CC + (size_t)row * 1024 + 512 + h * 64;
#pragma unroll
        for (int d = 0; d < 2; ++d) store16(dst + d * 32, o[d], 1.f, hh);
    }
}

DI void cvt8(bf16_t* dst, const float* src, float sc) {
    const f32x4 a = *(const f32x4*)src, b = *(const f32x4*)(src + 4);
    u32x4 w; w.x = pk2(a[0] * sc, a[1] * sc); w.y = pk2(a[2] * sc, a[3] * sc); w.z = pk2(b[0] * sc, b[1] * sc); w.w = pk2(b[2] * sc, b[3] * sc);
    *(u32x4*)dst = w;
}
DI void cvt_rows(bf16_t* dst, int ldd, const float* src, int lds_, int rows, int cols_src, const float* rowscale, size_t gtid, size_t gstride) {
    const int c8 = ldd >> 3; const size_t n = (size_t)rows * c8;
    for (size_t i = gtid; i < n; i += gstride) {
        const int k = (int)(i / c8), c = (int)(i % c8) * 8;
        if (c < cols_src) cvt8(dst + (size_t)k * ldd + c, src + (size_t)k * lds_ + c, rowscale ? rowscale[k] : 1.f);
        else { u32x4 z = {0u, 0u, 0u, 0u}; *(u32x4*)(dst + (size_t)k * ldd + c) = z; }
    }
}

DI void phase_pro_a(const Params& P, char* smem) {
    char* ws = P.ws;
    const size_t gtid = (size_t)lbid() * NTHR + ltid(), gstride = (size_t)gridDim.x * NTHR;
    for (int lf = 0; lf < 4; ++lf) {
        const float* sg = P.in[8] + (size_t)lf * 1024 * DFF; const float* su = P.in[9] + (size_t)lf * 1024 * DFF;
        bf16_t* dst = (bf16_t*)(ws + OFF_WGU + lf * SZ_WGU);
        for (size_t i = gtid; i < 1024ull * 704; i += gstride) {
            const int k = (int)(i / 704), n = (int)(i % 704) * 8, grp = n >> 6, w = n & 63;
            const float* src = ((w < 32) ? sg : su) + (size_t)k * DFF + grp * 32 + (w & 31);
            cvt8(dst + (size_t)k * 5632 + n, src, 1.f);
        }
        cvt_rows((bf16_t*)(ws + OFF_WD + lf * SZ_WD), 1024, P.in[10] + (size_t)lf * DFF * 1024, 1024, DFF, 1024, nullptr, gtid, gstride);
    }
    cvt_rows((bf16_t*)(ws + OFF_EVIN), 2048, P.in[11], 1952, 1024, 1952, nullptr, gtid, gstride);
    cvt_rows((bf16_t*)(ws + OFF_EVOUT), 1024, P.in[12], 1024, 1024, 1024, nullptr, gtid, gstride);
    cvt_rows((bf16_t*)(ws + OFF_UQ), 768, P.in[15], 768, 256, 768, P.in[13], gtid, gstride);
    cvt_rows((bf16_t*)(ws + OFF_UKV), 1024, P.in[16], 1024, 128, 1024, P.in[14], gtid, gstride);
    cvt_rows((bf16_t*)(ws + OFF_ODIN), 2048, P.in[19], 2048, 1024, 2048, nullptr, gtid, gstride);
    cvt_rows((bf16_t*)(ws + OFF_ODOUT), 1024, P.in[20], 1024, 1024, 1024, nullptr, gtid, gstride);
    cvt_rows((bf16_t*)(ws + OFF_POOL), 128, P.in[21], 128, 512, 128, nullptr, gtid, gstride);
    if (gtid < 128 * 8) { const int r = (int)gtid >> 3, i = (int)gtid & 7; const float inv = exp2f(-(float)i * (13.287712379549449f / 8.f)); float rev = (float)r * inv * 0.15915494309189535f; rev -= floorf(rev);
        f32x2 v = {__builtin_amdgcn_cosf(rev), __builtin_amdgcn_sinf(rev)}; ((f32x2*)(ws + OFF_TAR))[gtid] = v; if (r < 64) ((f32x2*)(ws + OFF_TAC))[gtid] = v; }
    if (gtid < 128 * 16) { const int r = (int)gtid >> 4, i = (int)gtid & 15; const float inv = exp2f(-(float)i * (13.287712379549449f / 16.f)); float rev = (float)r * inv * 0.15915494309189535f; rev -= floorf(rev);
        f32x2 v = {__builtin_amdgcn_cosf(rev), __builtin_amdgcn_sinf(rev)}; ((f32x2*)(ws + OFF_TBR))[gtid] = v; if (r < 64) ((f32x2*)(ws + OFF_TBC))[gtid] = v; }
    if (gtid == 0) {
        const float* lv = P.in[17]; float a = 0.f, b = 0.f;
        for (int i = 0; i < 64; ++i) { a += lv[i] * lv[64 + i]; b += lv[128 + i] * lv[192 + i]; }
        *(float*)(ws + OFF_LAM) = expf(a) - expf(b) + 0.2f;
    }
    float* sc = (float*)smem;
    float* red = sc + 5 * 1024;
    const int tid = ltid(), jj = tid & 31, ig = tid >> 5;
    __syncthreads();
    for (int i = tid; i < 5 * 1024; i += NTHR) { const float v = i < 4096 ? P.in[1][i] : P.in[3][i - 4096]; sc[i] = v / (1.f + expf(-v)); }
    __syncthreads();
    for (int u = lbid(); u < 576; u += gridDim.x) {
        const int l = u / 288, j0 = (u % 288) * 32;
        float a[5] = {0.f, 0.f, 0.f, 0.f, 0.f};
        const float* w = P.in[4] + (size_t)l * 1024 * 9216 + (size_t)(ig * 128) * 9216 + j0 + jj;
        for (int i0 = 0; i0 < 128; i0 += 8) {
            float wv[8];
#pragma unroll
            for (int k = 0; k < 8; ++k) wv[k] = w[(size_t)(i0 + k) * 9216];
#pragma unroll
            for (int k = 0; k < 8; ++k)
#pragma unroll
                for (int s2 = 0; s2 < 5; ++s2) a[s2] += sc[s2 * 1024 + ig * 128 + i0 + k] * wv[k];
        }
#pragma unroll
        for (int s2 = 0; s2 < 5; ++s2) red[(ig * 5 + s2) * 32 + jj] = a[s2];
        __syncthreads();
        if (tid < 160) {
            const int s2 = tid >> 5, j = tid & 31;
            float v = P.in[5][l * 9216 + j0 + j];
#pragma unroll
            for (int g = 0; g < 8; ++g) v += red[(g * 5 + s2) * 32 + j];
            ((float*)(ws + OFF_MOD))[(size_t)(l * 5 + s2) * 9216 + j0 + j] = v;
        }
        __syncthreads();
    }
}

DI void phase_pro_b(const Params& P) {
    char* ws = P.ws; bf16_t* XM = (bf16_t*)(ws + OFF_XM); const float* MOD = (const float*)(ws + OFF_MOD);
    const size_t gtid = (size_t)lbid() * NTHR + ltid(), gstride = (size_t)gridDim.x * NTHR;
    for (size_t i = gtid; i < (size_t)RT * 128; i += gstride) {
        const int row = (int)(i >> 7), c = (int)(i & 127) * 8;
        const float* src = row < RL ? P.in[0] + (size_t)row * 1024 + c : P.in[2] + (size_t)(row - RL) * 1024 + c;
        const int s = row < RL ? (row >> 13) : 4;
        const float* sh = MOD + (size_t)s * 9216 + c; const float* scl = sh + 1024;
        unsigned w[4];
#pragma unroll
        for (int hf = 0; hf < 2; ++hf) {
            const f32x4 x = *(const f32x4*)(src + 4 * hf), a = *(const f32x4*)(sh + 4 * hf), g = *(const f32x4*)(scl + 4 * hf);
            w[2 * hf] = pk2(x[0] * (1.f + g[0]) + a[0], x[1] * (1.f + g[1]) + a[1]);
            w[2 * hf + 1] = pk2(x[2] * (1.f + g[2]) + a[2], x[3] * (1.f + g[3]) + a[3]);
        }
        u32x4 o = {w[0], w[1], w[2], w[3]};
        *(u32x4*)(XM + (size_t)row * 1024 + c) = o;
    }
}

DI void phase_ln(const Params& P, int l, int which, int lnext, int mshift, bool final_) {
    char* ws = P.ws; float* X = (float*)(ws + OFF_X); bf16_t* XM = (bf16_t*)(ws + OFF_XM); const float* MOD = (const float*)(ws + OFF_MOD);
    const float* g = P.in[6] + (l * 3 + which) * 1024; const float* bb = P.in[7] + (l * 3 + which) * 1024;
    const int lane = ltid() & 63, wave = ltid() >> 6;
    const int nrows = final_ ? RL : RT;
    for (int row = lbid() * 4 + wave; row < nrows; row += gridDim.x * 4) {
        float* xp = X + (size_t)row * 1024;
        f32x4 v[4]; float s = 0.f;
#pragma unroll
        for (int i = 0; i < 4; ++i) { v[i] = *(const f32x4*)(xp + (i * 64 + lane) * 4); s += (v[i][0] + v[i][1]) + (v[i][2] + v[i][3]); }
#pragma unroll
        for (int o = 32; o >= 1; o >>= 1) s += __shfl_xor(s, o);
        const float mu = s * (1.f / 1024.f);
        float qv = 0.f;
#pragma unroll
        for (int i = 0; i < 4; ++i)
#pragma unroll
            for (int j = 0; j < 4; ++j) { const float d = v[i][j] - mu; qv += d * d; }
#pragma unroll
        for (int o = 32; o >= 1; o >>= 1) qv += __shfl_xor(qv, o);
        const float rstd = rsqrtf(qv * (1.f / 1024.f) + 1e-6f);
        const int sidx = row < RL ? (row >> 13) : 4;
        const float* sh = MOD + (size_t)(lnext * 5 + sidx) * 9216 + mshift * 1024; const float* scl = sh + 1024;
#pragma unroll
        for (int i = 0; i < 4; ++i) {
            const int c = (i * 64 + lane) * 4;
            const f32x4 gg = *(const f32x4*)(g + c), b4 = *(const f32x4*)(bb + c);
            f32x4 y;
#pragma unroll
            for (int j = 0; j < 4; ++j) y[j] = (v[i][j] - mu) * rstd * gg[j] + b4[j];
            if (final_) { *(f32x4*)(P.out + (size_t)row * 1024 + c) = y; }
            else {
                *(f32x4*)(xp + c) = y;
                const f32x4 a = *(const f32x4*)(sh + c), sg = *(const f32x4*)(scl + c);
                u32x2 w; w.x = pk2(y[0] * (1.f + sg[0]) + a[0], y[1] * (1.f + sg[1]) + a[1]); w.y = pk2(y[2] * (1.f + sg[2]) + a[2], y[3] * (1.f + sg[3]) + a[3]);
                *(u32x2*)(XM + (size_t)row * 1024 + c) = w;
            }
        }
    }
}

DI void phase_ev_rms(const Params& P) {
    char* ws = P.ws; bf16_t* QN = (bf16_t*)(ws + OFF_HID + HOFF_QN); bf16_t* KVN = (bf16_t*)((char*)P.out + OOFF_KVN);
    const int lane = ltid() & 63, wave = ltid() >> 6;
    for (int row = lbid() * 4 + wave; row < RT; row += gridDim.x * 4) {
        {
            u32x2* p = (u32x2*)(QN + (size_t)row * 256 + lane * 4); const u32x2 w = *p;
            float a = bflo(w.x), b = bfhi(w.x), c = bflo(w.y), d = bfhi(w.y);
            float s = a * a + b * b + c * c + d * d;
#pragma unroll
            for (int o = 32; o >= 1; o >>= 1) s += __shfl_xor(s, o);
            const float r = rsqrtf(s * (1.f / 256.f) + 1e-6f);
            u32x2 o2; o2.x = pk2(a * r, b * r); o2.y = pk2(c * r, d * r); *p = o2;
        }
        {
            unsigned* p = (unsigned*)(KVN + (size_t)row * 128 + lane * 2); const unsigned w = *p;
            float a = bflo(w), b = bfhi(w);
            float s = a * a + b * b;
#pragma unroll
            for (int o = 32; o >= 1; o >>= 1) s += __shfl_xor(s, o);
            const float r = rsqrtf(s * (1.f / 128.f) + 1e-6f);
            *p = pk2(a * r, b * r);
        }
    }
}

DI void phase_od_pool(const Params& P) {
    char* ws = P.ws; const bf16_t* U = (const bf16_t*)(ws + OFF_HID + HOFF_U); bf16_t* PL = (bf16_t*)(ws + OFF_HID + HOFF_PL);
    const size_t gtid = (size_t)lbid() * NTHR + ltid(), gstride = (size_t)gridDim.x * NTHR;
    for (size_t i = gtid; i < (size_t)RT * 64; i += gstride) {
        const int row = (int)(i >> 6), c = (int)(i & 63) * 8, grp = c >> 7;
        const int w = 2 << grp, left = w >> 1, right = w - 1 - left;
        int base, n, t;
        if (row < RL) { base = row & ~8191; n = SEQ; t = row & 8191; } else { const int rc = row - RL; base = RL + (rc & ~255); n = CTX; t = rc & 255; }
        const int lo = max(t - left, 0), hi = min(t + right + 1, n);
        float acc[8] = {0.f, 0.f, 0.f, 0.f, 0.f, 0.f, 0.f, 0.f};
        for (int tt = lo; tt < hi; ++tt) {
            const u32x4 v = *(const u32x4*)(U + (size_t)(base + tt) * 512 + c);
            acc[0] += bflo(v.x); acc[1] += bfhi(v.x); acc[2] += bflo(v.y); acc[3] += bfhi(v.y); acc[4] += bflo(v.z); acc[5] += bfhi(v.z); acc[6] += bflo(v.w); acc[7] += bfhi(v.w);
        }
        const float ic = 1.f / (float)(hi - lo);
        const u32x4 s = *(const u32x4*)(U + (size_t)row * 512 + c);
        u32x4 o;
        o.x = pk2(acc[0] * ic - bflo(s.x), acc[1] * ic - bfhi(s.x)); o.y = pk2(acc[2] * ic - bflo(s.y), acc[3] * ic - bfhi(s.y));
        o.z = pk2(acc[4] * ic - bflo(s.z), acc[5] * ic - bfhi(s.z)); o.w = pk2(acc[6] * ic - bflo(s.w), acc[7] * ic - bfhi(s.w));
        *(u32x4*)(PL + (size_t)row * 512 + c) = o;
    }
}

constexpr int NPHASE = 25;

DI void run_phase(const Params& P, int ph, char* smem) {
    char* ws = P.ws; char* hid = ws + OFF_HID; char* ob = (char*)P.out;
    float* X = (float*)(ws + OFF_X); bf16_t* XM = (bf16_t*)(ws + OFF_XM); bf16_t* HID = (bf16_t*)hid;
    const float* MOD = (const float*)(ws + OFF_MOD);
    if (ph == 0) { phase_pro_a(P, smem); return; }
    if (ph == 1) { phase_pro_b(P); return; }
    int l, op;
    if (ph < 14) { l = 0; op = ph - 2; } else { l = 1; op = ph - 14; if (op >= 6) op += 1; }
    const float* modl = MOD + (size_t)l * 5 * 9216;
    switch (op) {
    case 0: case 9: {
        const int f = op == 0 ? 0 : 1;
        EpiSwiglu e{HID};
        gemm_phase(XM, 1024, (const bf16_t*)(ws + OFF_WGU + (l * 2 + f) * SZ_WGU), 5632, 5632, 1024, e, smem);
    } break;
    case 1: case 10: {
        const int f = op == 1 ? 0 : 1;
        const bool first = (l == 0 && f == 0);
        EpiResid e{first ? P.in[0] : X, first ? P.in[2] : X + (size_t)RL * 1024, X, modl + (f == 0 ? 2 : 8) * 1024, 0.5f};
        gemm_phase(HID, DFF, (const bf16_t*)(ws + OFF_WD + (l * 2 + f) * SZ_WD), 1024, 1024, DFF, e, smem);
    } break;
    case 2: phase_ln(P, l, 0, l, 3, false); break;
    case 3: {
        if (l == 0) {
            EpiEvIn e{(bf16_t*)(hid + HOFF_QN), (bf16_t*)(hid + HOFF_QB), (bf16_t*)(ob + OOFF_KVN), (bf16_t*)(hid + HOFF_KA), (bf16_t*)(ob + OOFF_KB), (bf16_t*)(ob + OOFF_VB),
                      (const f32x2*)(ws + OFF_TAR), (const f32x2*)(ws + OFF_TAC), (const f32x2*)(ws + OFF_TBR), (const f32x2*)(ws + OFF_TBC)};
            gemm_phase(XM, 1024, (const bf16_t*)(ws + OFF_EVIN), 2048, 2048, 1024, e, smem);
        } else {
            EpiOdIn e{(bf16_t*)(hid + HOFF_U), (bf16_t*)(hid + HOFF_QD), (bf16_t*)(hid + HOFF_KD), (bf16_t*)(hid + HOFF_VD)};
            gemm_phase(XM, 1024, (const bf16_t*)(ws + OFF_ODIN), 2048, 2048, 1024, e, smem);
        }
    } break;
    case 4: if (l == 0) phase_ev_rms(P); else phase_od_pool(P); break;
    case 5: {
        if (l == 0) {
            EpiUQ e1{(bf16_t*)(hid + HOFF_QA), (const f32x2*)(ws + OFF_TAR), (const f32x2*)(ws + OFF_TAC)};
            gemm_phase((const bf16_t*)(hid + HOFF_QN), 256, (const bf16_t*)(ws + OFF_UQ), 768, 768, 256, e1, smem);
            EpiUKV e2{(bf16_t*)(hid + HOFF_KA), (bf16_t*)(hid + HOFF_VA)};
            gemm_phase((const bf16_t*)(ob + OOFF_KVN), 128, (const bf16_t*)(ws + OFF_UKV), 1024, 1024, 128, e2, smem);
        } else {
            odd_attention_phase(P, smem);
            for (int g = 0; g < 4; ++g) {
                EpiPool e{XM, P.in[22], g};
                gemm_phase((const bf16_t*)(hid + HOFF_PL) + g * 128, 512, (const bf16_t*)(ws + OFF_POOL) + g * 128 * 128, 128, 128, 128, e, smem);
            }
        }
    } break;
    case 6: even_attention_phase(P, smem); break;
    case 7: {
        EpiResid e{X, X + (size_t)RL * 1024, X, modl + 5 * 1024, 1.f};
        gemm_phase(XM, 1024, (const bf16_t*)(ws + (l == 0 ? OFF_EVOUT : OFF_ODOUT)), 1024, 1024, 1024, e, smem);
    } break;
    case 8: phase_ln(P, l, 1, l, 6, false); break;
    case 11: if (l == 0) phase_ln(P, 0, 2, 1, 0, false); else phase_ln(P, 1, 2, 1, 0, true); break;
    default: break;
    }
}

DI void grid_barrier(unsigned* ctr, unsigned target) {
    __syncthreads();
    if (threadIdx.x == 0) {
        __threadfence();
        __hip_atomic_fetch_add(ctr, 1u, __ATOMIC_RELEASE, __HIP_MEMORY_SCOPE_AGENT);
        while (__hip_atomic_load(ctr, __ATOMIC_RELAXED, __HIP_MEMORY_SCOPE_AGENT) < target) __builtin_amdgcn_s_sleep(8);
        __threadfence();
    }
    __syncthreads();
}

__global__ void __launch_bounds__(NTHR, 2) mega(Params P, int ph_lo, int ph_hi) {
    __shared__ __attribute__((aligned(16))) char smem[SMEM_BYTES];
    unsigned nsync = 0;
    for (int ph = ph_lo; ph < ph_hi; ++ph) {
        run_phase(P, ph, smem);
        if (ph + 1 < ph_hi) {
            if (ph == ph_lo) cg::this_grid().sync();
            else { ++nsync; grid_barrier((unsigned*)(P.ws + OFF_BAR), nsync * gridDim.x); }
        }
    }
}

extern "C" void kernel_launch(void* const* d_in, const int* in_sizes, int n_in, void* d_out, int out_size, void* d_ws, size_t ws_size, hipStream_t stream) {
    if (ws_size < WS_NEED) { fprintf(stderr, "workspace too small: %zu < %zu\n", ws_size, (size_t)WS_NEED); return; }
    Params P{};
    for (int i = 0; i < 24; ++i) P.in[i] = (const float*)d_in[i];
    P.out = (float*)d_out; P.ws = (char*)d_ws;
    static int grid_blocks = 0;
    if (!grid_blocks) {
        int dev = 0, cus = 0, per_cu = 0;
        hipGetDevice(&dev);
        hipDeviceGetAttribute(&cus, hipDeviceAttributeMultiprocessorCount, dev);
        hipOccupancyMaxActiveBlocksPerMultiprocessor(&per_cu, mega, NTHR, 0);
        if (per_cu < 1) per_cu = 1;
        if (per_cu > 2) per_cu = 2;
        grid_blocks = cus * per_cu;
    }
#if COOP
    hipMemsetAsync((char*)d_ws + OFF_BAR, 0, 256, stream);
    int lo = 0, hi = NPHASE;
    void* args[] = {&P, &lo, &hi};
    hipError_t e = hipLaunchCooperativeKernel((void*)mega, dim3(grid_blocks), dim3(NTHR), args, 0, stream);
    if (e != hipSuccess) fprintf(stderr, "cooperative launch failed: %s (grid %d)\n", hipGetErrorString(e), grid_blocks);
#else
    for (int ph = 0; ph < NPHASE; ++ph) mega<<<grid_blocks, NTHR, 0, stream>>>(P, ph, ph + 1);
#endif
}
```

```cpp
#include <hip/hip_runtime.h>
#include <hip/hip_cooperative_groups.h>
#include <cstdio>
#include <cstdint>
namespace cg = cooperative_groups;

#ifndef COOP
#define COOP 1
#endif

#define DI __device__ __forceinline__
typedef unsigned short bf16_t;
typedef short bf16x8 __attribute__((ext_vector_type(8)));
typedef short s16x4 __attribute__((ext_vector_type(4)));
typedef __bf16 bfx4 __attribute__((ext_vector_type(4)));
typedef __bf16 bfx2 __attribute__((ext_vector_type(2)));
typedef float f32x2 __attribute__((ext_vector_type(2)));
typedef float f32x4 __attribute__((ext_vector_type(4)));
typedef float f32x16 __attribute__((ext_vector_type(16)));
typedef unsigned u32x2 __attribute__((ext_vector_type(2)));
typedef unsigned u32x4 __attribute__((ext_vector_type(4)));
#define LDS_AS __attribute__((address_space(3)))

constexpr int DM = 1024, NB = 4, SEQ = 8192, CTX = 256, DFF = 2816;
constexpr int RL = NB * SEQ, RC = NB * CTX, RT = RL + RC;
constexpr int NK = SEQ + CTX;
constexpr float ALPHA = 1.41421356237f;
constexpr float LOG2E = 1.4426950408889634f;
constexpr float QA_SCALE = 0.10206207261596575f * LOG2E;
constexpr float QB_SCALE = 0.125f * LOG2E;
constexpr float QD_SCALE = 0.125f * LOG2E;
constexpr int NTHR = 512, NWAVE = NTHR / 64;

constexpr size_t SZ_WGU = 1024ull * 5632 * 2, SZ_WD = 2816ull * 1024 * 2;
constexpr size_t OFF_WGU = 0;
constexpr size_t OFF_WD = OFF_WGU + 4 * SZ_WGU;
constexpr size_t OFF_EVIN = OFF_WD + 4 * SZ_WD;
constexpr size_t OFF_EVOUT = OFF_EVIN + 1024ull * 2048 * 2;
constexpr size_t OFF_UQ = OFF_EVOUT + 1024ull * 1024 * 2;
constexpr size_t OFF_UKV = OFF_UQ + 256ull * 768 * 2;
constexpr size_t OFF_ODIN = OFF_UKV + 128ull * 1024 * 2;
constexpr size_t OFF_ODOUT = OFF_ODIN + 1024ull * 2048 * 2;
constexpr size_t OFF_POOL = OFF_ODOUT + 1024ull * 1024 * 2;
constexpr size_t OFF_MOD = OFF_POOL + 512ull * 512 * 2;
constexpr size_t OFF_TAR = OFF_MOD + 2ull * 5 * 9216 * 4;
constexpr size_t OFF_TAC = OFF_TAR + 128 * 8 * 8;
constexpr size_t OFF_TBR = OFF_TAC + 64 * 8 * 8;
constexpr size_t OFF_TBC = OFF_TBR + 128 * 16 * 8;
constexpr size_t OFF_LAM = OFF_TBC + 64 * 16 * 8;
constexpr size_t OFF_BAR = OFF_LAM + 256;
constexpr size_t OFF_X = OFF_BAR + 256;
constexpr size_t OFF_XM = OFF_X + (size_t)RT * 1024 * 4;
constexpr size_t OFF_HID = OFF_XM + (size_t)RT * 1024 * 2;
constexpr size_t WS_NEED = OFF_HID + (size_t)RT * DFF * 2;
constexpr size_t SZ_H96 = (size_t)NB * 8 * NK * 96 * 2, SZ_H64 = (size_t)NB * 8 * NK * 64 * 2;
constexpr size_t HOFF_QA = 0, HOFF_KA = SZ_H96, HOFF_VA = 2 * SZ_H96, HOFF_QB = HOFF_VA + SZ_H64, HOFF_QN = HOFF_QB + SZ_H64;
static_assert(HOFF_QN + (size_t)RT * 256 * 2 <= (size_t)RT * DFF * 2, "HID region overflow");
constexpr size_t HOFF_U = 0, HOFF_PL = SZ_H64, HOFF_QD = 2 * SZ_H64, HOFF_KD = 3 * SZ_H64, HOFF_VD = 4 * SZ_H64;
constexpr size_t OOFF_KB = 0, OOFF_VB = SZ_H64, OOFF_KVN = 2 * SZ_H64;
static_assert(OOFF_KVN + (size_t)RT * 128 * 2 <= (size_t)RL * 1024 * 4, "d_out region overflow");

struct Params {
    const float* in[24];
    float* out;
    char* ws;
};

DI int ltid() { int t = threadIdx.x; asm volatile("" : "+v"(t)); return t; }
DI int lbid() { int t = blockIdx.x; asm volatile("" : "+s"(t)); return t; }
DI unsigned pk2(float a, float b) { f32x2 v = {a, b}; bfx2 r = __builtin_convertvector(v, bfx2); return __builtin_bit_cast(unsigned, r); }
DI float bf2f(unsigned short u) { return __uint_as_float(((unsigned)u) << 16); }
DI float bflo(unsigned u) { return __uint_as_float(u << 16); }
DI float bfhi(unsigned u) { return __uint_as_float(u & 0xffff0000u); }
DI float silu_f(float x) { return x * __builtin_amdgcn_rcpf(1.f + __expf(-x)); }
DI f32x16 mfma32(bf16x8 a, bf16x8 b, f32x16 c) { return __builtin_amdgcn_mfma_f32_32x32x16_bf16(a, b, c, 0, 0, 0); }
DI s16x4 tr_read(const char* p) { bfx4 r = __builtin_amdgcn_ds_read_tr16_b64_v4bf16((LDS_AS bfx4*)p); return __builtin_bit_cast(s16x4, r); }
DI bf16x8 cat8(s16x4 lo, s16x4 hi) { return __builtin_shufflevector(lo, hi, 0, 1, 2, 3, 4, 5, 6, 7); }

struct RowInfo { int b, j, s; bool lat; };
DI RowInfo rowinfo(int row) {
    RowInfo r;
    if (row < RL) { r.b = row >> 13; r.j = row & 8191; r.s = r.b; r.lat = true; }
    else { int rc = row - RL; r.b = rc >> 8; r.j = 8192 + (rc & 255); r.s = 4; r.lat = false; }
    return r;
}
DI void store16(bf16_t* dst32, const f32x16& v, float sc, int hh) {
#pragma unroll
    for (int q4 = 0; q4 < 4; ++q4) {
        u32x2 w; w.x = pk2(v[4 * q4] * sc, v[4 * q4 + 1] * sc); w.y = pk2(v[4 * q4 + 2] * sc, v[4 * q4 + 3] * sc);
        *(u32x2*)(dst32 + 8 * q4 + 4 * hh) = w;
    }
}
DI f32x16 ropeB(const f32x16& v, const f32x2* tab, int hh) {
    f32x16 o;
#pragma unroll
    for (int r = 0; r < 8; ++r) {
        const int i = (r & 3) + 8 * (r >> 2) + 4 * hh;
        const f32x2 cs = tab[i];
        o[r] = v[r] * cs.x - v[r + 8] * cs.y;
        o[r + 8] = v[r + 8] * cs.x + v[r] * cs.y;
    }
    return o;
}
DI f32x16 ropeA(const f32x16& v, const f32x2* tr, const f32x2* tc, int hh) {
    f32x16 o;
#pragma unroll
    for (int r = 0; r < 4; ++r) {
        const int i = 4 * hh + r;
        const f32x2 a = tr[i], c = tc[i];
        o[r] = v[r] * a.x - v[r + 4] * a.y;
        o[r + 4] = v[r + 4] * a.x + v[r] * a.y;
        o[8 + r] = v[8 + r] * c.x - v[12 + r] * c.y;
        o[12 + r] = v[12 + r] * c.x + v[8 + r] * c.y;
    }
    return o;
}

constexpr int GA_S = 144, GB_S = 576;
constexpr int GSTAGE = 256 * GA_S + 64 * GB_S;
constexpr int GEMM_LDS = 2 * GSTAGE;

template <int BM, class Epi>
DI void gemm_tile(const bf16_t* __restrict__ A, int lda, const bf16_t* __restrict__ B, int ldb, int K, int row0, int col0, const Epi& epi, char* smem) {
    constexpr int MI = BM / 64, NA_ = BM / 64;
    const int tid = ltid(), lane = tid & 63, wave = tid >> 6, wm = wave >> 2, wn = wave & 3;
    const int l31 = lane & 31, hh = lane >> 5, q = (lane & 15) >> 2, p = lane & 3, nblk = (lane >> 4) & 1;
    f32x16 acc[MI][2];
#pragma unroll
    for (int i = 0; i < MI; ++i)
#pragma unroll
        for (int j = 0; j < 2; ++j)
#pragma unroll
            for (int r = 0; r < 16; ++r) acc[i][j][r] = 0.f;
    u32x4 ra[NA_], rb[4];
    const bf16_t* ag = A + (size_t)(row0 + (tid >> 3)) * lda + (tid & 7) * 8;
    const bf16_t* bg = B + (size_t)(tid >> 5) * ldb + col0 + (tid & 31) * 8;
    const int aw = (tid >> 3) * GA_S + (tid & 7) * 16, bw = BM * GA_S + (tid >> 5) * GB_S + (tid & 31) * 16;
    const int nk = K >> 6;
    const int xoff = (wm * (BM / 2) + l31) * GA_S + hh * 16;
    const int woff = BM * GA_S + (hh * 8 + q) * GB_S + (wn * 64 + nblk * 16 + 4 * p) * 2;
#pragma unroll
    for (int i = 0; i < NA_; ++i) ra[i] = *(const u32x4*)(ag + (size_t)(64 * i) * lda);
#pragma unroll
    for (int i = 0; i < 4; ++i) rb[i] = *(const u32x4*)(bg + (size_t)(16 * i) * ldb);
    __syncthreads();
#pragma unroll
    for (int i = 0; i < NA_; ++i) *(u32x4*)(smem + aw + 64 * i * GA_S) = ra[i];
#pragma unroll
    for (int i = 0; i < 4; ++i) *(u32x4*)(smem + bw + 16 * i * GB_S) = rb[i];
    if (nk > 1) {
#pragma unroll
        for (int i = 0; i < NA_; ++i) ra[i] = *(const u32x4*)(ag + 64 + (size_t)(64 * i) * lda);
#pragma unroll
        for (int i = 0; i < 4; ++i) rb[i] = *(const u32x4*)(bg + (size_t)(64 + 16 * i) * ldb);
    }
    __syncthreads();
    for (int kt = 0; kt < nk; ++kt) {
        const char* cur = smem + (kt & 1) * GSTAGE;
        char* nxt = smem + ((kt & 1) ^ 1) * GSTAGE;
        const bool w1 = kt + 1 < nk, l2 = kt + 2 < nk;
        const bf16_t* a2 = ag + (size_t)(kt + 2) * 64; const bf16_t* b2 = bg + (size_t)(kt + 2) * 64 * ldb;
#pragma unroll
        for (int s = 0; s < 4; ++s) {
            bf16x8 xf[MI], wf[2];
#pragma unroll
            for (int mi = 0; mi < MI; ++mi) xf[mi] = *(const bf16x8*)(cur + xoff + mi * 32 * GA_S + s * 32);
#pragma unroll
            for (int ni = 0; ni < 2; ++ni) {
                const char* wp = cur + woff + s * 16 * GB_S + ni * 64;
                wf[ni] = cat8(tr_read(wp), tr_read(wp + 4 * GB_S));
            }
#pragma unroll
            for (int mi = 0; mi < MI; ++mi)
#pragma unroll
                for (int ni = 0; ni < 2; ++ni) acc[mi][ni] = mfma32(wf[ni], xf[mi], acc[mi][ni]);
            if (w1) {
                if (s < NA_) *(u32x4*)(nxt + aw + 64 * s * GA_S) = ra[s];
                *(u32x4*)(nxt + bw + 16 * s * GB_S) = rb[s];
            }
            if (l2) {
                if (s < NA_) ra[s] = *(const u32x4*)(a2 + (size_t)(64 * s) * lda);
                rb[s] = *(const u32x4*)(b2 + (size_t)(16 * s) * ldb);
            }
            __builtin_amdgcn_sched_barrier(0);
        }
        __syncthreads();
    }
#pragma unroll
    for (int mi = 0; mi < MI; ++mi) epi(acc[mi][0], acc[mi][1], row0 + wm * (BM / 2) + mi * 32 + l31, col0 + wn * 64, hh);
}

template <class Epi>
DI void gemm_phase(const bf16_t* A, int lda, const bf16_t* B, int ldb, int N, int K, const Epi& epi, char* smem) {
    const int nt = N >> 8, small = (RC / 128) * nt;
    const int bid = lbid(), G = gridDim.x;
    if ((G & 7) == 0) {
        const int xcd = bid & 7, loc = bid >> 3, per = G >> 3, mine = (RL / 256 / 8) * nt;
        for (int i = loc; i < mine; i += per) gemm_tile<256>(A, lda, B, ldb, K, ((i & 15) * 8 + xcd) * 256, (i >> 4) * 256, epi, smem);
    } else {
        const int big = (RL / 256) * nt;
        for (int t = bid; t < big; t += G) gemm_tile<256>(A, lda, B, ldb, K, (t / nt) * 256, (t % nt) * 256, epi, smem);
    }
    for (int u = bid; u < small; u += G) gemm_tile<128>(A, lda, B, ldb, K, RL + (u / nt) * 128, (u % nt) * 256, epi, smem);
}

struct EpiSwiglu {
    bf16_t* hid;
    DI void operator()(const f32x16& a0, const f32x16& a1, int row, int cbase, int hh) const {
        bf16_t* dst = hid + (size_t)row * DFF + (cbase >> 1) + 4 * hh;
#pragma unroll
        for (int q4 = 0; q4 < 4; ++q4) {
            float h[4];
#pragma unroll
            for (int j = 0; j < 4; ++j) h[j] = silu_f(a0[4 * q4 + j]) * a1[4 * q4 + j];
            u32x2 w; w.x = pk2(h[0], h[1]); w.y = pk2(h[2], h[3]);
            *(u32x2*)(dst + 8 * q4) = w;
        }
    }
};
struct EpiResid {
    const float* res_lat; const float* res_ctx; float* X; const float* gate; float coef;
    DI void operator()(const f32x16& a0, const f32x16& a1, int row, int cbase, int hh) const {
        const int s = row < RL ? (row >> 13) : 4;
        const float* rp = row < RL ? res_lat + (size_t)row * 1024 : res_ctx + (size_t)(row - RL) * 1024;
        const float* gp = gate + s * 9216;
        float* xp = X + (size_t)row * 1024;
#pragma unroll
        for (int ni = 0; ni < 2; ++ni)
#pragma unroll
            for (int q4 = 0; q4 < 4; ++q4) {
                const int c = cbase + ni * 32 + 8 * q4 + 4 * hh;
                const f32x4 r = *(const f32x4*)(rp + c), g = *(const f32x4*)(gp + c);
                f32x4 z;
#pragma unroll
                for (int j = 0; j < 4; ++j) z[j] = ALPHA * r[j] + coef * g[j] * (ni ? a1[4 * q4 + j] : a0[4 * q4 + j]);
                *(f32x4*)(xp + c) = z;
            }
    }
};
struct EpiEvIn {
    bf16_t *QN, *QB, *KVN, *KA, *KB, *VB; const f32x2 *tAr, *tAc, *tBr, *tBc;
    DI void operator()(const f32x16& a0, const f32x16& a1, int row, int cbase, int hh) const {
        const RowInfo ri = rowinfo(row);
        const int gr = (ri.j >> 6) & 127, gc = ri.j & 63;
#pragma unroll
        for (int ni = 0; ni < 2; ++ni) {
            const int g = (cbase >> 5) + ni;
            const f32x16& v = ni ? a1 : a0;
            if (g < 8) store16(QN + (size_t)row * 256 + g * 32, v, 1.f, hh);
            else if (g < 24) {
                const int hv = (g - 8) >> 1, half = (g - 8) & 1;
                f32x16 w = v; if (ri.lat) w = ropeB(v, half ? tBc + gc * 16 : tBr + gr * 16, hh);
                store16(QB + ((size_t)(ri.b * 8 + hv) * NK + ri.j) * 64 + half * 32, w, QB_SCALE, hh);
            } else if (g < 28) store16(KVN + (size_t)row * 128 + (g - 24) * 32, v, 1.f, hh);
            else if (g == 28) {
                f32x16 w = v; if (ri.lat) w = ropeA(v, tAr + gr * 8, tAc + gc * 8, hh);
                for (int h = 0; h < 8; ++h) store16(KA + ((size_t)(ri.b * 8 + h) * NK + ri.j) * 96 + 64, w, 1.f, hh);
            } else if (g < 45) {
                const int hv = (g - 29) >> 1, half = (g - 29) & 1;
                f32x16 w = v; if (ri.lat) w = ropeB(v, half ? tBc + gc * 16 : tBr + gr * 16, hh);
                store16(KB + ((size_t)(ri.b * 8 + hv) * NK + ri.j) * 64 + half * 32, w, 1.f, hh);
            } else if (g < 61) {
                const int idx = g - 45, h = idx >> 2, part = idx & 3;
                store16(VB + ((size_t)(ri.b * 4 + h) * NK + ri.j) * 128 + part * 32, v, 1.f, hh);
            }
        }
    }
};
struct EpiUQ {
    bf16_t* QA; const f32x2 *tAr, *tAc;
    DI void operator()(const f32x16& a0, const f32x16& a1, int row, int cbase, int hh) const {
        const RowInfo ri = rowinfo(row);
        const int gr = (ri.j >> 6) & 127, gc = ri.j & 63;
#pragma unroll
        for (int ni = 0; ni < 2; ++ni) {
            const int g = (cbase >> 5) + ni, h = g / 3, part = g - 3 * h;
            f32x16 w = ni ? a1 : a0;
            if (part == 2 && ri.lat) w = ropeA(ni ? a1 : a0, tAr + gr * 8, tAc + gc * 8, hh);
            store16(QA + ((size_t)(ri.b * 8 + h) * NK + ri.j) * 96 + part * 32, w, QA_SCALE, hh);
        }
    }
};
struct EpiUKV {
    bf16_t *KA, *VA;
    DI void operator()(const f32x16& a0, const f32x16& a1, int row, int cbase, int hh) const {
        const RowInfo ri = rowinfo(row);
#pragma unroll
        for (int ni = 0; ni < 2; ++ni) {
            const int g = (cbase >> 5) + ni, h = g >> 2, part = g & 3;
            const size_t tk = (size_t)(ri.b * 8 + h) * NK + ri.j;
            if (part < 2) store16(KA + tk * 96 + part * 32, ni ? a1 : a0, 1.f, hh);
            else store16(VA + tk * 64 + (part - 2) * 32, ni ? a1 : a0, 1.f, hh);
        }
    }
};
struct EpiOdIn {
    bf16_t *U, *QD, *KD, *VD;
    DI void operator()(const f32x16& a0, const f32x16& a1, int row, int cbase, int hh) const {
        const RowInfo ri = rowinfo(row);
#pragma unroll
        for (int ni = 0; ni < 2; ++ni) {
            const int g = (cbase >> 5) + ni;
            const f32x16& v = ni ? a1 : a0;
            if (g < 16) store16(U + (size_t)row * 512 + g * 32, v, 1.f, hh);
            else {
                const int gg = (g - 16) & 15, h = gg >> 1, half = gg & 1;
                const size_t off = ((size_t)(ri.b * 8 + h) * NK + ri.j) * 64 + half * 32;
                if (g < 32) store16(QD + off, v, QD_SCALE, hh);
                else if (g < 48) store16(KD + off, v, 1.f, hh);
                else store16(VD + off, v, 1.f, hh);
            }
        }
    }
};
struct EpiPool {
    bf16_t* CC; const float* pscale; int gidx;
    DI void operator()(const f32x16& a0, const f32x16& a1, int row, int cbase, int hh) const {
#pragma unroll
        for (int ni = 0; ni < 2; ++ni)
#pragma unroll
            for (int q4 = 0; q4 < 4; ++q4) {
                const int c = gidx * 128 + cbase + ni * 32 + 8 * q4 + 4 * hh;
                const f32x4 s = *(const f32x4*)(pscale + c);
                const f32x16& v = ni ? a1 : a0;
                u32x2 w; w.x = pk2(v[4 * q4] * s[0], v[4 * q4 + 1] * s[1]); w.y = pk2(v[4 * q4 + 2] * s[2], v[4 * q4 + 3] * s[3]);
                *(u32x2*)(CC + (size_t)row * 1024 + c) = w;
            }
    }
};

constexpr int ATT_LDS = 64 * (96 + 8) * 2 + 64 * (128 * 2 + 64);
constexpr int RPB_OFF = ATT_LDS;
constexpr int SMEM_BYTES = GEMM_LDS;

struct NAInfo { int qr; int kstart; };

template <int DQK, int DV, bool NA>
DI void attend(const bf16_t* __restrict__ Q, int q0, const bf16_t* __restrict__ Kb, const bf16_t* __restrict__ Vb,
               int s0, int n0, int s1, int n1, f32x16 (&o)[DV / 32], char* smem, NAInfo na) {
    constexpr int KS = (DQK + 8) * 2, VS = DV * 2 + 64;
    constexpr int KCH = DQK / 8, KN = (64 * KCH + NTHR - 1) / NTHR, VCH = DV / 8, VN = (64 * VCH + NTHR - 1) / NTHR;
    constexpr int NS = DQK / 16, NDT = DV / 32;
    const int tid = ltid(), lane = tid & 63, wave = tid >> 6;
    const int l31 = lane & 31, hh = lane >> 5, q = (lane & 15) >> 2, p = lane & 3, dblk = (lane >> 4) & 1;
    char* sK = smem; char* sV = smem + 64 * KS;
    bf16x8 qf[NS];
    {
        const bf16_t* qp = Q + (size_t)(q0 + wave * 32 + l31) * DQK + hh * 8;
#pragma unroll
        for (int s = 0; s < NS; ++s) qf[s] = *(const bf16x8*)(qp + s * 16);
    }
#pragma unroll
    for (int d = 0; d < NDT; ++d)
#pragma unroll
        for (int r = 0; r < 16; ++r) o[d][r] = 0.f;
    float m = -INFINITY, l = 0.f;
    u32x4 rk[KN], rv[VN];
    const int nt = n0 + n1;
    auto gload = [&](int t) {
        const int j0 = t < n0 ? s0 + t * 64 : s1 + (t - n0) * 64;
#pragma unroll
        for (int i = 0; i < KN; ++i) { const int id = tid + NTHR * i, row = id / KCH, ch = id - row * KCH; if (id < 64 * KCH) rk[i] = *(const u32x4*)(Kb + (size_t)(j0 + row) * DQK + ch * 8); }
#pragma unroll
        for (int i = 0; i < VN; ++i) { const int id = tid + NTHR * i, row = id / VCH, ch = id - row * VCH; if (id < 64 * VCH) rv[i] = *(const u32x4*)(Vb + (size_t)(j0 + row) * DV + ch * 8); }
    };
    gload(0);
    int qc = 0, cs = 0, rs = 0;
    if (NA) { qc = (wave & 1) * 32 + l31; cs = min(max(qc - 8, 0), 48); rs = min(max(na.qr - 4, 0), 120); }
    const float* rpb = (const float*)(smem + RPB_OFF);
    for (int t = 0; t < nt; ++t) {
        __syncthreads();
#pragma unroll
        for (int i = 0; i < KN; ++i) { const int id = tid + NTHR * i, row = id / KCH, ch = id - row * KCH; if (id < 64 * KCH) *(u32x4*)(sK + row * KS + ch * 16) = rk[i]; }
#pragma unroll
        for (int i = 0; i < VN; ++i) { const int id = tid + NTHR * i, row = id / VCH, ch = id - row * VCH; if (id < 64 * VCH) *(u32x4*)(sV + row * VS + ch * 16) = rv[i]; }
        __syncthreads();
        if (t + 1 < nt) gload(t + 1);
        __builtin_amdgcn_sched_barrier(0);
        bool active = true; int kr = 0;
        if (NA && t < n0) { kr = na.kstart + t; active = (kr >= rs) && (kr < rs + 8); }
        if (active) {
#pragma unroll 1
            for (int sub = 0; sub < 2; ++sub) {
                f32x16 st;
#pragma unroll
                for (int r = 0; r < 16; ++r) st[r] = 0.f;
#pragma unroll
                for (int s = 0; s < NS; ++s) {
                    const bf16x8 kf = *(const bf16x8*)(sK + (sub * 32 + l31) * KS + (s * 16 + hh * 8) * 2);
                    st = mfma32(kf, qf[s], st);
                }
                if (NA && t < n0) {
                    const float* brow = rpb + (kr - na.qr + 7) * 31 + 15 - qc;
#pragma unroll
                    for (int r = 0; r < 16; ++r) {
                        const int kc = sub * 32 + (r & 3) + 8 * (r >> 2) + 4 * hh;
                        const bool valid = (kc >= cs) && (kc < cs + 16);
                        const int bi = valid ? kc : cs;
                        const float bias = brow[bi];
                        st[r] = valid ? st[r] + bias : -INFINITY;
                    }
                }
                float mx = st[0];
#pragma unroll
                for (int r = 1; r < 16; ++r) mx = fmaxf(mx, st[r]);
                mx = fmaxf(mx, __shfl_xor(mx, 32));
                float muse;
                if (NA) {
                    const float mnew = fmaxf(m, mx);
                    muse = (mnew == -INFINITY) ? 0.f : mnew;
                    const float alpha = __builtin_amdgcn_exp2f(m - muse);
                    m = mnew;
                    l *= alpha;
#pragma unroll
                    for (int d = 0; d < NDT; ++d)
#pragma unroll
                        for (int r = 0; r < 16; ++r) o[d][r] *= alpha;
                } else {
                    if (__builtin_amdgcn_ballot_w64(mx > m + 8.f) != 0) {
                        const float mnew = fmaxf(m, mx);
                        const float alpha = __builtin_amdgcn_exp2f(m - mnew);
                        m = mnew;
                        l *= alpha;
#pragma unroll
                        for (int d = 0; d < NDT; ++d)
#pragma unroll
                            for (int r = 0; r < 16; ++r) o[d][r] *= alpha;
                    }
                    muse = m;
                }
                float rsum = 0.f;
#pragma unroll
                for (int r = 0; r < 16; ++r) { st[r] = __builtin_amdgcn_exp2f(st[r] - muse); rsum += st[r]; }
                l += rsum;
                bf16x8 pf[2];
#pragma unroll
                for (int s2 = 0; s2 < 2; ++s2) {
                    u32x4 w;
                    w.x = pk2(st[8 * s2], st[8 * s2 + 1]); w.y = pk2(st[8 * s2 + 2], st[8 * s2 + 3]);
                    w.z = pk2(st[8 * s2 + 4], st[8 * s2 + 5]); w.w = pk2(st[8 * s2 + 6], st[8 * s2 + 7]);
                    pf[s2] = __builtin_bit_cast(bf16x8, w);
                }
#pragma unroll
                for (int d = 0; d < NDT; ++d)
#pragma unroll
                    for (int s2 = 0; s2 < 2; ++s2) {
                        const char* vp = sV + (sub * 32 + 16 * s2 + 4 * hh + q) * VS + (d * 32 + dblk * 16 + 4 * p) * 2;
                        const bf16x8 vf = cat8(tr_read(vp), tr_read(vp + 8 * VS));
                        o[d] = mfma32(vf, pf[s2], o[d]);
                    }
            }
        }
    }
    l += __shfl_xor(l, 32);
    const float inv = 1.f / l;
#pragma unroll
    for (int d = 0; d < NDT; ++d)
#pragma unroll
        for (int r = 0; r < 16; ++r) o[d][r] *= inv;
}

DI int qrow_of(int b, int j) { return j < SEQ ? b * SEQ + j : RL + b * CTX + (j - SEQ); }

DI void even_attention_phase(const Params& P, char* smem) {
    char* ws = P.ws; char* hid = ws + OFF_HID; char* ob = (char*)P.out;
    const bf16_t* QA = (const bf16_t*)(hid + HOFF_QA); const bf16_t* KA = (const bf16_t*)(hid + HOFF_KA); const bf16_t* VA = (const bf16_t*)(hid + HOFF_VA);
    const bf16_t* QB = (const bf16_t*)(hid + HOFF_QB); const bf16_t* KB = (const bf16_t*)(ob + OOFF_KB); const bf16_t* VB = (const bf16_t*)(ob + OOFF_VB);
    bf16_t* CC = (bf16_t*)(ws + OFF_XM);
    const float lam = *(const float*)(ws + OFF_LAM);
    const float* gsub = P.in[18];
    const int lane = ltid() & 63, wave = ltid() >> 6, l31 = lane & 31, hh = lane >> 5;
    constexpr int NQT = 33, NDIFF = NB * 4 * NQT, NMLA = NB * 8 * NQT;
    NAInfo na; na.qr = 0; na.kstart = 0;
    unsigned* wq = (unsigned*)(ws + OFF_BAR + 128);
    volatile int* slot = (volatile int*)(smem + 36000);
    for (;;) {
        __syncthreads();
        if (ltid() == 0) *slot = (int)atomicAdd(wq, 1u);
        __syncthreads();
        const int u = *slot;
        if (u >= NDIFF + NMLA) break;
        if (u < NDIFF) {
            const int qt = u % NQT, bh = u / NQT, h = bh & 3, b = bh >> 2;
            const int q0 = qt < 32 ? qt * 256 : SEQ;
            const int s0 = qt < 32 ? 0 : SEQ, n0 = qt < 32 ? NK / 64 : CTX / 64;
            const bf16_t* V = VB + (size_t)(b * 4 + h) * NK * 128;
            f32x16 o[4];
            attend<64, 128, false>(QB + (size_t)(b * 8 + 2 * h) * NK * 64, q0, KB + (size_t)(b * 8 + 2 * h) * NK * 64, V, s0, n0, 0, 0, o, smem, na);
            const int row = qrow_of(b, q0 + wave * 32 + l31);
            bf16_t* dst = CC + (size_t)row * 1024 + 512 + h * 128;
#pragma unroll
            for (int d = 0; d < 4; ++d) store16(dst + d * 32, o[d], 1.f, hh);
            f32x16 o2[4];
            attend<64, 128, false>(QB + (size_t)(b * 8 + 2 * h + 1) * NK * 64, q0, KB + (size_t)(b * 8 + 2 * h + 1) * NK * 64, V, s0, n0, 0, 0, o2, smem, na);
            float ss = 0.f;
#pragma unroll
            for (int d = 0; d < 4; ++d)
#pragma unroll
                for (int q4 = 0; q4 < 4; ++q4) {
                    const u32x2 w = *(const volatile u32x2*)(dst + d * 32 + 8 * q4 + 4 * hh);
                    const float a0 = bflo(w.x) - lam * o2[d][4 * q4], a1 = bfhi(w.x) - lam * o2[d][4 * q4 + 1], a2 = bflo(w.y) - lam * o2[d][4 * q4 + 2], a3 = bfhi(w.y) - lam * o2[d][4 * q4 + 3];
                    o[d][4 * q4] = a0; o[d][4 * q4 + 1] = a1; o[d][4 * q4 + 2] = a2; o[d][4 * q4 + 3] = a3;
                    ss += (a0 * a0 + a1 * a1) + (a2 * a2 + a3 * a3);
                }
            ss += __shfl_xor(ss, 32);
            const float rn = rsqrtf(ss * (1.f / 128.f) + 1e-5f) * 0.8f;
#pragma unroll
            for (int d = 0; d < 4; ++d)
#pragma unroll
                for (int q4 = 0; q4 < 4; ++q4) {
                    const int c = d * 32 + 8 * q4 + 4 * hh;
                    const f32x4 g = *(const f32x4*)(gsub + c);
                    u32x2 w; w.x = pk2(o[d][4 * q4] * rn * g[0], o[d][4 * q4 + 1] * rn * g[1]); w.y = pk2(o[d][4 * q4 + 2] * rn * g[2], o[d][4 * q4 + 3] * rn * g[3]);
                    *(u32x2*)(dst + c) = w;
                }
        } else {
            const int v = u - NDIFF, qt = v % NQT, bh = v / NQT, h = bh & 7, b = bh >> 3;
            const int q0 = qt < 32 ? qt * 256 : SEQ;
            const int s0 = qt < 32 ? 0 : SEQ, n0 = qt < 32 ? NK / 64 : CTX / 64;
            f32x16 o[2];
            attend<96, 64, false>(QA + (size_t)(b * 8 + h) * NK * 96, q0, KA + (size_t)(b * 8 + h) * NK * 96, VA + (size_t)(b * 8 + h) * NK * 64, s0, n0, 0, 0, o, smem, na);
            const int row = qrow_of(b, q0 + wave * 32 + l31);
            bf16_t* dst = CC + (size_t)row * 1024 + h * 64;
#pragma unroll
            for (int d = 0; d < 2; ++d) store16(dst + d * 32, o[d], 1.f, hh);
        }
    }
}

DI void odd_attention_phase(const Params& P, char* smem) {
    char* ws = P.ws; char* hid = ws + OFF_HID;
    const bf16_t* QD = (const bf16_t*)(hid + HOFF_QD); const bf16_t* KD = (const bf16_t*)(hid + HOFF_KD); const bf16_t* VD = (const bf16_t*)(hid + HOFF_VD);
    bf16_t* CC = (bf16_t*)(ws + OFF_XM);
    const float* rpbg = P.in[23];
    const int lane = ltid() & 63, wave = ltid() >> 6, l31 = lane & 31, hh = lane >> 5;
    float* rpbl = (float*)(smem + RPB_OFF);
    constexpr int NU = NB * 8 * 32;
    for (int u = lbid(); u < NU; u += gridDim.x) {
        const int rp = u & 31, bh = u >> 5, h = bh & 7, b = bh >> 3;
        __syncthreads();
        for (int i = ltid(); i < 465; i += NTHR) rpbl[i] = rpbg[h * 465 + i] * LOG2E;
        const int r0 = rp * 4;
        NAInfo na; na.qr = r0 + (wave >> 1);
        const int rs0 = min(max(r0 - 4, 0), 120);
        na.kstart = min(rs0, 117);
        f32x16 o[2];
        const size_t hb = (size_t)(b * 8 + h) * NK * 64;
        attend<64, 64, true>(QD + hb, r0 * 64, KD + hb, VD + hb, na.kstart * 64, 11, SEQ, CTX / 64, o, smem, na);
        const int row = b * SEQ + r0 * 64 + wave * 32 + l31;
        bf16_t* dst = CC + (size_t)row * 1024 + 512 + h * 64;
#pragma unroll
        for (int d = 0; d < 2; ++d) store16(dst + d * 32, o[d], 1.f, hh);
    }
}

DI void cvt8(bf16_t* dst, const float* src, float sc) {
    const f32x4 a = *(const f32x4*)src, b = *(const f32x4*)(src + 4);
    u32x4 w; w.x = pk2(a[0] * sc, a[1] * sc); w.y = pk2(a[2] * sc, a[3] * sc); w.z = pk2(b[0] * sc, b[1] * sc); w.w = pk2(b[2] * sc, b[3] * sc);
    *(u32x4*)dst = w;
}
DI void cvt_rows(bf16_t* dst, int ldd, const float* src, int lds_, int rows, int cols_src, const float* rowscale, size_t gtid, size_t gstride) {
    const int c8 = ldd >> 3; const size_t n = (size_t)rows * c8;
    for (size_t i = gtid; i < n; i += gstride) {
        const int k = (int)(i / c8), c = (int)(i % c8) * 8;
        if (c < cols_src) cvt8(dst + (size_t)k * ldd + c, src + (size_t)k * lds_ + c, rowscale ? rowscale[k] : 1.f);
        else { u32x4 z = {0u, 0u, 0u, 0u}; *(u32x4*)(dst + (size_t)k * ldd + c) = z; }
    }
}

DI void phase_pro_a(const Params& P, char* smem) {
    char* ws = P.ws;
    const size_t gtid = (size_t)lbid() * NTHR + ltid(), gstride = (size_t)gridDim.x * NTHR;
    for (int lf = 0; lf < 4; ++lf) {
        const float* sg = P.in[8] + (size_t)lf * 1024 * DFF; const float* su = P.in[9] + (size_t)lf * 1024 * DFF;
        bf16_t* dst = (bf16_t*)(ws + OFF_WGU + lf * SZ_WGU);
        for (size_t i = gtid; i < 1024ull * 704; i += gstride) {
            const int k = (int)(i / 704), n = (int)(i % 704) * 8, grp = n >> 6, w = n & 63;
            const float* src = ((w < 32) ? sg : su) + (size_t)k * DFF + grp * 32 + (w & 31);
            cvt8(dst + (size_t)k * 5632 + n, src, 1.f);
        }
        cvt_rows((bf16_t*)(ws + OFF_WD + lf * SZ_WD), 1024, P.in[10] + (size_t)lf * DFF * 1024, 1024, DFF, 1024, nullptr, gtid, gstride);
    }
    cvt_rows((bf16_t*)(ws + OFF_EVIN), 2048, P.in[11], 1952, 1024, 1952, nullptr, gtid, gstride);
    cvt_rows((bf16_t*)(ws + OFF_EVOUT), 1024, P.in[12], 1024, 1024, 1024, nullptr, gtid, gstride);
    cvt_rows((bf16_t*)(ws + OFF_UQ), 768, P.in[15], 768, 256, 768, P.in[13], gtid, gstride);
    cvt_rows((bf16_t*)(ws + OFF_UKV), 1024, P.in[16], 1024, 128, 1024, P.in[14], gtid, gstride);
    cvt_rows((bf16_t*)(ws + OFF_ODIN), 2048, P.in[19], 2048, 1024, 2048, nullptr, gtid, gstride);
    cvt_rows((bf16_t*)(ws + OFF_ODOUT), 1024, P.in[20], 1024, 1024, 1024, nullptr, gtid, gstride);
    for (size_t i = gtid; i < 512ull * 64; i += gstride) {
        const int k = (int)(i >> 6), n = (int)(i & 63) * 8;
        bf16_t* d = (bf16_t*)(ws + OFF_POOL) + (size_t)k * 512 + n;
        if ((k >> 7) == (n >> 7)) cvt8(d, P.in[21] + (size_t)k * 128 + (n & 127), 1.f);
        else { u32x4 z = {0u, 0u, 0u, 0u}; *(u32x4*)d = z; }
    }
    if (gtid < 128 * 8) { const int r = (int)gtid >> 3, i = (int)gtid & 7; const float inv = exp2f(-(float)i * (13.287712379549449f / 8.f)); float rev = (float)r * inv * 0.15915494309189535f; rev -= floorf(rev);
        f32x2 v = {__builtin_amdgcn_cosf(rev), __builtin_amdgcn_sinf(rev)}; ((f32x2*)(ws + OFF_TAR))[gtid] = v; if (r < 64) ((f32x2*)(ws + OFF_TAC))[gtid] = v; }
    if (gtid < 128 * 16) { const int r = (int)gtid >> 4, i = (int)gtid & 15; const float inv = exp2f(-(float)i * (13.287712379549449f / 16.f)); float rev = (float)r * inv * 0.15915494309189535f; rev -= floorf(rev);
        f32x2 v = {__builtin_amdgcn_cosf(rev), __builtin_amdgcn_sinf(rev)}; ((f32x2*)(ws + OFF_TBR))[gtid] = v; if (r < 64) ((f32x2*)(ws + OFF_TBC))[gtid] = v; }
    if (gtid == 0) {
        const float* lv = P.in[17]; float a = 0.f, b = 0.f;
        for (int i = 0; i < 64; ++i) { a += lv[i] * lv[64 + i]; b += lv[128 + i] * lv[192 + i]; }
        *(float*)(ws + OFF_LAM) = expf(a) - expf(b) + 0.2f;
    }
    float* sc = (float*)smem;
    float* red = sc + 5 * 1024;
    const int tid = ltid(), jj = tid & 31, ig = tid >> 5;
    __syncthreads();
    for (int i = tid; i < 5 * 1024; i += NTHR) { const float v = i < 4096 ? P.in[1][i] : P.in[3][i - 4096]; sc[i] = v / (1.f + expf(-v)); }
    __syncthreads();
    for (int u = lbid(); u < 576; u += gridDim.x) {
        const int l = u / 288, j0 = (u % 288) * 32;
        float a[5] = {0.f, 0.f, 0.f, 0.f, 0.f};
        const float* w = P.in[4] + (size_t)l * 1024 * 9216 + (size_t)(ig * 64) * 9216 + j0 + jj;
        for (int i0 = 0; i0 < 64; i0 += 8) {
            float wv[8];
#pragma unroll
            for (int k = 0; k < 8; ++k) wv[k] = w[(size_t)(i0 + k) * 9216];
#pragma unroll
            for (int k = 0; k < 8; ++k)
#pragma unroll
                for (int s2 = 0; s2 < 5; ++s2) a[s2] += sc[s2 * 1024 + ig * 64 + i0 + k] * wv[k];
        }
#pragma unroll
        for (int s2 = 0; s2 < 5; ++s2) red[(ig * 5 + s2) * 32 + jj] = a[s2];
        __syncthreads();
        if (tid < 160) {
            const int s2 = tid >> 5, j = tid & 31;
            float v = P.in[5][l * 9216 + j0 + j];
#pragma unroll
            for (int g = 0; g < 16; ++g) v += red[(g * 5 + s2) * 32 + j];
            ((float*)(ws + OFF_MOD))[(size_t)(l * 5 + s2) * 9216 + j0 + j] = v;
        }
        __syncthreads();
    }
}

DI void phase_pro_b(const Params& P) {
    char* ws = P.ws; bf16_t* XM = (bf16_t*)(ws + OFF_XM); const float* MOD = (const float*)(ws + OFF_MOD);
    const size_t gtid = (size_t)lbid() * NTHR + ltid(), gstride = (size_t)gridDim.x * NTHR;
    for (size_t i = gtid; i < (size_t)RT * 128; i += gstride) {
        const int row = (int)(i >> 7), c = (int)(i & 127) * 8;
        const float* src = row < RL ? P.in[0] + (size_t)row * 1024 + c : P.in[2] + (size_t)(row - RL) * 1024 + c;
        const int s = row < RL ? (row >> 13) : 4;
        const float* sh = MOD + (size_t)s * 9216 + c; const float* scl = sh + 1024;
        unsigned w[4];
#pragma unroll
        for (int hf = 0; hf < 2; ++hf) {
            const f32x4 x = *(const f32x4*)(src + 4 * hf), a = *(const f32x4*)(sh + 4 * hf), g = *(const f32x4*)(scl + 4 * hf);
            w[2 * hf] = pk2(x[0] * (1.f + g[0]) + a[0], x[1] * (1.f + g[1]) + a[1]);
            w[2 * hf + 1] = pk2(x[2] * (1.f + g[2]) + a[2], x[3] * (1.f + g[3]) + a[3]);
        }
        u32x4 o = {w[0], w[1], w[2], w[3]};
        *(u32x4*)(XM + (size_t)row * 1024 + c) = o;
    }
}

DI void phase_ln(const Params& P, int l, int which, int lnext, int mshift, bool final_) {
    char* ws = P.ws; float* X = (float*)(ws + OFF_X); bf16_t* XM = (bf16_t*)(ws + OFF_XM); const float* MOD = (const float*)(ws + OFF_MOD);
    const float* g = P.in[6] + (l * 3 + which) * 1024; const float* bb = P.in[7] + (l * 3 + which) * 1024;
    const int lane = ltid() & 63, wave = ltid() >> 6;
    const int nrows = final_ ? RL : RT;
    for (int row = lbid() * NWAVE + wave; row < nrows; row += gridDim.x * NWAVE) {
        float* xp = X + (size_t)row * 1024;
        f32x4 v[4]; float s = 0.f;
#pragma unroll
        for (int i = 0; i < 4; ++i) { v[i] = *(const f32x4*)(xp + (i * 64 + lane) * 4); s += (v[i][0] + v[i][1]) + (v[i][2] + v[i][3]); }
#pragma unroll
        for (int o = 32; o >= 1; o >>= 1) s += __shfl_xor(s, o);
        const float mu = s * (1.f / 1024.f);
        float qv = 0.f;
#pragma unroll
        for (int i = 0; i < 4; ++i)
#pragma unroll
            for (int j = 0; j < 4; ++j) { const float d = v[i][j] - mu; qv += d * d; }
#pragma unroll
        for (int o = 32; o >= 1; o >>= 1) qv += __shfl_xor(qv, o);
        const float rstd = rsqrtf(qv * (1.f / 1024.f) + 1e-6f);
        const int sidx = row < RL ? (row >> 13) : 4;
        const float* sh = MOD + (size_t)(lnext * 5 + sidx) * 9216 + mshift * 1024; const float* scl = sh + 1024;
#pragma unroll
        for (int i = 0; i < 4; ++i) {
            const int c = (i * 64 + lane) * 4;
            const f32x4 gg = *(const f32x4*)(g + c), b4 = *(const f32x4*)(bb + c);
            f32x4 y;
#pragma unroll
            for (int j = 0; j < 4; ++j) y[j] = (v[i][j] - mu) * rstd * gg[j] + b4[j];
            if (final_) { *(f32x4*)(P.out + (size_t)row * 1024 + c) = y; }
            else {
                *(f32x4*)(xp + c) = y;
                const f32x4 a = *(const f32x4*)(sh + c), sg = *(const f32x4*)(scl + c);
                u32x2 w; w.x = pk2(y[0] * (1.f + sg[0]) + a[0], y[1] * (1.f + sg[1]) + a[1]); w.y = pk2(y[2] * (1.f + sg[2]) + a[2], y[3] * (1.f + sg[3]) + a[3]);
                *(u32x2*)(XM + (size_t)row * 1024 + c) = w;
            }
        }
    }
}

DI void phase_ev_rms(const Params& P) {
    char* ws = P.ws; bf16_t* QN = (bf16_t*)(ws + OFF_HID + HOFF_QN); bf16_t* KVN = (bf16_t*)((char*)P.out + OOFF_KVN);
    const int lane = ltid() & 63, wave = ltid() >> 6;
    for (int row = lbid() * NWAVE + wave; row < RT; row += gridDim.x * NWAVE) {
        {
            u32x2* p = (u32x2*)(QN + (size_t)row * 256 + lane * 4); const u32x2 w = *p;
            float a = bflo(w.x), b = bfhi(w.x), c = bflo(w.y), d = bfhi(w.y);
            float s = a * a + b * b + c * c + d * d;
#pragma unroll
            for (int o = 32; o >= 1; o >>= 1) s += __shfl_xor(s, o);
            const float r = rsqrtf(s * (1.f / 256.f) + 1e-6f);
            u32x2 o2; o2.x = pk2(a * r, b * r); o2.y = pk2(c * r, d * r); *p = o2;
        }
        {
            unsigned* p = (unsigned*)(KVN + (size_t)row * 128 + lane * 2); const unsigned w = *p;
            float a = bflo(w), b = bfhi(w);
            float s = a * a + b * b;
#pragma unroll
            for (int o = 32; o >= 1; o >>= 1) s += __shfl_xor(s, o);
            const float r = rsqrtf(s * (1.f / 128.f) + 1e-6f);
            *p = pk2(a * r, b * r);
        }
    }
}

DI void phase_od_pool(const Params& P) {
    char* ws = P.ws; const bf16_t* U = (const bf16_t*)(ws + OFF_HID + HOFF_U); bf16_t* PL = (bf16_t*)(ws + OFF_HID + HOFF_PL);
    const size_t gtid = (size_t)lbid() * NTHR + ltid(), gstride = (size_t)gridDim.x * NTHR;
    for (size_t i = gtid; i < (size_t)RT * 64; i += gstride) {
        const int row = (int)(i >> 6), c = (int)(i & 63) * 8, grp = c >> 7;
        const int w = 2 << grp, left = w >> 1, right = w - 1 - left;
        int base, n, t;
        if (row < RL) { base = row & ~8191; n = SEQ; t = row & 8191; } else { const int rc = row - RL; base = RL + (rc & ~255); n = CTX; t = rc & 255; }
        const int lo = max(t - left, 0), hi = min(t + right + 1, n);
        float acc[8] = {0.f, 0.f, 0.f, 0.f, 0.f, 0.f, 0.f, 0.f};
        for (int tt = lo; tt < hi; ++tt) {
            const u32x4 v = *(const u32x4*)(U + (size_t)(base + tt) * 512 + c);
            acc[0] += bflo(v.x); acc[1] += bfhi(v.x); acc[2] += bflo(v.y); acc[3] += bfhi(v.y); acc[4] += bflo(v.z); acc[5] += bfhi(v.z); acc[6] += bflo(v.w); acc[7] += bfhi(v.w);
        }
        const float ic = 1.f / (float)(hi - lo);
        const u32x4 s = *(const u32x4*)(U + (size_t)row * 512 + c);
        u32x4 o;
        o.x = pk2(acc[0] * ic - bflo(s.x), acc[1] * ic - bfhi(s.x)); o.y = pk2(acc[2] * ic - bflo(s.y), acc[3] * ic - bfhi(s.y));
        o.z = pk2(acc[4] * ic - bflo(s.z), acc[5] * ic - bfhi(s.z)); o.w = pk2(acc[6] * ic - bflo(s.w), acc[7] * ic - bfhi(s.w));
        *(u32x4*)(PL + (size_t)row * 512 + c) = o;
    }
}

constexpr int NPHASE = 25;

DI void run_phase(const Params& P, int ph, char* smem) {
    char* ws = P.ws; char* hid = ws + OFF_HID; char* ob = (char*)P.out;
    float* X = (float*)(ws + OFF_X); bf16_t* XM = (bf16_t*)(ws + OFF_XM); bf16_t* HID = (bf16_t*)hid;
    const float* MOD = (const float*)(ws + OFF_MOD);
    if (ph == 0) { phase_pro_a(P, smem); return; }
    if (ph == 1) { phase_pro_b(P); return; }
    int l, op;
    if (ph < 14) { l = 0; op = ph - 2; } else { l = 1; op = ph - 14; if (op >= 6) op += 1; }
    const float* modl = MOD + (size_t)l * 5 * 9216;
    switch (op) {
    case 0: case 9: {
        const int f = op == 0 ? 0 : 1;
        EpiSwiglu e{HID};
        gemm_phase(XM, 1024, (const bf16_t*)(ws + OFF_WGU + (l * 2 + f) * SZ_WGU), 5632, 5632, 1024, e, smem);
    } break;
    case 1: case 10: {
        const int f = op == 1 ? 0 : 1;
        const bool first = (l == 0 && f == 0);
        EpiResid e{first ? P.in[0] : X, first ? P.in[2] : X + (size_t)RL * 1024, X, modl + (f == 0 ? 2 : 8) * 1024, 0.5f};
        gemm_phase(HID, DFF, (const bf16_t*)(ws + OFF_WD + (l * 2 + f) * SZ_WD), 1024, 1024, DFF, e, smem);
    } break;
    case 2: phase_ln(P, l, 0, l, 3, false); break;
    case 3: {
        if (l == 0) {
            EpiEvIn e{(bf16_t*)(hid + HOFF_QN), (bf16_t*)(hid + HOFF_QB), (bf16_t*)(ob + OOFF_KVN), (bf16_t*)(hid + HOFF_KA), (bf16_t*)(ob + OOFF_KB), (bf16_t*)(ob + OOFF_VB),
                      (const f32x2*)(ws + OFF_TAR), (const f32x2*)(ws + OFF_TAC), (const f32x2*)(ws + OFF_TBR), (const f32x2*)(ws + OFF_TBC)};
            gemm_phase(XM, 1024, (const bf16_t*)(ws + OFF_EVIN), 2048, 2048, 1024, e, smem);
        } else {
            EpiOdIn e{(bf16_t*)(hid + HOFF_U), (bf16_t*)(hid + HOFF_QD), (bf16_t*)(hid + HOFF_KD), (bf16_t*)(hid + HOFF_VD)};
            gemm_phase(XM, 1024, (const bf16_t*)(ws + OFF_ODIN), 2048, 2048, 1024, e, smem);
        }
    } break;
    case 4: if (l == 0) phase_ev_rms(P); else phase_od_pool(P); break;
    case 5: {
        if (l == 0) {
            EpiUQ e1{(bf16_t*)(hid + HOFF_QA), (const f32x2*)(ws + OFF_TAR), (const f32x2*)(ws + OFF_TAC)};
            gemm_phase((const bf16_t*)(hid + HOFF_QN), 256, (const bf16_t*)(ws + OFF_UQ), 768, 768, 256, e1, smem);
            EpiUKV e2{(bf16_t*)(hid + HOFF_KA), (bf16_t*)(hid + HOFF_VA)};
            gemm_phase((const bf16_t*)(ob + OOFF_KVN), 128, (const bf16_t*)(ws + OFF_UKV), 1024, 1024, 128, e2, smem);
        } else {
            odd_attention_phase(P, smem);
            EpiPool e{XM, P.in[22], 0};
            gemm_phase((const bf16_t*)(hid + HOFF_PL), 512, (const bf16_t*)(ws + OFF_POOL), 512, 512, 512, e, smem);
        }
    } break;
    case 6: even_attention_phase(P, smem); break;
    case 7: {
        EpiResid e{X, X + (size_t)RL * 1024, X, modl + 5 * 1024, 1.f};
        gemm_phase(XM, 1024, (const bf16_t*)(ws + (l == 0 ? OFF_EVOUT : OFF_ODOUT)), 1024, 1024, 1024, e, smem);
    } break;
    case 8: phase_ln(P, l, 1, l, 6, false); break;
    case 11: if (l == 0) phase_ln(P, 0, 2, 1, 0, false); else phase_ln(P, 1, 2, 1, 0, true); break;
    default: break;
    }
}

DI void grid_barrier(unsigned* ctr, unsigned target) {
    __syncthreads();
    if (threadIdx.x == 0) {
        __threadfence();
        __hip_atomic_fetch_add(ctr, 1u, __ATOMIC_RELEASE, __HIP_MEMORY_SCOPE_AGENT);
        while (__hip_atomic_load(ctr, __ATOMIC_RELAXED, __HIP_MEMORY_SCOPE_AGENT) < target) __builtin_amdgcn_s_sleep(8);
        __threadfence();
    }
    __syncthreads();
}

__global__ void __launch_bounds__(NTHR, 2) mega(Params P, int ph_lo, int ph_hi) {
    extern __shared__ __attribute__((aligned(16))) char smem[];
    unsigned nsync = 0;
    for (int ph = ph_lo; ph < ph_hi; ++ph) {
        run_phase(P, ph, smem);
        if (ph + 1 < ph_hi) {
            if (ph == ph_lo) cg::this_grid().sync();
            else { ++nsync; grid_barrier((unsigned*)(P.ws + OFF_BAR), nsync * gridDim.x); }
        }
    }
}

extern "C" void kernel_launch(void* const* d_in, const int* in_sizes, int n_in, void* d_out, int out_size, void* d_ws, size_t ws_size, hipStream_t stream) {
    if (ws_size < WS_NEED) { fprintf(stderr, "workspace too small: %zu < %zu\n", ws_size, (size_t)WS_NEED); return; }
    Params P{};
    for (int i = 0; i < 24; ++i) P.in[i] = (const float*)d_in[i];
    P.out = (float*)d_out; P.ws = (char*)d_ws;
    static int grid_blocks = 0;
    if (!grid_blocks) {
        int dev = 0, cus = 0, per_cu = 0;
        hipGetDevice(&dev);
        hipDeviceGetAttribute(&cus, hipDeviceAttributeMultiprocessorCount, dev);
        hipFuncSetAttribute((const void*)mega, hipFuncAttributeMaxDynamicSharedMemorySize, SMEM_BYTES);
        hipOccupancyMaxActiveBlocksPerMultiprocessor(&per_cu, mega, NTHR, SMEM_BYTES);
        if (per_cu < 1) per_cu = 1;
        if (per_cu > 1) per_cu = 1;
        grid_blocks = cus * per_cu;
    }
#if COOP
    hipMemsetAsync((char*)d_ws + OFF_BAR, 0, 256, stream);
    int lo = 0, hi = NPHASE;
    void* args[] = {&P, &lo, &hi};
    hipError_t e = hipLaunchCooperativeKernel((void*)mega, dim3(grid_blocks), dim3(NTHR), args, SMEM_BYTES, stream);
    if (e != hipSuccess) fprintf(stderr, "cooperative launch failed: %s (grid %d)\n", hipGetErrorString(e), grid_blocks);
#else
    for (int ph = 0; ph < NPHASE; ++ph) mega<<<grid_blocks, NTHR, SMEM_BYTES, stream>>>(P, ph, ph + 1);
#endif
}
```

```cpp
#include <hip/hip_runtime.h>
#include <hip/hip_cooperative_groups.h>
#include <cstdio>
#include <cstdint>
namespace cg = cooperative_groups;

#ifndef COOP
#define COOP 1
#endif

#define DI __device__ __forceinline__
typedef unsigned short bf16_t;
typedef short bf16x8 __attribute__((ext_vector_type(8)));
typedef short s16x4 __attribute__((ext_vector_type(4)));
typedef __bf16 bfx4 __attribute__((ext_vector_type(4)));
typedef __bf16 bfx2 __attribute__((ext_vector_type(2)));
typedef float f32x2 __attribute__((ext_vector_type(2)));
typedef float f32x4 __attribute__((ext_vector_type(4)));
typedef float f32x16 __attribute__((ext_vector_type(16)));
typedef unsigned u32x2 __attribute__((ext_vector_type(2)));
typedef unsigned u32x4 __attribute__((ext_vector_type(4)));
#define LDS_AS __attribute__((address_space(3)))

constexpr int DM = 1024, NB = 4, SEQ = 8192, CTX = 256, DFF = 2816;
constexpr int RL = NB * SEQ, RC = NB * CTX, RT = RL + RC;
constexpr int NK = SEQ + CTX;
constexpr float ALPHA = 1.41421356237f;
constexpr float LOG2E = 1.4426950408889634f;
constexpr float QA_SCALE = 0.10206207261596575f * LOG2E;
constexpr float QB_SCALE = 0.125f * LOG2E;
constexpr float QD_SCALE = 0.125f * LOG2E;
constexpr int NTHR = 512, NWAVE = NTHR / 64;

constexpr size_t SZ_WGU = 1024ull * 5632 * 2, SZ_WD = 2816ull * 1024 * 2;
constexpr size_t OFF_WGU = 0;
constexpr size_t OFF_WD = OFF_WGU + 4 * SZ_WGU;
constexpr size_t OFF_EVIN = OFF_WD + 4 * SZ_WD;
constexpr size_t OFF_EVOUT = OFF_EVIN + 1024ull * 2048 * 2;
constexpr size_t OFF_UQ = OFF_EVOUT + 1024ull * 1024 * 2;
constexpr size_t OFF_UKV = OFF_UQ + 256ull * 768 * 2;
constexpr size_t OFF_ODIN = OFF_UKV + 128ull * 1024 * 2;
constexpr size_t OFF_ODOUT = OFF_ODIN + 1024ull * 2048 * 2;
constexpr size_t OFF_POOL = OFF_ODOUT + 1024ull * 1024 * 2;
constexpr size_t OFF_MOD = OFF_POOL + 512ull * 512 * 2;
constexpr size_t OFF_TAR = OFF_MOD + 2ull * 5 * 9216 * 4;
constexpr size_t OFF_TAC = OFF_TAR + 128 * 8 * 8;
constexpr size_t OFF_TBR = OFF_TAC + 64 * 8 * 8;
constexpr size_t OFF_TBC = OFF_TBR + 128 * 16 * 8;
constexpr size_t OFF_LAM = OFF_TBC + 64 * 16 * 8;
constexpr size_t OFF_BAR = OFF_LAM + 256;
constexpr size_t OFF_X = OFF_BAR + 256;
constexpr size_t OFF_XM = OFF_X + (size_t)RT * 1024 * 4;
constexpr size_t OFF_HID = OFF_XM + (size_t)RT * 1024 * 2;
constexpr size_t WS_NEED = OFF_HID + (size_t)RT * DFF * 2;
constexpr size_t SZ_H96 = (size_t)NB * 8 * NK * 96 * 2, SZ_H64 = (size_t)NB * 8 * NK * 64 * 2;
constexpr size_t HOFF_QA = 0, HOFF_KA = SZ_H96, HOFF_VA = 2 * SZ_H96, HOFF_QB = HOFF_VA + SZ_H64, HOFF_QN = HOFF_QB + SZ_H64;
static_assert(HOFF_QN + (size_t)RT * 256 * 2 <= (size_t)RT * DFF * 2, "HID region overflow");
constexpr size_t HOFF_U = 0, HOFF_PL = SZ_H64, HOFF_QD = 2 * SZ_H64, HOFF_KD = 3 * SZ_H64, HOFF_VD = 4 * SZ_H64;
constexpr size_t OOFF_KB = 0, OOFF_VB = SZ_H64, OOFF_KVN = 2 * SZ_H64;
static_assert(OOFF_KVN + (size_t)RT * 128 * 2 <= (size_t)RL * 1024 * 4, "d_out region overflow");

struct Params {
    const float* in[24];
    float* out;
    char* ws;
};

DI int ltid() { int t = threadIdx.x; asm volatile("" : "+v"(t)); return t; }
DI int lbid() { int t = blockIdx.x; asm volatile("" : "+s"(t)); return t; }
DI unsigned pk2(float a, float b) { f32x2 v = {a, b}; bfx2 r = __builtin_convertvector(v, bfx2); return __builtin_bit_cast(unsigned, r); }
DI float bf2f(unsigned short u) { return __uint_as_float(((unsigned)u) << 16); }
DI float bflo(unsigned u) { return __uint_as_float(u << 16); }
DI float bfhi(unsigned u) { return __uint_as_float(u & 0xffff0000u); }
DI float silu_f(float x) { return x * __builtin_amdgcn_rcpf(1.f + __expf(-x)); }
DI f32x16 mfma32(bf16x8 a, bf16x8 b, f32x16 c) { return __builtin_amdgcn_mfma_f32_32x32x16_bf16(a, b, c, 0, 0, 0); }
DI s16x4 tr_read(const char* p) { bfx4 r = __builtin_amdgcn_ds_read_tr16_b64_v4bf16((LDS_AS bfx4*)p); return __builtin_bit_cast(s16x4, r); }
DI float xor32_max(float x) { const unsigned u = __float_as_uint(x); auto r = __builtin_amdgcn_permlane32_swap(u, u, false, false); return fmaxf(__uint_as_float(r[0]), __uint_as_float(r[1])); }
DI float xor32_sum(float x) { const unsigned u = __float_as_uint(x); auto r = __builtin_amdgcn_permlane32_swap(u, u, false, false); return __uint_as_float(r[0]) + __uint_as_float(r[1]); }
DI bf16x8 cat8(s16x4 lo, s16x4 hi) { return __builtin_shufflevector(lo, hi, 0, 1, 2, 3, 4, 5, 6, 7); }

struct RowInfo { int b, j, s; bool lat; };
DI RowInfo rowinfo(int row) {
    RowInfo r;
    if (row < RL) { r.b = row >> 13; r.j = row & 8191; r.s = r.b; r.lat = true; }
    else { int rc = row - RL; r.b = rc >> 8; r.j = 8192 + (rc & 255); r.s = 4; r.lat = false; }
    return r;
}
DI void store16(bf16_t* dst32, const f32x16& v, float sc, int hh) {
#pragma unroll
    for (int q4 = 0; q4 < 4; ++q4) {
        u32x2 w; w.x = pk2(v[4 * q4] * sc, v[4 * q4 + 1] * sc); w.y = pk2(v[4 * q4 + 2] * sc, v[4 * q4 + 3] * sc);
        *(u32x2*)(dst32 + 8 * q4 + 4 * hh) = w;
    }
}
DI f32x16 ropeB(const f32x16& v, const f32x2* tab, int hh) {
    f32x16 o;
#pragma unroll
    for (int r = 0; r < 8; ++r) {
        const int i = (r & 3) + 8 * (r >> 2) + 4 * hh;
        const f32x2 cs = tab[i];
        o[r] = v[r] * cs.x - v[r + 8] * cs.y;
        o[r + 8] = v[r + 8] * cs.x + v[r] * cs.y;
    }
    return o;
}
DI f32x16 ropeA(const f32x16& v, const f32x2* tr, const f32x2* tc, int hh) {
    f32x16 o;
#pragma unroll
    for (int r = 0; r < 4; ++r) {
        const int i = 4 * hh + r;
        const f32x2 a = tr[i], c = tc[i];
        o[r] = v[r] * a.x - v[r + 4] * a.y;
        o[r + 4] = v[r + 4] * a.x + v[r] * a.y;
        o[8 + r] = v[8 + r] * c.x - v[12 + r] * c.y;
        o[12 + r] = v[12 + r] * c.x + v[8 + r] * c.y;
    }
    return o;
}

constexpr int GA_S = 144, GB_S = 576;
constexpr int GSTAGE = 256 * GA_S + 64 * GB_S;
constexpr int GEMM_LDS = 2 * GSTAGE;

template <int BM, class Epi>
DI void gemm_tile(const bf16_t* __restrict__ A, int lda, const bf16_t* __restrict__ B, int ldb, int K, int row0, int col0, const Epi& epi, char* smem) {
    constexpr int MI = BM / 64, NA_ = BM / 64;
    const int tid = ltid(), lane = tid & 63, wave = tid >> 6, wm = wave >> 2, wn = wave & 3;
    const int l31 = lane & 31, hh = lane >> 5, q = (lane & 15) >> 2, p = lane & 3, nblk = (lane >> 4) & 1;
    f32x16 acc[MI][2];
#pragma unroll
    for (int i = 0; i < MI; ++i)
#pragma unroll
        for (int j = 0; j < 2; ++j)
#pragma unroll
            for (int r = 0; r < 16; ++r) acc[i][j][r] = 0.f;
    u32x4 ra[NA_], rb[4];
    const bf16_t* ag = A + (size_t)(row0 + (tid >> 3)) * lda + (tid & 7) * 8;
    const bf16_t* bg = B + (size_t)(tid >> 5) * ldb + col0 + (tid & 31) * 8;
    const int aw = (tid >> 3) * GA_S + (tid & 7) * 16, bw = BM * GA_S + (tid >> 5) * GB_S + (tid & 31) * 16;
    const int nk = K >> 6;
    const int xoff = (wm * (BM / 2) + l31) * GA_S + hh * 16;
    const int woff = BM * GA_S + (hh * 8 + q) * GB_S + (wn * 64 + nblk * 16 + 4 * p) * 2;
#pragma unroll
    for (int i = 0; i < NA_; ++i) ra[i] = *(const u32x4*)(ag + (size_t)(64 * i) * lda);
#pragma unroll
    for (int i = 0; i < 4; ++i) rb[i] = *(const u32x4*)(bg + (size_t)(16 * i) * ldb);
    __syncthreads();
#pragma unroll
    for (int i = 0; i < NA_; ++i) *(u32x4*)(smem + aw + 64 * i * GA_S) = ra[i];
#pragma unroll
    for (int i = 0; i < 4; ++i) *(u32x4*)(smem + bw + 16 * i * GB_S) = rb[i];
    if (nk > 1) {
#pragma unroll
        for (int i = 0; i < NA_; ++i) ra[i] = *(const u32x4*)(ag + 64 + (size_t)(64 * i) * lda);
#pragma unroll
        for (int i = 0; i < 4; ++i) rb[i] = *(const u32x4*)(bg + (size_t)(64 + 16 * i) * ldb);
    }
    __syncthreads();
    for (int kt = 0; kt < nk; ++kt) {
        const char* cur = smem + (kt & 1) * GSTAGE;
        char* nxt = smem + ((kt & 1) ^ 1) * GSTAGE;
        const bool w1 = kt + 1 < nk, l2 = kt + 2 < nk;
        const bf16_t* a2 = ag + (size_t)(kt + 2) * 64; const bf16_t* b2 = bg + (size_t)(kt + 2) * 64 * ldb;
#pragma unroll
        for (int s = 0; s < 4; ++s) {
            bf16x8 xf[MI], wf[2];
#pragma unroll
            for (int mi = 0; mi < MI; ++mi) xf[mi] = *(const bf16x8*)(cur + xoff + mi * 32 * GA_S + s * 32);
#pragma unroll
            for (int ni = 0; ni < 2; ++ni) {
                const char* wp = cur + woff + s * 16 * GB_S + ni * 64;
                wf[ni] = cat8(tr_read(wp), tr_read(wp + 4 * GB_S));
            }
#pragma unroll
            for (int mi = 0; mi < MI; ++mi)
#pragma unroll
                for (int ni = 0; ni < 2; ++ni) acc[mi][ni] = mfma32(wf[ni], xf[mi], acc[mi][ni]);
            if (w1) {
                if (s < NA_) *(u32x4*)(nxt + aw + 64 * s * GA_S) = ra[s];
                *(u32x4*)(nxt + bw + 16 * s * GB_S) = rb[s];
            }
            if (l2) {
                if (s < NA_) ra[s] = *(const u32x4*)(a2 + (size_t)(64 * s) * lda);
                rb[s] = *(const u32x4*)(b2 + (size_t)(16 * s) * ldb);
            }
            __builtin_amdgcn_sched_barrier(0);
        }
        __syncthreads();
    }
#pragma unroll
    for (int mi = 0; mi < MI; ++mi) epi(acc[mi][0], acc[mi][1], row0 + wm * (BM / 2) + mi * 32 + l31, col0 + wn * 64, hh);
}

template <class Epi>
DI void gemm_phase(const bf16_t* A, int lda, const bf16_t* B, int ldb, int N, int K, const Epi& epi, char* smem) {
    const int nt = N >> 8, small = (RC / 128) * nt;
    const int bid = lbid(), G = gridDim.x;
    if ((G & 7) == 0) {
        const int xcd = bid & 7, loc = bid >> 3, per = G >> 3, mine = (RL / 256 / 8) * nt;
        for (int i = loc; i < mine; i += per) {
            const int cg = i >> 7, rem = i & 127, cw = min(8, nt - cg * 8);
            int pg, w;
            if (cw == 8) { pg = rem >> 5; w = rem & 31; } else { const int rr = i - cg * 128; pg = rr / (4 * cw); w = rr - pg * 4 * cw; }
            const int pl = pg * 4 + (w & 3), cl = cg * 8 + (w >> 2);
            gemm_tile<256>(A, lda, B, ldb, K, (pl * 8 + xcd) * 256, cl * 256, epi, smem);
        }
    } else {
        const int big = (RL / 256) * nt;
        for (int t = bid; t < big; t += G) gemm_tile<256>(A, lda, B, ldb, K, (t / nt) * 256, (t % nt) * 256, epi, smem);
    }
    for (int u = bid; u < small; u += G) gemm_tile<128>(A, lda, B, ldb, K, RL + (u / nt) * 128, (u % nt) * 256, epi, smem);
}

struct EpiSwiglu {
    bf16_t* hid;
    DI void operator()(const f32x16& a0, const f32x16& a1, int row, int cbase, int hh) const {
        bf16_t* dst = hid + (size_t)row * DFF + (cbase >> 1) + 4 * hh;
#pragma unroll
        for (int q4 = 0; q4 < 4; ++q4) {
            float h[4];
#pragma unroll
            for (int j = 0; j < 4; ++j) h[j] = silu_f(a0[4 * q4 + j]) * a1[4 * q4 + j];
            u32x2 w; w.x = pk2(h[0], h[1]); w.y = pk2(h[2], h[3]);
            *(u32x2*)(dst + 8 * q4) = w;
        }
    }
};
struct EpiResid {
    const float* res_lat; const float* res_ctx; float* X; const float* gate; float coef;
    DI void operator()(const f32x16& a0, const f32x16& a1, int row, int cbase, int hh) const {
        const int s = row < RL ? (row >> 13) : 4;
        const float* rp = row < RL ? res_lat + (size_t)row * 1024 : res_ctx + (size_t)(row - RL) * 1024;
        const float* gp = gate + s * 9216;
        float* xp = X + (size_t)row * 1024;
#pragma unroll
        for (int ni = 0; ni < 2; ++ni)
#pragma unroll
            for (int q4 = 0; q4 < 4; ++q4) {
                const int c = cbase + ni * 32 + 8 * q4 + 4 * hh;
                const f32x4 r = *(const f32x4*)(rp + c), g = *(const f32x4*)(gp + c);
                f32x4 z;
#pragma unroll
                for (int j = 0; j < 4; ++j) z[j] = ALPHA * r[j] + coef * g[j] * (ni ? a1[4 * q4 + j] : a0[4 * q4 + j]);
                *(f32x4*)(xp + c) = z;
            }
    }
};
struct EpiEvIn {
    bf16_t *QN, *QB, *KVN, *KA, *KB, *VB; const f32x2 *tAr, *tAc, *tBr, *tBc;
    DI void operator()(const f32x16& a0, const f32x16& a1, int row, int cbase, int hh) const {
        const RowInfo ri = rowinfo(row);
        const int gr = (ri.j >> 6) & 127, gc = ri.j & 63;
#pragma unroll
        for (int ni = 0; ni < 2; ++ni) {
            const int g = (cbase >> 5) + ni;
            const f32x16& v = ni ? a1 : a0;
            if (g < 8) store16(QN + (size_t)row * 256 + g * 32, v, 1.f, hh);
            else if (g < 24) {
                const int hv = (g - 8) >> 1, half = (g - 8) & 1;
                f32x16 w = v; if (ri.lat) w = ropeB(v, half ? tBc + gc * 16 : tBr + gr * 16, hh);
                store16(QB + ((size_t)(ri.b * 8 + hv) * NK + ri.j) * 64 + half * 32, w, QB_SCALE, hh);
            } else if (g < 28) store16(KVN + (size_t)row * 128 + (g - 24) * 32, v, 1.f, hh);
            else if (g == 28) {
                f32x16 w = v; if (ri.lat) w = ropeA(v, tAr + gr * 8, tAc + gc * 8, hh);
                for (int h = 0; h < 8; ++h) store16(KA + ((size_t)(ri.b * 8 + h) * NK + ri.j) * 96 + 64, w, 1.f, hh);
            } else if (g < 45) {
                const int hv = (g - 29) >> 1, half = (g - 29) & 1;
                f32x16 w = v; if (ri.lat) w = ropeB(v, half ? tBc + gc * 16 : tBr + gr * 16, hh);
                store16(KB + ((size_t)(ri.b * 8 + hv) * NK + ri.j) * 64 + half * 32, w, 1.f, hh);
            } else if (g < 61) {
                const int idx = g - 45, h = idx >> 2, part = idx & 3;
                store16(VB + ((size_t)(ri.b * 4 + h) * NK + ri.j) * 128 + part * 32, v, 1.f, hh);
            }
        }
    }
};
struct EpiUQ {
    bf16_t* QA; const f32x2 *tAr, *tAc;
    DI void operator()(const f32x16& a0, const f32x16& a1, int row, int cbase, int hh) const {
        const RowInfo ri = rowinfo(row);
        const int gr = (ri.j >> 6) & 127, gc = ri.j & 63;
#pragma unroll
        for (int ni = 0; ni < 2; ++ni) {
            const int g = (cbase >> 5) + ni, h = g / 3, part = g - 3 * h;
            f32x16 w = ni ? a1 : a0;
            if (part == 2 && ri.lat) w = ropeA(ni ? a1 : a0, tAr + gr * 8, tAc + gc * 8, hh);
            store16(QA + ((size_t)(ri.b * 8 + h) * NK + ri.j) * 96 + part * 32, w, QA_SCALE, hh);
        }
    }
};
struct EpiUKV {
    bf16_t *KA, *VA;
    DI void operator()(const f32x16& a0, const f32x16& a1, int row, int cbase, int hh) const {
        const RowInfo ri = rowinfo(row);
#pragma unroll
        for (int ni = 0; ni < 2; ++ni) {
            const int g = (cbase >> 5) + ni, h = g >> 2, part = g & 3;
            const size_t tk = (size_t)(ri.b * 8 + h) * NK + ri.j;
            if (part < 2) store16(KA + tk * 96 + part * 32, ni ? a1 : a0, 1.f, hh);
            else store16(VA + tk * 64 + (part - 2) * 32, ni ? a1 : a0, 1.f, hh);
        }
    }
};
struct EpiOdIn {
    bf16_t *U, *QD, *KD, *VD;
    DI void operator()(const f32x16& a0, const f32x16& a1, int row, int cbase, int hh) const {
        const RowInfo ri = rowinfo(row);
#pragma unroll
        for (int ni = 0; ni < 2; ++ni) {
            const int g = (cbase >> 5) + ni;
            const f32x16& v = ni ? a1 : a0;
            if (g < 16) store16(U + (size_t)row * 512 + g * 32, v, 1.f, hh);
            else {
                const int gg = (g - 16) & 15, h = gg >> 1, half = gg & 1;
                const size_t off = ((size_t)(ri.b * 8 + h) * NK + ri.j) * 64 + half * 32;
                if (g < 32) store16(QD + off, v, QD_SCALE, hh);
                else if (g < 48) store16(KD + off, v, 1.f, hh);
                else store16(VD + off, v, 1.f, hh);
            }
        }
    }
};
struct EpiPool {
    bf16_t* CC; const float* pscale; int gidx;
    DI void operator()(const f32x16& a0, const f32x16& a1, int row, int cbase, int hh) const {
#pragma unroll
        for (int ni = 0; ni < 2; ++ni)
#pragma unroll
            for (int q4 = 0; q4 < 4; ++q4) {
                const int c = gidx * 128 + cbase + ni * 32 + 8 * q4 + 4 * hh;
                const f32x4 s = *(const f32x4*)(pscale + c);
                const f32x16& v = ni ? a1 : a0;
                u32x2 w; w.x = pk2(v[4 * q4] * s[0], v[4 * q4 + 1] * s[1]); w.y = pk2(v[4 * q4 + 2] * s[2], v[4 * q4 + 3] * s[3]);
                *(u32x2*)(CC + (size_t)row * 1024 + c) = w;
            }
    }
};

constexpr int ATT_LDS = 64 * (96 + 8) * 2 + 64 * (128 * 2 + 64);
constexpr int RPB_OFF = 2 * ATT_LDS;
constexpr int SMEM_BYTES = GEMM_LDS;

struct NAInfo { int qr; int kstart; };

template <int DQK, int DV, bool NA>
DI void attend(const bf16_t* __restrict__ Q, int q0, const bf16_t* __restrict__ Kb, const bf16_t* __restrict__ Vb,
               int s0, int n0, int s1, int n1, f32x16 (&o)[DV / 32], char* smem, NAInfo na) {
    constexpr int KS = (DQK + 8) * 2, VS = DV * 2 + 64;
    constexpr int KCH = DQK / 8, KN = (64 * KCH + NTHR - 1) / NTHR, VCH = DV / 8, VN = (64 * VCH + NTHR - 1) / NTHR;
    constexpr int NS = DQK / 16, NDT = DV / 32;
    const int tid = ltid(), lane = tid & 63, wave = tid >> 6;
    const int l31 = lane & 31, hh = lane >> 5, q = (lane & 15) >> 2, p = lane & 3, dblk = (lane >> 4) & 1;
    bf16x8 qf[NS];
    {
        const bf16_t* qp = Q + (size_t)(q0 + wave * 32 + l31) * DQK + hh * 8;
#pragma unroll
        for (int s = 0; s < NS; ++s) qf[s] = *(const bf16x8*)(qp + s * 16);
    }
#pragma unroll
    for (int d = 0; d < NDT; ++d)
#pragma unroll
        for (int r = 0; r < 16; ++r) o[d][r] = 0.f;
    float m = NA ? -INFINITY : 0.f, l = 0.f;
    f32x16 cinit;
#pragma unroll
    for (int r = 0; r < 16; ++r) cinit[r] = 0.f;
    u32x4 rk[KN], rv[VN];
    const int nt = n0 + n1;
    auto gload = [&](int t) {
        const int j0 = t < n0 ? s0 + t * 64 : s1 + (t - n0) * 64;
#pragma unroll
        for (int i = 0; i < KN; ++i) { int id = tid + NTHR * i; if (id >= 64 * KCH) id -= 64 * KCH; const int row = id / KCH, ch = id - row * KCH; rk[i] = *(const u32x4*)(Kb + (size_t)(j0 + row) * DQK + ch * 8); }
#pragma unroll
        for (int i = 0; i < VN; ++i) { int id = tid + NTHR * i; if (id >= 64 * VCH) id -= 64 * VCH; const int row = id / VCH, ch = id - row * VCH; rv[i] = *(const u32x4*)(Vb + (size_t)(j0 + row) * DV + ch * 8); }
    };
    gload(0);
    int qc = 0, cs = 0, rs = 0;
    if (NA) { qc = (wave & 1) * 32 + l31; cs = min(max(qc - 8, 0), 48); rs = min(max(na.qr - 4, 0), 120); }
    const float* rpb = (const float*)(smem + RPB_OFF);
    auto lwrite = [&](char* stg) {
#pragma unroll
        for (int i = 0; i < KN; ++i) { int id = tid + NTHR * i; if (id >= 64 * KCH) id -= 64 * KCH; const int row = id / KCH, ch = id - row * KCH; *(u32x4*)(stg + row * KS + ch * 16) = rk[i]; }
#pragma unroll
        for (int i = 0; i < VN; ++i) { int id = tid + NTHR * i; if (id >= 64 * VCH) id -= 64 * VCH; const int row = id / VCH, ch = id - row * VCH; *(u32x4*)(stg + 64 * KS + row * VS + ch * 16) = rv[i]; }
    };
    __syncthreads();
    lwrite(smem);
    if (nt > 1) gload(1);
    __syncthreads();
    for (int t = 0; t < nt; ++t) {
        const char* sK = smem + (t & 1) * ATT_LDS; const char* sV = sK + 64 * KS;
        bool active = true; int kr = 0;
        if (NA && t < n0) { kr = na.kstart + t; active = (kr >= rs) && (kr < rs + 8); }
        if (active) {
#pragma unroll 1
            for (int sub = 0; sub < 2; ++sub) {
                f32x16 st;
                if (NA) {
#pragma unroll
                    for (int r = 0; r < 16; ++r) st[r] = 0.f;
                } else st = cinit;
#pragma unroll
                for (int s = 0; s < NS; ++s) {
                    const bf16x8 kf = *(const bf16x8*)(sK + (sub * 32 + l31) * KS + (s * 16 + hh * 8) * 2);
                    st = mfma32(kf, qf[s], st);
                }
                if (NA && t < n0) {
                    const float* brow = rpb + (kr - na.qr + 7) * 31 + 15 - qc;
#pragma unroll
                    for (int r = 0; r < 16; ++r) {
                        const int kc = sub * 32 + (r & 3) + 8 * (r >> 2) + 4 * hh;
                        const bool valid = (kc >= cs) && (kc < cs + 16);
                        const int bi = valid ? kc : cs;
                        const float bias = brow[bi];
                        st[r] = valid ? st[r] + bias : -INFINITY;
                    }
                }
                float mx = st[0];
#pragma unroll
                for (int r = 1; r < 16; ++r) mx = fmaxf(mx, st[r]);
                mx = xor32_max(mx);
                float rsum = 0.f;
                if (NA) {
                    const float mnew = fmaxf(m, mx);
                    const float muse = (mnew == -INFINITY) ? 0.f : mnew;
                    const float alpha = __builtin_amdgcn_exp2f(m - muse);
                    m = mnew;
                    l *= alpha;
#pragma unroll
                    for (int d = 0; d < NDT; ++d)
#pragma unroll
                        for (int r = 0; r < 16; ++r) o[d][r] *= alpha;
#pragma unroll
                    for (int r = 0; r < 16; ++r) { st[r] = __builtin_amdgcn_exp2f(st[r] - muse); rsum += st[r]; }
                } else {
                    const bool first = (t == 0) && (sub == 0);
                    if (first || __builtin_amdgcn_ballot_w64(mx > 8.f) != 0) {
                        const float delta = first ? mx : fmaxf(mx, 0.f);
                        const float alpha = first ? 1.f : __builtin_amdgcn_exp2f(-delta);
                        m += delta;
                        l *= alpha;
#pragma unroll
                        for (int d = 0; d < NDT; ++d)
#pragma unroll
                            for (int r = 0; r < 16; ++r) o[d][r] *= alpha;
#pragma unroll
                        for (int r = 0; r < 16; ++r) { st[r] -= delta; cinit[r] = -m; }
                    }
#pragma unroll
                    for (int r = 0; r < 16; ++r) { st[r] = __builtin_amdgcn_exp2f(st[r]); rsum += st[r]; }
                }
                l += rsum;
                bf16x8 pf[2];
#pragma unroll
                for (int s2 = 0; s2 < 2; ++s2) {
                    u32x4 w;
                    w.x = pk2(st[8 * s2], st[8 * s2 + 1]); w.y = pk2(st[8 * s2 + 2], st[8 * s2 + 3]);
                    w.z = pk2(st[8 * s2 + 4], st[8 * s2 + 5]); w.w = pk2(st[8 * s2 + 6], st[8 * s2 + 7]);
                    pf[s2] = __builtin_bit_cast(bf16x8, w);
                }
#pragma unroll
                for (int d = 0; d < NDT; ++d)
#pragma unroll
                    for (int s2 = 0; s2 < 2; ++s2) {
                        const char* vp = sV + (sub * 32 + 16 * s2 + 4 * hh + q) * VS + (d * 32 + dblk * 16 + 4 * p) * 2;
                        const bf16x8 vf = cat8(tr_read(vp), tr_read(vp + 8 * VS));
                        o[d] = mfma32(vf, pf[s2], o[d]);
                    }
            }
        }
        if (t + 1 < nt) lwrite(smem + ((t & 1) ^ 1) * ATT_LDS);
        if (t + 2 < nt) gload(t + 2);
        __syncthreads();
    }
    l = xor32_sum(l);
    const float inv = 1.f / l;
#pragma unroll
    for (int d = 0; d < NDT; ++d)
#pragma unroll
        for (int r = 0; r < 16; ++r) o[d][r] *= inv;
}

DI int qrow_of(int b, int j) { return j < SEQ ? b * SEQ + j : RL + b * CTX + (j - SEQ); }

DI void even_attention_phase(const Params& P, char* smem) {
    char* ws = P.ws; char* hid = ws + OFF_HID; char* ob = (char*)P.out;
    const bf16_t* QA = (const bf16_t*)(hid + HOFF_QA); const bf16_t* KA = (const bf16_t*)(hid + HOFF_KA); const bf16_t* VA = (const bf16_t*)(hid + HOFF_VA);
    const bf16_t* QB = (const bf16_t*)(hid + HOFF_QB); const bf16_t* KB = (const bf16_t*)(ob + OOFF_KB); const bf16_t* VB = (const bf16_t*)(ob + OOFF_VB);
    bf16_t* CC = (bf16_t*)(ws + OFF_XM);
    const float lam = *(const float*)(ws + OFF_LAM);
    const float* gsub = P.in[18];
    const int lane = ltid() & 63, wave = ltid() >> 6, l31 = lane & 31, hh = lane >> 5;
    constexpr int NQT = 33, NDIFF = NB * 4 * NQT, NMLA = NB * 8 * NQT;
    NAInfo na; na.qr = 0; na.kstart = 0;
    unsigned* wq = (unsigned*)(ws + OFF_BAR + 128);
    volatile int* slot = (volatile int*)(smem + 2 * ATT_LDS + 2048);
    for (;;) {
        __syncthreads();
        if (ltid() == 0) *slot = (int)atomicAdd(wq, 1u);
        __syncthreads();
        const int u = *slot;
        if (u >= NDIFF + NMLA) break;
        if (u < NDIFF) {
            const int qt = u % NQT, bh = u / NQT, h = bh & 3, b = bh >> 2;
            const int q0 = qt < 32 ? qt * 256 : SEQ;
            const int s0 = qt < 32 ? 0 : SEQ, n0 = qt < 32 ? NK / 64 : CTX / 64;
            const bf16_t* V = VB + (size_t)(b * 4 + h) * NK * 128;
            f32x16 o[4];
            attend<64, 128, false>(QB + (size_t)(b * 8 + 2 * h) * NK * 64, q0, KB + (size_t)(b * 8 + 2 * h) * NK * 64, V, s0, n0, 0, 0, o, smem, na);
            const int row = qrow_of(b, q0 + wave * 32 + l31);
            bf16_t* dst = CC + (size_t)row * 1024 + 512 + h * 128;
#pragma unroll
            for (int d = 0; d < 4; ++d) store16(dst + d * 32, o[d], 1.f, hh);
            f32x16 o2[4];
            attend<64, 128, false>(QB + (size_t)(b * 8 + 2 * h + 1) * NK * 64, q0, KB + (size_t)(b * 8 + 2 * h + 1) * NK * 64, V, s0, n0, 0, 0, o2, smem, na);
            float ss = 0.f;
#pragma unroll
            for (int d = 0; d < 4; ++d)
#pragma unroll
                for (int q4 = 0; q4 < 4; ++q4) {
                    const u32x2 w = *(const volatile u32x2*)(dst + d * 32 + 8 * q4 + 4 * hh);
                    const float a0 = bflo(w.x) - lam * o2[d][4 * q4], a1 = bfhi(w.x) - lam * o2[d][4 * q4 + 1], a2 = bflo(w.y) - lam * o2[d][4 * q4 + 2], a3 = bfhi(w.y) - lam * o2[d][4 * q4 + 3];
                    o[d][4 * q4] = a0; o[d][4 * q4 + 1] = a1; o[d][4 * q4 + 2] = a2; o[d][4 * q4 + 3] = a3;
                    ss += (a0 * a0 + a1 * a1) + (a2 * a2 + a3 * a3);
                }
            ss = xor32_sum(ss);
            const float rn = rsqrtf(ss * (1.f / 128.f) + 1e-5f) * 0.8f;
#pragma unroll
            for (int d = 0; d < 4; ++d)
#pragma unroll
                for (int q4 = 0; q4 < 4; ++q4) {
                    const int c = d * 32 + 8 * q4 + 4 * hh;
                    const f32x4 g = *(const f32x4*)(gsub + c);
                    u32x2 w; w.x = pk2(o[d][4 * q4] * rn * g[0], o[d][4 * q4 + 1] * rn * g[1]); w.y = pk2(o[d][4 * q4 + 2] * rn * g[2], o[d][4 * q4 + 3] * rn * g[3]);
                    *(u32x2*)(dst + c) = w;
                }
        } else {
            const int v = u - NDIFF, qt = v % NQT, bh = v / NQT, h = bh & 7, b = bh >> 3;
            const int q0 = qt < 32 ? qt * 256 : SEQ;
            const int s0 = qt < 32 ? 0 : SEQ, n0 = qt < 32 ? NK / 64 : CTX / 64;
            f32x16 o[2];
            attend<96, 64, false>(QA + (size_t)(b * 8 + h) * NK * 96, q0, KA + (size_t)(b * 8 + h) * NK * 96, VA + (size_t)(b * 8 + h) * NK * 64, s0, n0, 0, 0, o, smem, na);
            const int row = qrow_of(b, q0 + wave * 32 + l31);
            bf16_t* dst = CC + (size_t)row * 1024 + h * 64;
#pragma unroll
            for (int d = 0; d < 2; ++d) store16(dst + d * 32, o[d], 1.f, hh);
        }
    }
}

DI void odd_attention_phase(const Params& P, char* smem) {
    char* ws = P.ws; char* hid = ws + OFF_HID;
    const bf16_t* QD = (const bf16_t*)(hid + HOFF_QD); const bf16_t* KD = (const bf16_t*)(hid + HOFF_KD); const bf16_t* VD = (const bf16_t*)(hid + HOFF_VD);
    bf16_t* CC = (bf16_t*)(ws + OFF_XM);
    const float* rpbg = P.in[23];
    const int lane = ltid() & 63, wave = ltid() >> 6, l31 = lane & 31, hh = lane >> 5;
    float* rpbl = (float*)(smem + RPB_OFF);
    constexpr int NU = NB * 8 * 32;
    for (int u = lbid(); u < NU; u += gridDim.x) {
        const int rp = u & 31, bh = u >> 5, h = bh & 7, b = bh >> 3;
        __syncthreads();
        for (int i = ltid(); i < 465; i += NTHR) rpbl[i] = rpbg[h * 465 + i] * LOG2E;
        const int r0 = rp * 4;
        NAInfo na; na.qr = r0 + (wave >> 1);
        const int rs0 = min(max(r0 - 4, 0), 120);
        na.kstart = min(rs0, 117);
        f32x16 o[2];
        const size_t hb = (size_t)(b * 8 + h) * NK * 64;
        attend<64, 64, true>(QD + hb, r0 * 64, KD + hb, VD + hb, na.kstart * 64, 11, SEQ, CTX / 64, o, smem, na);
        const int row = b * SEQ + r0 * 64 + wave * 32 + l31;
        bf16_t* dst = CC + (size_t)row * 1024 + 512 + h * 64;
#pragma unroll
        for (int d = 0; d < 2; ++d) store16(dst + d * 32, o[d], 1.f, hh);
    }
}

DI void cvt8(bf16_t* dst, const float* src, float sc) {
    const f32x4 a = *(const f32x4*)src, b = *(const f32x4*)(src + 4);
    u32x4 w; w.x = pk2(a[0] * sc, a[1] * sc); w.y = pk2(a[2] * sc, a[3] * sc); w.z = pk2(b[0] * sc, b[1] * sc); w.w = pk2(b[2] * sc, b[3] * sc);
    *(u32x4*)dst = w;
}
DI void cvt_rows(bf16_t* dst, int ldd, const float* src, int lds_, int rows, int cols_src, const float* rowscale, size_t gtid, size_t gstride) {
    const int c8 = ldd >> 3; const size_t n = (size_t)rows * c8;
    for (size_t i = gtid; i < n; i += gstride) {
        const int k = (int)(i / c8), c = (int)(i % c8) * 8;
        if (c < cols_src) cvt8(dst + (size_t)k * ldd + c, src + (size_t)k * lds_ + c, rowscale ? rowscale[k] : 1.f);
        else { u32x4 z = {0u, 0u, 0u, 0u}; *(u32x4*)(dst + (size_t)k * ldd + c) = z; }
    }
}

DI void phase_pro_a(const Params& P, char* smem) {
    char* ws = P.ws;
    const size_t gtid = (size_t)lbid() * NTHR + ltid(), gstride = (size_t)gridDim.x * NTHR;
    for (int lf = 0; lf < 4; ++lf) {
        const float* sg = P.in[8] + (size_t)lf * 1024 * DFF; const float* su = P.in[9] + (size_t)lf * 1024 * DFF;
        bf16_t* dst = (bf16_t*)(ws + OFF_WGU + lf * SZ_WGU);
        for (size_t i = gtid; i < 1024ull * 704; i += gstride) {
            const int k = (int)(i / 704), n = (int)(i % 704) * 8, grp = n >> 6, w = n & 63;
            const float* src = ((w < 32) ? sg : su) + (size_t)k * DFF + grp * 32 + (w & 31);
            cvt8(dst + (size_t)k * 5632 + n, src, 1.f);
        }
        cvt_rows((bf16_t*)(ws + OFF_WD + lf * SZ_WD), 1024, P.in[10] + (size_t)lf * DFF * 1024, 1024, DFF, 1024, nullptr, gtid, gstride);
    }
    cvt_rows((bf16_t*)(ws + OFF_EVIN), 2048, P.in[11], 1952, 1024, 1952, nullptr, gtid, gstride);
    cvt_rows((bf16_t*)(ws + OFF_EVOUT), 1024, P.in[12], 1024, 1024, 1024, nullptr, gtid, gstride);
    cvt_rows((bf16_t*)(ws + OFF_UQ), 768, P.in[15], 768, 256, 768, P.in[13], gtid, gstride);
    cvt_rows((bf16_t*)(ws + OFF_UKV), 1024, P.in[16], 1024, 128, 1024, P.in[14], gtid, gstride);
    cvt_rows((bf16_t*)(ws + OFF_ODIN), 2048, P.in[19], 2048, 1024, 2048, nullptr, gtid, gstride);
    cvt_rows((bf16_t*)(ws + OFF_ODOUT), 1024, P.in[20], 1024, 1024, 1024, nullptr, gtid, gstride);
    for (size_t i = gtid; i < 512ull * 64; i += gstride) {
        const int k = (int)(i >> 6), n = (int)(i & 63) * 8;
        bf16_t* d = (bf16_t*)(ws + OFF_POOL) + (size_t)k * 512 + n;
        if ((k >> 7) == (n >> 7)) cvt8(d, P.in[21] + (size_t)k * 128 + (n & 127), 1.f);
        else { u32x4 z = {0u, 0u, 0u, 0u}; *(u32x4*)d = z; }
    }
    if (gtid < 128 * 8) { const int r = (int)gtid >> 3, i = (int)gtid & 7; const float inv = exp2f(-(float)i * (13.287712379549449f / 8.f)); float rev = (float)r * inv * 0.15915494309189535f; rev -= floorf(rev);
        f32x2 v = {__builtin_amdgcn_cosf(rev), __builtin_amdgcn_sinf(rev)}; ((f32x2*)(ws + OFF_TAR))[gtid] = v; if (r < 64) ((f32x2*)(ws + OFF_TAC))[gtid] = v; }
    if (gtid < 128 * 16) { const int r = (int)gtid >> 4, i = (int)gtid & 15; const float inv = exp2f(-(float)i * (13.287712379549449f / 16.f)); float rev = (float)r * inv * 0.15915494309189535f; rev -= floorf(rev);
        f32x2 v = {__builtin_amdgcn_cosf(rev), __builtin_amdgcn_sinf(rev)}; ((f32x2*)(ws + OFF_TBR))[gtid] = v; if (r < 64) ((f32x2*)(ws + OFF_TBC))[gtid] = v; }
    if (gtid == 0) {
        const float* lv = P.in[17]; float a = 0.f, b = 0.f;
        for (int i = 0; i < 64; ++i) { a += lv[i] * lv[64 + i]; b += lv[128 + i] * lv[192 + i]; }
        *(float*)(ws + OFF_LAM) = expf(a) - expf(b) + 0.2f;
    }
    float* sc = (float*)smem;
    float* red = sc + 5 * 1024;
    const int tid = ltid(), jj = tid & 31, ig = tid >> 5;
    __syncthreads();
    for (int i = tid; i < 5 * 1024; i += NTHR) { const float v = i < 4096 ? P.in[1][i] : P.in[3][i - 4096]; sc[i] = v / (1.f + expf(-v)); }
    __syncthreads();
    for (int u = lbid(); u < 576; u += gridDim.x) {
        const int l = u / 288, j0 = (u % 288) * 32;
        float a[5] = {0.f, 0.f, 0.f, 0.f, 0.f};
        const float* w = P.in[4] + (size_t)l * 1024 * 9216 + (size_t)(ig * 64) * 9216 + j0 + jj;
        for (int i0 = 0; i0 < 64; i0 += 8) {
            float wv[8];
#pragma unroll
            for (int k = 0; k < 8; ++k) wv[k] = w[(size_t)(i0 + k) * 9216];
#pragma unroll
            for (int k = 0; k < 8; ++k)
#pragma unroll
                for (int s2 = 0; s2 < 5; ++s2) a[s2] += sc[s2 * 1024 + ig * 64 + i0 + k] * wv[k];
        }
#pragma unroll
        for (int s2 = 0; s2 < 5; ++s2) red[(ig * 5 + s2) * 32 + jj] = a[s2];
        __syncthreads();
        if (tid < 160) {
            const int s2 = tid >> 5, j = tid & 31;
            float v = P.in[5][l * 9216 + j0 + j];
#pragma unroll
            for (int g = 0; g < 16; ++g) v += red[(g * 5 + s2) * 32 + j];
            ((float*)(ws + OFF_MOD))[(size_t)(l * 5 + s2) * 9216 + j0 + j] = v;
        }
        __syncthreads();
    }
}

DI void phase_pro_b(const Params& P) {
    char* ws = P.ws; bf16_t* XM = (bf16_t*)(ws + OFF_XM); const float* MOD = (const float*)(ws + OFF_MOD);
    const size_t gtid = (size_t)lbid() * NTHR + ltid(), gstride = (size_t)gridDim.x * NTHR;
    for (size_t i = gtid; i < (size_t)RT * 128; i += gstride) {
        const int row = (int)(i >> 7), c = (int)(i & 127) * 8;
        const float* src = row < RL ? P.in[0] + (size_t)row * 1024 + c : P.in[2] + (size_t)(row - RL) * 1024 + c;
        const int s = row < RL ? (row >> 13) : 4;
        const float* sh = MOD + (size_t)s * 9216 + c; const float* scl = sh + 1024;
        unsigned w[4];
#pragma unroll
        for (int hf = 0; hf < 2; ++hf) {
            const f32x4 x = *(const f32x4*)(src + 4 * hf), a = *(const f32x4*)(sh + 4 * hf), g = *(const f32x4*)(scl + 4 * hf);
            w[2 * hf] = pk2(x[0] * (1.f + g[0]) + a[0], x[1] * (1.f + g[1]) + a[1]);
            w[2 * hf + 1] = pk2(x[2] * (1.f + g[2]) + a[2], x[3] * (1.f + g[3]) + a[3]);
        }
        u32x4 o = {w[0], w[1], w[2], w[3]};
        *(u32x4*)(XM + (size_t)row * 1024 + c) = o;
    }
}

struct LnSpec { int l, which, lnext, mshift; bool final_; unsigned* cnt; };
template <int NR>
DI void ln_rows(const Params& P, const LnSpec& sp, int row, int stride, int lane) {
    char* ws = P.ws; float* X = (float*)(ws + OFF_X); bf16_t* XM = (bf16_t*)(ws + OFF_XM); const float* MOD = (const float*)(ws + OFF_MOD);
    const float* g = P.in[6] + (sp.l * 3 + sp.which) * 1024; const float* bb = P.in[7] + (sp.l * 3 + sp.which) * 1024;
    f32x4 v[NR][4]; float s[NR], qv[NR];
#pragma unroll
    for (int k = 0; k < NR; ++k) {
        const float* xp = X + (size_t)(row + k * stride) * 1024;
#pragma unroll
        for (int i = 0; i < 4; ++i) v[k][i] = *(const f32x4*)(xp + (i * 64 + lane) * 4);
    }
#pragma unroll
    for (int k = 0; k < NR; ++k) {
        s[k] = 0.f;
#pragma unroll
        for (int i = 0; i < 4; ++i) s[k] += (v[k][i][0] + v[k][i][1]) + (v[k][i][2] + v[k][i][3]);
    }
#pragma unroll
    for (int o = 32; o >= 1; o >>= 1)
#pragma unroll
        for (int k = 0; k < NR; ++k) s[k] += __shfl_xor(s[k], o);
#pragma unroll
    for (int k = 0; k < NR; ++k) {
        s[k] *= (1.f / 1024.f); qv[k] = 0.f;
#pragma unroll
        for (int i = 0; i < 4; ++i)
#pragma unroll
            for (int j = 0; j < 4; ++j) { const float d = v[k][i][j] - s[k]; qv[k] += d * d; }
    }
#pragma unroll
    for (int o = 32; o >= 1; o >>= 1)
#pragma unroll
        for (int k = 0; k < NR; ++k) qv[k] += __shfl_xor(qv[k], o);
#pragma unroll
    for (int k = 0; k < NR; ++k) {
        const int r = row + k * stride;
        const float mu = s[k], rstd = rsqrtf(qv[k] * (1.f / 1024.f) + 1e-6f);
        const int sidx = r < RL ? (r >> 13) : 4;
        const float* sh = MOD + (size_t)(sp.lnext * 5 + sidx) * 9216 + sp.mshift * 1024; const float* scl = sh + 1024;
        float* xp = X + (size_t)r * 1024;
#pragma unroll
        for (int i = 0; i < 4; ++i) {
            const int c = (i * 64 + lane) * 4;
            const f32x4 gg = *(const f32x4*)(g + c), b4 = *(const f32x4*)(bb + c);
            f32x4 y;
#pragma unroll
            for (int j = 0; j < 4; ++j) y[j] = (v[k][i][j] - mu) * rstd * gg[j] + b4[j];
            if (sp.final_) { *(f32x4*)(P.out + (size_t)r * 1024 + c) = y; }
            else {
                *(f32x4*)(xp + c) = y;
                const f32x4 a = *(const f32x4*)(sh + c), sg = *(const f32x4*)(scl + c);
                u32x2 w; w.x = pk2(y[0] * (1.f + sg[0]) + a[0], y[1] * (1.f + sg[1]) + a[1]); w.y = pk2(y[2] * (1.f + sg[2]) + a[2], y[3] * (1.f + sg[3]) + a[3]);
                *(u32x2*)(XM + (size_t)r * 1024 + c) = w;
            }
        }
    }
}
DI void phase_ln(const Params& P, int l, int which, int lnext, int mshift, bool final_) {
    const LnSpec sp{l, which, lnext, mshift, final_, nullptr};
    const int lane = ltid() & 63, wave = ltid() >> 6;
    const int nq = (final_ ? RL : RT) / 4;
    for (int q = lbid() * NWAVE + wave; q < nq; q += gridDim.x * NWAVE) ln_rows<4>(P, sp, 4 * q, 1, lane);
}

DI void phase_ev_rms(const Params& P) {
    char* ws = P.ws; bf16_t* QN = (bf16_t*)(ws + OFF_HID + HOFF_QN); bf16_t* KVN = (bf16_t*)((char*)P.out + OOFF_KVN);
    const int lane = ltid() & 63, wave = ltid() >> 6;
    for (int row = lbid() * NWAVE + wave; row < RT; row += gridDim.x * NWAVE) {
        {
            u32x2* p = (u32x2*)(QN + (size_t)row * 256 + lane * 4); const u32x2 w = *p;
            float a = bflo(w.x), b = bfhi(w.x), c = bflo(w.y), d = bfhi(w.y);
            float s = a * a + b * b + c * c + d * d;
#pragma unroll
            for (int o = 32; o >= 1; o >>= 1) s += __shfl_xor(s, o);
            const float r = rsqrtf(s * (1.f / 256.f) + 1e-6f);
            u32x2 o2; o2.x = pk2(a * r, b * r); o2.y = pk2(c * r, d * r); *p = o2;
        }
        {
            unsigned* p = (unsigned*)(KVN + (size_t)row * 128 + lane * 2); const unsigned w = *p;
            float a = bflo(w), b = bfhi(w);
            float s = a * a + b * b;
#pragma unroll
            for (int o = 32; o >= 1; o >>= 1) s += __shfl_xor(s, o);
            const float r = rsqrtf(s * (1.f / 128.f) + 1e-6f);
            *p = pk2(a * r, b * r);
        }
    }
}

DI void phase_od_pool(const Params& P) {
    char* ws = P.ws; const bf16_t* U = (const bf16_t*)(ws + OFF_HID + HOFF_U); bf16_t* PL = (bf16_t*)(ws + OFF_HID + HOFF_PL);
    const size_t gtid = (size_t)lbid() * NTHR + ltid(), gstride = (size_t)gridDim.x * NTHR;
    for (size_t i = gtid; i < (size_t)RT * 64; i += gstride) {
        const int row = (int)(i >> 6), c = (int)(i & 63) * 8, grp = c >> 7;
        const int w = 2 << grp, left = w >> 1, right = w - 1 - left;
        int base, n, t;
        if (row < RL) { base = row & ~8191; n = SEQ; t = row & 8191; } else { const int rc = row - RL; base = RL + (rc & ~255); n = CTX; t = rc & 255; }
        const int lo = max(t - left, 0), hi = min(t + right + 1, n);
        float acc[8] = {0.f, 0.f, 0.f, 0.f, 0.f, 0.f, 0.f, 0.f};
        for (int tt = lo; tt < hi; ++tt) {
            const u32x4 v = *(const u32x4*)(U + (size_t)(base + tt) * 512 + c);
            acc[0] += bflo(v.x); acc[1] += bfhi(v.x); acc[2] += bflo(v.y); acc[3] += bfhi(v.y); acc[4] += bflo(v.z); acc[5] += bfhi(v.z); acc[6] += bflo(v.w); acc[7] += bfhi(v.w);
        }
        const float ic = 1.f / (float)(hi - lo);
        const u32x4 s = *(const u32x4*)(U + (size_t)row * 512 + c);
        u32x4 o;
        o.x = pk2(acc[0] * ic - bflo(s.x), acc[1] * ic - bfhi(s.x)); o.y = pk2(acc[2] * ic - bflo(s.y), acc[3] * ic - bfhi(s.y));
        o.z = pk2(acc[4] * ic - bflo(s.z), acc[5] * ic - bfhi(s.z)); o.w = pk2(acc[6] * ic - bflo(s.w), acc[7] * ic - bfhi(s.w));
        *(u32x4*)(PL + (size_t)row * 512 + c) = o;
    }
}

constexpr int NPHASE = 25;

DI void run_phase(const Params& P, int ph, char* smem) {
    char* ws = P.ws; char* hid = ws + OFF_HID; char* ob = (char*)P.out;
    float* X = (float*)(ws + OFF_X); bf16_t* XM = (bf16_t*)(ws + OFF_XM); bf16_t* HID = (bf16_t*)hid;
    const float* MOD = (const float*)(ws + OFF_MOD);
    if (ph == 0) { phase_pro_a(P, smem); return; }
    if (ph == 1) { phase_pro_b(P); return; }
    int l, op;
    if (ph < 14) { l = 0; op = ph - 2; } else { l = 1; op = ph - 14; if (op >= 6) op += 1; }
    const float* modl = MOD + (size_t)l * 5 * 9216;
    switch (op) {
    case 0: case 9: {
        const int f = op == 0 ? 0 : 1;
        EpiSwiglu e{HID};
        gemm_phase(XM, 1024, (const bf16_t*)(ws + OFF_WGU + (l * 2 + f) * SZ_WGU), 5632, 5632, 1024, e, smem);
    } break;
    case 1: case 10: {
        const int f = op == 1 ? 0 : 1;
        const bool first = (l == 0 && f == 0);
        EpiResid e{first ? P.in[0] : X, first ? P.in[2] : X + (size_t)RL * 1024, X, modl + (f == 0 ? 2 : 8) * 1024, 0.5f};
        gemm_phase(HID, DFF, (const bf16_t*)(ws + OFF_WD + (l * 2 + f) * SZ_WD), 1024, 1024, DFF, e, smem);
    } break;
    case 2: phase_ln(P, l, 0, l, 3, false); break;
    case 3: {
        if (l == 0) {
            EpiEvIn e{(bf16_t*)(hid + HOFF_QN), (bf16_t*)(hid + HOFF_QB), (bf16_t*)(ob + OOFF_KVN), (bf16_t*)(hid + HOFF_KA), (bf16_t*)(ob + OOFF_KB), (bf16_t*)(ob + OOFF_VB),
                      (const f32x2*)(ws + OFF_TAR), (const f32x2*)(ws + OFF_TAC), (const f32x2*)(ws + OFF_TBR), (const f32x2*)(ws + OFF_TBC)};
            gemm_phase(XM, 1024, (const bf16_t*)(ws + OFF_EVIN), 2048, 2048, 1024, e, smem);
        } else {
            EpiOdIn e{(bf16_t*)(hid + HOFF_U), (bf16_t*)(hid + HOFF_QD), (bf16_t*)(hid + HOFF_KD), (bf16_t*)(hid + HOFF_VD)};
            gemm_phase(XM, 1024, (const bf16_t*)(ws + OFF_ODIN), 2048, 2048, 1024, e, smem);
        }
    } break;
    case 4: if (l == 0) phase_ev_rms(P); else phase_od_pool(P); break;
    case 5: {
        if (l == 0) {
            EpiUQ e1{(bf16_t*)(hid + HOFF_QA), (const f32x2*)(ws + OFF_TAR), (const f32x2*)(ws + OFF_TAC)};
            gemm_phase((const bf16_t*)(hid + HOFF_QN), 256, (const bf16_t*)(ws + OFF_UQ), 768, 768, 256, e1, smem);
            EpiUKV e2{(bf16_t*)(hid + HOFF_KA), (bf16_t*)(hid + HOFF_VA)};
            gemm_phase((const bf16_t*)(ob + OOFF_KVN), 128, (const bf16_t*)(ws + OFF_UKV), 1024, 1024, 128, e2, smem);
        } else {
            odd_attention_phase(P, smem);
            EpiPool e{XM, P.in[22], 0};
            gemm_phase((const bf16_t*)(hid + HOFF_PL), 512, (const bf16_t*)(ws + OFF_POOL), 512, 512, 512, e, smem);
        }
    } break;
    case 6: even_attention_phase(P, smem); break;
    case 7: {
        EpiResid e{X, X + (size_t)RL * 1024, X, modl + 5 * 1024, 1.f};
        gemm_phase(XM, 1024, (const bf16_t*)(ws + (l == 0 ? OFF_EVOUT : OFF_ODOUT)), 1024, 1024, 1024, e, smem);
    } break;
    case 8: phase_ln(P, l, 1, l, 6, false); break;
    case 11: if (l == 0) phase_ln(P, 0, 2, 1, 0, false); else phase_ln(P, 1, 2, 1, 0, true); break;
    default: break;
    }
}

DI void grid_barrier(unsigned* ctr, unsigned target) {
    __syncthreads();
    if (threadIdx.x == 0) {
        __threadfence();
        __hip_atomic_fetch_add(ctr, 1u, __ATOMIC_RELEASE, __HIP_MEMORY_SCOPE_AGENT);
        while (__hip_atomic_load(ctr, __ATOMIC_RELAXED, __HIP_MEMORY_SCOPE_AGENT) < target) __builtin_amdgcn_s_sleep(8);
        __threadfence();
    }
    __syncthreads();
}

__global__ void __launch_bounds__(NTHR, 2) mega(Params P, int ph_lo, int ph_hi) {
    extern __shared__ __attribute__((aligned(16))) char smem[];
    unsigned nsync = 0;
    for (int ph = ph_lo; ph < ph_hi; ++ph) {
        run_phase(P, ph, smem);
        if (ph + 1 < ph_hi) {
            if (ph == ph_lo) cg::this_grid().sync();
            else { ++nsync; grid_barrier((unsigned*)(P.ws + OFF_BAR), nsync * gridDim.x); }
        }
    }
}

extern "C" void kernel_launch(void* const* d_in, const int* in_sizes, int n_in, void* d_out, int out_size, void* d_ws, size_t ws_size, hipStream_t stream) {
    if (ws_size < WS_NEED) { fprintf(stderr, "workspace too small: %zu < %zu\n", ws_size, (size_t)WS_NEED); return; }
    Params P{};
    for (int i = 0; i < 24; ++i) P.in[i] = (const float*)d_in[i];
    P.out = (float*)d_out; P.ws = (char*)d_ws;
    static int grid_blocks = 0;
    if (!grid_blocks) {
        int dev = 0, cus = 0, per_cu = 0;
        hipGetDevice(&dev);
        hipDeviceGetAttribute(&cus, hipDeviceAttributeMultiprocessorCount, dev);
        hipFuncSetAttribute((const void*)mega, hipFuncAttributeMaxDynamicSharedMemorySize, SMEM_BYTES);
        hipOccupancyMaxActiveBlocksPerMultiprocessor(&per_cu, mega, NTHR, SMEM_BYTES);
        if (per_cu < 1) per_cu = 1;
        if (per_cu > 1) per_cu = 1;
        grid_blocks = cus * per_cu;
    }
#if COOP
    hipMemsetAsync((char*)d_ws + OFF_BAR, 0, 256, stream);
    int lo = 0, hi = NPHASE;
    void* args[] = {&P, &lo, &hi};
    hipError_t e = hipLaunchCooperativeKernel((void*)mega, dim3(grid_blocks), dim3(NTHR), args, SMEM_BYTES, stream);
    if (e != hipSuccess) fprintf(stderr, "cooperative launch failed: %s (grid %d)\n", hipGetErrorString(e), grid_blocks);
#else
    for (int ph = 0; ph < NPHASE; ++ph) mega<<<grid_blocks, NTHR, SMEM_BYTES, stream>>>(P, ph, ph + 1);
#endif
}
```

```cpp
#include <hip/hip_runtime.h>
#include <hip/hip_cooperative_groups.h>
#include <cstdio>
#include <cstdint>
namespace cg = cooperative_groups;

#ifndef COOP
#define COOP 1
#endif

#define DI __device__ __forceinline__
typedef unsigned short bf16_t;
typedef short bf16x8 __attribute__((ext_vector_type(8)));
typedef short s16x4 __attribute__((ext_vector_type(4)));
typedef __bf16 bfx4 __attribute__((ext_vector_type(4)));
typedef __bf16 bfx2 __attribute__((ext_vector_type(2)));
typedef float f32x2 __attribute__((ext_vector_type(2)));
typedef float f32x4 __attribute__((ext_vector_type(4)));
typedef float f32x16 __attribute__((ext_vector_type(16)));
typedef unsigned u32x2 __attribute__((ext_vector_type(2)));
typedef unsigned u32x4 __attribute__((ext_vector_type(4)));
#define LDS_AS __attribute__((address_space(3)))

constexpr int DM = 1024, NB = 4, SEQ = 8192, CTX = 256, DFF = 2816;
constexpr int RL = NB * SEQ, RC = NB * CTX, RT = RL + RC;
constexpr int NK = SEQ + CTX;
constexpr float ALPHA = 1.41421356237f;
constexpr float LOG2E = 1.4426950408889634f;
constexpr float QA_SCALE = 0.10206207261596575f * LOG2E;
constexpr float QB_SCALE = 0.125f * LOG2E;
constexpr float QD_SCALE = 0.125f * LOG2E;
constexpr int NTHR = 512, NWAVE = NTHR / 64;

constexpr size_t SZ_WGU = 1024ull * 5632 * 2, SZ_WD = 2816ull * 1024 * 2;
constexpr size_t OFF_WGU = 0;
constexpr size_t OFF_WD = OFF_WGU + 4 * SZ_WGU;
constexpr size_t OFF_EVIN = OFF_WD + 4 * SZ_WD;
constexpr size_t OFF_EVOUT = OFF_EVIN + 1024ull * 2048 * 2;
constexpr size_t OFF_UQ = OFF_EVOUT + 1024ull * 1024 * 2;
constexpr size_t OFF_UKV = OFF_UQ + 256ull * 768 * 2;
constexpr size_t OFF_ODIN = OFF_UKV + 128ull * 1024 * 2;
constexpr size_t OFF_ODOUT = OFF_ODIN + 1024ull * 2048 * 2;
constexpr size_t OFF_POOL = OFF_ODOUT + 1024ull * 1024 * 2;
constexpr size_t OFF_MOD = OFF_POOL + 512ull * 512 * 2;
constexpr size_t OFF_TAR = OFF_MOD + 2ull * 5 * 9216 * 4;
constexpr size_t OFF_TAC = OFF_TAR + 128 * 8 * 8;
constexpr size_t OFF_TBR = OFF_TAC + 64 * 8 * 8;
constexpr size_t OFF_TBC = OFF_TBR + 128 * 16 * 8;
constexpr size_t OFF_LAM = OFF_TBC + 64 * 16 * 8;
constexpr size_t OFF_BAR = OFF_LAM + 256;
constexpr size_t OFF_X = OFF_BAR + 256;
constexpr size_t OFF_XM = OFF_X + (size_t)RT * 1024 * 4;
constexpr size_t OFF_HID = OFF_XM + (size_t)RT * 1024 * 2;
constexpr size_t WS_NEED = OFF_HID + (size_t)RT * DFF * 2;
constexpr size_t SZ_H96 = (size_t)NB * 8 * NK * 96 * 2, SZ_H64 = (size_t)NB * 8 * NK * 64 * 2;
constexpr size_t HOFF_QA = 0, HOFF_KA = SZ_H96, HOFF_VA = 2 * SZ_H96, HOFF_QB = HOFF_VA + SZ_H64, HOFF_QN = HOFF_QB + SZ_H64;
static_assert(HOFF_QN + (size_t)RT * 256 * 2 <= (size_t)RT * DFF * 2, "HID region overflow");
constexpr size_t HOFF_U = 0, HOFF_PL = SZ_H64, HOFF_QD = 2 * SZ_H64, HOFF_KD = 3 * SZ_H64, HOFF_VD = 4 * SZ_H64;
constexpr size_t OOFF_KB = 0, OOFF_VB = SZ_H64, OOFF_KVN = 2 * SZ_H64;
static_assert(OOFF_KVN + (size_t)RT * 128 * 2 <= (size_t)RL * 1024 * 4, "d_out region overflow");

struct Params {
    const float* in[24];
    float* out;
    char* ws;
};

DI int ltid() { int t = threadIdx.x; asm volatile("" : "+v"(t)); return t; }
DI int lbid() { int t = blockIdx.x; asm volatile("" : "+s"(t)); return t; }
DI unsigned pk2(float a, float b) { f32x2 v = {a, b}; bfx2 r = __builtin_convertvector(v, bfx2); return __builtin_bit_cast(unsigned, r); }
DI float bf2f(unsigned short u) { return __uint_as_float(((unsigned)u) << 16); }
DI float bflo(unsigned u) { return __uint_as_float(u << 16); }
DI float bfhi(unsigned u) { return __uint_as_float(u & 0xffff0000u); }
DI float silu_f(float x) { return x * __builtin_amdgcn_rcpf(1.f + __expf(-x)); }
DI f32x16 mfma32(bf16x8 a, bf16x8 b, f32x16 c) { return __builtin_amdgcn_mfma_f32_32x32x16_bf16(a, b, c, 0, 0, 0); }
DI s16x4 tr_read(const char* p) { bfx4 r = __builtin_amdgcn_ds_read_tr16_b64_v4bf16((LDS_AS bfx4*)p); return __builtin_bit_cast(s16x4, r); }
DI float xor32_max(float x) { const unsigned u = __float_as_uint(x); auto r = __builtin_amdgcn_permlane32_swap(u, u, false, false); return fmaxf(__uint_as_float(r[0]), __uint_as_float(r[1])); }
DI float xor32_sum(float x) { const unsigned u = __float_as_uint(x); auto r = __builtin_amdgcn_permlane32_swap(u, u, false, false); return __uint_as_float(r[0]) + __uint_as_float(r[1]); }
DI bf16x8 cat8(s16x4 lo, s16x4 hi) { return __builtin_shufflevector(lo, hi, 0, 1, 2, 3, 4, 5, 6, 7); }

struct RowInfo { int b, j, s; bool lat; };
DI RowInfo rowinfo(int row) {
    RowInfo r;
    if (row < RL) { r.b = row >> 13; r.j = row & 8191; r.s = r.b; r.lat = true; }
    else { int rc = row - RL; r.b = rc >> 8; r.j = 8192 + (rc & 255); r.s = 4; r.lat = false; }
    return r;
}
DI void store16(bf16_t* dst32, const f32x16& v, float sc, int hh) {
#pragma unroll
    for (int q4 = 0; q4 < 4; ++q4) {
        u32x2 w; w.x = pk2(v[4 * q4] * sc, v[4 * q4 + 1] * sc); w.y = pk2(v[4 * q4 + 2] * sc, v[4 * q4 + 3] * sc);
        *(u32x2*)(dst32 + 8 * q4 + 4 * hh) = w;
    }
}
DI f32x16 ropeB(const f32x16& v, const f32x2* tab, int hh) {
    f32x16 o;
#pragma unroll
    for (int r = 0; r < 8; ++r) {
        const int i = (r & 3) + 8 * (r >> 2) + 4 * hh;
        const f32x2 cs = tab[i];
        o[r] = v[r] * cs.x - v[r + 8] * cs.y;
        o[r + 8] = v[r + 8] * cs.x + v[r] * cs.y;
    }
    return o;
}
DI f32x16 ropeA(const f32x16& v, const f32x2* tr, const f32x2* tc, int hh) {
    f32x16 o;
#pragma unroll
    for (int r = 0; r < 4; ++r) {
        const int i = 4 * hh + r;
        const f32x2 a = tr[i], c = tc[i];
        o[r] = v[r] * a.x - v[r + 4] * a.y;
        o[r + 4] = v[r + 4] * a.x + v[r] * a.y;
        o[8 + r] = v[8 + r] * c.x - v[12 + r] * c.y;
        o[12 + r] = v[12 + r] * c.x + v[8 + r] * c.y;
    }
    return o;
}

constexpr int GA_S = 144, GB_S = 576;
constexpr int GSTAGE = 256 * GA_S + 64 * GB_S;
constexpr int GEMM_LDS = 2 * GSTAGE;

template <int BM, class Epi>
DI void gemm_tile(const bf16_t* __restrict__ A, int lda, const bf16_t* __restrict__ B, int ldb, int K, int row0, int col0, const Epi& epi, char* smem) {
    constexpr int MI = BM / 64, NA_ = BM / 64;
    const int tid = ltid(), lane = tid & 63, wave = tid >> 6, wm = wave >> 2, wn = wave & 3;
    const int l31 = lane & 31, hh = lane >> 5, q = (lane & 15) >> 2, p = lane & 3, nblk = (lane >> 4) & 1;
    f32x16 acc[MI][2];
#pragma unroll
    for (int i = 0; i < MI; ++i)
#pragma unroll
        for (int j = 0; j < 2; ++j)
#pragma unroll
            for (int r = 0; r < 16; ++r) acc[i][j][r] = 0.f;
    u32x4 ra[NA_], rb[4];
    const bf16_t* ag = A + (size_t)(row0 + (tid >> 3)) * lda + (tid & 7) * 8;
    const bf16_t* bg = B + (size_t)(tid >> 5) * ldb + col0 + (tid & 31) * 8;
    const int aw = (tid >> 3) * GA_S + (tid & 7) * 16, bw = BM * GA_S + (tid >> 5) * GB_S + (tid & 31) * 16;
    const int nk = K >> 6;
    const int xoff = (wm * (BM / 2) + l31) * GA_S + hh * 16;
    const int woff = BM * GA_S + (hh * 8 + q) * GB_S + (wn * 64 + nblk * 16 + 4 * p) * 2;
#pragma unroll
    for (int i = 0; i < NA_; ++i) ra[i] = *(const u32x4*)(ag + (size_t)(64 * i) * lda);
#pragma unroll
    for (int i = 0; i < 4; ++i) rb[i] = *(const u32x4*)(bg + (size_t)(16 * i) * ldb);
    __syncthreads();
#pragma unroll
    for (int i = 0; i < NA_; ++i) *(u32x4*)(smem + aw + 64 * i * GA_S) = ra[i];
#pragma unroll
    for (int i = 0; i < 4; ++i) *(u32x4*)(smem + bw + 16 * i * GB_S) = rb[i];
    if (nk > 1) {
#pragma unroll
        for (int i = 0; i < NA_; ++i) ra[i] = *(const u32x4*)(ag + 64 + (size_t)(64 * i) * lda);
#pragma unroll
        for (int i = 0; i < 4; ++i) rb[i] = *(const u32x4*)(bg + (size_t)(64 + 16 * i) * ldb);
    }
    __syncthreads();
    for (int kt = 0; kt < nk; ++kt) {
        const char* cur = smem + (kt & 1) * GSTAGE;
        char* nxt = smem + ((kt & 1) ^ 1) * GSTAGE;
        const bool w1 = kt + 1 < nk, l2 = kt + 2 < nk;
        const bf16_t* a2 = ag + (size_t)(kt + 2) * 64; const bf16_t* b2 = bg + (size_t)(kt + 2) * 64 * ldb;
#pragma unroll
        for (int s = 0; s < 4; ++s) {
            bf16x8 xf[MI], wf[2];
#pragma unroll
            for (int mi = 0; mi < MI; ++mi) xf[mi] = *(const bf16x8*)(cur + xoff + mi * 32 * GA_S + s * 32);
#pragma unroll
            for (int ni = 0; ni < 2; ++ni) {
                const char* wp = cur + woff + s * 16 * GB_S + ni * 64;
                wf[ni] = cat8(tr_read(wp), tr_read(wp + 4 * GB_S));
            }
#pragma unroll
            for (int mi = 0; mi < MI; ++mi)
#pragma unroll
                for (int ni = 0; ni < 2; ++ni) acc[mi][ni] = mfma32(wf[ni], xf[mi], acc[mi][ni]);
            if (w1) {
                if (s < NA_) *(u32x4*)(nxt + aw + 64 * s * GA_S) = ra[s];
                *(u32x4*)(nxt + bw + 16 * s * GB_S) = rb[s];
            }
            if (l2) {
                if (s < NA_) ra[s] = *(const u32x4*)(a2 + (size_t)(64 * s) * lda);
                rb[s] = *(const u32x4*)(b2 + (size_t)(16 * s) * ldb);
            }
            __builtin_amdgcn_sched_barrier(0);
        }
        __syncthreads();
    }
#pragma unroll
    for (int mi = 0; mi < MI; ++mi) epi(acc[mi][0], acc[mi][1], row0 + wm * (BM / 2) + mi * 32 + l31, col0 + wn * 64, hh);
}

template <class Epi>
DI void gemm_phase(const bf16_t* A, int lda, const bf16_t* B, int ldb, int N, int K, const Epi& epi, char* smem) {
    const int nt = N >> 8, small = (RC / 128) * nt;
    const int bid = lbid(), G = gridDim.x;
    if ((G & 7) == 0) {
        const int xcd = bid & 7, loc = bid >> 3, per = G >> 3, mine = (RL / 256 / 8) * nt;
        for (int i = loc; i < mine; i += per) {
            const int cg = i >> 7, rem = i & 127, cw = min(8, nt - cg * 8);
            int pg, w;
            if (cw == 8) { pg = rem >> 5; w = rem & 31; } else { const int rr = i - cg * 128; pg = rr / (4 * cw); w = rr - pg * 4 * cw; }
            const int pl = pg * 4 + (w & 3), cl = cg * 8 + (w >> 2);
            gemm_tile<256>(A, lda, B, ldb, K, (pl * 8 + xcd) * 256, cl * 256, epi, smem);
        }
    } else {
        const int big = (RL / 256) * nt;
        for (int t = bid; t < big; t += G) gemm_tile<256>(A, lda, B, ldb, K, (t / nt) * 256, (t % nt) * 256, epi, smem);
    }
    for (int u = bid; u < small; u += G) gemm_tile<128>(A, lda, B, ldb, K, RL + (u / nt) * 128, (u % nt) * 256, epi, smem);
}

struct EpiSwiglu {
    bf16_t* hid;
    DI void operator()(const f32x16& a0, const f32x16& a1, int row, int cbase, int hh) const {
        bf16_t* dst = hid + (size_t)row * DFF + (cbase >> 1) + 4 * hh;
#pragma unroll
        for (int q4 = 0; q4 < 4; ++q4) {
            float h[4];
#pragma unroll
            for (int j = 0; j < 4; ++j) h[j] = silu_f(a0[4 * q4 + j]) * a1[4 * q4 + j];
            u32x2 w; w.x = pk2(h[0], h[1]); w.y = pk2(h[2], h[3]);
            *(u32x2*)(dst + 8 * q4) = w;
        }
    }
};
struct EpiResid {
    const float* res_lat; const float* res_ctx; float* X; const float* gate; float coef;
    DI void operator()(const f32x16& a0, const f32x16& a1, int row, int cbase, int hh) const {
        const int s = row < RL ? (row >> 13) : 4;
        const float* rp = row < RL ? res_lat + (size_t)row * 1024 : res_ctx + (size_t)(row - RL) * 1024;
        const float* gp = gate + s * 9216;
        float* xp = X + (size_t)row * 1024;
#pragma unroll
        for (int ni = 0; ni < 2; ++ni)
#pragma unroll
            for (int q4 = 0; q4 < 4; ++q4) {
                const int c = cbase + ni * 32 + 8 * q4 + 4 * hh;
                const f32x4 r = *(const f32x4*)(rp + c), g = *(const f32x4*)(gp + c);
                f32x4 z;
#pragma unroll
                for (int j = 0; j < 4; ++j) z[j] = ALPHA * r[j] + coef * g[j] * (ni ? a1[4 * q4 + j] : a0[4 * q4 + j]);
                *(f32x4*)(xp + c) = z;
            }
    }
};
struct EpiEvIn {
    bf16_t *QN, *QB, *KVN, *KA, *KB, *VB; const f32x2 *tAr, *tAc, *tBr, *tBc;
    DI void operator()(const f32x16& a0, const f32x16& a1, int row, int cbase, int hh) const {
        const RowInfo ri = rowinfo(row);
        const int gr = (ri.j >> 6) & 127, gc = ri.j & 63;
#pragma unroll
        for (int ni = 0; ni < 2; ++ni) {
            const int g = (cbase >> 5) + ni;
            const f32x16& v = ni ? a1 : a0;
            if (g < 8) store16(QN + (size_t)row * 256 + g * 32, v, 1.f, hh);
            else if (g < 24) {
                const int hv = (g - 8) >> 1, half = (g - 8) & 1;
                f32x16 w = v; if (ri.lat) w = ropeB(v, half ? tBc + gc * 16 : tBr + gr * 16, hh);
                store16(QB + ((size_t)(ri.b * 8 + hv) * NK + ri.j) * 64 + half * 32, w, QB_SCALE, hh);
            } else if (g < 28) store16(KVN + (size_t)row * 128 + (g - 24) * 32, v, 1.f, hh);
            else if (g == 28) {
                f32x16 w = v; if (ri.lat) w = ropeA(v, tAr + gr * 8, tAc + gc * 8, hh);
                for (int h = 0; h < 8; ++h) store16(KA + ((size_t)(ri.b * 8 + h) * NK + ri.j) * 96 + 64, w, 1.f, hh);
            } else if (g < 45) {
                const int hv = (g - 29) >> 1, half = (g - 29) & 1;
                f32x16 w = v; if (ri.lat) w = ropeB(v, half ? tBc + gc * 16 : tBr + gr * 16, hh);
                store16(KB + ((size_t)(ri.b * 8 + hv) * NK + ri.j) * 64 + half * 32, w, 1.f, hh);
            } else if (g < 61) {
                const int idx = g - 45, h = idx >> 2, part = idx & 3;
                store16(VB + ((size_t)(ri.b * 4 + h) * NK + ri.j) * 128 + part * 32, v, 1.f, hh);
            }
        }
    }
};
struct EpiUQ {
    bf16_t* QA; const f32x2 *tAr, *tAc;
    DI void operator()(const f32x16& a0, const f32x16& a1, int row, int cbase, int hh) const {
        const RowInfo ri = rowinfo(row);
        const int gr = (ri.j >> 6) & 127, gc = ri.j & 63;
#pragma unroll
        for (int ni = 0; ni < 2; ++ni) {
            const int g = (cbase >> 5) + ni, h = g / 3, part = g - 3 * h;
            f32x16 w = ni ? a1 : a0;
            if (part == 2 && ri.lat) w = ropeA(ni ? a1 : a0, tAr + gr * 8, tAc + gc * 8, hh);
            store16(QA + ((size_t)(ri.b * 8 + h) * NK + ri.j) * 96 + part * 32, w, QA_SCALE, hh);
        }
    }
};
struct EpiUKV {
    bf16_t *KA, *VA;
    DI void operator()(const f32x16& a0, const f32x16& a1, int row, int cbase, int hh) const {
        const RowInfo ri = rowinfo(row);
#pragma unroll
        for (int ni = 0; ni < 2; ++ni) {
            const int g = (cbase >> 5) + ni, h = g >> 2, part = g & 3;
            const size_t tk = (size_t)(ri.b * 8 + h) * NK + ri.j;
            if (part < 2) store16(KA + tk * 96 + part * 32, ni ? a1 : a0, 1.f, hh);
            else store16(VA + tk * 64 + (part - 2) * 32, ni ? a1 : a0, 1.f, hh);
        }
    }
};
struct EpiOdIn {
    bf16_t *U, *QD, *KD, *VD;
    DI void operator()(const f32x16& a0, const f32x16& a1, int row, int cbase, int hh) const {
        const RowInfo ri = rowinfo(row);
#pragma unroll
        for (int ni = 0; ni < 2; ++ni) {
            const int g = (cbase >> 5) + ni;
            const f32x16& v = ni ? a1 : a0;
            if (g < 16) store16(U + (size_t)row * 512 + g * 32, v, 1.f, hh);
            else {
                const int gg = (g - 16) & 15, h = gg >> 1, half = gg & 1;
                const size_t off = ((size_t)(ri.b * 8 + h) * NK + ri.j) * 64 + half * 32;
                if (g < 32) store16(QD + off, v, QD_SCALE, hh);
                else if (g < 48) store16(KD + off, v, 1.f, hh);
                else store16(VD + off, v, 1.f, hh);
            }
        }
    }
};
struct EpiPool {
    bf16_t* CC; const float* pscale; int gidx;
    DI void operator()(const f32x16& a0, const f32x16& a1, int row, int cbase, int hh) const {
#pragma unroll
        for (int ni = 0; ni < 2; ++ni)
#pragma unroll
            for (int q4 = 0; q4 < 4; ++q4) {
                const int c = gidx * 128 + cbase + ni * 32 + 8 * q4 + 4 * hh;
                const f32x4 s = *(const f32x4*)(pscale + c);
                const f32x16& v = ni ? a1 : a0;
                u32x2 w; w.x = pk2(v[4 * q4] * s[0], v[4 * q4 + 1] * s[1]); w.y = pk2(v[4 * q4 + 2] * s[2], v[4 * q4 + 3] * s[3]);
                *(u32x2*)(CC + (size_t)row * 1024 + c) = w;
            }
    }
};

constexpr int ATT_LDS = 64 * (96 + 8) * 2 + 64 * (128 * 2 + 64);
constexpr int RPB_OFF = 2 * ATT_LDS;
constexpr int SMEM_BYTES = GEMM_LDS;

struct NAInfo { int qr; int kstart; };

template <int DQK, int DV, bool NA>
DI void attend(const bf16_t* __restrict__ Q, int q0, const bf16_t* __restrict__ Kb, const bf16_t* __restrict__ Vb,
               int s0, int n0, int s1, int n1, f32x16 (&o)[DV / 32], char* smem, NAInfo na) {
    constexpr int KS = (DQK + 8) * 2, VS = DV * 2 + 64;
    constexpr int KCH = DQK / 8, KN = (64 * KCH + NTHR - 1) / NTHR, VCH = DV / 8, VN = (64 * VCH + NTHR - 1) / NTHR;
    constexpr int NS = DQK / 16, NDT = DV / 32;
    const int tid = ltid(), lane = tid & 63, wave = tid >> 6;
    const int l31 = lane & 31, hh = lane >> 5, q = (lane & 15) >> 2, p = lane & 3, dblk = (lane >> 4) & 1;
    bf16x8 qf[NS];
    {
        const bf16_t* qp = Q + (size_t)(q0 + wave * 32 + l31) * DQK + hh * 8;
#pragma unroll
        for (int s = 0; s < NS; ++s) qf[s] = *(const bf16x8*)(qp + s * 16);
    }
#pragma unroll
    for (int d = 0; d < NDT; ++d)
#pragma unroll
        for (int r = 0; r < 16; ++r) o[d][r] = 0.f;
    float m = NA ? -INFINITY : 0.f, l = 0.f;
    f32x16 cinit;
#pragma unroll
    for (int r = 0; r < 16; ++r) cinit[r] = 0.f;
    u32x4 rk[KN], rv[VN];
    const int nt = n0 + n1;
    auto gload = [&](int t) {
        const int j0 = t < n0 ? s0 + t * 64 : s1 + (t - n0) * 64;
#pragma unroll
        for (int i = 0; i < KN; ++i) { int id = tid + NTHR * i; if (id >= 64 * KCH) id -= 64 * KCH; const int row = id / KCH, ch = id - row * KCH; rk[i] = *(const u32x4*)(Kb + (size_t)(j0 + row) * DQK + ch * 8); }
#pragma unroll
        for (int i = 0; i < VN; ++i) { int id = tid + NTHR * i; if (id >= 64 * VCH) id -= 64 * VCH; const int row = id / VCH, ch = id - row * VCH; rv[i] = *(const u32x4*)(Vb + (size_t)(j0 + row) * DV + ch * 8); }
    };
    gload(0);
    int qc = 0, cs = 0, rs = 0;
    if (NA) { qc = (wave & 1) * 32 + l31; cs = min(max(qc - 8, 0), 48); rs = min(max(na.qr - 4, 0), 120); }
    const float* rpb = (const float*)(smem + RPB_OFF);
    auto lwrite = [&](char* stg) {
#pragma unroll
        for (int i = 0; i < KN; ++i) { int id = tid + NTHR * i; if (id >= 64 * KCH) id -= 64 * KCH; const int row = id / KCH, ch = id - row * KCH; *(u32x4*)(stg + row * KS + ch * 16) = rk[i]; }
#pragma unroll
        for (int i = 0; i < VN; ++i) { int id = tid + NTHR * i; if (id >= 64 * VCH) id -= 64 * VCH; const int row = id / VCH, ch = id - row * VCH; *(u32x4*)(stg + 64 * KS + row * VS + ch * 16) = rv[i]; }
    };
    __syncthreads();
    lwrite(smem);
    if (nt > 1) gload(1);
    __syncthreads();
    for (int t = 0; t < nt; ++t) {
        const char* sK = smem + (t & 1) * ATT_LDS; const char* sV = sK + 64 * KS;
        bool active = true; int kr = 0;
        if (NA && t < n0) { kr = na.kstart + t; active = (kr >= rs) && (kr < rs + 8); }
        if (active) {
#pragma unroll 1
            for (int sub = 0; sub < 2; ++sub) {
                f32x16 st;
                if (NA) {
#pragma unroll
                    for (int r = 0; r < 16; ++r) st[r] = 0.f;
                } else st = cinit;
#pragma unroll
                for (int s = 0; s < NS; ++s) {
                    const bf16x8 kf = *(const bf16x8*)(sK + (sub * 32 + l31) * KS + (s * 16 + hh * 8) * 2);
                    st = mfma32(kf, qf[s], st);
                }
                if (NA && t < n0) {
                    const float* brow = rpb + (kr - na.qr + 7) * 31 + 15 - qc;
#pragma unroll
                    for (int r = 0; r < 16; ++r) {
                        const int kc = sub * 32 + (r & 3) + 8 * (r >> 2) + 4 * hh;
                        const bool valid = (kc >= cs) && (kc < cs + 16);
                        const int bi = valid ? kc : cs;
                        const float bias = brow[bi];
                        st[r] = valid ? st[r] + bias : -INFINITY;
                    }
                }
                float mx = st[0];
#pragma unroll
                for (int r = 1; r < 16; ++r) mx = fmaxf(mx, st[r]);
                mx = xor32_max(mx);
                float rsum = 0.f;
                if (NA) {
                    const float mnew = fmaxf(m, mx);
                    const float muse = (mnew == -INFINITY) ? 0.f : mnew;
                    const float alpha = __builtin_amdgcn_exp2f(m - muse);
                    m = mnew;
                    l *= alpha;
#pragma unroll
                    for (int d = 0; d < NDT; ++d)
#pragma unroll
                        for (int r = 0; r < 16; ++r) o[d][r] *= alpha;
#pragma unroll
                    for (int r = 0; r < 16; ++r) { st[r] = __builtin_amdgcn_exp2f(st[r] - muse); rsum += st[r]; }
                } else {
                    const bool first = (t == 0) && (sub == 0);
                    if (first || __builtin_amdgcn_ballot_w64(mx > 8.f) != 0) {
                        const float delta = first ? mx : fmaxf(mx, 0.f);
                        const float alpha = first ? 1.f : __builtin_amdgcn_exp2f(-delta);
                        m += delta;
                        l *= alpha;
#pragma unroll
                        for (int d = 0; d < NDT; ++d)
#pragma unroll
                            for (int r = 0; r < 16; ++r) o[d][r] *= alpha;
#pragma unroll
                        for (int r = 0; r < 16; ++r) { st[r] -= delta; cinit[r] = -m; }
                    }
#pragma unroll
                    for (int r = 0; r < 16; ++r) { st[r] = __builtin_amdgcn_exp2f(st[r]); rsum += st[r]; }
                }
                l += rsum;
                bf16x8 pf[2];
#pragma unroll
                for (int s2 = 0; s2 < 2; ++s2) {
                    u32x4 w;
                    w.x = pk2(st[8 * s2], st[8 * s2 + 1]); w.y = pk2(st[8 * s2 + 2], st[8 * s2 + 3]);
                    w.z = pk2(st[8 * s2 + 4], st[8 * s2 + 5]); w.w = pk2(st[8 * s2 + 6], st[8 * s2 + 7]);
                    pf[s2] = __builtin_bit_cast(bf16x8, w);
                }
#pragma unroll
                for (int d = 0; d < NDT; ++d)
#pragma unroll
                    for (int s2 = 0; s2 < 2; ++s2) {
                        const char* vp = sV + (sub * 32 + 16 * s2 + 4 * hh + q) * VS + (d * 32 + dblk * 16 + 4 * p) * 2;
                        const bf16x8 vf = cat8(tr_read(vp), tr_read(vp + 8 * VS));
                        o[d] = mfma32(vf, pf[s2], o[d]);
                    }
            }
        }
        if (t + 1 < nt) lwrite(smem + ((t & 1) ^ 1) * ATT_LDS);
        if (t + 2 < nt) gload(t + 2);
        __syncthreads();
    }
    l = xor32_sum(l);
    const float inv = 1.f / l;
#pragma unroll
    for (int d = 0; d < NDT; ++d)
#pragma unroll
        for (int r = 0; r < 16; ++r) o[d][r] *= inv;
}

DI int qrow_of(int b, int j) { return j < SEQ ? b * SEQ + j : RL + b * CTX + (j - SEQ); }

DI void even_attention_phase(const Params& P, char* smem) {
    char* ws = P.ws; char* hid = ws + OFF_HID; char* ob = (char*)P.out;
    const bf16_t* QA = (const bf16_t*)(hid + HOFF_QA); const bf16_t* KA = (const bf16_t*)(hid + HOFF_KA); const bf16_t* VA = (const bf16_t*)(hid + HOFF_VA);
    const bf16_t* QB = (const bf16_t*)(hid + HOFF_QB); const bf16_t* KB = (const bf16_t*)(ob + OOFF_KB); const bf16_t* VB = (const bf16_t*)(ob + OOFF_VB);
    bf16_t* CC = (bf16_t*)(ws + OFF_XM);
    const float lam = *(const float*)(ws + OFF_LAM);
    const float* gsub = P.in[18];
    const int lane = ltid() & 63, wave = ltid() >> 6, l31 = lane & 31, hh = lane >> 5;
    constexpr int NQT = 33, NDIFF = NB * 4 * NQT, NMLA = NB * 8 * NQT;
    NAInfo na; na.qr = 0; na.kstart = 0;
    unsigned* wq = (unsigned*)(ws + OFF_BAR + 128);
    volatile int* slot = (volatile int*)(smem + 2 * ATT_LDS + 2048);
    for (;;) {
        __syncthreads();
        if (ltid() == 0) *slot = (int)atomicAdd(wq, 1u);
        __syncthreads();
        const int u = *slot;
        if (u >= NDIFF + NMLA) break;
        if (u < NDIFF) {
            const int qt = u % NQT, bh = u / NQT, h = bh & 3, b = bh >> 2;
            const int q0 = qt < 32 ? qt * 256 : SEQ;
            const int s0 = qt < 32 ? 0 : SEQ, n0 = qt < 32 ? NK / 64 : CTX / 64;
            const bf16_t* V = VB + (size_t)(b * 4 + h) * NK * 128;
            f32x16 o[4];
            attend<64, 128, false>(QB + (size_t)(b * 8 + 2 * h) * NK * 64, q0, KB + (size_t)(b * 8 + 2 * h) * NK * 64, V, s0, n0, 0, 0, o, smem, na);
            const int row = qrow_of(b, q0 + wave * 32 + l31);
            bf16_t* dst = CC + (size_t)row * 1024 + 512 + h * 128;
#pragma unroll
            for (int d = 0; d < 4; ++d) store16(dst + d * 32, o[d], 1.f, hh);
            f32x16 o2[4];
            attend<64, 128, false>(QB + (size_t)(b * 8 + 2 * h + 1) * NK * 64, q0, KB + (size_t)(b * 8 + 2 * h + 1) * NK * 64, V, s0, n0, 0, 0, o2, smem, na);
            float ss = 0.f;
#pragma unroll
            for (int d = 0; d < 4; ++d)
#pragma unroll
                for (int q4 = 0; q4 < 4; ++q4) {
                    const u32x2 w = *(const volatile u32x2*)(dst + d * 32 + 8 * q4 + 4 * hh);
                    const float a0 = bflo(w.x) - lam * o2[d][4 * q4], a1 = bfhi(w.x) - lam * o2[d][4 * q4 + 1], a2 = bflo(w.y) - lam * o2[d][4 * q4 + 2], a3 = bfhi(w.y) - lam * o2[d][4 * q4 + 3];
                    o[d][4 * q4] = a0; o[d][4 * q4 + 1] = a1; o[d][4 * q4 + 2] = a2; o[d][4 * q4 + 3] = a3;
                    ss += (a0 * a0 + a1 * a1) + (a2 * a2 + a3 * a3);
                }
            ss = xor32_sum(ss);
            const float rn = rsqrtf(ss * (1.f / 128.f) + 1e-5f) * 0.8f;
#pragma unroll
            for (int d = 0; d < 4; ++d)
#pragma unroll
                for (int q4 = 0; q4 < 4; ++q4) {
                    const int c = d * 32 + 8 * q4 + 4 * hh;
                    const f32x4 g = *(const f32x4*)(gsub + c);
                    u32x2 w; w.x = pk2(o[d][4 * q4] * rn * g[0], o[d][4 * q4 + 1] * rn * g[1]); w.y = pk2(o[d][4 * q4 + 2] * rn * g[2], o[d][4 * q4 + 3] * rn * g[3]);
                    *(u32x2*)(dst + c) = w;
                }
        } else {
            const int v = u - NDIFF, qt = v % NQT, bh = v / NQT, h = bh & 7, b = bh >> 3;
            const int q0 = qt < 32 ? qt * 256 : SEQ;
            const int s0 = qt < 32 ? 0 : SEQ, n0 = qt < 32 ? NK / 64 : CTX / 64;
            f32x16 o[2];
            attend<96, 64, false>(QA + (size_t)(b * 8 + h) * NK * 96, q0, KA + (size_t)(b * 8 + h) * NK * 96, VA + (size_t)(b * 8 + h) * NK * 64, s0, n0, 0, 0, o, smem, na);
            const int row = qrow_of(b, q0 + wave * 32 + l31);
            bf16_t* dst = CC + (size_t)row * 1024 + h * 64;
#pragma unroll
            for (int d = 0; d < 2; ++d) store16(dst + d * 32, o[d], 1.f, hh);
        }
    }
}

DI void odd_attention_phase(const Params& P, char* smem) {
    char* ws = P.ws; char* hid = ws + OFF_HID;
    const bf16_t* QD = (const bf16_t*)(hid + HOFF_QD); const bf16_t* KD = (const bf16_t*)(hid + HOFF_KD); const bf16_t* VD = (const bf16_t*)(hid + HOFF_VD);
    bf16_t* CC = (bf16_t*)(ws + OFF_XM);
    const float* rpbg = P.in[23];
    const int lane = ltid() & 63, wave = ltid() >> 6, l31 = lane & 31, hh = lane >> 5;
    float* rpbl = (float*)(smem + RPB_OFF);
    constexpr int NU = NB * 8 * 32;
    for (int u = lbid(); u < NU; u += gridDim.x) {
        const int rp = u & 31, bh = u >> 5, h = bh & 7, b = bh >> 3;
        __syncthreads();
        for (int i = ltid(); i < 465; i += NTHR) rpbl[i] = rpbg[h * 465 + i] * LOG2E;
        const int r0 = rp * 4;
        NAInfo na; na.qr = r0 + (wave >> 1);
        const int rs0 = min(max(r0 - 4, 0), 120);
        na.kstart = min(rs0, 117);
        f32x16 o[2];
        const size_t hb = (size_t)(b * 8 + h) * NK * 64;
        attend<64, 64, true>(QD + hb, r0 * 64, KD + hb, VD + hb, na.kstart * 64, 11, SEQ, CTX / 64, o, smem, na);
        const int row = b * SEQ + r0 * 64 + wave * 32 + l31;
        bf16_t* dst = CC + (size_t)row * 1024 + 512 + h * 64;
#pragma unroll
        for (int d = 0; d < 2; ++d) store16(dst + d * 32, o[d], 1.f, hh);
    }
}

DI void cvt8(bf16_t* dst, const float* src, float sc) {
    const f32x4 a = *(const f32x4*)src, b = *(const f32x4*)(src + 4);
    u32x4 w; w.x = pk2(a[0] * sc, a[1] * sc); w.y = pk2(a[2] * sc, a[3] * sc); w.z = pk2(b[0] * sc, b[1] * sc); w.w = pk2(b[2] * sc, b[3] * sc);
    *(u32x4*)dst = w;
}
DI void cvt_rows(bf16_t* dst, int ldd, const float* src, int lds_, int rows, int cols_src, const float* rowscale, size_t gtid, size_t gstride) {
    const int c8 = ldd >> 3; const size_t n = (size_t)rows * c8;
    for (size_t i0 = gtid; i0 < n; i0 += 4 * gstride) {
        f32x4 a[4], b[4]; float sc[4];
#pragma unroll
        for (int u = 0; u < 4; ++u) {
            const size_t i = i0 + u * gstride;
            const int k = (int)(i / c8), c = (int)(i % c8) * 8;
            const bool ok = i < n && c < cols_src;
            const float* p = src + (ok ? (size_t)k * lds_ + c : 0);
            a[u] = *(const f32x4*)p; b[u] = *(const f32x4*)(p + 4);
            sc[u] = !ok ? 0.f : (rowscale ? rowscale[k] : 1.f);
        }
#pragma unroll
        for (int u = 0; u < 4; ++u) {
            const size_t i = i0 + u * gstride;
            if (i < n) {
                const int k = (int)(i / c8), c = (int)(i % c8) * 8;
                u32x4 w; w.x = pk2(a[u][0] * sc[u], a[u][1] * sc[u]); w.y = pk2(a[u][2] * sc[u], a[u][3] * sc[u]); w.z = pk2(b[u][0] * sc[u], b[u][1] * sc[u]); w.w = pk2(b[u][2] * sc[u], b[u][3] * sc[u]);
                *(u32x4*)(dst + (size_t)k * ldd + c) = w;
            }
        }
    }
}

DI void phase_pro_a(const Params& P, char* smem) {
    char* ws = P.ws;
    const size_t gtid = (size_t)lbid() * NTHR + ltid(), gstride = (size_t)gridDim.x * NTHR;
    for (int lf = 0; lf < 4; ++lf) {
        const float* sg = P.in[8] + (size_t)lf * 1024 * DFF; const float* su = P.in[9] + (size_t)lf * 1024 * DFF;
        bf16_t* dst = (bf16_t*)(ws + OFF_WGU + lf * SZ_WGU);
        for (size_t i0 = gtid; i0 < 1024ull * 704; i0 += 4 * gstride) {
            f32x4 a[4], b[4];
#pragma unroll
            for (int u = 0; u < 4; ++u) {
                const size_t i = i0 + u * gstride < 1024ull * 704 ? i0 + u * gstride : i0;
                const int k = (int)(i / 704), n = (int)(i % 704) * 8, grp = n >> 6, w = n & 63;
                const float* src = ((w < 32) ? sg : su) + (size_t)k * DFF + grp * 32 + (w & 31);
                a[u] = *(const f32x4*)src; b[u] = *(const f32x4*)(src + 4);
            }
#pragma unroll
            for (int u = 0; u < 4; ++u) {
                const size_t i = i0 + u * gstride;
                if (i < 1024ull * 704) {
                    const int k = (int)(i / 704), n = (int)(i % 704) * 8;
                    u32x4 w; w.x = pk2(a[u][0], a[u][1]); w.y = pk2(a[u][2], a[u][3]); w.z = pk2(b[u][0], b[u][1]); w.w = pk2(b[u][2], b[u][3]);
                    *(u32x4*)(dst + (size_t)k * 5632 + n) = w;
                }
            }
        }
        cvt_rows((bf16_t*)(ws + OFF_WD + lf * SZ_WD), 1024, P.in[10] + (size_t)lf * DFF * 1024, 1024, DFF, 1024, nullptr, gtid, gstride);
    }
    cvt_rows((bf16_t*)(ws + OFF_EVIN), 2048, P.in[11], 1952, 1024, 1952, nullptr, gtid, gstride);
    cvt_rows((bf16_t*)(ws + OFF_EVOUT), 1024, P.in[12], 1024, 1024, 1024, nullptr, gtid, gstride);
    cvt_rows((bf16_t*)(ws + OFF_UQ), 768, P.in[15], 768, 256, 768, P.in[13], gtid, gstride);
    cvt_rows((bf16_t*)(ws + OFF_UKV), 1024, P.in[16], 1024, 128, 1024, P.in[14], gtid, gstride);
    cvt_rows((bf16_t*)(ws + OFF_ODIN), 2048, P.in[19], 2048, 1024, 2048, nullptr, gtid, gstride);
    cvt_rows((bf16_t*)(ws + OFF_ODOUT), 1024, P.in[20], 1024, 1024, 1024, nullptr, gtid, gstride);
    for (size_t i = gtid; i < 512ull * 64; i += gstride) {
        const int k = (int)(i >> 6), n = (int)(i & 63) * 8;
        bf16_t* d = (bf16_t*)(ws + OFF_POOL) + (size_t)k * 512 + n;
        if ((k >> 7) == (n >> 7)) cvt8(d, P.in[21] + (size_t)k * 128 + (n & 127), 1.f);
        else { u32x4 z = {0u, 0u, 0u, 0u}; *(u32x4*)d = z; }
    }
    if (gtid < 128 * 8) { const int r = (int)gtid >> 3, i = (int)gtid & 7; const float inv = exp2f(-(float)i * (13.287712379549449f / 8.f)); float rev = (float)r * inv * 0.15915494309189535f; rev -= floorf(rev);
        f32x2 v = {__builtin_amdgcn_cosf(rev), __builtin_amdgcn_sinf(rev)}; ((f32x2*)(ws + OFF_TAR))[gtid] = v; if (r < 64) ((f32x2*)(ws + OFF_TAC))[gtid] = v; }
    if (gtid < 128 * 16) { const int r = (int)gtid >> 4, i = (int)gtid & 15; const float inv = exp2f(-(float)i * (13.287712379549449f / 16.f)); float rev = (float)r * inv * 0.15915494309189535f; rev -= floorf(rev);
        f32x2 v = {__builtin_amdgcn_cosf(rev), __builtin_amdgcn_sinf(rev)}; ((f32x2*)(ws + OFF_TBR))[gtid] = v; if (r < 64) ((f32x2*)(ws + OFF_TBC))[gtid] = v; }
    if (gtid == 0) {
        const float* lv = P.in[17]; float a = 0.f, b = 0.f;
        for (int i = 0; i < 64; ++i) { a += lv[i] * lv[64 + i]; b += lv[128 + i] * lv[192 + i]; }
        *(float*)(ws + OFF_LAM) = expf(a) - expf(b) + 0.2f;
    }
    float* sc = (float*)smem;
    float* red = sc + 5 * 1024;
    const int tid = ltid(), jj = tid & 31, ig = tid >> 5;
    __syncthreads();
    for (int i = tid; i < 5 * 1024; i += NTHR) { const float v = i < 4096 ? P.in[1][i] : P.in[3][i - 4096]; sc[i] = v / (1.f + expf(-v)); }
    __syncthreads();
    for (int u = lbid(); u < 576; u += gridDim.x) {
        const int l = u / 288, j0 = (u % 288) * 32;
        float a[5] = {0.f, 0.f, 0.f, 0.f, 0.f};
        const float* w = P.in[4] + (size_t)l * 1024 * 9216 + (size_t)(ig * 64) * 9216 + j0 + jj;
        for (int i0 = 0; i0 < 64; i0 += 8) {
            float wv[8];
#pragma unroll
            for (int k = 0; k < 8; ++k) wv[k] = w[(size_t)(i0 + k) * 9216];
#pragma unroll
            for (int k = 0; k < 8; ++k)
#pragma unroll
                for (int s2 = 0; s2 < 5; ++s2) a[s2] += sc[s2 * 1024 + ig * 64 + i0 + k] * wv[k];
        }
#pragma unroll
        for (int s2 = 0; s2 < 5; ++s2) red[(ig * 5 + s2) * 32 + jj] = a[s2];
        __syncthreads();
        if (tid < 160) {
            const int s2 = tid >> 5, j = tid & 31;
            float v = P.in[5][l * 9216 + j0 + j];
#pragma unroll
            for (int g = 0; g < 16; ++g) v += red[(g * 5 + s2) * 32 + j];
            ((float*)(ws + OFF_MOD))[(size_t)(l * 5 + s2) * 9216 + j0 + j] = v;
        }
        __syncthreads();
    }
}

DI void phase_pro_b(const Params& P) {
    char* ws = P.ws; bf16_t* XM = (bf16_t*)(ws + OFF_XM); const float* MOD = (const float*)(ws + OFF_MOD);
    const size_t gtid = (size_t)lbid() * NTHR + ltid(), gstride = (size_t)gridDim.x * NTHR;
    for (size_t i = gtid; i < (size_t)RT * 128; i += gstride) {
        const int row = (int)(i >> 7), c = (int)(i & 127) * 8;
        const float* src = row < RL ? P.in[0] + (size_t)row * 1024 + c : P.in[2] + (size_t)(row - RL) * 1024 + c;
        const int s = row < RL ? (row >> 13) : 4;
        const float* sh = MOD + (size_t)s * 9216 + c; const float* scl = sh + 1024;
        unsigned w[4];
#pragma unroll
        for (int hf = 0; hf < 2; ++hf) {
            const f32x4 x = *(const f32x4*)(src + 4 * hf), a = *(const f32x4*)(sh + 4 * hf), g = *(const f32x4*)(scl + 4 * hf);
            w[2 * hf] = pk2(x[0] * (1.f + g[0]) + a[0], x[1] * (1.f + g[1]) + a[1]);
            w[2 * hf + 1] = pk2(x[2] * (1.f + g[2]) + a[2], x[3] * (1.f + g[3]) + a[3]);
        }
        u32x4 o = {w[0], w[1], w[2], w[3]};
        *(u32x4*)(XM + (size_t)row * 1024 + c) = o;
    }
}

struct LnSpec { int l, which, lnext, mshift; bool final_; unsigned* cnt; };
template <int NR>
DI void ln_rows(const Params& P, const LnSpec& sp, int row, int stride, int lane) {
    char* ws = P.ws; float* X = (float*)(ws + OFF_X); bf16_t* XM = (bf16_t*)(ws + OFF_XM); const float* MOD = (const float*)(ws + OFF_MOD);
    const float* g = P.in[6] + (sp.l * 3 + sp.which) * 1024; const float* bb = P.in[7] + (sp.l * 3 + sp.which) * 1024;
    f32x4 v[NR][4]; float s[NR], qv[NR];
#pragma unroll
    for (int k = 0; k < NR; ++k) {
        const float* xp = X + (size_t)(row + k * stride) * 1024;
#pragma unroll
        for (int i = 0; i < 4; ++i) v[k][i] = *(const f32x4*)(xp + (i * 64 + lane) * 4);
    }
#pragma unroll
    for (int k = 0; k < NR; ++k) {
        s[k] = 0.f;
#pragma unroll
        for (int i = 0; i < 4; ++i) s[k] += (v[k][i][0] + v[k][i][1]) + (v[k][i][2] + v[k][i][3]);
    }
#pragma unroll
    for (int o = 32; o >= 1; o >>= 1)
#pragma unroll
        for (int k = 0; k < NR; ++k) s[k] += __shfl_xor(s[k], o);
#pragma unroll
    for (int k = 0; k < NR; ++k) {
        s[k] *= (1.f / 1024.f); qv[k] = 0.f;
#pragma unroll
        for (int i = 0; i < 4; ++i)
#pragma unroll
            for (int j = 0; j < 4; ++j) { const float d = v[k][i][j] - s[k]; qv[k] += d * d; }
    }
#pragma unroll
    for (int o = 32; o >= 1; o >>= 1)
#pragma unroll
        for (int k = 0; k < NR; ++k) qv[k] += __shfl_xor(qv[k], o);
#pragma unroll
    for (int k = 0; k < NR; ++k) {
        const int r = row + k * stride;
        const float mu = s[k], rstd = rsqrtf(qv[k] * (1.f / 1024.f) + 1e-6f);
        const int sidx = r < RL ? (r >> 13) : 4;
        const float* sh = MOD + (size_t)(sp.lnext * 5 + sidx) * 9216 + sp.mshift * 1024; const float* scl = sh + 1024;
        float* xp = X + (size_t)r * 1024;
#pragma unroll
        for (int i = 0; i < 4; ++i) {
            const int c = (i * 64 + lane) * 4;
            const f32x4 gg = *(const f32x4*)(g + c), b4 = *(const f32x4*)(bb + c);
            f32x4 y;
#pragma unroll
            for (int j = 0; j < 4; ++j) y[j] = (v[k][i][j] - mu) * rstd * gg[j] + b4[j];
            if (sp.final_) { *(f32x4*)(P.out + (size_t)r * 1024 + c) = y; }
            else {
                *(f32x4*)(xp + c) = y;
                const f32x4 a = *(const f32x4*)(sh + c), sg = *(const f32x4*)(scl + c);
                u32x2 w; w.x = pk2(y[0] * (1.f + sg[0]) + a[0], y[1] * (1.f + sg[1]) + a[1]); w.y = pk2(y[2] * (1.f + sg[2]) + a[2], y[3] * (1.f + sg[3]) + a[3]);
                *(u32x2*)(XM + (size_t)r * 1024 + c) = w;
            }
        }
    }
}
DI void phase_ln(const Params& P, int l, int which, int lnext, int mshift, bool final_) {
    const LnSpec sp{l, which, lnext, mshift, final_, nullptr};
    const int lane = ltid() & 63, wave = ltid() >> 6;
    const int nq = (final_ ? RL : RT) / 4;
    for (int q = lbid() * NWAVE + wave; q < nq; q += gridDim.x * NWAVE) ln_rows<4>(P, sp, 4 * q, 1, lane);
}

DI void phase_ev_rms(const Params& P) {
    char* ws = P.ws; bf16_t* QN = (bf16_t*)(ws + OFF_HID + HOFF_QN); bf16_t* KVN = (bf16_t*)((char*)P.out + OOFF_KVN);
    const int lane = ltid() & 63, wave = ltid() >> 6;
    for (int row = lbid() * NWAVE + wave; row < RT; row += gridDim.x * NWAVE) {
        {
            u32x2* p = (u32x2*)(QN + (size_t)row * 256 + lane * 4); const u32x2 w = *p;
            float a = bflo(w.x), b = bfhi(w.x), c = bflo(w.y), d = bfhi(w.y);
            float s = a * a + b * b + c * c + d * d;
#pragma unroll
            for (int o = 32; o >= 1; o >>= 1) s += __shfl_xor(s, o);
            const float r = rsqrtf(s * (1.f / 256.f) + 1e-6f);
            u32x2 o2; o2.x = pk2(a * r, b * r); o2.y = pk2(c * r, d * r); *p = o2;
        }
        {
            unsigned* p = (unsigned*)(KVN + (size_t)row * 128 + lane * 2); const unsigned w = *p;
            float a = bflo(w), b = bfhi(w);
            float s = a * a + b * b;
#pragma unroll
            for (int o = 32; o >= 1; o >>= 1) s += __shfl_xor(s, o);
            const float r = rsqrtf(s * (1.f / 128.f) + 1e-6f);
            *p = pk2(a * r, b * r);
        }
    }
}

DI void phase_od_pool(const Params& P) {
    char* ws = P.ws; const bf16_t* U = (const bf16_t*)(ws + OFF_HID + HOFF_U); bf16_t* PL = (bf16_t*)(ws + OFF_HID + HOFF_PL);
    const size_t gtid = (size_t)lbid() * NTHR + ltid(), gstride = (size_t)gridDim.x * NTHR;
    for (size_t i = gtid; i < (size_t)RT * 64; i += gstride) {
        const int row = (int)(i >> 6), c = (int)(i & 63) * 8, grp = c >> 7;
        const int w = 2 << grp, left = w >> 1, right = w - 1 - left;
        int base, n, t;
        if (row < RL) { base = row & ~8191; n = SEQ; t = row & 8191; } else { const int rc = row - RL; base = RL + (rc & ~255); n = CTX; t = rc & 255; }
        const int lo = max(t - left, 0), hi = min(t + right + 1, n);
        float acc[8] = {0.f, 0.f, 0.f, 0.f, 0.f, 0.f, 0.f, 0.f};
        for (int tt = lo; tt < hi; ++tt) {
            const u32x4 v = *(const u32x4*)(U + (size_t)(base + tt) * 512 + c);
            acc[0] += bflo(v.x); acc[1] += bfhi(v.x); acc[2] += bflo(v.y); acc[3] += bfhi(v.y); acc[4] += bflo(v.z); acc[5] += bfhi(v.z); acc[6] += bflo(v.w); acc[7] += bfhi(v.w);
        }
        const float ic = 1.f / (float)(hi - lo);
        const u32x4 s = *(const u32x4*)(U + (size_t)row * 512 + c);
        u32x4 o;
        o.x = pk2(acc[0] * ic - bflo(s.x), acc[1] * ic - bfhi(s.x)); o.y = pk2(acc[2] * ic - bflo(s.y), acc[3] * ic - bfhi(s.y));
        o.z = pk2(acc[4] * ic - bflo(s.z), acc[5] * ic - bfhi(s.z)); o.w = pk2(acc[6] * ic - bflo(s.w), acc[7] * ic - bfhi(s.w));
        *(u32x4*)(PL + (size_t)row * 512 + c) = o;
    }
}

constexpr int NPHASE = 25;

DI void run_phase(const Params& P, int ph, char* smem) {
    char* ws = P.ws; char* hid = ws + OFF_HID; char* ob = (char*)P.out;
    float* X = (float*)(ws + OFF_X); bf16_t* XM = (bf16_t*)(ws + OFF_XM); bf16_t* HID = (bf16_t*)hid;
    const float* MOD = (const float*)(ws + OFF_MOD);
    if (ph == 0) { phase_pro_a(P, smem); return; }
    if (ph == 1) { phase_pro_b(P); return; }
    int l, op;
    if (ph < 14) { l = 0; op = ph - 2; } else { l = 1; op = ph - 14; if (op >= 6) op += 1; }
    const float* modl = MOD + (size_t)l * 5 * 9216;
    switch (op) {
    case 0: case 9: {
        const int f = op == 0 ? 0 : 1;
        EpiSwiglu e{HID};
        gemm_phase(XM, 1024, (const bf16_t*)(ws + OFF_WGU + (l * 2 + f) * SZ_WGU), 5632, 5632, 1024, e, smem);
    } break;
    case 1: case 10: {
        const int f = op == 1 ? 0 : 1;
        const bool first = (l == 0 && f == 0);
        EpiResid e{first ? P.in[0] : X, first ? P.in[2] : X + (size_t)RL * 1024, X, modl + (f == 0 ? 2 : 8) * 1024, 0.5f};
        gemm_phase(HID, DFF, (const bf16_t*)(ws + OFF_WD + (l * 2 + f) * SZ_WD), 1024, 1024, DFF, e, smem);
    } break;
    case 2: phase_ln(P, l, 0, l, 3, false); break;
    case 3: {
        if (l == 0) {
            EpiEvIn e{(bf16_t*)(hid + HOFF_QN), (bf16_t*)(hid + HOFF_QB), (bf16_t*)(ob + OOFF_KVN), (bf16_t*)(hid + HOFF_KA), (bf16_t*)(ob + OOFF_KB), (bf16_t*)(ob + OOFF_VB),
                      (const f32x2*)(ws + OFF_TAR), (const f32x2*)(ws + OFF_TAC), (const f32x2*)(ws + OFF_TBR), (const f32x2*)(ws + OFF_TBC)};
            gemm_phase(XM, 1024, (const bf16_t*)(ws + OFF_EVIN), 2048, 2048, 1024, e, smem);
        } else {
            EpiOdIn e{(bf16_t*)(hid + HOFF_U), (bf16_t*)(hid + HOFF_QD), (bf16_t*)(hid + HOFF_KD), (bf16_t*)(hid + HOFF_VD)};
            gemm_phase(XM, 1024, (const bf16_t*)(ws + OFF_ODIN), 2048, 2048, 1024, e, smem);
        }
    } break;
    case 4: if (l == 0) phase_ev_rms(P); else phase_od_pool(P); break;
    case 5: {
        if (l == 0) {
            EpiUQ e1{(bf16_t*)(hid + HOFF_QA), (const f32x2*)(ws + OFF_TAR), (const f32x2*)(ws + OFF_TAC)};
            gemm_phase((const bf16_t*)(hid + HOFF_QN), 256, (const bf16_t*)(ws + OFF_UQ), 768, 768, 256, e1, smem);
            EpiUKV e2{(bf16_t*)(hid + HOFF_KA), (bf16_t*)(hid + HOFF_VA)};
            gemm_phase((const bf16_t*)(ob + OOFF_KVN), 128, (const bf16_t*)(ws + OFF_UKV), 1024, 1024, 128, e2, smem);
        } else {
            odd_attention_phase(P, smem);
            EpiPool e{XM, P.in[22], 0};
            gemm_phase((const bf16_t*)(hid + HOFF_PL), 512, (const bf16_t*)(ws + OFF_POOL), 512, 512, 512, e, smem);
        }
    } break;
    case 6: even_attention_phase(P, smem); break;
    case 7: {
        EpiResid e{X, X + (size_t)RL * 1024, X, modl + 5 * 1024, 1.f};
        gemm_phase(XM, 1024, (const bf16_t*)(ws + (l == 0 ? OFF_EVOUT : OFF_ODOUT)), 1024, 1024, 1024, e, smem);
    } break;
    case 8: phase_ln(P, l, 1, l, 6, false); break;
    case 11: if (l == 0) phase_ln(P, 0, 2, 1, 0, false); else phase_ln(P, 1, 2, 1, 0, true); break;
    default: break;
    }
}

DI void grid_barrier(unsigned* ctr, unsigned target) {
    __syncthreads();
    if (threadIdx.x == 0) {
        __builtin_amdgcn_fence(__ATOMIC_RELEASE, "agent");
        __hip_atomic_fetch_add(ctr, 1u, __ATOMIC_RELAXED, __HIP_MEMORY_SCOPE_AGENT);
        while (__hip_atomic_load(ctr, __ATOMIC_RELAXED, __HIP_MEMORY_SCOPE_AGENT) < target) __builtin_amdgcn_s_sleep(2);
        __builtin_amdgcn_fence(__ATOMIC_ACQUIRE, "agent");
    }
    __syncthreads();
}

__global__ void __launch_bounds__(NTHR, 2) mega(Params P, int ph_lo, int ph_hi) {
    extern __shared__ __attribute__((aligned(16))) char smem[];
    unsigned nsync = 0;
    for (int ph = ph_lo; ph < ph_hi; ++ph) {
        run_phase(P, ph, smem);
        if (ph + 1 < ph_hi) {
            if (ph == ph_lo) cg::this_grid().sync();
            else { ++nsync; grid_barrier((unsigned*)(P.ws + OFF_BAR), nsync * gridDim.x); }
        }
    }
}

extern "C" void kernel_launch(void* const* d_in, const int* in_sizes, int n_in, void* d_out, int out_size, void* d_ws, size_t ws_size, hipStream_t stream) {
    if (ws_size < WS_NEED) { fprintf(stderr, "workspace too small: %zu < %zu\n", ws_size, (size_t)WS_NEED); return; }
    Params P{};
    for (int i = 0; i < 24; ++i) P.in[i] = (const float*)d_in[i];
    P.out = (float*)d_out; P.ws = (char*)d_ws;
    static int grid_blocks = 0;
    if (!grid_blocks) {
        int dev = 0, cus = 0, per_cu = 0;
        hipGetDevice(&dev);
        hipDeviceGetAttribute(&cus, hipDeviceAttributeMultiprocessorCount, dev);
        hipFuncSetAttribute((const void*)mega, hipFuncAttributeMaxDynamicSharedMemorySize, SMEM_BYTES);
        hipOccupancyMaxActiveBlocksPerMultiprocessor(&per_cu, mega, NTHR, SMEM_BYTES);
        if (per_cu < 1) per_cu = 1;
        if (per_cu > 1) per_cu = 1;
        grid_blocks = cus * per_cu;
    }
#if COOP
    hipMemsetAsync((char*)d_ws + OFF_BAR, 0, 256, stream);
    int lo = 0, hi = NPHASE;
    void* args[] = {&P, &lo, &hi};
    hipError_t e = hipLaunchCooperativeKernel((void*)mega, dim3(grid_blocks), dim3(NTHR), args, SMEM_BYTES, stream);
    if (e != hipSuccess) fprintf(stderr, "cooperative launch failed: %s (grid %d)\n", hipGetErrorString(e), grid_blocks);
#else
    for (int ph = 0; ph < NPHASE; ++ph) mega<<<grid_blocks, NTHR, SMEM_BYTES, stream>>>(P, ph, ph + 1);
#endif
}
```

```cpp
#include <hip/hip_runtime.h>
#include <hip/hip_cooperative_groups.h>
#include <cstdio>
#include <cstdint>
namespace cg = cooperative_groups;

#ifndef COOP
#define COOP 1
#endif

#define DI __device__ __forceinline__
typedef unsigned short bf16_t;
typedef short bf16x8 __attribute__((ext_vector_type(8)));
typedef short s16x4 __attribute__((ext_vector_type(4)));
typedef __bf16 bfx4 __attribute__((ext_vector_type(4)));
typedef __bf16 bfx2 __attribute__((ext_vector_type(2)));
typedef float f32x2 __attribute__((ext_vector_type(2)));
typedef float f32x4 __attribute__((ext_vector_type(4)));
typedef float f32x16 __attribute__((ext_vector_type(16)));
typedef unsigned u32x2 __attribute__((ext_vector_type(2)));
typedef unsigned u32x4 __attribute__((ext_vector_type(4)));
#define LDS_AS __attribute__((address_space(3)))

constexpr int DM = 1024, NB = 4, SEQ = 8192, CTX = 256, DFF = 2816;
constexpr int RL = NB * SEQ, RC = NB * CTX, RT = RL + RC;
constexpr int NK = SEQ + CTX;
constexpr float ALPHA = 1.41421356237f;
constexpr float LOG2E = 1.4426950408889634f;
constexpr float QA_SCALE = 0.10206207261596575f * LOG2E;
constexpr float QB_SCALE = 0.125f * LOG2E;
constexpr float QD_SCALE = 0.125f * LOG2E;
constexpr int NTHR = 512, NWAVE = NTHR / 64;

constexpr size_t SZ_WGU = 1024ull * 5632 * 2, SZ_WD = 2816ull * 1024 * 2;
constexpr size_t OFF_WGU = 0;
constexpr size_t OFF_WD = OFF_WGU + 4 * SZ_WGU;
constexpr size_t OFF_EVIN = OFF_WD + 4 * SZ_WD;
constexpr size_t OFF_EVOUT = OFF_EVIN + 1024ull * 2048 * 2;
constexpr size_t OFF_UQ = OFF_EVOUT + 1024ull * 1024 * 2;
constexpr size_t OFF_UKV = OFF_UQ + 256ull * 768 * 2;
constexpr size_t OFF_ODIN = OFF_UKV + 128ull * 1024 * 2;
constexpr size_t OFF_ODOUT = OFF_ODIN + 1024ull * 2048 * 2;
constexpr size_t OFF_POOL = OFF_ODOUT + 1024ull * 1024 * 2;
constexpr size_t OFF_MOD = OFF_POOL + 512ull * 512 * 2;
constexpr size_t OFF_TAR = OFF_MOD + 2ull * 5 * 9216 * 4;
constexpr size_t OFF_TAC = OFF_TAR + 128 * 8 * 8;
constexpr size_t OFF_TBR = OFF_TAC + 64 * 8 * 8;
constexpr size_t OFF_TBC = OFF_TBR + 128 * 16 * 8;
constexpr size_t OFF_LAM = OFF_TBC + 64 * 16 * 8;
constexpr size_t OFF_BAR = OFF_LAM + 256;
constexpr size_t OFF_X = OFF_BAR + 256;
constexpr size_t OFF_XM = OFF_X + (size_t)RT * 1024 * 4;
constexpr size_t OFF_HID = OFF_XM + (size_t)RT * 1024 * 2;
constexpr size_t WS_NEED = OFF_HID + (size_t)RT * DFF * 2;
constexpr size_t SZ_H96 = (size_t)NB * 8 * NK * 96 * 2, SZ_H64 = (size_t)NB * 8 * NK * 64 * 2;
constexpr size_t HOFF_QA = 0, HOFF_KA = SZ_H96, HOFF_VA = 2 * SZ_H96, HOFF_QB = HOFF_VA + SZ_H64, HOFF_QN = HOFF_QB + SZ_H64;
static_assert(HOFF_QN + (size_t)RT * 256 * 2 <= (size_t)RT * DFF * 2, "HID region overflow");
constexpr size_t HOFF_U = 0, HOFF_PL = SZ_H64, HOFF_QD = 2 * SZ_H64, HOFF_KD = 3 * SZ_H64, HOFF_VD = 4 * SZ_H64;
constexpr size_t OOFF_KB = 0, OOFF_VB = SZ_H64, OOFF_KVN = 2 * SZ_H64;
static_assert(OOFF_KVN + (size_t)RT * 128 * 2 <= (size_t)RL * 1024 * 4, "d_out region overflow");

struct Params {
    const float* in[24];
    float* out;
    char* ws;
};

DI int ltid() { int t = threadIdx.x; asm volatile("" : "+v"(t)); return t; }
DI int lbid() { int t = blockIdx.x; asm volatile("" : "+s"(t)); return t; }
DI unsigned pk2(float a, float b) { f32x2 v = {a, b}; bfx2 r = __builtin_convertvector(v, bfx2); return __builtin_bit_cast(unsigned, r); }
DI float bf2f(unsigned short u) { return __uint_as_float(((unsigned)u) << 16); }
DI float bflo(unsigned u) { return __uint_as_float(u << 16); }
DI float bfhi(unsigned u) { return __uint_as_float(u & 0xffff0000u); }
DI float silu_f(float x) { return x * __builtin_amdgcn_rcpf(1.f + __expf(-x)); }
DI f32x16 mfma32(bf16x8 a, bf16x8 b, f32x16 c) { return __builtin_amdgcn_mfma_f32_32x32x16_bf16(a, b, c, 0, 0, 0); }
DI s16x4 tr_read(const char* p) { bfx4 r = __builtin_amdgcn_ds_read_tr16_b64_v4bf16((LDS_AS bfx4*)p); return __builtin_bit_cast(s16x4, r); }
DI float xor32_max(float x) { const unsigned u = __float_as_uint(x); auto r = __builtin_amdgcn_permlane32_swap(u, u, false, false); return fmaxf(__uint_as_float(r[0]), __uint_as_float(r[1])); }
DI float xor32_sum(float x) { const unsigned u = __float_as_uint(x); auto r = __builtin_amdgcn_permlane32_swap(u, u, false, false); return __uint_as_float(r[0]) + __uint_as_float(r[1]); }
DI bf16x8 cat8(s16x4 lo, s16x4 hi) { return __builtin_shufflevector(lo, hi, 0, 1, 2, 3, 4, 5, 6, 7); }

struct RowInfo { int b, j, s; bool lat; };
DI RowInfo rowinfo(int row) {
    RowInfo r;
    if (row < RL) { r.b = row >> 13; r.j = row & 8191; r.s = r.b; r.lat = true; }
    else { int rc = row - RL; r.b = rc >> 8; r.j = 8192 + (rc & 255); r.s = 4; r.lat = false; }
    return r;
}
DI void store16(bf16_t* dst32, const f32x16& v, float sc, int hh) {
#pragma unroll
    for (int q4 = 0; q4 < 4; ++q4) {
        u32x2 w; w.x = pk2(v[4 * q4] * sc, v[4 * q4 + 1] * sc); w.y = pk2(v[4 * q4 + 2] * sc, v[4 * q4 + 3] * sc);
        *(u32x2*)(dst32 + 8 * q4 + 4 * hh) = w;
    }
}
DI f32x16 ropeB(const f32x16& v, const f32x2* tab, int hh) {
    f32x16 o;
#pragma unroll
    for (int r = 0; r < 8; ++r) {
        const int i = (r & 3) + 8 * (r >> 2) + 4 * hh;
        const f32x2 cs = tab[i];
        o[r] = v[r] * cs.x - v[r + 8] * cs.y;
        o[r + 8] = v[r + 8] * cs.x + v[r] * cs.y;
    }
    return o;
}
DI f32x16 ropeA(const f32x16& v, const f32x2* tr, const f32x2* tc, int hh) {
    f32x16 o;
#pragma unroll
    for (int r = 0; r < 4; ++r) {
        const int i = 4 * hh + r;
        const f32x2 a = tr[i], c = tc[i];
        o[r] = v[r] * a.x - v[r + 4] * a.y;
        o[r + 4] = v[r + 4] * a.x + v[r] * a.y;
        o[8 + r] = v[8 + r] * c.x - v[12 + r] * c.y;
        o[12 + r] = v[12 + r] * c.x + v[8 + r] * c.y;
    }
    return o;
}

constexpr int GA_S = 144, GB_S = 576;
constexpr int GSTAGE = 256 * GA_S + 64 * GB_S;
constexpr int GEMM_LDS = 2 * GSTAGE;

template <int BM, class Epi>
DI void gemm_tile(const bf16_t* __restrict__ A, int lda, const bf16_t* __restrict__ B, int ldb, int K, int row0, int col0, const Epi& epi, char* smem) {
    constexpr int MI = BM / 64, NA_ = BM / 64;
    const int tid = ltid(), lane = tid & 63, wave = tid >> 6, wm = wave >> 2, wn = wave & 3;
    const int l31 = lane & 31, hh = lane >> 5, q = (lane & 15) >> 2, p = lane & 3, nblk = (lane >> 4) & 1;
    f32x16 acc[MI][2];
#pragma unroll
    for (int i = 0; i < MI; ++i)
#pragma unroll
        for (int j = 0; j < 2; ++j)
#pragma unroll
            for (int r = 0; r < 16; ++r) acc[i][j][r] = 0.f;
    u32x4 ra[NA_], rb[4];
    const bf16_t* ag = A + (size_t)(row0 + (tid >> 3)) * lda + (tid & 7) * 8;
    const bf16_t* bg = B + (size_t)(tid >> 5) * ldb + col0 + (tid & 31) * 8;
    const int aw = (tid >> 3) * GA_S + (tid & 7) * 16, bw = BM * GA_S + (tid >> 5) * GB_S + (tid & 31) * 16;
    const int nk = K >> 6;
    const int xoff = (wm * (BM / 2) + l31) * GA_S + hh * 16;
    const int woff = BM * GA_S + (hh * 8 + q) * GB_S + (wn * 64 + nblk * 16 + 4 * p) * 2;
#pragma unroll
    for (int i = 0; i < NA_; ++i) ra[i] = *(const u32x4*)(ag + (size_t)(64 * i) * lda);
#pragma unroll
    for (int i = 0; i < 4; ++i) rb[i] = *(const u32x4*)(bg + (size_t)(16 * i) * ldb);
    __syncthreads();
#pragma unroll
    for (int i = 0; i < NA_; ++i) *(u32x4*)(smem + aw + 64 * i * GA_S) = ra[i];
#pragma unroll
    for (int i = 0; i < 4; ++i) *(u32x4*)(smem + bw + 16 * i * GB_S) = rb[i];
    if (nk > 1) {
#pragma unroll
        for (int i = 0; i < NA_; ++i) ra[i] = *(const u32x4*)(ag + 64 + (size_t)(64 * i) * lda);
#pragma unroll
        for (int i = 0; i < 4; ++i) rb[i] = *(const u32x4*)(bg + (size_t)(64 + 16 * i) * ldb);
    }
    __syncthreads();
    for (int kt = 0; kt < nk; ++kt) {
        const char* cur = smem + (kt & 1) * GSTAGE;
        char* nxt = smem + ((kt & 1) ^ 1) * GSTAGE;
        const bool w1 = kt + 1 < nk, l2 = kt + 2 < nk;
        const bf16_t* a2 = ag + (size_t)(kt + 2) * 64; const bf16_t* b2 = bg + (size_t)(kt + 2) * 64 * ldb;
#pragma unroll
        for (int s = 0; s < 4; ++s) {
            bf16x8 xf[MI], wf[2];
#pragma unroll
            for (int mi = 0; mi < MI; ++mi) xf[mi] = *(const bf16x8*)(cur + xoff + mi * 32 * GA_S + s * 32);
#pragma unroll
            for (int ni = 0; ni < 2; ++ni) {
                const char* wp = cur + woff + s * 16 * GB_S + ni * 64;
                wf[ni] = cat8(tr_read(wp), tr_read(wp + 4 * GB_S));
            }
#pragma unroll
            for (int mi = 0; mi < MI; ++mi)
#pragma unroll
                for (int ni = 0; ni < 2; ++ni) acc[mi][ni] = mfma32(wf[ni], xf[mi], acc[mi][ni]);
            if (w1) {
                if (s < NA_) *(u32x4*)(nxt + aw + 64 * s * GA_S) = ra[s];
                *(u32x4*)(nxt + bw + 16 * s * GB_S) = rb[s];
            }
            if (l2) {
                if (s < NA_) ra[s] = *(const u32x4*)(a2 + (size_t)(64 * s) * lda);
                rb[s] = *(const u32x4*)(b2 + (size_t)(16 * s) * ldb);
            }
            __builtin_amdgcn_sched_barrier(0);
        }
        __syncthreads();
    }
#pragma unroll
    for (int mi = 0; mi < MI; ++mi) epi(acc[mi][0], acc[mi][1], row0 + wm * (BM / 2) + mi * 32 + l31, col0 + wn * 64, hh);
}

template <class Epi>
DI void gemm_phase(const bf16_t* A, int lda, const bf16_t* B, int ldb, int N, int K, const Epi& epi, char* smem, bool do_ctx = true) {
    const int nt = N >> 8, small = do_ctx ? (RC / 128) * nt : 0;
    const int bid = lbid(), G = gridDim.x;
    if ((G & 7) == 0) {
        const int xcd = bid & 7, loc = bid >> 3, per = G >> 3, mine = (RL / 256 / 8) * nt;
        for (int i = loc; i < mine; i += per) {
            const int cg = i >> 7, rem = i & 127, cw = min(8, nt - cg * 8);
            int pg, w;
            if (cw == 8) { pg = rem >> 5; w = rem & 31; } else { const int rr = i - cg * 128; pg = rr / (4 * cw); w = rr - pg * 4 * cw; }
            const int pl = pg * 4 + (w & 3), cl = cg * 8 + (w >> 2);
            gemm_tile<256>(A, lda, B, ldb, K, (pl * 8 + xcd) * 256, cl * 256, epi, smem);
        }
    } else {
        const int big = (RL / 256) * nt;
        for (int t = bid; t < big; t += G) gemm_tile<256>(A, lda, B, ldb, K, (t / nt) * 256, (t % nt) * 256, epi, smem);
    }
    for (int u = bid; u < small; u += G) gemm_tile<128>(A, lda, B, ldb, K, RL + (u / nt) * 128, (u % nt) * 256, epi, smem);
}

struct EpiSwiglu {
    bf16_t* hid;
    DI void operator()(const f32x16& a0, const f32x16& a1, int row, int cbase, int hh) const {
        bf16_t* dst = hid + (size_t)row * DFF + (cbase >> 1) + 4 * hh;
#pragma unroll
        for (int q4 = 0; q4 < 4; ++q4) {
            float h[4];
#pragma unroll
            for (int j = 0; j < 4; ++j) h[j] = silu_f(a0[4 * q4 + j]) * a1[4 * q4 + j];
            u32x2 w; w.x = pk2(h[0], h[1]); w.y = pk2(h[2], h[3]);
            *(u32x2*)(dst + 8 * q4) = w;
        }
    }
};
struct EpiResid {
    const float* res_lat; const float* res_ctx; float* X; const float* gate; float coef;
    DI void operator()(const f32x16& a0, const f32x16& a1, int row, int cbase, int hh) const {
        const int s = row < RL ? (row >> 13) : 4;
        const float* rp = row < RL ? res_lat + (size_t)row * 1024 : res_ctx + (size_t)(row - RL) * 1024;
        const float* gp = gate + s * 9216;
        float* xp = X + (size_t)row * 1024;
#pragma unroll
        for (int ni = 0; ni < 2; ++ni)
#pragma unroll
            for (int q4 = 0; q4 < 4; ++q4) {
                const int c = cbase + ni * 32 + 8 * q4 + 4 * hh;
                const f32x4 r = *(const f32x4*)(rp + c), g = *(const f32x4*)(gp + c);
                f32x4 z;
#pragma unroll
                for (int j = 0; j < 4; ++j) z[j] = ALPHA * r[j] + coef * g[j] * (ni ? a1[4 * q4 + j] : a0[4 * q4 + j]);
                *(f32x4*)(xp + c) = z;
            }
    }
};
struct EpiEvIn {
    bf16_t *QN, *QB, *KVN, *KA, *KB, *VB; const f32x2 *tAr, *tAc, *tBr, *tBc;
    DI void operator()(const f32x16& a0, const f32x16& a1, int row, int cbase, int hh) const {
        const RowInfo ri = rowinfo(row);
        const int gr = (ri.j >> 6) & 127, gc = ri.j & 63;
#pragma unroll
        for (int ni = 0; ni < 2; ++ni) {
            const int g = (cbase >> 5) + ni;
            const f32x16& v = ni ? a1 : a0;
            if (g < 8) store16(QN + (size_t)row * 256 + g * 32, v, 1.f, hh);
            else if (g < 24) {
                const int hv = (g - 8) >> 1, half = (g - 8) & 1;
                f32x16 w = v; if (ri.lat) w = ropeB(v, half ? tBc + gc * 16 : tBr + gr * 16, hh);
                store16(QB + ((size_t)(ri.b * 8 + hv) * NK + ri.j) * 64 + half * 32, w, QB_SCALE, hh);
            } else if (g < 28) store16(KVN + (size_t)row * 128 + (g - 24) * 32, v, 1.f, hh);
            else if (g == 28) {
                f32x16 w = v; if (ri.lat) w = ropeA(v, tAr + gr * 8, tAc + gc * 8, hh);
                for (int h = 0; h < 8; ++h) store16(KA + ((size_t)(ri.b * 8 + h) * NK + ri.j) * 96 + 64, w, 1.f, hh);
            } else if (g < 45) {
                const int hv = (g - 29) >> 1, half = (g - 29) & 1;
                f32x16 w = v; if (ri.lat) w = ropeB(v, half ? tBc + gc * 16 : tBr + gr * 16, hh);
                store16(KB + ((size_t)(ri.b * 8 + hv) * NK + ri.j) * 64 + half * 32, w, 1.f, hh);
            } else if (g < 61) {
                const int idx = g - 45, h = idx >> 2, part = idx & 3;
                store16(VB + ((size_t)(ri.b * 4 + h) * NK + ri.j) * 128 + part * 32, v, 1.f, hh);
            }
        }
    }
};
struct EpiUQ {
    bf16_t* QA; const f32x2 *tAr, *tAc;
    DI void operator()(const f32x16& a0, const f32x16& a1, int row, int cbase, int hh) const {
        const RowInfo ri = rowinfo(row);
        const int gr = (ri.j >> 6) & 127, gc = ri.j & 63;
#pragma unroll
        for (int ni = 0; ni < 2; ++ni) {
            const int g = (cbase >> 5) + ni, h = g / 3, part = g - 3 * h;
            f32x16 w = ni ? a1 : a0;
            if (part == 2 && ri.lat) w = ropeA(ni ? a1 : a0, tAr + gr * 8, tAc + gc * 8, hh);
            store16(QA + ((size_t)(ri.b * 8 + h) * NK + ri.j) * 96 + part * 32, w, QA_SCALE, hh);
        }
    }
};
struct EpiUKV {
    bf16_t *KA, *VA;
    DI void operator()(const f32x16& a0, const f32x16& a1, int row, int cbase, int hh) const {
        const RowInfo ri = rowinfo(row);
#pragma unroll
        for (int ni = 0; ni < 2; ++ni) {
            const int g = (cbase >> 5) + ni, h = g >> 2, part = g & 3;
            const size_t tk = (size_t)(ri.b * 8 + h) * NK + ri.j;
            if (part < 2) store16(KA + tk * 96 + part * 32, ni ? a1 : a0, 1.f, hh);
            else store16(VA + tk * 64 + (part - 2) * 32, ni ? a1 : a0, 1.f, hh);
        }
    }
};
struct EpiOdIn {
    bf16_t *U, *QD, *KD, *VD;
    DI void operator()(const f32x16& a0, const f32x16& a1, int row, int cbase, int hh) const {
        const RowInfo ri = rowinfo(row);
#pragma unroll
        for (int ni = 0; ni < 2; ++ni) {
            const int g = (cbase >> 5) + ni;
            const f32x16& v = ni ? a1 : a0;
            if (g < 16) store16(U + (size_t)row * 512 + g * 32, v, 1.f, hh);
            else {
                const int gg = (g - 16) & 15, h = gg >> 1, half = gg & 1;
                const size_t off = ((size_t)(ri.b * 8 + h) * NK + ri.j) * 64 + half * 32;
                if (g < 32) store16(QD + off, v, QD_SCALE, hh);
                else if (g < 48) store16(KD + off, v, 1.f, hh);
                else store16(VD + off, v, 1.f, hh);
            }
        }
    }
};
struct EpiPool {
    bf16_t* CC; const float* pscale; int gidx;
    DI void operator()(const f32x16& a0, const f32x16& a1, int row, int cbase, int hh) const {
#pragma unroll
        for (int ni = 0; ni < 2; ++ni)
#pragma unroll
            for (int q4 = 0; q4 < 4; ++q4) {
                const int c = gidx * 128 + cbase + ni * 32 + 8 * q4 + 4 * hh;
                const f32x4 s = *(const f32x4*)(pscale + c);
                const f32x16& v = ni ? a1 : a0;
                u32x2 w; w.x = pk2(v[4 * q4] * s[0], v[4 * q4 + 1] * s[1]); w.y = pk2(v[4 * q4 + 2] * s[2], v[4 * q4 + 3] * s[3]);
                *(u32x2*)(CC + (size_t)row * 1024 + c) = w;
            }
    }
};

constexpr int ATT_LDS = 64 * (96 + 8) * 2 + 64 * (128 * 2 + 64);
constexpr int RPB_OFF = 2 * ATT_LDS;
constexpr int SMEM_BYTES = GEMM_LDS;

struct NAInfo { int qr; int kstart; };

template <int DQK, int DV, bool NA>
DI void attend(const bf16_t* __restrict__ Q, int q0, const bf16_t* __restrict__ Kb, const bf16_t* __restrict__ Vb,
               int s0, int n0, int s1, int n1, f32x16 (&o)[DV / 32], char* smem, NAInfo na) {
    constexpr int KS = (DQK + 8) * 2, VS = DV * 2 + 64;
    constexpr int KCH = DQK / 8, KN = (64 * KCH + NTHR - 1) / NTHR, VCH = DV / 8, VN = (64 * VCH + NTHR - 1) / NTHR;
    constexpr int NS = DQK / 16, NDT = DV / 32;
    const int tid = ltid(), lane = tid & 63, wave = tid >> 6;
    const int l31 = lane & 31, hh = lane >> 5, q = (lane & 15) >> 2, p = lane & 3, dblk = (lane >> 4) & 1;
    bf16x8 qf[NS];
    {
        const bf16_t* qp = Q + (size_t)(q0 + wave * 32 + l31) * DQK + hh * 8;
#pragma unroll
        for (int s = 0; s < NS; ++s) qf[s] = *(const bf16x8*)(qp + s * 16);
    }
#pragma unroll
    for (int d = 0; d < NDT; ++d)
#pragma unroll
        for (int r = 0; r < 16; ++r) o[d][r] = 0.f;
    float m = NA ? -INFINITY : 0.f, l = 0.f;
    f32x16 cinit;
#pragma unroll
    for (int r = 0; r < 16; ++r) cinit[r] = 0.f;
    u32x4 rk[KN], rv[VN];
    const int nt = n0 + n1;
    auto gload = [&](int t) {
        const int j0 = t < n0 ? s0 + t * 64 : s1 + (t - n0) * 64;
#pragma unroll
        for (int i = 0; i < KN; ++i) { int id = tid + NTHR * i; if (id >= 64 * KCH) id -= 64 * KCH; const int row = id / KCH, ch = id - row * KCH; rk[i] = *(const u32x4*)(Kb + (size_t)(j0 + row) * DQK + ch * 8); }
#pragma unroll
        for (int i = 0; i < VN; ++i) { int id = tid + NTHR * i; if (id >= 64 * VCH) id -= 64 * VCH; const int row = id / VCH, ch = id - row * VCH; rv[i] = *(const u32x4*)(Vb + (size_t)(j0 + row) * DV + ch * 8); }
    };
    gload(0);
    int qc = 0, cs = 0, rs = 0;
    if (NA) { qc = (wave & 1) * 32 + l31; cs = min(max(qc - 8, 0), 48); rs = min(max(na.qr - 4, 0), 120); }
    const float* rpb = (const float*)(smem + RPB_OFF);
    auto lwrite = [&](char* stg) {
#pragma unroll
        for (int i = 0; i < KN; ++i) { int id = tid + NTHR * i; if (id >= 64 * KCH) id -= 64 * KCH; const int row = id / KCH, ch = id - row * KCH; *(u32x4*)(stg + row * KS + ch * 16) = rk[i]; }
#pragma unroll
        for (int i = 0; i < VN; ++i) { int id = tid + NTHR * i; if (id >= 64 * VCH) id -= 64 * VCH; const int row = id / VCH, ch = id - row * VCH; *(u32x4*)(stg + 64 * KS + row * VS + ch * 16) = rv[i]; }
    };
    __syncthreads();
    lwrite(smem);
    if (nt > 1) gload(1);
    __syncthreads();
    for (int t = 0; t < nt; ++t) {
        const char* sK = smem + (t & 1) * ATT_LDS; const char* sV = sK + 64 * KS;
        bool active = true; int kr = 0;
        if (NA && t < n0) { kr = na.kstart + t; active = (kr >= rs) && (kr < rs + 8); }
        if (active) {
#pragma unroll 1
            for (int sub = 0; sub < 2; ++sub) {
                f32x16 st;
                if (NA) {
#pragma unroll
                    for (int r = 0; r < 16; ++r) st[r] = 0.f;
                } else st = cinit;
                {
                    bf16x8 kf[NS];
#pragma unroll
                    for (int s = 0; s < NS; ++s) kf[s] = *(const bf16x8*)(sK + (sub * 32 + l31) * KS + (s * 16 + hh * 8) * 2);
                    __builtin_amdgcn_sched_barrier(0);
#pragma unroll
                    for (int s = 0; s < NS; ++s) st = mfma32(kf[s], qf[s], st);
                }
                if (NA && t < n0) {
                    const float* brow = rpb + (kr - na.qr + 7) * 31 + 15 - qc;
#pragma unroll
                    for (int r = 0; r < 16; ++r) {
                        const int kc = sub * 32 + (r & 3) + 8 * (r >> 2) + 4 * hh;
                        const bool valid = (kc >= cs) && (kc < cs + 16);
                        const int bi = valid ? kc : cs;
                        const float bias = brow[bi];
                        st[r] = valid ? st[r] + bias : -INFINITY;
                    }
                }
                float mx = st[0];
#pragma unroll
                for (int r = 1; r < 16; ++r) mx = fmaxf(mx, st[r]);
                mx = xor32_max(mx);
                float rsum = 0.f;
                if (NA) {
                    const float mnew = fmaxf(m, mx);
                    const float muse = (mnew == -INFINITY) ? 0.f : mnew;
                    const float alpha = __builtin_amdgcn_exp2f(m - muse);
                    m = mnew;
                    l *= alpha;
#pragma unroll
                    for (int d = 0; d < NDT; ++d)
#pragma unroll
                        for (int r = 0; r < 16; ++r) o[d][r] *= alpha;
#pragma unroll
                    for (int r = 0; r < 16; ++r) { st[r] = __builtin_amdgcn_exp2f(st[r] - muse); rsum += st[r]; }
                } else {
                    const bool first = (t == 0) && (sub == 0);
                    if (first || __builtin_amdgcn_ballot_w64(mx > 8.f) != 0) {
                        const float delta = first ? mx : fmaxf(mx, 0.f);
                        const float alpha = first ? 1.f : __builtin_amdgcn_exp2f(-delta);
                        m += delta;
                        l *= alpha;
#pragma unroll
                        for (int d = 0; d < NDT; ++d)
#pragma unroll
                            for (int r = 0; r < 16; ++r) o[d][r] *= alpha;
#pragma unroll
                        for (int r = 0; r < 16; ++r) { st[r] -= delta; cinit[r] = -m; }
                    }
#pragma unroll
                    for (int r = 0; r < 16; ++r) { st[r] = __builtin_amdgcn_exp2f(st[r]); rsum += st[r]; }
                }
                l += rsum;
                bf16x8 pf[2];
#pragma unroll
                for (int s2 = 0; s2 < 2; ++s2) {
                    u32x4 w;
                    w.x = pk2(st[8 * s2], st[8 * s2 + 1]); w.y = pk2(st[8 * s2 + 2], st[8 * s2 + 3]);
                    w.z = pk2(st[8 * s2 + 4], st[8 * s2 + 5]); w.w = pk2(st[8 * s2 + 6], st[8 * s2 + 7]);
                    pf[s2] = __builtin_bit_cast(bf16x8, w);
                }
#pragma unroll
                for (int d = 0; d < NDT; ++d)
#pragma unroll
                    for (int s2 = 0; s2 < 2; ++s2) {
                        const char* vp = sV + (sub * 32 + 16 * s2 + 4 * hh + q) * VS + (d * 32 + dblk * 16 + 4 * p) * 2;
                        const bf16x8 vf = cat8(tr_read(vp), tr_read(vp + 8 * VS));
                        o[d] = mfma32(vf, pf[s2], o[d]);
                    }
            }
        }
        if (t + 1 < nt) lwrite(smem + ((t & 1) ^ 1) * ATT_LDS);
        if (t + 2 < nt) gload(t + 2);
        __syncthreads();
    }
    l = xor32_sum(l);
    const float inv = 1.f / l;
#pragma unroll
    for (int d = 0; d < NDT; ++d)
#pragma unroll
        for (int r = 0; r < 16; ++r) o[d][r] *= inv;
}

DI int qrow_of(int b, int j) { return j < SEQ ? b * SEQ + j : RL + b * CTX + (j - SEQ); }

DI void even_attention_phase(const Params& P, char* smem) {
    char* ws = P.ws; char* hid = ws + OFF_HID; char* ob = (char*)P.out;
    const bf16_t* QA = (const bf16_t*)(hid + HOFF_QA); const bf16_t* KA = (const bf16_t*)(hid + HOFF_KA); const bf16_t* VA = (const bf16_t*)(hid + HOFF_VA);
    const bf16_t* QB = (const bf16_t*)(hid + HOFF_QB); const bf16_t* KB = (const bf16_t*)(ob + OOFF_KB); const bf16_t* VB = (const bf16_t*)(ob + OOFF_VB);
    bf16_t* CC = (bf16_t*)(ws + OFF_XM);
    const float lam = *(const float*)(ws + OFF_LAM);
    const float* gsub = P.in[18];
    const int lane = ltid() & 63, wave = ltid() >> 6, l31 = lane & 31, hh = lane >> 5;
    constexpr int NQT = 33, NDIFF = NB * 4 * NQT, NMLA = NB * 8 * NQT;
    NAInfo na; na.qr = 0; na.kstart = 0;
    unsigned* wq = (unsigned*)(ws + OFF_BAR + 128);
    volatile int* slot = (volatile int*)(smem + 2 * ATT_LDS + 2048);
    for (;;) {
        __syncthreads();
        if (ltid() == 0) *slot = (int)atomicAdd(wq, 1u);
        __syncthreads();
        const int u = *slot;
        if (u >= NDIFF + NMLA) break;
        if (u < NDIFF) {
            const int qt = u % NQT, bh = u / NQT, h = bh & 3, b = bh >> 2;
            const int q0 = qt < 32 ? qt * 256 : SEQ;
            const int s0 = qt < 32 ? 0 : SEQ, n0 = qt < 32 ? NK / 64 : CTX / 64;
            const bf16_t* V = VB + (size_t)(b * 4 + h) * NK * 128;
            f32x16 o[4];
            attend<64, 128, false>(QB + (size_t)(b * 8 + 2 * h) * NK * 64, q0, KB + (size_t)(b * 8 + 2 * h) * NK * 64, V, s0, n0, 0, 0, o, smem, na);
            const int row = qrow_of(b, q0 + wave * 32 + l31);
            bf16_t* dst = CC + (size_t)row * 1024 + 512 + h * 128;
#pragma unroll
            for (int d = 0; d < 4; ++d) store16(dst + d * 32, o[d], 1.f, hh);
            f32x16 o2[4];
            attend<64, 128, false>(QB + (size_t)(b * 8 + 2 * h + 1) * NK * 64, q0, KB + (size_t)(b * 8 + 2 * h + 1) * NK * 64, V, s0, n0, 0, 0, o2, smem, na);
            float ss = 0.f;
#pragma unroll
            for (int d = 0; d < 4; ++d)
#pragma unroll
                for (int q4 = 0; q4 < 4; ++q4) {
                    const u32x2 w = *(const volatile u32x2*)(dst + d * 32 + 8 * q4 + 4 * hh);
                    const float a0 = bflo(w.x) - lam * o2[d][4 * q4], a1 = bfhi(w.x) - lam * o2[d][4 * q4 + 1], a2 = bflo(w.y) - lam * o2[d][4 * q4 + 2], a3 = bfhi(w.y) - lam * o2[d][4 * q4 + 3];
                    o[d][4 * q4] = a0; o[d][4 * q4 + 1] = a1; o[d][4 * q4 + 2] = a2; o[d][4 * q4 + 3] = a3;
                    ss += (a0 * a0 + a1 * a1) + (a2 * a2 + a3 * a3);
                }
            ss = xor32_sum(ss);
            const float rn = rsqrtf(ss * (1.f / 128.f) + 1e-5f) * 0.8f;
#pragma unroll
            for (int d = 0; d < 4; ++d)
#pragma unroll
                for (int q4 = 0; q4 < 4; ++q4) {
                    const int c = d * 32 + 8 * q4 + 4 * hh;
                    const f32x4 g = *(const f32x4*)(gsub + c);
                    u32x2 w; w.x = pk2(o[d][4 * q4] * rn * g[0], o[d][4 * q4 + 1] * rn * g[1]); w.y = pk2(o[d][4 * q4 + 2] * rn * g[2], o[d][4 * q4 + 3] * rn * g[3]);
                    *(u32x2*)(dst + c) = w;
                }
        } else {
            const int v = u - NDIFF, qt = v % NQT, bh = v / NQT, h = bh & 7, b = bh >> 3;
            const int q0 = qt < 32 ? qt * 256 : SEQ;
            const int s0 = qt < 32 ? 0 : SEQ, n0 = qt < 32 ? NK / 64 : CTX / 64;
            f32x16 o[2];
            attend<96, 64, false>(QA + (size_t)(b * 8 + h) * NK * 96, q0, KA + (size_t)(b * 8 + h) * NK * 96, VA + (size_t)(b * 8 + h) * NK * 64, s0, n0, 0, 0, o, smem, na);
            const int row = qrow_of(b, q0 + wave * 32 + l31);
            bf16_t* dst = CC + (size_t)row * 1024 + h * 64;
#pragma unroll
            for (int d = 0; d < 2; ++d) store16(dst + d * 32, o[d], 1.f, hh);
        }
    }
}

DI void odd_attention_phase(const Params& P, char* smem) {
    char* ws = P.ws; char* hid = ws + OFF_HID;
    const bf16_t* QD = (const bf16_t*)(hid + HOFF_QD); const bf16_t* KD = (const bf16_t*)(hid + HOFF_KD); const bf16_t* VD = (const bf16_t*)(hid + HOFF_VD);
    bf16_t* CC = (bf16_t*)(ws + OFF_XM);
    const float* rpbg = P.in[23];
    const int lane = ltid() & 63, wave = ltid() >> 6, l31 = lane & 31, hh = lane >> 5;
    float* rpbl = (float*)(smem + RPB_OFF);
    constexpr int NU = NB * 8 * 32;
    for (int u = lbid(); u < NU; u += gridDim.x) {
        const int rp = u & 31, bh = u >> 5, h = bh & 7, b = bh >> 3;
        __syncthreads();
        for (int i = ltid(); i < 465; i += NTHR) rpbl[i] = rpbg[h * 465 + i] * LOG2E;
        const int r0 = rp * 4;
        NAInfo na; na.qr = r0 + (wave >> 1);
        const int rs0 = min(max(r0 - 4, 0), 120);
        na.kstart = min(rs0, 117);
        f32x16 o[2];
        const size_t hb = (size_t)(b * 8 + h) * NK * 64;
        attend<64, 64, true>(QD + hb, r0 * 64, KD + hb, VD + hb, na.kstart * 64, 11, SEQ, CTX / 64, o, smem, na);
        const int row = b * SEQ + r0 * 64 + wave * 32 + l31;
        bf16_t* dst = CC + (size_t)row * 1024 + 512 + h * 64;
#pragma unroll
        for (int d = 0; d < 2; ++d) store16(dst + d * 32, o[d], 1.f, hh);
    }
}

DI void cvt8(bf16_t* dst, const float* src, float sc) {
    const f32x4 a = *(const f32x4*)src, b = *(const f32x4*)(src + 4);
    u32x4 w; w.x = pk2(a[0] * sc, a[1] * sc); w.y = pk2(a[2] * sc, a[3] * sc); w.z = pk2(b[0] * sc, b[1] * sc); w.w = pk2(b[2] * sc, b[3] * sc);
    *(u32x4*)dst = w;
}
DI void cvt_rows(bf16_t* dst, int ldd, const float* src, int lds_, int rows, int cols_src, const float* rowscale, size_t gtid, size_t gstride) {
    const int c8 = ldd >> 3; const size_t n = (size_t)rows * c8;
    for (size_t i0 = gtid; i0 < n; i0 += 4 * gstride) {
        f32x4 a[4], b[4]; float sc[4];
#pragma unroll
        for (int u = 0; u < 4; ++u) {
            const size_t i = i0 + u * gstride;
            const int k = (int)(i / c8), c = (int)(i % c8) * 8;
            const bool ok = i < n && c < cols_src;
            const float* p = src + (ok ? (size_t)k * lds_ + c : 0);
            a[u] = *(const f32x4*)p; b[u] = *(const f32x4*)(p + 4);
            sc[u] = !ok ? 0.f : (rowscale ? rowscale[k] : 1.f);
        }
#pragma unroll
        for (int u = 0; u < 4; ++u) {
            const size_t i = i0 + u * gstride;
            if (i < n) {
                const int k = (int)(i / c8), c = (int)(i % c8) * 8;
                u32x4 w; w.x = pk2(a[u][0] * sc[u], a[u][1] * sc[u]); w.y = pk2(a[u][2] * sc[u], a[u][3] * sc[u]); w.z = pk2(b[u][0] * sc[u], b[u][1] * sc[u]); w.w = pk2(b[u][2] * sc[u], b[u][3] * sc[u]);
                *(u32x4*)(dst + (size_t)k * ldd + c) = w;
            }
        }
    }
}

DI void phase_pro_a(const Params& P, char* smem) {
    char* ws = P.ws;
    const size_t gtid = (size_t)lbid() * NTHR + ltid(), gstride = (size_t)gridDim.x * NTHR;
    for (int lf = 0; lf < 4; ++lf) {
        const float* sg = P.in[8] + (size_t)lf * 1024 * DFF; const float* su = P.in[9] + (size_t)lf * 1024 * DFF;
        bf16_t* dst = (bf16_t*)(ws + OFF_WGU + lf * SZ_WGU);
        for (size_t i0 = gtid; i0 < 1024ull * 704; i0 += 4 * gstride) {
            f32x4 a[4], b[4];
#pragma unroll
            for (int u = 0; u < 4; ++u) {
                const size_t i = i0 + u * gstride < 1024ull * 704 ? i0 + u * gstride : i0;
                const int k = (int)(i / 704), n = (int)(i % 704) * 8, grp = n >> 6, w = n & 63;
                const float* src = ((w < 32) ? sg : su) + (size_t)k * DFF + grp * 32 + (w & 31);
                a[u] = *(const f32x4*)src; b[u] = *(const f32x4*)(src + 4);
            }
#pragma unroll
            for (int u = 0; u < 4; ++u) {
                const size_t i = i0 + u * gstride;
                if (i < 1024ull * 704) {
                    const int k = (int)(i / 704), n = (int)(i % 704) * 8;
                    u32x4 w; w.x = pk2(a[u][0], a[u][1]); w.y = pk2(a[u][2], a[u][3]); w.z = pk2(b[u][0], b[u][1]); w.w = pk2(b[u][2], b[u][3]);
                    *(u32x4*)(dst + (size_t)k * 5632 + n) = w;
                }
            }
        }
        cvt_rows((bf16_t*)(ws + OFF_WD + lf * SZ_WD), 1024, P.in[10] + (size_t)lf * DFF * 1024, 1024, DFF, 1024, nullptr, gtid, gstride);
    }
    cvt_rows((bf16_t*)(ws + OFF_EVIN), 2048, P.in[11], 1952, 1024, 1952, nullptr, gtid, gstride);
    cvt_rows((bf16_t*)(ws + OFF_EVOUT), 1024, P.in[12], 1024, 1024, 1024, nullptr, gtid, gstride);
    cvt_rows((bf16_t*)(ws + OFF_UQ), 768, P.in[15], 768, 256, 768, P.in[13], gtid, gstride);
    cvt_rows((bf16_t*)(ws + OFF_UKV), 1024, P.in[16], 1024, 128, 1024, P.in[14], gtid, gstride);
    cvt_rows((bf16_t*)(ws + OFF_ODIN), 2048, P.in[19], 2048, 1024, 2048, nullptr, gtid, gstride);
    cvt_rows((bf16_t*)(ws + OFF_ODOUT), 1024, P.in[20], 1024, 1024, 1024, nullptr, gtid, gstride);
    for (size_t i = gtid; i < 512ull * 64; i += gstride) {
        const int k = (int)(i >> 6), n = (int)(i & 63) * 8;
        bf16_t* d = (bf16_t*)(ws + OFF_POOL) + (size_t)k * 512 + n;
        if ((k >> 7) == (n >> 7)) cvt8(d, P.in[21] + (size_t)k * 128 + (n & 127), 1.f);
        else { u32x4 z = {0u, 0u, 0u, 0u}; *(u32x4*)d = z; }
    }
    if (gtid < 128 * 8) { const int r = (int)gtid >> 3, i = (int)gtid & 7; const float inv = exp2f(-(float)i * (13.287712379549449f / 8.f)); float rev = (float)r * inv * 0.15915494309189535f; rev -= floorf(rev);
        f32x2 v = {__builtin_amdgcn_cosf(rev), __builtin_amdgcn_sinf(rev)}; ((f32x2*)(ws + OFF_TAR))[gtid] = v; if (r < 64) ((f32x2*)(ws + OFF_TAC))[gtid] = v; }
    if (gtid < 128 * 16) { const int r = (int)gtid >> 4, i = (int)gtid & 15; const float inv = exp2f(-(float)i * (13.287712379549449f / 16.f)); float rev = (float)r * inv * 0.15915494309189535f; rev -= floorf(rev);
        f32x2 v = {__builtin_amdgcn_cosf(rev), __builtin_amdgcn_sinf(rev)}; ((f32x2*)(ws + OFF_TBR))[gtid] = v; if (r < 64) ((f32x2*)(ws + OFF_TBC))[gtid] = v; }
    if (gtid == 0) {
        const float* lv = P.in[17]; float a = 0.f, b = 0.f;
        for (int i = 0; i < 64; ++i) { a += lv[i] * lv[64 + i]; b += lv[128 + i] * lv[192 + i]; }
        *(float*)(ws + OFF_LAM) = expf(a) - expf(b) + 0.2f;
    }
    float* sc = (float*)smem;
    float* red = sc + 5 * 1024;
    const int tid = ltid(), jj = tid & 31, ig = tid >> 5;
    __syncthreads();
    for (int i = tid; i < 5 * 1024; i += NTHR) { const float v = i < 4096 ? P.in[1][i] : P.in[3][i - 4096]; sc[i] = v / (1.f + expf(-v)); }
    __syncthreads();
    for (int u = lbid(); u < 576; u += gridDim.x) {
        const int l = u / 288, j0 = (u % 288) * 32;
        float a[5] = {0.f, 0.f, 0.f, 0.f, 0.f};
        const float* w = P.in[4] + (size_t)l * 1024 * 9216 + (size_t)(ig * 64) * 9216 + j0 + jj;
        for (int i0 = 0; i0 < 64; i0 += 8) {
            float wv[8];
#pragma unroll
            for (int k = 0; k < 8; ++k) wv[k] = w[(size_t)(i0 + k) * 9216];
#pragma unroll
            for (int k = 0; k < 8; ++k)
#pragma unroll
                for (int s2 = 0; s2 < 5; ++s2) a[s2] += sc[s2 * 1024 + ig * 64 + i0 + k] * wv[k];
        }
#pragma unroll
        for (int s2 = 0; s2 < 5; ++s2) red[(ig * 5 + s2) * 32 + jj] = a[s2];
        __syncthreads();
        if (tid < 160) {
            const int s2 = tid >> 5, j = tid & 31;
            float v = P.in[5][l * 9216 + j0 + j];
#pragma unroll
            for (int g = 0; g < 16; ++g) v += red[(g * 5 + s2) * 32 + j];
            ((float*)(ws + OFF_MOD))[(size_t)(l * 5 + s2) * 9216 + j0 + j] = v;
        }
        __syncthreads();
    }
}

DI void phase_pro_b(const Params& P) {
    char* ws = P.ws; bf16_t* XM = (bf16_t*)(ws + OFF_XM); const float* MOD = (const float*)(ws + OFF_MOD);
    const size_t gtid = (size_t)lbid() * NTHR + ltid(), gstride = (size_t)gridDim.x * NTHR;
    for (size_t i = gtid; i < (size_t)RT * 128; i += gstride) {
        const int row = (int)(i >> 7), c = (int)(i & 127) * 8;
        const float* src = row < RL ? P.in[0] + (size_t)row * 1024 + c : P.in[2] + (size_t)(row - RL) * 1024 + c;
        const int s = row < RL ? (row >> 13) : 4;
        const float* sh = MOD + (size_t)s * 9216 + c; const float* scl = sh + 1024;
        unsigned w[4];
#pragma unroll
        for (int hf = 0; hf < 2; ++hf) {
            const f32x4 x = *(const f32x4*)(src + 4 * hf), a = *(const f32x4*)(sh + 4 * hf), g = *(const f32x4*)(scl + 4 * hf);
            w[2 * hf] = pk2(x[0] * (1.f + g[0]) + a[0], x[1] * (1.f + g[1]) + a[1]);
            w[2 * hf + 1] = pk2(x[2] * (1.f + g[2]) + a[2], x[3] * (1.f + g[3]) + a[3]);
        }
        u32x4 o = {w[0], w[1], w[2], w[3]};
        *(u32x4*)(XM + (size_t)row * 1024 + c) = o;
    }
}

struct LnSpec { int l, which, lnext, mshift; bool final_; unsigned* cnt; };
template <int NR>
DI void ln_rows(const Params& P, const LnSpec& sp, int row, int stride, int lane) {
    char* ws = P.ws; float* X = (float*)(ws + OFF_X); bf16_t* XM = (bf16_t*)(ws + OFF_XM); const float* MOD = (const float*)(ws + OFF_MOD);
    const float* g = P.in[6] + (sp.l * 3 + sp.which) * 1024; const float* bb = P.in[7] + (sp.l * 3 + sp.which) * 1024;
    f32x4 v[NR][4]; float s[NR], qv[NR];
#pragma unroll
    for (int k = 0; k < NR; ++k) {
        const float* xp = X + (size_t)(row + k * stride) * 1024;
#pragma unroll
        for (int i = 0; i < 4; ++i) v[k][i] = *(const f32x4*)(xp + (i * 64 + lane) * 4);
    }
#pragma unroll
    for (int k = 0; k < NR; ++k) {
        s[k] = 0.f;
#pragma unroll
        for (int i = 0; i < 4; ++i) s[k] += (v[k][i][0] + v[k][i][1]) + (v[k][i][2] + v[k][i][3]);
    }
#pragma unroll
    for (int o = 32; o >= 1; o >>= 1)
#pragma unroll
        for (int k = 0; k < NR; ++k) s[k] += __shfl_xor(s[k], o);
#pragma unroll
    for (int k = 0; k < NR; ++k) {
        s[k] *= (1.f / 1024.f); qv[k] = 0.f;
#pragma unroll
        for (int i = 0; i < 4; ++i)
#pragma unroll
            for (int j = 0; j < 4; ++j) { const float d = v[k][i][j] - s[k]; qv[k] += d * d; }
    }
#pragma unroll
    for (int o = 32; o >= 1; o >>= 1)
#pragma unroll
        for (int k = 0; k < NR; ++k) qv[k] += __shfl_xor(qv[k], o);
#pragma unroll
    for (int k = 0; k < NR; ++k) {
        const int r = row + k * stride;
        const float mu = s[k], rstd = rsqrtf(qv[k] * (1.f / 1024.f) + 1e-6f);
        const int sidx = r < RL ? (r >> 13) : 4;
        const float* sh = MOD + (size_t)(sp.lnext * 5 + sidx) * 9216 + sp.mshift * 1024; const float* scl = sh + 1024;
        float* xp = X + (size_t)r * 1024;
#pragma unroll
        for (int i = 0; i < 4; ++i) {
            const int c = (i * 64 + lane) * 4;
            const f32x4 gg = *(const f32x4*)(g + c), b4 = *(const f32x4*)(bb + c);
            f32x4 y;
#pragma unroll
            for (int j = 0; j < 4; ++j) y[j] = (v[k][i][j] - mu) * rstd * gg[j] + b4[j];
            if (sp.final_) { *(f32x4*)(P.out + (size_t)r * 1024 + c) = y; }
            else {
                *(f32x4*)(xp + c) = y;
                const f32x4 a = *(const f32x4*)(sh + c), sg = *(const f32x4*)(scl + c);
                u32x2 w; w.x = pk2(y[0] * (1.f + sg[0]) + a[0], y[1] * (1.f + sg[1]) + a[1]); w.y = pk2(y[2] * (1.f + sg[2]) + a[2], y[3] * (1.f + sg[3]) + a[3]);
                *(u32x2*)(XM + (size_t)r * 1024 + c) = w;
            }
        }
    }
}
DI void phase_ln(const Params& P, int l, int which, int lnext, int mshift, bool final_, bool lat_only = false) {
    const LnSpec sp{l, which, lnext, mshift, final_, nullptr};
    const int lane = ltid() & 63, wave = ltid() >> 6;
    const int nq = ((final_ || lat_only) ? RL : RT) / 4;
    for (int q = lbid() * NWAVE + wave; q < nq; q += gridDim.x * NWAVE) ln_rows<4>(P, sp, 4 * q, 1, lane);
}

DI void phase_ev_rms(const Params& P) {
    char* ws = P.ws; bf16_t* QN = (bf16_t*)(ws + OFF_HID + HOFF_QN); bf16_t* KVN = (bf16_t*)((char*)P.out + OOFF_KVN);
    const int lane = ltid() & 63, wave = ltid() >> 6;
    for (int row = lbid() * NWAVE + wave; row < RT; row += gridDim.x * NWAVE) {
        {
            u32x2* p = (u32x2*)(QN + (size_t)row * 256 + lane * 4); const u32x2 w = *p;
            float a = bflo(w.x), b = bfhi(w.x), c = bflo(w.y), d = bfhi(w.y);
            float s = a * a + b * b + c * c + d * d;
#pragma unroll
            for (int o = 32; o >= 1; o >>= 1) s += __shfl_xor(s, o);
            const float r = rsqrtf(s * (1.f / 256.f) + 1e-6f);
            u32x2 o2; o2.x = pk2(a * r, b * r); o2.y = pk2(c * r, d * r); *p = o2;
        }
        {
            unsigned* p = (unsigned*)(KVN + (size_t)row * 128 + lane * 2); const unsigned w = *p;
            float a = bflo(w), b = bfhi(w);
            float s = a * a + b * b;
#pragma unroll
            for (int o = 32; o >= 1; o >>= 1) s += __shfl_xor(s, o);
            const float r = rsqrtf(s * (1.f / 128.f) + 1e-6f);
            *p = pk2(a * r, b * r);
        }
    }
}

DI void phase_od_pool(const Params& P) {
    char* ws = P.ws; const bf16_t* U = (const bf16_t*)(ws + OFF_HID + HOFF_U); bf16_t* PL = (bf16_t*)(ws + OFF_HID + HOFF_PL);
    const size_t gtid = (size_t)lbid() * NTHR + ltid(), gstride = (size_t)gridDim.x * NTHR;
    for (size_t i = gtid; i < (size_t)RT * 64; i += gstride) {
        const int row = (int)(i >> 6), c = (int)(i & 63) * 8, grp = c >> 7;
        const int w = 2 << grp, left = w >> 1, right = w - 1 - left;
        int base, n, t;
        if (row < RL) { base = row & ~8191; n = SEQ; t = row & 8191; } else { const int rc = row - RL; base = RL + (rc & ~255); n = CTX; t = rc & 255; }
        const int lo = max(t - left, 0), hi = min(t + right + 1, n);
        float acc[8] = {0.f, 0.f, 0.f, 0.f, 0.f, 0.f, 0.f, 0.f};
        for (int tt = lo; tt < hi; ++tt) {
            const u32x4 v = *(const u32x4*)(U + (size_t)(base + tt) * 512 + c);
            acc[0] += bflo(v.x); acc[1] += bfhi(v.x); acc[2] += bflo(v.y); acc[3] += bfhi(v.y); acc[4] += bflo(v.z); acc[5] += bfhi(v.z); acc[6] += bflo(v.w); acc[7] += bfhi(v.w);
        }
        const float ic = 1.f / (float)(hi - lo);
        const u32x4 s = *(const u32x4*)(U + (size_t)row * 512 + c);
        u32x4 o;
        o.x = pk2(acc[0] * ic - bflo(s.x), acc[1] * ic - bfhi(s.x)); o.y = pk2(acc[2] * ic - bflo(s.y), acc[3] * ic - bfhi(s.y));
        o.z = pk2(acc[4] * ic - bflo(s.z), acc[5] * ic - bfhi(s.z)); o.w = pk2(acc[6] * ic - bflo(s.w), acc[7] * ic - bfhi(s.w));
        *(u32x4*)(PL + (size_t)row * 512 + c) = o;
    }
}

constexpr int NPHASE = 25;

DI void run_phase(const Params& P, int ph, char* smem) {
    char* ws = P.ws; char* hid = ws + OFF_HID; char* ob = (char*)P.out;
    float* X = (float*)(ws + OFF_X); bf16_t* XM = (bf16_t*)(ws + OFF_XM); bf16_t* HID = (bf16_t*)hid;
    const float* MOD = (const float*)(ws + OFF_MOD);
    if (ph == 0) { phase_pro_a(P, smem); return; }
    if (ph == 1) { phase_pro_b(P); return; }
    int l, op;
    if (ph < 14) { l = 0; op = ph - 2; } else { l = 1; op = ph - 14; if (op >= 6) op += 1; }
    const float* modl = MOD + (size_t)l * 5 * 9216;
    switch (op) {
    case 0: case 9: {
        const int f = op == 0 ? 0 : 1;
        EpiSwiglu e{HID};
        gemm_phase(XM, 1024, (const bf16_t*)(ws + OFF_WGU + (l * 2 + f) * SZ_WGU), 5632, 5632, 1024, e, smem, !(l == 1 && f == 1));
    } break;
    case 1: case 10: {
        const int f = op == 1 ? 0 : 1;
        const bool first = (l == 0 && f == 0);
        EpiResid e{first ? P.in[0] : X, first ? P.in[2] : X + (size_t)RL * 1024, X, modl + (f == 0 ? 2 : 8) * 1024, 0.5f};
        gemm_phase(HID, DFF, (const bf16_t*)(ws + OFF_WD + (l * 2 + f) * SZ_WD), 1024, 1024, DFF, e, smem, !(l == 1 && f == 1));
    } break;
    case 2: phase_ln(P, l, 0, l, 3, false); break;
    case 3: {
        if (l == 0) {
            EpiEvIn e{(bf16_t*)(hid + HOFF_QN), (bf16_t*)(hid + HOFF_QB), (bf16_t*)(ob + OOFF_KVN), (bf16_t*)(hid + HOFF_KA), (bf16_t*)(ob + OOFF_KB), (bf16_t*)(ob + OOFF_VB),
                      (const f32x2*)(ws + OFF_TAR), (const f32x2*)(ws + OFF_TAC), (const f32x2*)(ws + OFF_TBR), (const f32x2*)(ws + OFF_TBC)};
            gemm_phase(XM, 1024, (const bf16_t*)(ws + OFF_EVIN), 2048, 2048, 1024, e, smem);
        } else {
            EpiOdIn e{(bf16_t*)(hid + HOFF_U), (bf16_t*)(hid + HOFF_QD), (bf16_t*)(hid + HOFF_KD), (bf16_t*)(hid + HOFF_VD)};
            gemm_phase(XM, 1024, (const bf16_t*)(ws + OFF_ODIN), 2048, 2048, 1024, e, smem);
        }
    } break;
    case 4: if (l == 0) phase_ev_rms(P); else phase_od_pool(P); break;
    case 5: {
        if (l == 0) {
            EpiUQ e1{(bf16_t*)(hid + HOFF_QA), (const f32x2*)(ws + OFF_TAR), (const f32x2*)(ws + OFF_TAC)};
            gemm_phase((const bf16_t*)(hid + HOFF_QN), 256, (const bf16_t*)(ws + OFF_UQ), 768, 768, 256, e1, smem);
            EpiUKV e2{(bf16_t*)(hid + HOFF_KA), (bf16_t*)(hid + HOFF_VA)};
            gemm_phase((const bf16_t*)(ob + OOFF_KVN), 128, (const bf16_t*)(ws + OFF_UKV), 1024, 1024, 128, e2, smem);
        } else {
            odd_attention_phase(P, smem);
            EpiPool e{XM, P.in[22], 0};
            gemm_phase((const bf16_t*)(hid + HOFF_PL), 512, (const bf16_t*)(ws + OFF_POOL), 512, 512, 512, e, smem);
        }
    } break;
    case 6: even_attention_phase(P, smem); break;
    case 7: {
        EpiResid e{X, X + (size_t)RL * 1024, X, modl + 5 * 1024, 1.f};
        gemm_phase(XM, 1024, (const bf16_t*)(ws + (l == 0 ? OFF_EVOUT : OFF_ODOUT)), 1024, 1024, 1024, e, smem, l == 0);
    } break;
    case 8: phase_ln(P, l, 1, l, 6, false, l == 1); break;
    case 11: if (l == 0) phase_ln(P, 0, 2, 1, 0, false); else phase_ln(P, 1, 2, 1, 0, true); break;
    default: break;
    }
}

DI void grid_barrier(unsigned* ctr, unsigned target) {
    __syncthreads();
    if (threadIdx.x == 0) {
        __builtin_amdgcn_fence(__ATOMIC_RELEASE, "agent");
        __hip_atomic_fetch_add(ctr, 1u, __ATOMIC_RELAXED, __HIP_MEMORY_SCOPE_AGENT);
        while (__hip_atomic_load(ctr, __ATOMIC_RELAXED, __HIP_MEMORY_SCOPE_AGENT) < target) __builtin_amdgcn_s_sleep(2);
        __builtin_amdgcn_fence(__ATOMIC_ACQUIRE, "agent");
    }
    __syncthreads();
}

__global__ void __launch_bounds__(NTHR, 2) mega(Params P, int ph_lo, int ph_hi) {
    extern __shared__ __attribute__((aligned(16))) char smem[];
    unsigned nsync = 0;
    for (int ph = ph_lo; ph < ph_hi; ++ph) {
        run_phase(P, ph, smem);
        if (ph + 1 < ph_hi) {
            if (ph == ph_lo) cg::this_grid().sync();
            else { ++nsync; grid_barrier((unsigned*)(P.ws + OFF_BAR), nsync * gridDim.x); }
        }
    }
}

extern "C" void kernel_launch(void* const* d_in, const int* in_sizes, int n_in, void* d_out, int out_size, void* d_ws, size_t ws_size, hipStream_t stream) {
    if (ws_size < WS_NEED) { fprintf(stderr, "workspace too small: %zu < %zu\n", ws_size, (size_t)WS_NEED); return; }
    Params P{};
    for (int i = 0; i < 24; ++i) P.in[i] = (const float*)d_in[i];
    P.out = (float*)d_out; P.ws = (char*)d_ws;
    static int grid_blocks = 0;
    if (!grid_blocks) {
        int dev = 0, cus = 0, per_cu = 0;
        hipGetDevice(&dev);
        hipDeviceGetAttribute(&cus, hipDeviceAttributeMultiprocessorCount, dev);
        hipFuncSetAttribute((const void*)mega, hipFuncAttributeMaxDynamicSharedMemorySize, SMEM_BYTES);
        hipOccupancyMaxActiveBlocksPerMultiprocessor(&per_cu, mega, NTHR, SMEM_BYTES);
        if (per_cu < 1) per_cu = 1;
        if (per_cu > 1) per_cu = 1;
        grid_blocks = cus * per_cu;
    }
#if COOP
    hipMemsetAsync((char*)d_ws + OFF_BAR, 0, 256, stream);
    int lo = 0, hi = NPHASE;
    void* args[] = {&P, &lo, &hi};
    hipError_t e = hipLaunchCooperativeKernel((void*)mega, dim3(grid_blocks), dim3(NTHR), args, SMEM_BYTES, stream);
    if (e != hipSuccess) fprintf(stderr, "cooperative launch failed: %s (grid %d)\n", hipGetErrorString(e), grid_blocks);
#else
    for (int ph = 0; ph < NPHASE; ++ph) mega<<<grid_blocks, NTHR, SMEM_BYTES, stream>>>(P, ph, ph + 1);
#endif
}
```

```cpp
#include <hip/hip_runtime.h>
#include <hip/hip_cooperative_groups.h>
#include <cstdio>
#include <cstdint>
namespace cg = cooperative_groups;

#ifndef COOP
#define COOP 1
#endif

#define DI __device__ __forceinline__
typedef unsigned short bf16_t;
typedef short bf16x8 __attribute__((ext_vector_type(8)));
typedef short s16x4 __attribute__((ext_vector_type(4)));
typedef __bf16 bfx4 __attribute__((ext_vector_type(4)));
typedef __bf16 bfx2 __attribute__((ext_vector_type(2)));
typedef float f32x2 __attribute__((ext_vector_type(2)));
typedef float f32x4 __attribute__((ext_vector_type(4)));
typedef float f32x16 __attribute__((ext_vector_type(16)));
typedef unsigned u32x2 __attribute__((ext_vector_type(2)));
typedef unsigned u32x4 __attribute__((ext_vector_type(4)));
#define LDS_AS __attribute__((address_space(3)))

constexpr int DM = 1024, NB = 4, SEQ = 8192, CTX = 256, DFF = 2816;
constexpr int RL = NB * SEQ, RC = NB * CTX, RT = RL + RC;
constexpr int NK = SEQ + CTX;
constexpr float ALPHA = 1.41421356237f;
constexpr float LOG2E = 1.4426950408889634f;
constexpr float QA_SCALE = 0.10206207261596575f * LOG2E;
constexpr float QB_SCALE = 0.125f * LOG2E;
constexpr float QD_SCALE = 0.125f * LOG2E;
constexpr int NTHR = 512, NWAVE = NTHR / 64;

constexpr size_t SZ_WGU = 1024ull * 5632 * 2, SZ_WD = 2816ull * 1024 * 2;
constexpr size_t OFF_WGU = 0;
constexpr size_t OFF_WD = OFF_WGU + 4 * SZ_WGU;
constexpr size_t OFF_EVIN = OFF_WD + 4 * SZ_WD;
constexpr size_t OFF_EVOUT = OFF_EVIN + 1024ull * 2048 * 2;
constexpr size_t OFF_UQ = OFF_EVOUT + 1024ull * 1024 * 2;
constexpr size_t OFF_UKV = OFF_UQ + 256ull * 768 * 2;
constexpr size_t OFF_ODIN = OFF_UKV + 128ull * 1024 * 2;
constexpr size_t OFF_ODOUT = OFF_ODIN + 1024ull * 2048 * 2;
constexpr size_t OFF_POOL = OFF_ODOUT + 1024ull * 1024 * 2;
constexpr size_t OFF_MOD = OFF_POOL + 512ull * 512 * 2;
constexpr size_t OFF_TAR = OFF_MOD + 2ull * 5 * 9216 * 4;
constexpr size_t OFF_TAC = OFF_TAR + 128 * 8 * 8;
constexpr size_t OFF_TBR = OFF_TAC + 64 * 8 * 8;
constexpr size_t OFF_TBC = OFF_TBR + 128 * 16 * 8;
constexpr size_t OFF_LAM = OFF_TBC + 64 * 16 * 8;
constexpr size_t OFF_BAR = OFF_LAM + 256;
constexpr size_t OFF_X = OFF_BAR + 256;
constexpr size_t OFF_XM = OFF_X + (size_t)RT * 1024 * 4;
constexpr size_t OFF_HID = OFF_XM + (size_t)RT * 1024 * 2;
constexpr size_t WS_NEED = OFF_HID + (size_t)RT * DFF * 2;
constexpr size_t SZ_H96 = (size_t)NB * 8 * NK * 96 * 2, SZ_H64 = (size_t)NB * 8 * NK * 64 * 2;
constexpr size_t HOFF_QA = 0, HOFF_KA = SZ_H96, HOFF_VA = 2 * SZ_H96, HOFF_QB = HOFF_VA + SZ_H64, HOFF_QN = HOFF_QB + SZ_H64;
static_assert(HOFF_QN + (size_t)RT * 256 * 2 <= (size_t)RT * DFF * 2, "HID region overflow");
constexpr size_t HOFF_U = 0, HOFF_PL = SZ_H64, HOFF_QD = 2 * SZ_H64, HOFF_KD = 3 * SZ_H64, HOFF_VD = 4 * SZ_H64;
constexpr size_t OOFF_KB = 0, OOFF_VB = SZ_H64, OOFF_KVN = 2 * SZ_H64;
static_assert(OOFF_KVN + (size_t)RT * 128 * 2 <= (size_t)RL * 1024 * 4, "d_out region overflow");

struct Params {
    const float* in[24];
    float* out;
    char* ws;
};

DI int ltid() { int t = threadIdx.x; asm volatile("" : "+v"(t)); return t; }
DI int lbid() { int t = blockIdx.x; asm volatile("" : "+s"(t)); return t; }
DI unsigned pk2(float a, float b) { f32x2 v = {a, b}; bfx2 r = __builtin_convertvector(v, bfx2); return __builtin_bit_cast(unsigned, r); }
DI float bf2f(unsigned short u) { return __uint_as_float(((unsigned)u) << 16); }
DI float bflo(unsigned u) { return __uint_as_float(u << 16); }
DI float bfhi(unsigned u) { return __uint_as_float(u & 0xffff0000u); }
DI float silu_f(float x) { return x * __builtin_amdgcn_rcpf(1.f + __expf(-x)); }
DI f32x16 mfma32(bf16x8 a, bf16x8 b, f32x16 c) { return __builtin_amdgcn_mfma_f32_32x32x16_bf16(a, b, c, 0, 0, 0); }
DI s16x4 tr_read(const char* p) { bfx4 r = __builtin_amdgcn_ds_read_tr16_b64_v4bf16((LDS_AS bfx4*)p); return __builtin_bit_cast(s16x4, r); }
DI float xor32_max(float x) { const unsigned u = __float_as_uint(x); auto r = __builtin_amdgcn_permlane32_swap(u, u, false, false); return fmaxf(__uint_as_float(r[0]), __uint_as_float(r[1])); }
DI float xor32_sum(float x) { const unsigned u = __float_as_uint(x); auto r = __builtin_amdgcn_permlane32_swap(u, u, false, false); return __uint_as_float(r[0]) + __uint_as_float(r[1]); }
DI bf16x8 cat8(s16x4 lo, s16x4 hi) { return __builtin_shufflevector(lo, hi, 0, 1, 2, 3, 4, 5, 6, 7); }

struct RowInfo { int b, j, s; bool lat; };
DI RowInfo rowinfo(int row) {
    RowInfo r;
    if (row < RL) { r.b = row >> 13; r.j = row & 8191; r.s = r.b; r.lat = true; }
    else { int rc = row - RL; r.b = rc >> 8; r.j = 8192 + (rc & 255); r.s = 4; r.lat = false; }
    return r;
}
DI void store16(bf16_t* dst32, const f32x16& v, float sc, int hh) {
#pragma unroll
    for (int q4 = 0; q4 < 4; ++q4) {
        u32x2 w; w.x = pk2(v[4 * q4] * sc, v[4 * q4 + 1] * sc); w.y = pk2(v[4 * q4 + 2] * sc, v[4 * q4 + 3] * sc);
        *(u32x2*)(dst32 + 8 * q4 + 4 * hh) = w;
    }
}
DI f32x16 ropeB(const f32x16& v, const f32x2* tab, int hh) {
    f32x16 o;
#pragma unroll
    for (int r = 0; r < 8; ++r) {
        const int i = (r & 3) + 8 * (r >> 2) + 4 * hh;
        const f32x2 cs = tab[i];
        o[r] = v[r] * cs.x - v[r + 8] * cs.y;
        o[r + 8] = v[r + 8] * cs.x + v[r] * cs.y;
    }
    return o;
}
DI f32x16 ropeA(const f32x16& v, const f32x2* tr, const f32x2* tc, int hh) {
    f32x16 o;
#pragma unroll
    for (int r = 0; r < 4; ++r) {
        const int i = 4 * hh + r;
        const f32x2 a = tr[i], c = tc[i];
        o[r] = v[r] * a.x - v[r + 4] * a.y;
        o[r + 4] = v[r + 4] * a.x + v[r] * a.y;
        o[8 + r] = v[8 + r] * c.x - v[12 + r] * c.y;
        o[12 + r] = v[12 + r] * c.x + v[8 + r] * c.y;
    }
    return o;
}

constexpr int GA_S = 144, GB_S = 576;
constexpr int GSTAGE = 256 * GA_S + 64 * GB_S;
constexpr int GEMM_LDS = 2 * GSTAGE;

template <int BM, class Epi>
DI void gemm_tile(const bf16_t* __restrict__ A, int lda, const bf16_t* __restrict__ B, int ldb, int K, int row0, int col0, const Epi& epi, char* smem) {
    constexpr int MI = BM / 64, NA_ = BM / 64;
    const int tid = ltid(), lane = tid & 63, wave = tid >> 6, wm = wave >> 2, wn = wave & 3;
    const int l31 = lane & 31, hh = lane >> 5, q = (lane & 15) >> 2, p = lane & 3, nblk = (lane >> 4) & 1;
    f32x16 acc[MI][2];
#pragma unroll
    for (int i = 0; i < MI; ++i)
#pragma unroll
        for (int j = 0; j < 2; ++j)
#pragma unroll
            for (int r = 0; r < 16; ++r) acc[i][j][r] = 0.f;
    u32x4 ra[NA_], rb[4];
    const bf16_t* ag = A + (size_t)(row0 + (tid >> 3)) * lda + (tid & 7) * 8;
    const bf16_t* bg = B + (size_t)(tid >> 5) * ldb + col0 + (tid & 31) * 8;
    const int aw = (tid >> 3) * GA_S + (tid & 7) * 16, bw = BM * GA_S + (tid >> 5) * GB_S + (tid & 31) * 16;
    const int nk = K >> 6;
    const int xoff = (wm * (BM / 2) + l31) * GA_S + hh * 16;
    const int woff = BM * GA_S + (hh * 8 + q) * GB_S + (wn * 64 + nblk * 16 + 4 * p) * 2;
#pragma unroll
    for (int i = 0; i < NA_; ++i) ra[i] = *(const u32x4*)(ag + (size_t)(64 * i) * lda);
#pragma unroll
    for (int i = 0; i < 4; ++i) rb[i] = *(const u32x4*)(bg + (size_t)(16 * i) * ldb);
    __syncthreads();
#pragma unroll
    for (int i = 0; i < NA_; ++i) *(u32x4*)(smem + aw + 64 * i * GA_S) = ra[i];
#pragma unroll
    for (int i = 0; i < 4; ++i) *(u32x4*)(smem + bw + 16 * i * GB_S) = rb[i];
    if (nk > 1) {
#pragma unroll
        for (int i = 0; i < NA_; ++i) ra[i] = *(const u32x4*)(ag + 64 + (size_t)(64 * i) * lda);
#pragma unroll
        for (int i = 0; i < 4; ++i) rb[i] = *(const u32x4*)(bg + (size_t)(64 + 16 * i) * ldb);
    }
    __syncthreads();
    for (int kt = 0; kt < nk; ++kt) {
        const char* cur = smem + (kt & 1) * GSTAGE;
        char* nxt = smem + ((kt & 1) ^ 1) * GSTAGE;
        const bool w1 = kt + 1 < nk, l2 = kt + 2 < nk;
        const bf16_t* a2 = ag + (size_t)(kt + 2) * 64; const bf16_t* b2 = bg + (size_t)(kt + 2) * 64 * ldb;
#pragma unroll
        for (int s = 0; s < 4; ++s) {
            bf16x8 xf[MI], wf[2];
#pragma unroll
            for (int mi = 0; mi < MI; ++mi) xf[mi] = *(const bf16x8*)(cur + xoff + mi * 32 * GA_S + s * 32);
#pragma unroll
            for (int ni = 0; ni < 2; ++ni) {
                const char* wp = cur + woff + s * 16 * GB_S + ni * 64;
                wf[ni] = cat8(tr_read(wp), tr_read(wp + 4 * GB_S));
            }
#pragma unroll
            for (int mi = 0; mi < MI; ++mi)
#pragma unroll
                for (int ni = 0; ni < 2; ++ni) acc[mi][ni] = mfma32(wf[ni], xf[mi], acc[mi][ni]);
            if (w1) {
                if (s < NA_) *(u32x4*)(nxt + aw + 64 * s * GA_S) = ra[s];
                *(u32x4*)(nxt + bw + 16 * s * GB_S) = rb[s];
            }
            if (l2) {
                if (s < NA_) ra[s] = *(const u32x4*)(a2 + (size_t)(64 * s) * lda);
                rb[s] = *(const u32x4*)(b2 + (size_t)(16 * s) * ldb);
            }
            __builtin_amdgcn_sched_barrier(0);
        }
        __syncthreads();
    }
#pragma unroll
    for (int mi = 0; mi < MI; ++mi) epi(acc[mi][0], acc[mi][1], row0 + wm * (BM / 2) + mi * 32 + l31, col0 + wn * 64, hh);
}

template <class Epi>
DI void gemm_phase(const bf16_t* A, int lda, const bf16_t* B, int ldb, int N, int K, const Epi& epi, char* smem, bool do_ctx = true) {
    const int nt = N >> 8, small = do_ctx ? (RC / 128) * nt : 0;
    const int bid = lbid(), G = gridDim.x;
    if ((G & 7) == 0) {
        const int xcd = bid & 7, loc = bid >> 3, per = G >> 3, mine = (RL / 256 / 8) * nt;
        for (int i = loc; i < mine; i += per) {
            const int cg = i >> 7, rem = i & 127, cw = min(8, nt - cg * 8);
            int pg, w;
            if (cw == 8) { pg = rem >> 5; w = rem & 31; } else { const int rr = i - cg * 128; pg = rr / (4 * cw); w = rr - pg * 4 * cw; }
            const int pl = pg * 4 + (w & 3), cl = cg * 8 + (w >> 2);
            gemm_tile<256>(A, lda, B, ldb, K, (pl * 8 + xcd) * 256, cl * 256, epi, smem);
        }
    } else {
        const int big = (RL / 256) * nt;
        for (int t = bid; t < big; t += G) gemm_tile<256>(A, lda, B, ldb, K, (t / nt) * 256, (t % nt) * 256, epi, smem);
    }
    for (int u = bid; u < small; u += G) gemm_tile<128>(A, lda, B, ldb, K, RL + (u / nt) * 128, (u % nt) * 256, epi, smem);
}

struct EpiSwiglu {
    bf16_t* hid;
    DI void operator()(const f32x16& a0, const f32x16& a1, int row, int cbase, int hh) const {
        bf16_t* dst = hid + (size_t)row * DFF + (cbase >> 1) + 4 * hh;
#pragma unroll
        for (int q4 = 0; q4 < 4; ++q4) {
            float h[4];
#pragma unroll
            for (int j = 0; j < 4; ++j) h[j] = silu_f(a0[4 * q4 + j]) * a1[4 * q4 + j];
            u32x2 w; w.x = pk2(h[0], h[1]); w.y = pk2(h[2], h[3]);
            *(u32x2*)(dst + 8 * q4) = w;
        }
    }
};
struct EpiResid {
    const float* res_lat; const float* res_ctx; float* X; const float* gate; float coef;
    DI void operator()(const f32x16& a0, const f32x16& a1, int row, int cbase, int hh) const {
        const int s = row < RL ? (row >> 13) : 4;
        const float* rp = row < RL ? res_lat + (size_t)row * 1024 : res_ctx + (size_t)(row - RL) * 1024;
        const float* gp = gate + s * 9216;
        float* xp = X + (size_t)row * 1024;
#pragma unroll
        for (int ni = 0; ni < 2; ++ni)
#pragma unroll
            for (int q4 = 0; q4 < 4; ++q4) {
                const int c = cbase + ni * 32 + 8 * q4 + 4 * hh;
                const f32x4 r = *(const f32x4*)(rp + c), g = *(const f32x4*)(gp + c);
                f32x4 z;
#pragma unroll
                for (int j = 0; j < 4; ++j) z[j] = ALPHA * r[j] + coef * g[j] * (ni ? a1[4 * q4 + j] : a0[4 * q4 + j]);
                *(f32x4*)(xp + c) = z;
            }
    }
};
struct EpiEvIn {
    bf16_t *QN, *QB, *KVN, *KA, *KB, *VB; const f32x2 *tAr, *tAc, *tBr, *tBc;
    DI void operator()(const f32x16& a0, const f32x16& a1, int row, int cbase, int hh) const {
        const RowInfo ri = rowinfo(row);
        const int gr = (ri.j >> 6) & 127, gc = ri.j & 63;
#pragma unroll
        for (int ni = 0; ni < 2; ++ni) {
            const int g = (cbase >> 5) + ni;
            const f32x16& v = ni ? a1 : a0;
            if (g < 8) store16(QN + (size_t)row * 256 + g * 32, v, 1.f, hh);
            else if (g < 24) {
                const int hv = (g - 8) >> 1, half = (g - 8) & 1;
                f32x16 w = v; if (ri.lat) w = ropeB(v, half ? tBc + gc * 16 : tBr + gr * 16, hh);
                store16(QB + ((size_t)(ri.b * 8 + hv) * NK + ri.j) * 64 + half * 32, w, QB_SCALE, hh);
            } else if (g < 28) store16(KVN + (size_t)row * 128 + (g - 24) * 32, v, 1.f, hh);
            else if (g == 28) {
                f32x16 w = v; if (ri.lat) w = ropeA(v, tAr + gr * 8, tAc + gc * 8, hh);
                for (int h = 0; h < 8; ++h) store16(KA + ((size_t)(ri.b * 8 + h) * NK + ri.j) * 96 + 64, w, 1.f, hh);
            } else if (g < 45) {
                const int hv = (g - 29) >> 1, half = (g - 29) & 1;
                f32x16 w = v; if (ri.lat) w = ropeB(v, half ? tBc + gc * 16 : tBr + gr * 16, hh);
                store16(KB + ((size_t)(ri.b * 8 + hv) * NK + ri.j) * 64 + half * 32, w, 1.f, hh);
            } else if (g < 61) {
                const int idx = g - 45, h = idx >> 2, part = idx & 3;
                store16(VB + ((size_t)(ri.b * 4 + h) * NK + ri.j) * 128 + part * 32, v, 1.f, hh);
            }
        }
    }
};
struct EpiUQ {
    bf16_t* QA; const f32x2 *tAr, *tAc;
    DI void operator()(const f32x16& a0, const f32x16& a1, int row, int cbase, int hh) const {
        const RowInfo ri = rowinfo(row);
        const int gr = (ri.j >> 6) & 127, gc = ri.j & 63;
#pragma unroll
        for (int ni = 0; ni < 2; ++ni) {
            const int g = (cbase >> 5) + ni, h = g / 3, part = g - 3 * h;
            f32x16 w = ni ? a1 : a0;
            if (part == 2 && ri.lat) w = ropeA(ni ? a1 : a0, tAr + gr * 8, tAc + gc * 8, hh);
            store16(QA + ((size_t)(ri.b * 8 + h) * NK + ri.j) * 96 + part * 32, w, QA_SCALE, hh);
        }
    }
};
struct EpiUKV {
    bf16_t *KA, *VA;
    DI void operator()(const f32x16& a0, const f32x16& a1, int row, int cbase, int hh) const {
        const RowInfo ri = rowinfo(row);
#pragma unroll
        for (int ni = 0; ni < 2; ++ni) {
            const int g = (cbase >> 5) + ni, h = g >> 2, part = g & 3;
            const size_t tk = (size_t)(ri.b * 8 + h) * NK + ri.j;
            if (part < 2) store16(KA + tk * 96 + part * 32, ni ? a1 : a0, 1.f, hh);
            else store16(VA + tk * 64 + (part - 2) * 32, ni ? a1 : a0, 1.f, hh);
        }
    }
};
struct EpiOdIn {
    bf16_t *U, *QD, *KD, *VD;
    DI void operator()(const f32x16& a0, const f32x16& a1, int row, int cbase, int hh) const {
        const RowInfo ri = rowinfo(row);
#pragma unroll
        for (int ni = 0; ni < 2; ++ni) {
            const int g = (cbase >> 5) + ni;
            const f32x16& v = ni ? a1 : a0;
            if (g < 16) store16(U + (size_t)row * 512 + g * 32, v, 1.f, hh);
            else {
                const int gg = (g - 16) & 15, h = gg >> 1, half = gg & 1;
                const size_t off = ((size_t)(ri.b * 8 + h) * NK + ri.j) * 64 + half * 32;
                if (g < 32) store16(QD + off, v, QD_SCALE, hh);
                else if (g < 48) store16(KD + off, v, 1.f, hh);
                else store16(VD + off, v, 1.f, hh);
            }
        }
    }
};
struct EpiPool {
    bf16_t* CC; const float* pscale; int gidx;
    DI void operator()(const f32x16& a0, const f32x16& a1, int row, int cbase, int hh) const {
#pragma unroll
        for (int ni = 0; ni < 2; ++ni)
#pragma unroll
            for (int q4 = 0; q4 < 4; ++q4) {
                const int c = gidx * 128 + cbase + ni * 32 + 8 * q4 + 4 * hh;
                const f32x4 s = *(const f32x4*)(pscale + c);
                const f32x16& v = ni ? a1 : a0;
                u32x2 w; w.x = pk2(v[4 * q4] * s[0], v[4 * q4 + 1] * s[1]); w.y = pk2(v[4 * q4 + 2] * s[2], v[4 * q4 + 3] * s[3]);
                *(u32x2*)(CC + (size_t)row * 1024 + c) = w;
            }
    }
};

constexpr int ATT_LDS = 64 * (96 + 8) * 2 + 64 * (128 * 2 + 64);
constexpr int RPB_OFF = 2 * ATT_LDS;
constexpr int SMEM_BYTES = GEMM_LDS;

struct NAInfo { int qr; int kstart; };

template <int DQK, int DV, bool NA>
DI void attend(const bf16_t* __restrict__ Q, int q0, const bf16_t* __restrict__ Kb, const bf16_t* __restrict__ Vb,
               int s0, int n0, int s1, int n1, f32x16 (&o)[DV / 32], char* smem, NAInfo na) {
    constexpr int KS = (DQK + 8) * 2, VS = DV * 2 + 64;
    constexpr int KCH = DQK / 8, KN = (64 * KCH + NTHR - 1) / NTHR, VCH = DV / 8, VN = (64 * VCH + NTHR - 1) / NTHR;
    constexpr int NS = DQK / 16, NDT = DV / 32;
    const int tid = ltid(), lane = tid & 63, wave = tid >> 6;
    const int l31 = lane & 31, hh = lane >> 5, q = (lane & 15) >> 2, p = lane & 3, dblk = (lane >> 4) & 1;
    bf16x8 qf[NS];
    {
        const bf16_t* qp = Q + (size_t)(q0 + wave * 32 + l31) * DQK + hh * 8;
#pragma unroll
        for (int s = 0; s < NS; ++s) qf[s] = *(const bf16x8*)(qp + s * 16);
    }
#pragma unroll
    for (int d = 0; d < NDT; ++d)
#pragma unroll
        for (int r = 0; r < 16; ++r) o[d][r] = 0.f;
    float m = NA ? -INFINITY : 0.f, l = 0.f;
    f32x16 cinit;
#pragma unroll
    for (int r = 0; r < 16; ++r) cinit[r] = 0.f;
    u32x4 rk[KN], rv[VN];
    const int nt = n0 + n1;
    auto gload = [&](int t) {
        const int j0 = t < n0 ? s0 + t * 64 : s1 + (t - n0) * 64;
#pragma unroll
        for (int i = 0; i < KN; ++i) { int id = tid + NTHR * i; if (id >= 64 * KCH) id -= 64 * KCH; const int row = id / KCH, ch = id - row * KCH; rk[i] = *(const u32x4*)(Kb + (size_t)(j0 + row) * DQK + ch * 8); }
#pragma unroll
        for (int i = 0; i < VN; ++i) { int id = tid + NTHR * i; if (id >= 64 * VCH) id -= 64 * VCH; const int row = id / VCH, ch = id - row * VCH; rv[i] = *(const u32x4*)(Vb + (size_t)(j0 + row) * DV + ch * 8); }
    };
    gload(0);
    int qc = 0, cs = 0, rs = 0;
    if (NA) { qc = (wave & 1) * 32 + l31; cs = min(max(qc - 8, 0), 48); rs = min(max(na.qr - 4, 0), 120); }
    const float* rpb = (const float*)(smem + RPB_OFF);
    auto lwrite = [&](char* stg) {
#pragma unroll
        for (int i = 0; i < KN; ++i) { int id = tid + NTHR * i; if (id >= 64 * KCH) id -= 64 * KCH; const int row = id / KCH, ch = id - row * KCH; *(u32x4*)(stg + row * KS + ch * 16) = rk[i]; }
#pragma unroll
        for (int i = 0; i < VN; ++i) { int id = tid + NTHR * i; if (id >= 64 * VCH) id -= 64 * VCH; const int row = id / VCH, ch = id - row * VCH; *(u32x4*)(stg + 64 * KS + row * VS + ch * 16) = rv[i]; }
    };
    __syncthreads();
    lwrite(smem);
    if (nt > 1) gload(1);
    __syncthreads();
    for (int t = 0; t < nt; ++t) {
        const char* sK = smem + (t & 1) * ATT_LDS; const char* sV = sK + 64 * KS;
        bool active = true; int kr = 0;
        if (NA && t < n0) { kr = na.kstart + t; active = (kr >= rs) && (kr < rs + 8); }
        if (active) {
#pragma unroll
            for (int sub = 0; sub < 2; ++sub) {
                f32x16 st;
                if (NA) {
#pragma unroll
                    for (int r = 0; r < 16; ++r) st[r] = 0.f;
                } else st = cinit;
                {
                    bf16x8 kf[NS];
#pragma unroll
                    for (int s = 0; s < NS; ++s) kf[s] = *(const bf16x8*)(sK + (sub * 32 + l31) * KS + (s * 16 + hh * 8) * 2);
                    __builtin_amdgcn_sched_barrier(0);
#pragma unroll
                    for (int s = 0; s < NS; ++s) st = mfma32(kf[s], qf[s], st);
                }
                if (NA && t < n0) {
                    const float* brow = rpb + (kr - na.qr + 7) * 31 + 15 - qc;
#pragma unroll
                    for (int r = 0; r < 16; ++r) {
                        const int kc = sub * 32 + (r & 3) + 8 * (r >> 2) + 4 * hh;
                        const bool valid = (kc >= cs) && (kc < cs + 16);
                        const int bi = valid ? kc : cs;
                        const float bias = brow[bi];
                        st[r] = valid ? st[r] + bias : -INFINITY;
                    }
                }
                float mx = st[0];
#pragma unroll
                for (int r = 1; r < 16; ++r) mx = fmaxf(mx, st[r]);
                mx = xor32_max(mx);
                float rsum = 0.f;
                if (NA) {
                    const float mnew = fmaxf(m, mx);
                    const float muse = (mnew == -INFINITY) ? 0.f : mnew;
                    const float alpha = __builtin_amdgcn_exp2f(m - muse);
                    m = mnew;
                    l *= alpha;
#pragma unroll
                    for (int d = 0; d < NDT; ++d)
#pragma unroll
                        for (int r = 0; r < 16; ++r) o[d][r] *= alpha;
#pragma unroll
                    for (int r = 0; r < 16; ++r) { st[r] = __builtin_amdgcn_exp2f(st[r] - muse); rsum += st[r]; }
                } else {
                    const bool first = (t == 0) && (sub == 0);
                    if (first || __builtin_amdgcn_ballot_w64(mx > 8.f) != 0) {
                        const float delta = first ? mx : fmaxf(mx, 0.f);
                        const float alpha = first ? 1.f : __builtin_amdgcn_exp2f(-delta);
                        m += delta;
                        l *= alpha;
#pragma unroll
                        for (int d = 0; d < NDT; ++d)
#pragma unroll
                            for (int r = 0; r < 16; ++r) o[d][r] *= alpha;
#pragma unroll
                        for (int r = 0; r < 16; ++r) { st[r] -= delta; cinit[r] = -m; }
                    }
#pragma unroll
                    for (int r = 0; r < 16; ++r) { st[r] = __builtin_amdgcn_exp2f(st[r]); rsum += st[r]; }
                }
                l += rsum;
                bf16x8 pf[2];
#pragma unroll
                for (int s2 = 0; s2 < 2; ++s2) {
                    u32x4 w;
                    w.x = pk2(st[8 * s2], st[8 * s2 + 1]); w.y = pk2(st[8 * s2 + 2], st[8 * s2 + 3]);
                    w.z = pk2(st[8 * s2 + 4], st[8 * s2 + 5]); w.w = pk2(st[8 * s2 + 6], st[8 * s2 + 7]);
                    pf[s2] = __builtin_bit_cast(bf16x8, w);
                }
#pragma unroll
                for (int d = 0; d < NDT; ++d)
#pragma unroll
                    for (int s2 = 0; s2 < 2; ++s2) {
                        const char* vp = sV + (sub * 32 + 16 * s2 + 4 * hh + q) * VS + (d * 32 + dblk * 16 + 4 * p) * 2;
                        const bf16x8 vf = cat8(tr_read(vp), tr_read(vp + 8 * VS));
                        o[d] = mfma32(vf, pf[s2], o[d]);
                    }
            }
        }
        if (t + 1 < nt) lwrite(smem + ((t & 1) ^ 1) * ATT_LDS);
        if (t + 2 < nt) gload(t + 2);
        __syncthreads();
    }
    l = xor32_sum(l);
    const float inv = 1.f / l;
#pragma unroll
    for (int d = 0; d < NDT; ++d)
#pragma unroll
        for (int r = 0; r < 16; ++r) o[d][r] *= inv;
}

DI int qrow_of(int b, int j) { return j < SEQ ? b * SEQ + j : RL + b * CTX + (j - SEQ); }

DI void even_attention_phase(const Params& P, char* smem) {
    char* ws = P.ws; char* hid = ws + OFF_HID; char* ob = (char*)P.out;
    const bf16_t* QA = (const bf16_t*)(hid + HOFF_QA); const bf16_t* KA = (const bf16_t*)(hid + HOFF_KA); const bf16_t* VA = (const bf16_t*)(hid + HOFF_VA);
    const bf16_t* QB = (const bf16_t*)(hid + HOFF_QB); const bf16_t* KB = (const bf16_t*)(ob + OOFF_KB); const bf16_t* VB = (const bf16_t*)(ob + OOFF_VB);
    bf16_t* CC = (bf16_t*)(ws + OFF_XM);
    const float lam = *(const float*)(ws + OFF_LAM);
    const float* gsub = P.in[18];
    const int lane = ltid() & 63, wave = ltid() >> 6, l31 = lane & 31, hh = lane >> 5;
    constexpr int NQT = 33, NDIFF = NB * 4 * NQT, NMLA = NB * 8 * NQT;
    NAInfo na; na.qr = 0; na.kstart = 0;
    unsigned* wq = (unsigned*)(ws + OFF_BAR + 128);
    volatile int* slot = (volatile int*)(smem + 2 * ATT_LDS + 2048);
    for (;;) {
        __syncthreads();
        if (ltid() == 0) *slot = (int)atomicAdd(wq, 1u);
        __syncthreads();
        const int u = *slot;
        if (u >= NDIFF + NMLA) break;
        if (u < NDIFF) {
            const int qt = u % NQT, bh = u / NQT, h = bh & 3, b = bh >> 2;
            const int q0 = qt < 32 ? qt * 256 : SEQ;
            const int s0 = qt < 32 ? 0 : SEQ, n0 = qt < 32 ? NK / 64 : CTX / 64;
            const bf16_t* V = VB + (size_t)(b * 4 + h) * NK * 128;
            f32x16 o[4];
            attend<64, 128, false>(QB + (size_t)(b * 8 + 2 * h) * NK * 64, q0, KB + (size_t)(b * 8 + 2 * h) * NK * 64, V, s0, n0, 0, 0, o, smem, na);
            const int row = qrow_of(b, q0 + wave * 32 + l31);
            bf16_t* dst = CC + (size_t)row * 1024 + 512 + h * 128;
#pragma unroll
            for (int d = 0; d < 4; ++d) store16(dst + d * 32, o[d], 1.f, hh);
            f32x16 o2[4];
            attend<64, 128, false>(QB + (size_t)(b * 8 + 2 * h + 1) * NK * 64, q0, KB + (size_t)(b * 8 + 2 * h + 1) * NK * 64, V, s0, n0, 0, 0, o2, smem, na);
            float ss = 0.f;
#pragma unroll
            for (int d = 0; d < 4; ++d)
#pragma unroll
                for (int q4 = 0; q4 < 4; ++q4) {
                    const u32x2 w = *(const volatile u32x2*)(dst + d * 32 + 8 * q4 + 4 * hh);
                    const float a0 = bflo(w.x) - lam * o2[d][4 * q4], a1 = bfhi(w.x) - lam * o2[d][4 * q4 + 1], a2 = bflo(w.y) - lam * o2[d][4 * q4 + 2], a3 = bfhi(w.y) - lam * o2[d][4 * q4 + 3];
                    o[d][4 * q4] = a0; o[d][4 * q4 + 1] = a1; o[d][4 * q4 + 2] = a2; o[d][4 * q4 + 3] = a3;
                    ss += (a0 * a0 + a1 * a1) + (a2 * a2 + a3 * a3);
                }
            ss = xor32_sum(ss);
            const float rn = rsqrtf(ss * (1.f / 128.f) + 1e-5f) * 0.8f;
#pragma unroll
            for (int d = 0; d < 4; ++d)
#pragma unroll
                for (int q4 = 0; q4 < 4; ++q4) {
                    const int c = d * 32 + 8 * q4 + 4 * hh;
                    const f32x4 g = *(const f32x4*)(gsub + c);
                    u32x2 w; w.x = pk2(o[d][4 * q4] * rn * g[0], o[d][4 * q4 + 1] * rn * g[1]); w.y = pk2(o[d][4 * q4 + 2] * rn * g[2], o[d][4 * q4 + 3] * rn * g[3]);
                    *(u32x2*)(dst + c) = w;
                }
        } else {
            const int v = u - NDIFF, qt = v % NQT, bh = v / NQT, h = bh & 7, b = bh >> 3;
            const int q0 = qt < 32 ? qt * 256 : SEQ;
            const int s0 = qt < 32 ? 0 : SEQ, n0 = qt < 32 ? NK / 64 : CTX / 64;
            f32x16 o[2];
            attend<96, 64, false>(QA + (size_t)(b * 8 + h) * NK * 96, q0, KA + (size_t)(b * 8 + h) * NK * 96, VA + (size_t)(b * 8 + h) * NK * 64, s0, n0, 0, 0, o, smem, na);
            const int row = qrow_of(b, q0 + wave * 32 + l31);
            bf16_t* dst = CC + (size_t)row * 1024 + h * 64;
#pragma unroll
            for (int d = 0; d < 2; ++d) store16(dst + d * 32, o[d], 1.f, hh);
        }
    }
}

DI void odd_attention_phase(const Params& P, char* smem) {
    char* ws = P.ws; char* hid = ws + OFF_HID;
    const bf16_t* QD = (const bf16_t*)(hid + HOFF_QD); const bf16_t* KD = (const bf16_t*)(hid + HOFF_KD); const bf16_t* VD = (const bf16_t*)(hid + HOFF_VD);
    bf16_t* CC = (bf16_t*)(ws + OFF_XM);
    const float* rpbg = P.in[23];
    const int lane = ltid() & 63, wave = ltid() >> 6, l31 = lane & 31, hh = lane >> 5;
    float* rpbl = (float*)(smem + RPB_OFF);
    constexpr int NU = NB * 8 * 32;
    for (int u = lbid(); u < NU; u += gridDim.x) {
        const int rp = u & 31, bh = u >> 5, h = bh & 7, b = bh >> 3;
        __syncthreads();
        for (int i = ltid(); i < 465; i += NTHR) rpbl[i] = rpbg[h * 465 + i] * LOG2E;
        const int r0 = rp * 4;
        NAInfo na; na.qr = r0 + (wave >> 1);
        const int rs0 = min(max(r0 - 4, 0), 120);
        na.kstart = min(rs0, 117);
        f32x16 o[2];
        const size_t hb = (size_t)(b * 8 + h) * NK * 64;
        attend<64, 64, true>(QD + hb, r0 * 64, KD + hb, VD + hb, na.kstart * 64, 11, SEQ, CTX / 64, o, smem, na);
        const int row = b * SEQ + r0 * 64 + wave * 32 + l31;
        bf16_t* dst = CC + (size_t)row * 1024 + 512 + h * 64;
#pragma unroll
        for (int d = 0; d < 2; ++d) store16(dst + d * 32, o[d], 1.f, hh);
    }
}

DI void cvt8(bf16_t* dst, const float* src, float sc) {
    const f32x4 a = *(const f32x4*)src, b = *(const f32x4*)(src + 4);
    u32x4 w; w.x = pk2(a[0] * sc, a[1] * sc); w.y = pk2(a[2] * sc, a[3] * sc); w.z = pk2(b[0] * sc, b[1] * sc); w.w = pk2(b[2] * sc, b[3] * sc);
    *(u32x4*)dst = w;
}
DI void cvt_rows(bf16_t* dst, int ldd, const float* src, int lds_, int rows, int cols_src, const float* rowscale, size_t gtid, size_t gstride) {
    const int c8 = ldd >> 3; const size_t n = (size_t)rows * c8;
    for (size_t i0 = gtid; i0 < n; i0 += 4 * gstride) {
        f32x4 a[4], b[4]; float sc[4];
#pragma unroll
        for (int u = 0; u < 4; ++u) {
            const size_t i = i0 + u * gstride;
            const int k = (int)(i / c8), c = (int)(i % c8) * 8;
            const bool ok = i < n && c < cols_src;
            const float* p = src + (ok ? (size_t)k * lds_ + c : 0);
            a[u] = *(const f32x4*)p; b[u] = *(const f32x4*)(p + 4);
            sc[u] = !ok ? 0.f : (rowscale ? rowscale[k] : 1.f);
        }
#pragma unroll
        for (int u = 0; u < 4; ++u) {
            const size_t i = i0 + u * gstride;
            if (i < n) {
                const int k = (int)(i / c8), c = (int)(i % c8) * 8;
                u32x4 w; w.x = pk2(a[u][0] * sc[u], a[u][1] * sc[u]); w.y = pk2(a[u][2] * sc[u], a[u][3] * sc[u]); w.z = pk2(b[u][0] * sc[u], b[u][1] * sc[u]); w.w = pk2(b[u][2] * sc[u], b[u][3] * sc[u]);
                *(u32x4*)(dst + (size_t)k * ldd + c) = w;
            }
        }
    }
}

DI void phase_pro_a(const Params& P, char* smem) {
    char* ws = P.ws;
    const size_t gtid = (size_t)lbid() * NTHR + ltid(), gstride = (size_t)gridDim.x * NTHR;
    for (int lf = 0; lf < 4; ++lf) {
        const float* sg = P.in[8] + (size_t)lf * 1024 * DFF; const float* su = P.in[9] + (size_t)lf * 1024 * DFF;
        bf16_t* dst = (bf16_t*)(ws + OFF_WGU + lf * SZ_WGU);
        for (size_t i0 = gtid; i0 < 1024ull * 704; i0 += 4 * gstride) {
            f32x4 a[4], b[4];
#pragma unroll
            for (int u = 0; u < 4; ++u) {
                const size_t i = i0 + u * gstride < 1024ull * 704 ? i0 + u * gstride : i0;
                const int k = (int)(i / 704), n = (int)(i % 704) * 8, grp = n >> 6, w = n & 63;
                const float* src = ((w < 32) ? sg : su) + (size_t)k * DFF + grp * 32 + (w & 31);
                a[u] = *(const f32x4*)src; b[u] = *(const f32x4*)(src + 4);
            }
#pragma unroll
            for (int u = 0; u < 4; ++u) {
                const size_t i = i0 + u * gstride;
                if (i < 1024ull * 704) {
                    const int k = (int)(i / 704), n = (int)(i % 704) * 8;
                    u32x4 w; w.x = pk2(a[u][0], a[u][1]); w.y = pk2(a[u][2], a[u][3]); w.z = pk2(b[u][0], b[u][1]); w.w = pk2(b[u][2], b[u][3]);
                    *(u32x4*)(dst + (size_t)k * 5632 + n) = w;
                }
            }
        }
        cvt_rows((bf16_t*)(ws + OFF_WD + lf * SZ_WD), 1024, P.in[10] + (size_t)lf * DFF * 1024, 1024, DFF, 1024, nullptr, gtid, gstride);
    }
    cvt_rows((bf16_t*)(ws + OFF_EVIN), 2048, P.in[11], 1952, 1024, 1952, nullptr, gtid, gstride);
    cvt_rows((bf16_t*)(ws + OFF_EVOUT), 1024, P.in[12], 1024, 1024, 1024, nullptr, gtid, gstride);
    cvt_rows((bf16_t*)(ws + OFF_UQ), 768, P.in[15], 768, 256, 768, P.in[13], gtid, gstride);
    cvt_rows((bf16_t*)(ws + OFF_UKV), 1024, P.in[16], 1024, 128, 1024, P.in[14], gtid, gstride);
    cvt_rows((bf16_t*)(ws + OFF_ODIN), 2048, P.in[19], 2048, 1024, 2048, nullptr, gtid, gstride);
    cvt_rows((bf16_t*)(ws + OFF_ODOUT), 1024, P.in[20], 1024, 1024, 1024, nullptr, gtid, gstride);
    for (size_t i = gtid; i < 512ull * 64; i += gstride) {
        const int k = (int)(i >> 6), n = (int)(i & 63) * 8;
        bf16_t* d = (bf16_t*)(ws + OFF_POOL) + (size_t)k * 512 + n;
        if ((k >> 7) == (n >> 7)) cvt8(d, P.in[21] + (size_t)k * 128 + (n & 127), 1.f);
        else { u32x4 z = {0u, 0u, 0u, 0u}; *(u32x4*)d = z; }
    }
    if (gtid < 128 * 8) { const int r = (int)gtid >> 3, i = (int)gtid & 7; const float inv = exp2f(-(float)i * (13.287712379549449f / 8.f)); float rev = (float)r * inv * 0.15915494309189535f; rev -= floorf(rev);
        f32x2 v = {__builtin_amdgcn_cosf(rev), __builtin_amdgcn_sinf(rev)}; ((f32x2*)(ws + OFF_TAR))[gtid] = v; if (r < 64) ((f32x2*)(ws + OFF_TAC))[gtid] = v; }
    if (gtid < 128 * 16) { const int r = (int)gtid >> 4, i = (int)gtid & 15; const float inv = exp2f(-(float)i * (13.287712379549449f / 16.f)); float rev = (float)r * inv * 0.15915494309189535f; rev -= floorf(rev);
        f32x2 v = {__builtin_amdgcn_cosf(rev), __builtin_amdgcn_sinf(rev)}; ((f32x2*)(ws + OFF_TBR))[gtid] = v; if (r < 64) ((f32x2*)(ws + OFF_TBC))[gtid] = v; }
    if (gtid == 0) {
        const float* lv = P.in[17]; float a = 0.f, b = 0.f;
        for (int i = 0; i < 64; ++i) { a += lv[i] * lv[64 + i]; b += lv[128 + i] * lv[192 + i]; }
        *(float*)(ws + OFF_LAM) = expf(a) - expf(b) + 0.2f;
    }
    float* sc = (float*)smem;
    float* red = sc + 5 * 1024;
    const int tid = ltid(), jj = tid & 31, ig = tid >> 5;
    __syncthreads();
    for (int i = tid; i < 5 * 1024; i += NTHR) { const float v = i < 4096 ? P.in[1][i] : P.in[3][i - 4096]; sc[i] = v / (1.f + expf(-v)); }
    __syncthreads();
    for (int u = lbid(); u < 576; u += gridDim.x) {
        const int l = u / 288, j0 = (u % 288) * 32;
        float a[5] = {0.f, 0.f, 0.f, 0.f, 0.f};
        const float* w = P.in[4] + (size_t)l * 1024 * 9216 + (size_t)(ig * 64) * 9216 + j0 + jj;
        for (int i0 = 0; i0 < 64; i0 += 8) {
            float wv[8];
#pragma unroll
            for (int k = 0; k < 8; ++k) wv[k] = w[(size_t)(i0 + k) * 9216];
#pragma unroll
            for (int k = 0; k < 8; ++k)
#pragma unroll
                for (int s2 = 0; s2 < 5; ++s2) a[s2] += sc[s2 * 1024 + ig * 64 + i0 + k] * wv[k];
        }
#pragma unroll
        for (int s2 = 0; s2 < 5; ++s2) red[(ig * 5 + s2) * 32 + jj] = a[s2];
        __syncthreads();
        if (tid < 160) {
            const int s2 = tid >> 5, j = tid & 31;
            float v = P.in[5][l * 9216 + j0 + j];
#pragma unroll
            for (int g = 0; g < 16; ++g) v += red[(g * 5 + s2) * 32 + j];
            ((float*)(ws + OFF_MOD))[(size_t)(l * 5 + s2) * 9216 + j0 + j] = v;
        }
        __syncthreads();
    }
}

DI void phase_pro_b(const Params& P) {
    char* ws = P.ws; bf16_t* XM = (bf16_t*)(ws + OFF_XM); const float* MOD = (const float*)(ws + OFF_MOD);
    const size_t gtid = (size_t)lbid() * NTHR + ltid(), gstride = (size_t)gridDim.x * NTHR;
    for (size_t i = gtid; i < (size_t)RT * 128; i += gstride) {
        const int row = (int)(i >> 7), c = (int)(i & 127) * 8;
        const float* src = row < RL ? P.in[0] + (size_t)row * 1024 + c : P.in[2] + (size_t)(row - RL) * 1024 + c;
        const int s = row < RL ? (row >> 13) : 4;
        const float* sh = MOD + (size_t)s * 9216 + c; const float* scl = sh + 1024;
        unsigned w[4];
#pragma unroll
        for (int hf = 0; hf < 2; ++hf) {
            const f32x4 x = *(const f32x4*)(src + 4 * hf), a = *(const f32x4*)(sh + 4 * hf), g = *(const f32x4*)(scl + 4 * hf);
            w[2 * hf] = pk2(x[0] * (1.f + g[0]) + a[0], x[1] * (1.f + g[1]) + a[1]);
            w[2 * hf + 1] = pk2(x[2] * (1.f + g[2]) + a[2], x[3] * (1.f + g[3]) + a[3]);
        }
        u32x4 o = {w[0], w[1], w[2], w[3]};
        *(u32x4*)(XM + (size_t)row * 1024 + c) = o;
    }
}

struct LnSpec { int l, which, lnext, mshift; bool final_; unsigned* cnt; };
template <int NR>
DI void ln_rows(const Params& P, const LnSpec& sp, int row, int stride, int lane) {
    char* ws = P.ws; float* X = (float*)(ws + OFF_X); bf16_t* XM = (bf16_t*)(ws + OFF_XM); const float* MOD = (const float*)(ws + OFF_MOD);
    const float* g = P.in[6] + (sp.l * 3 + sp.which) * 1024; const float* bb = P.in[7] + (sp.l * 3 + sp.which) * 1024;
    f32x4 v[NR][4]; float s[NR], qv[NR];
#pragma unroll
    for (int k = 0; k < NR; ++k) {
        const float* xp = X + (size_t)(row + k * stride) * 1024;
#pragma unroll
        for (int i = 0; i < 4; ++i) v[k][i] = *(const f32x4*)(xp + (i * 64 + lane) * 4);
    }
#pragma unroll
    for (int k = 0; k < NR; ++k) {
        s[k] = 0.f;
#pragma unroll
        for (int i = 0; i < 4; ++i) s[k] += (v[k][i][0] + v[k][i][1]) + (v[k][i][2] + v[k][i][3]);
    }
#pragma unroll
    for (int o = 32; o >= 1; o >>= 1)
#pragma unroll
        for (int k = 0; k < NR; ++k) s[k] += __shfl_xor(s[k], o);
#pragma unroll
    for (int k = 0; k < NR; ++k) {
        s[k] *= (1.f / 1024.f); qv[k] = 0.f;
#pragma unroll
        for (int i = 0; i < 4; ++i)
#pragma unroll
            for (int j = 0; j < 4; ++j) { const float d = v[k][i][j] - s[k]; qv[k] += d * d; }
    }
#pragma unroll
    for (int o = 32; o >= 1; o >>= 1)
#pragma unroll
        for (int k = 0; k < NR; ++k) qv[k] += __shfl_xor(qv[k], o);
#pragma unroll
    for (int k = 0; k < NR; ++k) {
        const int r = row + k * stride;
        const float mu = s[k], rstd = rsqrtf(qv[k] * (1.f / 1024.f) + 1e-6f);
        const int sidx = r < RL ? (r >> 13) : 4;
        const float* sh = MOD + (size_t)(sp.lnext * 5 + sidx) * 9216 + sp.mshift * 1024; const float* scl = sh + 1024;
        float* xp = X + (size_t)r * 1024;
#pragma unroll
        for (int i = 0; i < 4; ++i) {
            const int c = (i * 64 + lane) * 4;
            const f32x4 gg = *(const f32x4*)(g + c), b4 = *(const f32x4*)(bb + c);
            f32x4 y;
#pragma unroll
            for (int j = 0; j < 4; ++j) y[j] = (v[k][i][j] - mu) * rstd * gg[j] + b4[j];
            if (sp.final_) { *(f32x4*)(P.out + (size_t)r * 1024 + c) = y; }
            else {
                *(f32x4*)(xp + c) = y;
                const f32x4 a = *(const f32x4*)(sh + c), sg = *(const f32x4*)(scl + c);
                u32x2 w; w.x = pk2(y[0] * (1.f + sg[0]) + a[0], y[1] * (1.f + sg[1]) + a[1]); w.y = pk2(y[2] * (1.f + sg[2]) + a[2], y[3] * (1.f + sg[3]) + a[3]);
                *(u32x2*)(XM + (size_t)r * 1024 + c) = w;
            }
        }
    }
}
DI void phase_ln(const Params& P, int l, int which, int lnext, int mshift, bool final_, bool lat_only = false) {
    const LnSpec sp{l, which, lnext, mshift, final_, nullptr};
    const int lane = ltid() & 63, wave = ltid() >> 6;
    const int nq = ((final_ || lat_only) ? RL : RT) / 4;
    for (int q = lbid() * NWAVE + wave; q < nq; q += gridDim.x * NWAVE) ln_rows<4>(P, sp, 4 * q, 1, lane);
}

DI void phase_ev_rms(const Params& P) {
    char* ws = P.ws; bf16_t* QN = (bf16_t*)(ws + OFF_HID + HOFF_QN); bf16_t* KVN = (bf16_t*)((char*)P.out + OOFF_KVN);
    const int lane = ltid() & 63, wave = ltid() >> 6;
    for (int row = lbid() * NWAVE + wave; row < RT; row += gridDim.x * NWAVE) {
        {
            u32x2* p = (u32x2*)(QN + (size_t)row * 256 + lane * 4); const u32x2 w = *p;
            float a = bflo(w.x), b = bfhi(w.x), c = bflo(w.y), d = bfhi(w.y);
            float s = a * a + b * b + c * c + d * d;
#pragma unroll
            for (int o = 32; o >= 1; o >>= 1) s += __shfl_xor(s, o);
            const float r = rsqrtf(s * (1.f / 256.f) + 1e-6f);
            u32x2 o2; o2.x = pk2(a * r, b * r); o2.y = pk2(c * r, d * r); *p = o2;
        }
        {
            unsigned* p = (unsigned*)(KVN + (size_t)row * 128 + lane * 2); const unsigned w = *p;
            float a = bflo(w), b = bfhi(w);
            float s = a * a + b * b;
#pragma unroll
            for (int o = 32; o >= 1; o >>= 1) s += __shfl_xor(s, o);
            const float r = rsqrtf(s * (1.f / 128.f) + 1e-6f);
            *p = pk2(a * r, b * r);
        }
    }
}

DI void phase_od_pool(const Params& P) {
    char* ws = P.ws; const bf16_t* U = (const bf16_t*)(ws + OFF_HID + HOFF_U); bf16_t* PL = (bf16_t*)(ws + OFF_HID + HOFF_PL);
    const size_t gtid = (size_t)lbid() * NTHR + ltid(), gstride = (size_t)gridDim.x * NTHR;
    for (size_t i = gtid; i < (size_t)RT * 64; i += gstride) {
        const int row = (int)(i >> 6), c = (int)(i & 63) * 8, grp = c >> 7;
        const int w = 2 << grp, left = w >> 1, right = w - 1 - left;
        int base, n, t;
        if (row < RL) { base = row & ~8191; n = SEQ; t = row & 8191; } else { const int rc = row - RL; base = RL + (rc & ~255); n = CTX; t = rc & 255; }
        const int lo = max(t - left, 0), hi = min(t + right + 1, n);
        float acc[8] = {0.f, 0.f, 0.f, 0.f, 0.f, 0.f, 0.f, 0.f};
        for (int tt = lo; tt < hi; ++tt) {
            const u32x4 v = *(const u32x4*)(U + (size_t)(base + tt) * 512 + c);
            acc[0] += bflo(v.x); acc[1] += bfhi(v.x); acc[2] += bflo(v.y); acc[3] += bfhi(v.y); acc[4] += bflo(v.z); acc[5] += bfhi(v.z); acc[6] += bflo(v.w); acc[7] += bfhi(v.w);
        }
        const float ic = 1.f / (float)(hi - lo);
        const u32x4 s = *(const u32x4*)(U + (size_t)row * 512 + c);
        u32x4 o;
        o.x = pk2(acc[0] * ic - bflo(s.x), acc[1] * ic - bfhi(s.x)); o.y = pk2(acc[2] * ic - bflo(s.y), acc[3] * ic - bfhi(s.y));
        o.z = pk2(acc[4] * ic - bflo(s.z), acc[5] * ic - bfhi(s.z)); o.w = pk2(acc[6] * ic - bflo(s.w), acc[7] * ic - bfhi(s.w));
        *(u32x4*)(PL + (size_t)row * 512 + c) = o;
    }
}

constexpr int NPHASE = 25;

DI void run_phase(const Params& P, int ph, char* smem) {
    char* ws = P.ws; char* hid = ws + OFF_HID; char* ob = (char*)P.out;
    float* X = (float*)(ws + OFF_X); bf16_t* XM = (bf16_t*)(ws + OFF_XM); bf16_t* HID = (bf16_t*)hid;
    const float* MOD = (const float*)(ws + OFF_MOD);
    if (ph == 0) { phase_pro_a(P, smem); return; }
    if (ph == 1) { phase_pro_b(P); return; }
    int l, op;
    if (ph < 14) { l = 0; op = ph - 2; } else { l = 1; op = ph - 14; if (op >= 6) op += 1; }
    const float* modl = MOD + (size_t)l * 5 * 9216;
    switch (op) {
    case 0: case 9: {
        const int f = op == 0 ? 0 : 1;
        EpiSwiglu e{HID};
        gemm_phase(XM, 1024, (const bf16_t*)(ws + OFF_WGU + (l * 2 + f) * SZ_WGU), 5632, 5632, 1024, e, smem, !(l == 1 && f == 1));
    } break;
    case 1: case 10: {
        const int f = op == 1 ? 0 : 1;
        const bool first = (l == 0 && f == 0);
        EpiResid e{first ? P.in[0] : X, first ? P.in[2] : X + (size_t)RL * 1024, X, modl + (f == 0 ? 2 : 8) * 1024, 0.5f};
        gemm_phase(HID, DFF, (const bf16_t*)(ws + OFF_WD + (l * 2 + f) * SZ_WD), 1024, 1024, DFF, e, smem, !(l == 1 && f == 1));
    } break;
    case 2: phase_ln(P, l, 0, l, 3, false); break;
    case 3: {
        if (l == 0) {
            EpiEvIn e{(bf16_t*)(hid + HOFF_QN), (bf16_t*)(hid + HOFF_QB), (bf16_t*)(ob + OOFF_KVN), (bf16_t*)(hid + HOFF_KA), (bf16_t*)(ob + OOFF_KB), (bf16_t*)(ob + OOFF_VB),
                      (const f32x2*)(ws + OFF_TAR), (const f32x2*)(ws + OFF_TAC), (const f32x2*)(ws + OFF_TBR), (const f32x2*)(ws + OFF_TBC)};
            gemm_phase(XM, 1024, (const bf16_t*)(ws + OFF_EVIN), 2048, 2048, 1024, e, smem);
        } else {
            EpiOdIn e{(bf16_t*)(hid + HOFF_U), (bf16_t*)(hid + HOFF_QD), (bf16_t*)(hid + HOFF_KD), (bf16_t*)(hid + HOFF_VD)};
            gemm_phase(XM, 1024, (const bf16_t*)(ws + OFF_ODIN), 2048, 2048, 1024, e, smem);
        }
    } break;
    case 4: if (l == 0) phase_ev_rms(P); else phase_od_pool(P); break;
    case 5: {
        if (l == 0) {
            EpiUQ e1{(bf16_t*)(hid + HOFF_QA), (const f32x2*)(ws + OFF_TAR), (const f32x2*)(ws + OFF_TAC)};
            gemm_phase((const bf16_t*)(hid + HOFF_QN), 256, (const bf16_t*)(ws + OFF_UQ), 768, 768, 256, e1, smem);
            EpiUKV e2{(bf16_t*)(hid + HOFF_KA), (bf16_t*)(hid + HOFF_VA)};
            gemm_phase((const bf16_t*)(ob + OOFF_KVN), 128, (const bf16_t*)(ws + OFF_UKV), 1024, 1024, 128, e2, smem);
        } else {
            odd_attention_phase(P, smem);
            EpiPool e{XM, P.in[22], 0};
            gemm_phase((const bf16_t*)(hid + HOFF_PL), 512, (const bf16_t*)(ws + OFF_POOL), 512, 512, 512, e, smem);
        }
    } break;
    case 6: even_attention_phase(P, smem); break;
    case 7: {
        EpiResid e{X, X + (size_t)RL * 1024, X, modl + 5 * 1024, 1.f};
        gemm_phase(XM, 1024, (const bf16_t*)(ws + (l == 0 ? OFF_EVOUT : OFF_ODOUT)), 1024, 1024, 1024, e, smem, l == 0);
    } break;
    case 8: phase_ln(P, l, 1, l, 6, false, l == 1); break;
    case 11: if (l == 0) phase_ln(P, 0, 2, 1, 0, false); else phase_ln(P, 1, 2, 1, 0, true); break;
    default: break;
    }
}

DI void grid_barrier(unsigned* ctr, unsigned target) {
    __syncthreads();
    if (threadIdx.x == 0) {
        __builtin_amdgcn_fence(__ATOMIC_RELEASE, "agent");
        __hip_atomic_fetch_add(ctr, 1u, __ATOMIC_RELAXED, __HIP_MEMORY_SCOPE_AGENT);
        while (__hip_atomic_load(ctr, __ATOMIC_RELAXED, __HIP_MEMORY_SCOPE_AGENT) < target) __builtin_amdgcn_s_sleep(2);
        __builtin_amdgcn_fence(__ATOMIC_ACQUIRE, "agent");
    }
    __syncthreads();
}

__global__ void __launch_bounds__(NTHR, 2) mega(Params P, int ph_lo, int ph_hi) {
    extern __shared__ __attribute__((aligned(16))) char smem[];
    unsigned nsync = 0;
    for (int ph = ph_lo; ph < ph_hi; ++ph) {
        run_phase(P, ph, smem);
        if (ph + 1 < ph_hi) {
            if (ph == ph_lo) cg::this_grid().sync();
            else { ++nsync; grid_barrier((unsigned*)(P.ws + OFF_BAR), nsync * gridDim.x); }
        }
    }
}

extern "C" void kernel_launch(void* const* d_in, const int* in_sizes, int n_in, void* d_out, int out_size, void* d_ws, size_t ws_size, hipStream_t stream) {
    if (ws_size < WS_NEED) { fprintf(stderr, "workspace too small: %zu < %zu\n", ws_size, (size_t)WS_NEED); return; }
    Params P{};
    for (int i = 0; i < 24; ++i) P.in[i] = (const float*)d_in[i];
    P.out = (float*)d_out; P.ws = (char*)d_ws;
    static int grid_blocks = 0;
    if (!grid_blocks) {
        int dev = 0, cus = 0, per_cu = 0;
        hipGetDevice(&dev);
        hipDeviceGetAttribute(&cus, hipDeviceAttributeMultiprocessorCount, dev);
        hipFuncSetAttribute((const void*)mega, hipFuncAttributeMaxDynamicSharedMemorySize, SMEM_BYTES);
        hipOccupancyMaxActiveBlocksPerMultiprocessor(&per_cu, mega, NTHR, SMEM_BYTES);
        if (per_cu < 1) per_cu = 1;
        if (per_cu > 1) per_cu = 1;
        grid_blocks = cus * per_cu;
    }
#if COOP
    hipMemsetAsync((char*)d_ws + OFF_BAR, 0, 256, stream);
    int lo = 0, hi = NPHASE;
    void* args[] = {&P, &lo, &hi};
    hipError_t e = hipLaunchCooperativeKernel((void*)mega, dim3(grid_blocks), dim3(NTHR), args, SMEM_BYTES, stream);
    if (e != hipSuccess) fprintf(stderr, "cooperative launch failed: %s (grid %d)\n", hipGetErrorString(e), grid_blocks);
#else
    for (int ph = 0; ph < NPHASE; ++ph) mega<<<grid_blocks, NTHR, SMEM_BYTES, stream>>>(P, ph, ph + 1);
#endif
}
```

```cpp
#include <hip/hip_runtime.h>
#include <hip/hip_cooperative_groups.h>
#include <cstdio>
#include <cstdint>
namespace cg = cooperative_groups;

#ifndef COOP
#define COOP 1
#endif

#define DI __device__ __forceinline__
typedef unsigned short bf16_t;
typedef short bf16x8 __attribute__((ext_vector_type(8)));
typedef short s16x4 __attribute__((ext_vector_type(4)));
typedef __bf16 bfx4 __attribute__((ext_vector_type(4)));
typedef __bf16 bfx2 __attribute__((ext_vector_type(2)));
typedef float f32x2 __attribute__((ext_vector_type(2)));
typedef float f32x4 __attribute__((ext_vector_type(4)));
typedef float f32x16 __attribute__((ext_vector_type(16)));
typedef unsigned u32x2 __attribute__((ext_vector_type(2)));
typedef unsigned u32x4 __attribute__((ext_vector_type(4)));
#define LDS_AS __attribute__((address_space(3)))

constexpr int DM = 1024, NB = 4, SEQ = 8192, CTX = 256, DFF = 2816;
constexpr int RL = NB * SEQ, RC = NB * CTX, RT = RL + RC;
constexpr int NK = SEQ + CTX;
constexpr float ALPHA = 1.41421356237f;
constexpr float LOG2E = 1.4426950408889634f;
constexpr float QA_SCALE = 0.10206207261596575f * LOG2E;
constexpr float QB_SCALE = 0.125f * LOG2E;
constexpr float QD_SCALE = 0.125f * LOG2E;
constexpr int NTHR = 512, NWAVE = NTHR / 64;

constexpr size_t SZ_WGU = 1024ull * 5632 * 2, SZ_WD = 2816ull * 1024 * 2;
constexpr size_t OFF_WGU = 0;
constexpr size_t OFF_WD = OFF_WGU + 4 * SZ_WGU;
constexpr size_t OFF_EVIN = OFF_WD + 4 * SZ_WD;
constexpr size_t OFF_EVOUT = OFF_EVIN + 1024ull * 2048 * 2;
constexpr size_t OFF_UQ = OFF_EVOUT + 1024ull * 1024 * 2;
constexpr size_t OFF_UKV = OFF_UQ + 256ull * 768 * 2;
constexpr size_t OFF_ODIN = OFF_UKV + 128ull * 1024 * 2;
constexpr size_t OFF_ODOUT = OFF_ODIN + 1024ull * 2048 * 2;
constexpr size_t OFF_POOL = OFF_ODOUT + 1024ull * 1024 * 2;
constexpr size_t OFF_MOD = OFF_POOL + 512ull * 512 * 2;
constexpr size_t OFF_TAR = OFF_MOD + 2ull * 5 * 9216 * 4;
constexpr size_t OFF_TAC = OFF_TAR + 128 * 8 * 8;
constexpr size_t OFF_TBR = OFF_TAC + 64 * 8 * 8;
constexpr size_t OFF_TBC = OFF_TBR + 128 * 16 * 8;
constexpr size_t OFF_LAM = OFF_TBC + 64 * 16 * 8;
constexpr size_t OFF_BAR = OFF_LAM + 256;
constexpr size_t OFF_X = OFF_BAR + 256;
constexpr size_t OFF_XM = OFF_X + (size_t)RT * 1024 * 4;
constexpr size_t OFF_HID = OFF_XM + (size_t)RT * 1024 * 2;
constexpr size_t WS_NEED = OFF_HID + (size_t)RT * DFF * 2;
constexpr size_t SZ_H96 = (size_t)NB * 8 * NK * 96 * 2, SZ_H64 = (size_t)NB * 8 * NK * 64 * 2;
constexpr size_t HOFF_QA = 0, HOFF_KA = SZ_H96, HOFF_VA = 2 * SZ_H96, HOFF_QB = HOFF_VA + SZ_H64, HOFF_QN = HOFF_QB + SZ_H64;
static_assert(HOFF_QN + (size_t)RT * 256 * 2 <= (size_t)RT * DFF * 2, "HID region overflow");
constexpr size_t HOFF_U = 0, HOFF_PL = SZ_H64, HOFF_QD = 2 * SZ_H64, HOFF_KD = 3 * SZ_H64, HOFF_VD = 4 * SZ_H64;
constexpr size_t OOFF_KB = 0, OOFF_VB = SZ_H64, OOFF_KVN = 2 * SZ_H64;
static_assert(OOFF_KVN + (size_t)RT * 128 * 2 <= (size_t)RL * 1024 * 4, "d_out region overflow");

struct Params {
    const float* in[24];
    float* out;
    char* ws;
};

DI int ltid() { int t = threadIdx.x; asm volatile("" : "+v"(t)); return t; }
DI int lbid() { int t = blockIdx.x; asm volatile("" : "+s"(t)); return t; }
DI unsigned pk2(float a, float b) { f32x2 v = {a, b}; bfx2 r = __builtin_convertvector(v, bfx2); return __builtin_bit_cast(unsigned, r); }
DI float bf2f(unsigned short u) { return __uint_as_float(((unsigned)u) << 16); }
DI float bflo(unsigned u) { return __uint_as_float(u << 16); }
DI float bfhi(unsigned u) { return __uint_as_float(u & 0xffff0000u); }
DI float silu_f(float x) { return x * __builtin_amdgcn_rcpf(1.f + __expf(-x)); }
DI f32x16 mfma32(bf16x8 a, bf16x8 b, f32x16 c) { return __builtin_amdgcn_mfma_f32_32x32x16_bf16(a, b, c, 0, 0, 0); }
DI s16x4 tr_read(const char* p) { bfx4 r = __builtin_amdgcn_ds_read_tr16_b64_v4bf16((LDS_AS bfx4*)p); return __builtin_bit_cast(s16x4, r); }
DI float xor32_max(float x) { const unsigned u = __float_as_uint(x); auto r = __builtin_amdgcn_permlane32_swap(u, u, false, false); return fmaxf(__uint_as_float(r[0]), __uint_as_float(r[1])); }
DI float xor32_sum(float x) { const unsigned u = __float_as_uint(x); auto r = __builtin_amdgcn_permlane32_swap(u, u, false, false); return __uint_as_float(r[0]) + __uint_as_float(r[1]); }
DI bf16x8 cat8(s16x4 lo, s16x4 hi) { return __builtin_shufflevector(lo, hi, 0, 1, 2, 3, 4, 5, 6, 7); }

struct RowInfo { int b, j, s; bool lat; };
DI RowInfo rowinfo(int row) {
    RowInfo r;
    if (row < RL) { r.b = row >> 13; r.j = row & 8191; r.s = r.b; r.lat = true; }
    else { int rc = row - RL; r.b = rc >> 8; r.j = 8192 + (rc & 255); r.s = 4; r.lat = false; }
    return r;
}
DI void store16(bf16_t* dst32, const f32x16& v, float sc, int hh) {
#pragma unroll
    for (int q4 = 0; q4 < 4; ++q4) {
        u32x2 w; w.x = pk2(v[4 * q4] * sc, v[4 * q4 + 1] * sc); w.y = pk2(v[4 * q4 + 2] * sc, v[4 * q4 + 3] * sc);
        *(u32x2*)(dst32 + 8 * q4 + 4 * hh) = w;
    }
}
DI f32x16 ropeB(const f32x16& v, const f32x2* tab, int hh) {
    f32x16 o;
#pragma unroll
    for (int r = 0; r < 8; ++r) {
        const int i = (r & 3) + 8 * (r >> 2) + 4 * hh;
        const f32x2 cs = tab[i];
        o[r] = v[r] * cs.x - v[r + 8] * cs.y;
        o[r + 8] = v[r + 8] * cs.x + v[r] * cs.y;
    }
    return o;
}
DI f32x16 ropeA(const f32x16& v, const f32x2* tr, const f32x2* tc, int hh) {
    f32x16 o;
#pragma unroll
    for (int r = 0; r < 4; ++r) {
        const int i = 4 * hh + r;
        const f32x2 a = tr[i], c = tc[i];
        o[r] = v[r] * a.x - v[r + 4] * a.y;
        o[r + 4] = v[r + 4] * a.x + v[r] * a.y;
        o[8 + r] = v[8 + r] * c.x - v[12 + r] * c.y;
        o[12 + r] = v[12 + r] * c.x + v[8 + r] * c.y;
    }
    return o;
}

constexpr int GA_S = 144, GB_S = 576;
constexpr int GSTAGE = 256 * GA_S + 64 * GB_S;
constexpr int GEMM_LDS = 2 * GSTAGE;

template <int BM, class Epi>
DI void gemm_tile(const bf16_t* __restrict__ A, int lda, const bf16_t* __restrict__ B, int ldb, int K, int row0, int col0, const Epi& epi, char* smem) {
    constexpr int MI = BM / 64, NA_ = BM / 64;
    const int tid = ltid(), lane = tid & 63, wave = tid >> 6, wm = wave >> 2, wn = wave & 3;
    const int l31 = lane & 31, hh = lane >> 5, q = (lane & 15) >> 2, p = lane & 3, nblk = (lane >> 4) & 1;
    f32x16 acc[MI][2];
#pragma unroll
    for (int i = 0; i < MI; ++i)
#pragma unroll
        for (int j = 0; j < 2; ++j)
#pragma unroll
            for (int r = 0; r < 16; ++r) acc[i][j][r] = 0.f;
    u32x4 ra[NA_], rb[4];
    const bf16_t* ag = A + (size_t)(row0 + (tid >> 3)) * lda + (tid & 7) * 8;
    const bf16_t* bg = B + (size_t)(tid >> 5) * ldb + col0 + (tid & 31) * 8;
    const int aw = (tid >> 3) * GA_S + (tid & 7) * 16, bw = BM * GA_S + (tid >> 5) * GB_S + (tid & 31) * 16;
    const int nk = K >> 6;
    const int xoff = (wm * (BM / 2) + l31) * GA_S + hh * 16;
    const int woff = BM * GA_S + (hh * 8 + q) * GB_S + (wn * 64 + nblk * 16 + 4 * p) * 2;
#pragma unroll
    for (int i = 0; i < NA_; ++i) ra[i] = *(const u32x4*)(ag + (size_t)(64 * i) * lda);
#pragma unroll
    for (int i = 0; i < 4; ++i) rb[i] = *(const u32x4*)(bg + (size_t)(16 * i) * ldb);
    __syncthreads();
#pragma unroll
    for (int i = 0; i < NA_; ++i) *(u32x4*)(smem + aw + 64 * i * GA_S) = ra[i];
#pragma unroll
    for (int i = 0; i < 4; ++i) *(u32x4*)(smem + bw + 16 * i * GB_S) = rb[i];
    if (nk > 1) {
#pragma unroll
        for (int i = 0; i < NA_; ++i) ra[i] = *(const u32x4*)(ag + 64 + (size_t)(64 * i) * lda);
#pragma unroll
        for (int i = 0; i < 4; ++i) rb[i] = *(const u32x4*)(bg + (size_t)(64 + 16 * i) * ldb);
    }
    __syncthreads();
    for (int kt = 0; kt < nk; ++kt) {
        const char* cur = smem + (kt & 1) * GSTAGE;
        char* nxt = smem + ((kt & 1) ^ 1) * GSTAGE;
        const bool w1 = kt + 1 < nk, l2 = kt + 2 < nk;
        const bf16_t* a2 = ag + (size_t)(kt + 2) * 64; const bf16_t* b2 = bg + (size_t)(kt + 2) * 64 * ldb;
#pragma unroll
        for (int s = 0; s < 4; ++s) {
            bf16x8 xf[MI], wf[2];
#pragma unroll
            for (int mi = 0; mi < MI; ++mi) xf[mi] = *(const bf16x8*)(cur + xoff + mi * 32 * GA_S + s * 32);
#pragma unroll
            for (int ni = 0; ni < 2; ++ni) {
                const char* wp = cur + woff + s * 16 * GB_S + ni * 64;
                wf[ni] = cat8(tr_read(wp), tr_read(wp + 4 * GB_S));
            }
#pragma unroll
            for (int mi = 0; mi < MI; ++mi)
#pragma unroll
                for (int ni = 0; ni < 2; ++ni) acc[mi][ni] = mfma32(wf[ni], xf[mi], acc[mi][ni]);
            if (w1) {
                if (s < NA_) *(u32x4*)(nxt + aw + 64 * s * GA_S) = ra[s];
                *(u32x4*)(nxt + bw + 16 * s * GB_S) = rb[s];
            }
            if (l2) {
                if (s < NA_) ra[s] = *(const u32x4*)(a2 + (size_t)(64 * s) * lda);
                rb[s] = *(const u32x4*)(b2 + (size_t)(16 * s) * ldb);
            }
        }
        __syncthreads();
    }
#pragma unroll
    for (int mi = 0; mi < MI; ++mi) epi(acc[mi][0], acc[mi][1], row0 + wm * (BM / 2) + mi * 32 + l31, col0 + wn * 64, hh);
}

template <class Epi>
DI void gemm_phase(const bf16_t* A, int lda, const bf16_t* B, int ldb, int N, int K, const Epi& epi, char* smem, bool do_ctx = true) {
    const int nt = N >> 8, small = do_ctx ? (RC / 128) * nt : 0;
    const int bid = lbid(), G = gridDim.x;
    if ((G & 7) == 0) {
        const int xcd = bid & 7, loc = bid >> 3, per = G >> 3, mine = (RL / 256 / 8) * nt;
        for (int i = loc; i < mine; i += per) {
            const int cg = i >> 7, rem = i & 127, cw = min(8, nt - cg * 8);
            int pg, w;
            if (cw == 8) { pg = rem >> 5; w = rem & 31; } else { const int rr = i - cg * 128; pg = rr / (4 * cw); w = rr - pg * 4 * cw; }
            const int pl = pg * 4 + (w & 3), cl = cg * 8 + (w >> 2);
            gemm_tile<256>(A, lda, B, ldb, K, (pl * 8 + xcd) * 256, cl * 256, epi, smem);
        }
    } else {
        const int big = (RL / 256) * nt;
        for (int t = bid; t < big; t += G) gemm_tile<256>(A, lda, B, ldb, K, (t / nt) * 256, (t % nt) * 256, epi, smem);
    }
    for (int u = bid; u < small; u += G) gemm_tile<128>(A, lda, B, ldb, K, RL + (u / nt) * 128, (u % nt) * 256, epi, smem);
}

struct EpiSwiglu {
    bf16_t* hid;
    DI void operator()(const f32x16& a0, const f32x16& a1, int row, int cbase, int hh) const {
        bf16_t* dst = hid + (size_t)row * DFF + (cbase >> 1) + 4 * hh;
#pragma unroll
        for (int q4 = 0; q4 < 4; ++q4) {
            float h[4];
#pragma unroll
            for (int j = 0; j < 4; ++j) h[j] = silu_f(a0[4 * q4 + j]) * a1[4 * q4 + j];
            u32x2 w; w.x = pk2(h[0], h[1]); w.y = pk2(h[2], h[3]);
            *(u32x2*)(dst + 8 * q4) = w;
        }
    }
};
struct EpiResid {
    const float* res_lat; const float* res_ctx; float* X; const float* gate; float coef;
    DI void operator()(const f32x16& a0, const f32x16& a1, int row, int cbase, int hh) const {
        const int s = row < RL ? (row >> 13) : 4;
        const float* rp = row < RL ? res_lat + (size_t)row * 1024 : res_ctx + (size_t)(row - RL) * 1024;
        const float* gp = gate + s * 9216;
        float* xp = X + (size_t)row * 1024;
#pragma unroll
        for (int ni = 0; ni < 2; ++ni)
#pragma unroll
            for (int q4 = 0; q4 < 4; ++q4) {
                const int c = cbase + ni * 32 + 8 * q4 + 4 * hh;
                const f32x4 r = *(const f32x4*)(rp + c), g = *(const f32x4*)(gp + c);
                f32x4 z;
#pragma unroll
                for (int j = 0; j < 4; ++j) z[j] = ALPHA * r[j] + coef * g[j] * (ni ? a1[4 * q4 + j] : a0[4 * q4 + j]);
                *(f32x4*)(xp + c) = z;
            }
    }
};
struct EpiEvIn {
    bf16_t *QN, *QB, *KVN, *KA, *KB, *VB; const f32x2 *tAr, *tAc, *tBr, *tBc;
    DI void operator()(const f32x16& a0, const f32x16& a1, int row, int cbase, int hh) const {
        const RowInfo ri = rowinfo(row);
        const int gr = (ri.j >> 6) & 127, gc = ri.j & 63;
#pragma unroll
        for (int ni = 0; ni < 2; ++ni) {
            const int g = (cbase >> 5) + ni;
            const f32x16& v = ni ? a1 : a0;
            if (g < 8) store16(QN + (size_t)row * 256 + g * 32, v, 1.f, hh);
            else if (g < 24) {
                const int hv = (g - 8) >> 1, half = (g - 8) & 1;
                f32x16 w = v; if (ri.lat) w = ropeB(v, half ? tBc + gc * 16 : tBr + gr * 16, hh);
                store16(QB + ((size_t)(ri.b * 8 + hv) * NK + ri.j) * 64 + half * 32, w, QB_SCALE, hh);
            } else if (g < 28) store16(KVN + (size_t)row * 128 + (g - 24) * 32, v, 1.f, hh);
            else if (g == 28) {
                f32x16 w = v; if (ri.lat) w = ropeA(v, tAr + gr * 8, tAc + gc * 8, hh);
                for (int h = 0; h < 8; ++h) store16(KA + ((size_t)(ri.b * 8 + h) * NK + ri.j) * 96 + 64, w, 1.f, hh);
            } else if (g < 45) {
                const int hv = (g - 29) >> 1, half = (g - 29) & 1;
                f32x16 w = v; if (ri.lat) w = ropeB(v, half ? tBc + gc * 16 : tBr + gr * 16, hh);
                store16(KB + ((size_t)(ri.b * 8 + hv) * NK + ri.j) * 64 + half * 32, w, 1.f, hh);
            } else if (g < 61) {
                const int idx = g - 45, h = idx >> 2, part = idx & 3;
                store16(VB + ((size_t)(ri.b * 4 + h) * NK + ri.j) * 128 + part * 32, v, 1.f, hh);
            }
        }
    }
};
struct EpiUQ {
    bf16_t* QA; const f32x2 *tAr, *tAc;
    DI void operator()(const f32x16& a0, const f32x16& a1, int row, int cbase, int hh) const {
        const RowInfo ri = rowinfo(row);
        const int gr = (ri.j >> 6) & 127, gc = ri.j & 63;
#pragma unroll
        for (int ni = 0; ni < 2; ++ni) {
            const int g = (cbase >> 5) + ni, h = g / 3, part = g - 3 * h;
            f32x16 w = ni ? a1 : a0;
            if (part == 2 && ri.lat) w = ropeA(ni ? a1 : a0, tAr + gr * 8, tAc + gc * 8, hh);
            store16(QA + ((size_t)(ri.b * 8 + h) * NK + ri.j) * 96 + part * 32, w, QA_SCALE, hh);
        }
    }
};
struct EpiUKV {
    bf16_t *KA, *VA;
    DI void operator()(const f32x16& a0, const f32x16& a1, int row, int cbase, int hh) const {
        const RowInfo ri = rowinfo(row);
#pragma unroll
        for (int ni = 0; ni < 2; ++ni) {
            const int g = (cbase >> 5) + ni, h = g >> 2, part = g & 3;
            const size_t tk = (size_t)(ri.b * 8 + h) * NK + ri.j;
            if (part < 2) store16(KA + tk * 96 + part * 32, ni ? a1 : a0, 1.f, hh);
            else store16(VA + tk * 64 + (part - 2) * 32, ni ? a1 : a0, 1.f, hh);
        }
    }
};
struct EpiOdIn {
    bf16_t *U, *QD, *KD, *VD;
    DI void operator()(const f32x16& a0, const f32x16& a1, int row, int cbase, int hh) const {
        const RowInfo ri = rowinfo(row);
#pragma unroll
        for (int ni = 0; ni < 2; ++ni) {
            const int g = (cbase >> 5) + ni;
            const f32x16& v = ni ? a1 : a0;
            if (g < 16) store16(U + (size_t)row * 512 + g * 32, v, 1.f, hh);
            else {
                const int gg = (g - 16) & 15, h = gg >> 1, half = gg & 1;
                const size_t off = ((size_t)(ri.b * 8 + h) * NK + ri.j) * 64 + half * 32;
                if (g < 32) store16(QD + off, v, QD_SCALE, hh);
                else if (g < 48) store16(KD + off, v, 1.f, hh);
                else store16(VD + off, v, 1.f, hh);
            }
        }
    }
};
struct EpiPool {
    bf16_t* CC; const float* pscale; int gidx;
    DI void operator()(const f32x16& a0, const f32x16& a1, int row, int cbase, int hh) const {
#pragma unroll
        for (int ni = 0; ni < 2; ++ni)
#pragma unroll
            for (int q4 = 0; q4 < 4; ++q4) {
                const int c = gidx * 128 + cbase + ni * 32 + 8 * q4 + 4 * hh;
                const f32x4 s = *(const f32x4*)(pscale + c);
                const f32x16& v = ni ? a1 : a0;
                u32x2 w; w.x = pk2(v[4 * q4] * s[0], v[4 * q4 + 1] * s[1]); w.y = pk2(v[4 * q4 + 2] * s[2], v[4 * q4 + 3] * s[3]);
                *(u32x2*)(CC + (size_t)row * 1024 + c) = w;
            }
    }
};

constexpr int ATT_LDS = 64 * (96 + 8) * 2 + 64 * (128 * 2 + 64);
constexpr int RPB_OFF = 2 * ATT_LDS;
constexpr int SMEM_BYTES = GEMM_LDS;

struct NAInfo { int qr; int kstart; };

template <int DQK, int DV, bool NA>
DI void attend(const bf16_t* __restrict__ Q, int q0, const bf16_t* __restrict__ Kb, const bf16_t* __restrict__ Vb,
               int s0, int n0, int s1, int n1, f32x16 (&o)[DV / 32], char* smem, NAInfo na) {
    constexpr int KS = (DQK + 8) * 2, VS = DV * 2 + 64;
    constexpr int KCH = DQK / 8, KN = (64 * KCH + NTHR - 1) / NTHR, VCH = DV / 8, VN = (64 * VCH + NTHR - 1) / NTHR;
    constexpr int NS = DQK / 16, NDT = DV / 32;
    const int tid = ltid(), lane = tid & 63, wave = tid >> 6;
    const int l31 = lane & 31, hh = lane >> 5, q = (lane & 15) >> 2, p = lane & 3, dblk = (lane >> 4) & 1;
    bf16x8 qf[NS];
    {
        const bf16_t* qp = Q + (size_t)(q0 + wave * 32 + l31) * DQK + hh * 8;
#pragma unroll
        for (int s = 0; s < NS; ++s) qf[s] = *(const bf16x8*)(qp + s * 16);
    }
#pragma unroll
    for (int d = 0; d < NDT; ++d)
#pragma unroll
        for (int r = 0; r < 16; ++r) o[d][r] = 0.f;
    float m = NA ? -INFINITY : 0.f, l = 0.f;
    f32x16 cinit;
#pragma unroll
    for (int r = 0; r < 16; ++r) cinit[r] = 0.f;
    u32x4 rk[KN], rv[VN];
    const int nt = n0 + n1;
    auto gload = [&](int t) {
        const int j0 = t < n0 ? s0 + t * 64 : s1 + (t - n0) * 64;
#pragma unroll
        for (int i = 0; i < KN; ++i) { int id = tid + NTHR * i; if (id >= 64 * KCH) id -= 64 * KCH; const int row = id / KCH, ch = id - row * KCH; rk[i] = *(const u32x4*)(Kb + (size_t)(j0 + row) * DQK + ch * 8); }
#pragma unroll
        for (int i = 0; i < VN; ++i) { int id = tid + NTHR * i; if (id >= 64 * VCH) id -= 64 * VCH; const int row = id / VCH, ch = id - row * VCH; rv[i] = *(const u32x4*)(Vb + (size_t)(j0 + row) * DV + ch * 8); }
    };
    gload(0);
    int qc = 0, cs = 0, rs = 0;
    if (NA) { qc = (wave & 1) * 32 + l31; cs = min(max(qc - 8, 0), 48); rs = min(max(na.qr - 4, 0), 120); }
    const float* rpb = (const float*)(smem + RPB_OFF);
    auto lwrite = [&](char* stg) {
#pragma unroll
        for (int i = 0; i < KN; ++i) { int id = tid + NTHR * i; if (id >= 64 * KCH) id -= 64 * KCH; const int row = id / KCH, ch = id - row * KCH; *(u32x4*)(stg + row * KS + ch * 16) = rk[i]; }
#pragma unroll
        for (int i = 0; i < VN; ++i) { int id = tid + NTHR * i; if (id >= 64 * VCH) id -= 64 * VCH; const int row = id / VCH, ch = id - row * VCH; *(u32x4*)(stg + 64 * KS + row * VS + ch * 16) = rv[i]; }
    };
    __syncthreads();
    lwrite(smem);
    if (nt > 1) gload(1);
    __syncthreads();
    for (int t = 0; t < nt; ++t) {
        const char* sK = smem + (t & 1) * ATT_LDS; const char* sV = sK + 64 * KS;
        bool active = true; int kr = 0;
        if (NA && t < n0) { kr = na.kstart + t; active = (kr >= rs) && (kr < rs + 8); }
        if (active) {
#pragma unroll
            for (int sub = 0; sub < 2; ++sub) {
                f32x16 st;
                if (NA) {
#pragma unroll
                    for (int r = 0; r < 16; ++r) st[r] = 0.f;
                } else st = cinit;
                {
                    bf16x8 kf[NS];
#pragma unroll
                    for (int s = 0; s < NS; ++s) kf[s] = *(const bf16x8*)(sK + (sub * 32 + l31) * KS + (s * 16 + hh * 8) * 2);
                    __builtin_amdgcn_sched_barrier(0);
#pragma unroll
                    for (int s = 0; s < NS; ++s) st = mfma32(kf[s], qf[s], st);
                }
                if (NA && t < n0) {
                    const float* brow = rpb + (kr - na.qr + 7) * 31 + 15 - qc;
#pragma unroll
                    for (int r = 0; r < 16; ++r) {
                        const int kc = sub * 32 + (r & 3) + 8 * (r >> 2) + 4 * hh;
                        const bool valid = (kc >= cs) && (kc < cs + 16);
                        const int bi = valid ? kc : cs;
                        const float bias = brow[bi];
                        st[r] = valid ? st[r] + bias : -INFINITY;
                    }
                }
                float mx = st[0];
#pragma unroll
                for (int r = 1; r < 16; ++r) mx = fmaxf(mx, st[r]);
                mx = xor32_max(mx);
                float rsum = 0.f;
                if (NA) {
                    const float mnew = fmaxf(m, mx);
                    const float muse = (mnew == -INFINITY) ? 0.f : mnew;
                    const float alpha = __builtin_amdgcn_exp2f(m - muse);
                    m = mnew;
                    l *= alpha;
#pragma unroll
                    for (int d = 0; d < NDT; ++d)
#pragma unroll
                        for (int r = 0; r < 16; ++r) o[d][r] *= alpha;
#pragma unroll
                    for (int r = 0; r < 16; ++r) { st[r] = __builtin_amdgcn_exp2f(st[r] - muse); rsum += st[r]; }
                } else {
                    const bool first = (t == 0) && (sub == 0);
                    if (first || __builtin_amdgcn_ballot_w64(mx > 8.f) != 0) {
                        const float delta = first ? mx : fmaxf(mx, 0.f);
                        const float alpha = first ? 1.f : __builtin_amdgcn_exp2f(-delta);
                        m += delta;
                        l *= alpha;
#pragma unroll
                        for (int d = 0; d < NDT; ++d)
#pragma unroll
                            for (int r = 0; r < 16; ++r) o[d][r] *= alpha;
#pragma unroll
                        for (int r = 0; r < 16; ++r) { st[r] -= delta; cinit[r] = -m; }
                    }
#pragma unroll
                    for (int r = 0; r < 16; ++r) { st[r] = __builtin_amdgcn_exp2f(st[r]); rsum += st[r]; }
                }
                l += rsum;
                bf16x8 pf[2];
#pragma unroll
                for (int s2 = 0; s2 < 2; ++s2) {
                    u32x4 w;
                    w.x = pk2(st[8 * s2], st[8 * s2 + 1]); w.y = pk2(st[8 * s2 + 2], st[8 * s2 + 3]);
                    w.z = pk2(st[8 * s2 + 4], st[8 * s2 + 5]); w.w = pk2(st[8 * s2 + 6], st[8 * s2 + 7]);
                    pf[s2] = __builtin_bit_cast(bf16x8, w);
                }
#pragma unroll
                for (int d = 0; d < NDT; ++d)
#pragma unroll
                    for (int s2 = 0; s2 < 2; ++s2) {
                        const char* vp = sV + (sub * 32 + 16 * s2 + 4 * hh + q) * VS + (d * 32 + dblk * 16 + 4 * p) * 2;
                        const bf16x8 vf = cat8(tr_read(vp), tr_read(vp + 8 * VS));
                        o[d] = mfma32(vf, pf[s2], o[d]);
                    }
            }
        }
        if (t + 1 < nt) lwrite(smem + ((t & 1) ^ 1) * ATT_LDS);
        if (t + 2 < nt) gload(t + 2);
        __syncthreads();
    }
    l = xor32_sum(l);
    const float inv = 1.f / l;
#pragma unroll
    for (int d = 0; d < NDT; ++d)
#pragma unroll
        for (int r = 0; r < 16; ++r) o[d][r] *= inv;
}

DI int qrow_of(int b, int j) { return j < SEQ ? b * SEQ + j : RL + b * CTX + (j - SEQ); }

DI void even_attention_phase(const Params& P, char* smem) {
    char* ws = P.ws; char* hid = ws + OFF_HID; char* ob = (char*)P.out;
    const bf16_t* QA = (const bf16_t*)(hid + HOFF_QA); const bf16_t* KA = (const bf16_t*)(hid + HOFF_KA); const bf16_t* VA = (const bf16_t*)(hid + HOFF_VA);
    const bf16_t* QB = (const bf16_t*)(hid + HOFF_QB); const bf16_t* KB = (const bf16_t*)(ob + OOFF_KB); const bf16_t* VB = (const bf16_t*)(ob + OOFF_VB);
    bf16_t* CC = (bf16_t*)(ws + OFF_XM);
    const float lam = *(const float*)(ws + OFF_LAM);
    const float* gsub = P.in[18];
    const int lane = ltid() & 63, wave = ltid() >> 6, l31 = lane & 31, hh = lane >> 5;
    constexpr int NQT = 33, NDIFF = NB * 4 * NQT, NMLA = NB * 8 * NQT;
    NAInfo na; na.qr = 0; na.kstart = 0;
    unsigned* wq = (unsigned*)(ws + OFF_BAR + 128);
    volatile int* slot = (volatile int*)(smem + 2 * ATT_LDS + 2048);
    for (;;) {
        __syncthreads();
        if (ltid() == 0) *slot = (int)atomicAdd(wq, 1u);
        __syncthreads();
        const int u = *slot;
        if (u >= NDIFF + NMLA) break;
        if (u < NDIFF) {
            const int qt = u % NQT, bh = u / NQT, h = bh & 3, b = bh >> 2;
            const int q0 = qt < 32 ? qt * 256 : SEQ;
            const int s0 = qt < 32 ? 0 : SEQ, n0 = qt < 32 ? NK / 64 : CTX / 64;
            const bf16_t* V = VB + (size_t)(b * 4 + h) * NK * 128;
            f32x16 o[4];
            attend<64, 128, false>(QB + (size_t)(b * 8 + 2 * h) * NK * 64, q0, KB + (size_t)(b * 8 + 2 * h) * NK * 64, V, s0, n0, 0, 0, o, smem, na);
            const int row = qrow_of(b, q0 + wave * 32 + l31);
            bf16_t* dst = CC + (size_t)row * 1024 + 512 + h * 128;
#pragma unroll
            for (int d = 0; d < 4; ++d) store16(dst + d * 32, o[d], 1.f, hh);
            f32x16 o2[4];
            attend<64, 128, false>(QB + (size_t)(b * 8 + 2 * h + 1) * NK * 64, q0, KB + (size_t)(b * 8 + 2 * h + 1) * NK * 64, V, s0, n0, 0, 0, o2, smem, na);
            float ss = 0.f;
#pragma unroll
            for (int d = 0; d < 4; ++d)
#pragma unroll
                for (int q4 = 0; q4 < 4; ++q4) {
                    const u32x2 w = *(const volatile u32x2*)(dst + d * 32 + 8 * q4 + 4 * hh);
                    const float a0 = bflo(w.x) - lam * o2[d][4 * q4], a1 = bfhi(w.x) - lam * o2[d][4 * q4 + 1], a2 = bflo(w.y) - lam * o2[d][4 * q4 + 2], a3 = bfhi(w.y) - lam * o2[d][4 * q4 + 3];
                    o[d][4 * q4] = a0; o[d][4 * q4 + 1] = a1; o[d][4 * q4 + 2] = a2; o[d][4 * q4 + 3] = a3;
                    ss += (a0 * a0 + a1 * a1) + (a2 * a2 + a3 * a3);
                }
            ss = xor32_sum(ss);
            const float rn = rsqrtf(ss * (1.f / 128.f) + 1e-5f) * 0.8f;
#pragma unroll
            for (int d = 0; d < 4; ++d)
#pragma unroll
                for (int q4 = 0; q4 < 4; ++q4) {
                    const int c = d * 32 + 8 * q4 + 4 * hh;
                    const f32x4 g = *(const f32x4*)(gsub + c);
                    u32x2 w; w.x = pk2(o[d][4 * q4] * rn * g[0], o[d][4 * q4 + 1] * rn * g[1]); w.y = pk2(o[d][4 * q4 + 2] * rn * g[2], o[d][4 * q4 + 3] * rn * g[3]);
                    *(u32x2*)(dst + c) = w;
                }
        } else {
            const int v = u - NDIFF, qt = v % NQT, bh = v / NQT, h = bh & 7, b = bh >> 3;
            const int q0 = qt < 32 ? qt * 256 : SEQ;
            const int s0 = qt < 32 ? 0 : SEQ, n0 = qt < 32 ? NK / 64 : CTX / 64;
            f32x16 o[2];
            attend<96, 64, false>(QA + (size_t)(b * 8 + h) * NK * 96, q0, KA + (size_t)(b * 8 + h) * NK * 96, VA + (size_t)(b * 8 + h) * NK * 64, s0, n0, 0, 0, o, smem, na);
            const int row = qrow_of(b, q0 + wave * 32 + l31);
            bf16_t* dst = CC + (size_t)row * 1024 + h * 64;
#pragma unroll
            for (int d = 0; d < 2; ++d) store16(dst + d * 32, o[d], 1.f, hh);
        }
    }
}

DI void odd_attention_phase(const Params& P, char* smem) {
    char* ws = P.ws; char* hid = ws + OFF_HID;
    const bf16_t* QD = (const bf16_t*)(hid + HOFF_QD); const bf16_t* KD = (const bf16_t*)(hid + HOFF_KD); const bf16_t* VD = (const bf16_t*)(hid + HOFF_VD);
    bf16_t* CC = (bf16_t*)(ws + OFF_XM);
    const float* rpbg = P.in[23];
    const int lane = ltid() & 63, wave = ltid() >> 6, l31 = lane & 31, hh = lane >> 5;
    float* rpbl = (float*)(smem + RPB_OFF);
    constexpr int NU = NB * 8 * 32;
    for (int u = lbid(); u < NU; u += gridDim.x) {
        const int rp = u & 31, bh = u >> 5, h = bh & 7, b = bh >> 3;
        __syncthreads();
        for (int i = ltid(); i < 465; i += NTHR) rpbl[i] = rpbg[h * 465 + i] * LOG2E;
        const int r0 = rp * 4;
        NAInfo na; na.qr = r0 + (wave >> 1);
        const int rs0 = min(max(r0 - 4, 0), 120);
        na.kstart = min(rs0, 117);
        f32x16 o[2];
        const size_t hb = (size_t)(b * 8 + h) * NK * 64;
        attend<64, 64, true>(QD + hb, r0 * 64, KD + hb, VD + hb, na.kstart * 64, 11, SEQ, CTX / 64, o, smem, na);
        const int row = b * SEQ + r0 * 64 + wave * 32 + l31;
        bf16_t* dst = CC + (size_t)row * 1024 + 512 + h * 64;
#pragma unroll
        for (int d = 0; d < 2; ++d) store16(dst + d * 32, o[d], 1.f, hh);
    }
}

DI void cvt8(bf16_t* dst, const float* src, float sc) {
    const f32x4 a = *(const f32x4*)src, b = *(const f32x4*)(src + 4);
    u32x4 w; w.x = pk2(a[0] * sc, a[1] * sc); w.y = pk2(a[2] * sc, a[3] * sc); w.z = pk2(b[0] * sc, b[1] * sc); w.w = pk2(b[2] * sc, b[3] * sc);
    *(u32x4*)dst = w;
}
DI void cvt_rows(bf16_t* dst, int ldd, const float* src, int lds_, int rows, int cols_src, const float* rowscale, size_t gtid, size_t gstride) {
    const int c8 = ldd >> 3; const size_t n = (size_t)rows * c8;
    for (size_t i0 = gtid; i0 < n; i0 += 4 * gstride) {
        f32x4 a[4], b[4]; float sc[4];
#pragma unroll
        for (int u = 0; u < 4; ++u) {
            const size_t i = i0 + u * gstride;
            const int k = (int)(i / c8), c = (int)(i % c8) * 8;
            const bool ok = i < n && c < cols_src;
            const float* p = src + (ok ? (size_t)k * lds_ + c : 0);
            a[u] = *(const f32x4*)p; b[u] = *(const f32x4*)(p + 4);
            sc[u] = !ok ? 0.f : (rowscale ? rowscale[k] : 1.f);
        }
#pragma unroll
        for (int u = 0; u < 4; ++u) {
            const size_t i = i0 + u * gstride;
            if (i < n) {
                const int k = (int)(i / c8), c = (int)(i % c8) * 8;
                u32x4 w; w.x = pk2(a[u][0] * sc[u], a[u][1] * sc[u]); w.y = pk2(a[u][2] * sc[u], a[u][3] * sc[u]); w.z = pk2(b[u][0] * sc[u], b[u][1] * sc[u]); w.w = pk2(b[u][2] * sc[u], b[u][3] * sc[u]);
                *(u32x4*)(dst + (size_t)k * ldd + c) = w;
            }
        }
    }
}

DI void phase_pro_a(const Params& P, char* smem) {
    char* ws = P.ws;
    const size_t gtid = (size_t)lbid() * NTHR + ltid(), gstride = (size_t)gridDim.x * NTHR;
    for (int lf = 0; lf < 4; ++lf) {
        const float* sg = P.in[8] + (size_t)lf * 1024 * DFF; const float* su = P.in[9] + (size_t)lf * 1024 * DFF;
        bf16_t* dst = (bf16_t*)(ws + OFF_WGU + lf * SZ_WGU);
        for (size_t i0 = gtid; i0 < 1024ull * 704; i0 += 4 * gstride) {
            f32x4 a[4], b[4];
#pragma unroll
            for (int u = 0; u < 4; ++u) {
                const size_t i = i0 + u * gstride < 1024ull * 704 ? i0 + u * gstride : i0;
                const int k = (int)(i / 704), n = (int)(i % 704) * 8, grp = n >> 6, w = n & 63;
                const float* src = ((w < 32) ? sg : su) + (size_t)k * DFF + grp * 32 + (w & 31);
                a[u] = *(const f32x4*)src; b[u] = *(const f32x4*)(src + 4);
            }
#pragma unroll
            for (int u = 0; u < 4; ++u) {
                const size_t i = i0 + u * gstride;
                if (i < 1024ull * 704) {
                    const int k = (int)(i / 704), n = (int)(i % 704) * 8;
                    u32x4 w; w.x = pk2(a[u][0], a[u][1]); w.y = pk2(a[u][2], a[u][3]); w.z = pk2(b[u][0], b[u][1]); w.w = pk2(b[u][2], b[u][3]);
                    *(u32x4*)(dst + (size_t)k * 5632 + n) = w;
                }
            }
        }
        cvt_rows((bf16_t*)(ws + OFF_WD + lf * SZ_WD), 1024, P.in[10] + (size_t)lf * DFF * 1024, 1024, DFF, 1024, nullptr, gtid, gstride);
    }
    cvt_rows((bf16_t*)(ws + OFF_EVIN), 2048, P.in[11], 1952, 1024, 1952, nullptr, gtid, gstride);
    cvt_rows((bf16_t*)(ws + OFF_EVOUT), 1024, P.in[12], 1024, 1024, 1024, nullptr, gtid, gstride);
    cvt_rows((bf16_t*)(ws + OFF_UQ), 768, P.in[15], 768, 256, 768, P.in[13], gtid, gstride);
    cvt_rows((bf16_t*)(ws + OFF_UKV), 1024, P.in[16], 1024, 128, 1024, P.in[14], gtid, gstride);
    cvt_rows((bf16_t*)(ws + OFF_ODIN), 2048, P.in[19], 2048, 1024, 2048, nullptr, gtid, gstride);
    cvt_rows((bf16_t*)(ws + OFF_ODOUT), 1024, P.in[20], 1024, 1024, 1024, nullptr, gtid, gstride);
    for (size_t i = gtid; i < 512ull * 64; i += gstride) {
        const int k = (int)(i >> 6), n = (int)(i & 63) * 8;
        bf16_t* d = (bf16_t*)(ws + OFF_POOL) + (size_t)k * 512 + n;
        if ((k >> 7) == (n >> 7)) cvt8(d, P.in[21] + (size_t)k * 128 + (n & 127), 1.f);
        else { u32x4 z = {0u, 0u, 0u, 0u}; *(u32x4*)d = z; }
    }
    if (gtid < 128 * 8) { const int r = (int)gtid >> 3, i = (int)gtid & 7; const float inv = exp2f(-(float)i * (13.287712379549449f / 8.f)); float rev = (float)r * inv * 0.15915494309189535f; rev -= floorf(rev);
        f32x2 v = {__builtin_amdgcn_cosf(rev), __builtin_amdgcn_sinf(rev)}; ((f32x2*)(ws + OFF_TAR))[gtid] = v; if (r < 64) ((f32x2*)(ws + OFF_TAC))[gtid] = v; }
    if (gtid < 128 * 16) { const int r = (int)gtid >> 4, i = (int)gtid & 15; const float inv = exp2f(-(float)i * (13.287712379549449f / 16.f)); float rev = (float)r * inv * 0.15915494309189535f; rev -= floorf(rev);
        f32x2 v = {__builtin_amdgcn_cosf(rev), __builtin_amdgcn_sinf(rev)}; ((f32x2*)(ws + OFF_TBR))[gtid] = v; if (r < 64) ((f32x2*)(ws + OFF_TBC))[gtid] = v; }
    if (gtid == 0) {
        const float* lv = P.in[17]; float a = 0.f, b = 0.f;
        for (int i = 0; i < 64; ++i) { a += lv[i] * lv[64 + i]; b += lv[128 + i] * lv[192 + i]; }
        *(float*)(ws + OFF_LAM) = expf(a) - expf(b) + 0.2f;
    }
    float* sc = (float*)smem;
    float* red = sc + 5 * 1024;
    const int tid = ltid(), jj = tid & 31, ig = tid >> 5;
    __syncthreads();
    for (int i = tid; i < 5 * 1024; i += NTHR) { const float v = i < 4096 ? P.in[1][i] : P.in[3][i - 4096]; sc[i] = v / (1.f + expf(-v)); }
    __syncthreads();
    for (int u = lbid(); u < 576; u += gridDim.x) {
        const int l = u / 288, j0 = (u % 288) * 32;
        float a[5] = {0.f, 0.f, 0.f, 0.f, 0.f};
        const float* w = P.in[4] + (size_t)l * 1024 * 9216 + (size_t)(ig * 64) * 9216 + j0 + jj;
        for (int i0 = 0; i0 < 64; i0 += 8) {
            float wv[8];
#pragma unroll
            for (int k = 0; k < 8; ++k) wv[k] = w[(size_t)(i0 + k) * 9216];
#pragma unroll
            for (int k = 0; k < 8; ++k)
#pragma unroll
                for (int s2 = 0; s2 < 5; ++s2) a[s2] += sc[s2 * 1024 + ig * 64 + i0 + k] * wv[k];
        }
#pragma unroll
        for (int s2 = 0; s2 < 5; ++s2) red[(ig * 5 + s2) * 32 + jj] = a[s2];
        __syncthreads();
        if (tid < 160) {
            const int s2 = tid >> 5, j = tid & 31;
            float v = P.in[5][l * 9216 + j0 + j];
#pragma unroll
            for (int g = 0; g < 16; ++g) v += red[(g * 5 + s2) * 32 + j];
            ((float*)(ws + OFF_MOD))[(size_t)(l * 5 + s2) * 9216 + j0 + j] = v;
        }
        __syncthreads();
    }
}

DI void phase_pro_b(const Params& P) {
    char* ws = P.ws; bf16_t* XM = (bf16_t*)(ws + OFF_XM); const float* MOD = (const float*)(ws + OFF_MOD);
    const size_t gtid = (size_t)lbid() * NTHR + ltid(), gstride = (size_t)gridDim.x * NTHR;
    for (size_t i = gtid; i < (size_t)RT * 128; i += gstride) {
        const int row = (int)(i >> 7), c = (int)(i & 127) * 8;
        const float* src = row < RL ? P.in[0] + (size_t)row * 1024 + c : P.in[2] + (size_t)(row - RL) * 1024 + c;
        const int s = row < RL ? (row >> 13) : 4;
        const float* sh = MOD + (size_t)s * 9216 + c; const float* scl = sh + 1024;
        unsigned w[4];
#pragma unroll
        for (int hf = 0; hf < 2; ++hf) {
            const f32x4 x = *(const f32x4*)(src + 4 * hf), a = *(const f32x4*)(sh + 4 * hf), g = *(const f32x4*)(scl + 4 * hf);
            w[2 * hf] = pk2(x[0] * (1.f + g[0]) + a[0], x[1] * (1.f + g[1]) + a[1]);
            w[2 * hf + 1] = pk2(x[2] * (1.f + g[2]) + a[2], x[3] * (1.f + g[3]) + a[3]);
        }
        u32x4 o = {w[0], w[1], w[2], w[3]};
        *(u32x4*)(XM + (size_t)row * 1024 + c) = o;
    }
}

struct LnSpec { int l, which, lnext, mshift; bool final_; unsigned* cnt; };
template <int NR>
DI void ln_rows(const Params& P, const LnSpec& sp, int row, int stride, int lane) {
    char* ws = P.ws; float* X = (float*)(ws + OFF_X); bf16_t* XM = (bf16_t*)(ws + OFF_XM); const float* MOD = (const float*)(ws + OFF_MOD);
    const float* g = P.in[6] + (sp.l * 3 + sp.which) * 1024; const float* bb = P.in[7] + (sp.l * 3 + sp.which) * 1024;
    f32x4 v[NR][4]; float s[NR], qv[NR];
#pragma unroll
    for (int k = 0; k < NR; ++k) {
        const float* xp = X + (size_t)(row + k * stride) * 1024;
#pragma unroll
        for (int i = 0; i < 4; ++i) v[k][i] = *(const f32x4*)(xp + (i * 64 + lane) * 4);
    }
#pragma unroll
    for (int k = 0; k < NR; ++k) {
        s[k] = 0.f;
#pragma unroll
        for (int i = 0; i < 4; ++i) s[k] += (v[k][i][0] + v[k][i][1]) + (v[k][i][2] + v[k][i][3]);
    }
#pragma unroll
    for (int o = 32; o >= 1; o >>= 1)
#pragma unroll
        for (int k = 0; k < NR; ++k) s[k] += __shfl_xor(s[k], o);
#pragma unroll
    for (int k = 0; k < NR; ++k) {
        s[k] *= (1.f / 1024.f); qv[k] = 0.f;
#pragma unroll
        for (int i = 0; i < 4; ++i)
#pragma unroll
            for (int j = 0; j < 4; ++j) { const float d = v[k][i][j] - s[k]; qv[k] += d * d; }
    }
#pragma unroll
    for (int o = 32; o >= 1; o >>= 1)
#pragma unroll
        for (int k = 0; k < NR; ++k) qv[k] += __shfl_xor(qv[k], o);
#pragma unroll
    for (int k = 0; k < NR; ++k) {
        const int r = row + k * stride;
        const float mu = s[k], rstd = rsqrtf(qv[k] * (1.f / 1024.f) + 1e-6f);
        const int sidx = r < RL ? (r >> 13) : 4;
        const float* sh = MOD + (size_t)(sp.lnext * 5 + sidx) * 9216 + sp.mshift * 1024; const float* scl = sh + 1024;
        float* xp = X + (size_t)r * 1024;
#pragma unroll
        for (int i = 0; i < 4; ++i) {
            const int c = (i * 64 + lane) * 4;
            const f32x4 gg = *(const f32x4*)(g + c), b4 = *(const f32x4*)(bb + c);
            f32x4 y;
#pragma unroll
            for (int j = 0; j < 4; ++j) y[j] = (v[k][i][j] - mu) * rstd * gg[j] + b4[j];
            if (sp.final_) { *(f32x4*)(P.out + (size_t)r * 1024 + c) = y; }
            else {
                *(f32x4*)(xp + c) = y;
                const f32x4 a = *(const f32x4*)(sh + c), sg = *(const f32x4*)(scl + c);
                u32x2 w; w.x = pk2(y[0] * (1.f + sg[0]) + a[0], y[1] * (1.f + sg[1]) + a[1]); w.y = pk2(y[2] * (1.f + sg[2]) + a[2], y[3] * (1.f + sg[3]) + a[3]);
                *(u32x2*)(XM + (size_t)r * 1024 + c) = w;
            }
        }
    }
}
DI void phase_ln(const Params& P, int l, int which, int lnext, int mshift, bool final_, bool lat_only = false) {
    const LnSpec sp{l, which, lnext, mshift, final_, nullptr};
    const int lane = ltid() & 63, wave = ltid() >> 6;
    const int nq = ((final_ || lat_only) ? RL : RT) / 4;
    for (int q = lbid() * NWAVE + wave; q < nq; q += gridDim.x * NWAVE) ln_rows<4>(P, sp, 4 * q, 1, lane);
}

DI void phase_ev_rms(const Params& P) {
    char* ws = P.ws; bf16_t* QN = (bf16_t*)(ws + OFF_HID + HOFF_QN); bf16_t* KVN = (bf16_t*)((char*)P.out + OOFF_KVN);
    const int lane = ltid() & 63, wave = ltid() >> 6;
    for (int row = lbid() * NWAVE + wave; row < RT; row += gridDim.x * NWAVE) {
        {
            u32x2* p = (u32x2*)(QN + (size_t)row * 256 + lane * 4); const u32x2 w = *p;
            float a = bflo(w.x), b = bfhi(w.x), c = bflo(w.y), d = bfhi(w.y);
            float s = a * a + b * b + c * c + d * d;
#pragma unroll
            for (int o = 32; o >= 1; o >>= 1) s += __shfl_xor(s, o);
            const float r = rsqrtf(s * (1.f / 256.f) + 1e-6f);
            u32x2 o2; o2.x = pk2(a * r, b * r); o2.y = pk2(c * r, d * r); *p = o2;
        }
        {
            unsigned* p = (unsigned*)(KVN + (size_t)row * 128 + lane * 2); const unsigned w = *p;
            float a = bflo(w), b = bfhi(w);
            float s = a * a + b * b;
#pragma unroll
            for (int o = 32; o >= 1; o >>= 1) s += __shfl_xor(s, o);
            const float r = rsqrtf(s * (1.f / 128.f) + 1e-6f);
            *p = pk2(a * r, b * r);
        }
    }
}

DI void phase_od_pool(const Params& P) {
    char* ws = P.ws; const bf16_t* U = (const bf16_t*)(ws + OFF_HID + HOFF_U); bf16_t* PL = (bf16_t*)(ws + OFF_HID + HOFF_PL);
    const size_t gtid = (size_t)lbid() * NTHR + ltid(), gstride = (size_t)gridDim.x * NTHR;
    for (size_t i = gtid; i < (size_t)RT * 64; i += gstride) {
        const int row = (int)(i >> 6), c = (int)(i & 63) * 8, grp = c >> 7;
        const int w = 2 << grp, left = w >> 1, right = w - 1 - left;
        int base, n, t;
        if (row < RL) { base = row & ~8191; n = SEQ; t = row & 8191; } else { const int rc = row - RL; base = RL + (rc & ~255); n = CTX; t = rc & 255; }
        const int lo = max(t - left, 0), hi = min(t + right + 1, n);
        float acc[8] = {0.f, 0.f, 0.f, 0.f, 0.f, 0.f, 0.f, 0.f};
        for (int tt = lo; tt < hi; ++tt) {
            const u32x4 v = *(const u32x4*)(U + (size_t)(base + tt) * 512 + c);
            acc[0] += bflo(v.x); acc[1] += bfhi(v.x); acc[2] += bflo(v.y); acc[3] += bfhi(v.y); acc[4] += bflo(v.z); acc[5] += bfhi(v.z); acc[6] += bflo(v.w); acc[7] += bfhi(v.w);
        }
        const float ic = 1.f / (float)(hi - lo);
        const u32x4 s = *(const u32x4*)(U + (size_t)row * 512 + c);
        u32x4 o;
        o.x = pk2(acc[0] * ic - bflo(s.x), acc[1] * ic - bfhi(s.x)); o.y = pk2(acc[2] * ic - bflo(s.y), acc[3] * ic - bfhi(s.y));
        o.z = pk2(acc[4] * ic - bflo(s.z), acc[5] * ic - bfhi(s.z)); o.w = pk2(acc[6] * ic - bflo(s.w), acc[7] * ic - bfhi(s.w));
        *(u32x4*)(PL + (size_t)row * 512 + c) = o;
    }
}

constexpr int NPHASE = 25;

DI void run_phase(const Params& P, int ph, char* smem) {
    char* ws = P.ws; char* hid = ws + OFF_HID; char* ob = (char*)P.out;
    float* X = (float*)(ws + OFF_X); bf16_t* XM = (bf16_t*)(ws + OFF_XM); bf16_t* HID = (bf16_t*)hid;
    const float* MOD = (const float*)(ws + OFF_MOD);
    if (ph == 0) { phase_pro_a(P, smem); return; }
    if (ph == 1) { phase_pro_b(P); return; }
    int l, op;
    if (ph < 14) { l = 0; op = ph - 2; } else { l = 1; op = ph - 14; if (op >= 6) op += 1; }
    const float* modl = MOD + (size_t)l * 5 * 9216;
    switch (op) {
    case 0: case 9: {
        const int f = op == 0 ? 0 : 1;
        EpiSwiglu e{HID};
        gemm_phase(XM, 1024, (const bf16_t*)(ws + OFF_WGU + (l * 2 + f) * SZ_WGU), 5632, 5632, 1024, e, smem, !(l == 1 && f == 1));
    } break;
    case 1: case 10: {
        const int f = op == 1 ? 0 : 1;
        const bool first = (l == 0 && f == 0);
        EpiResid e{first ? P.in[0] : X, first ? P.in[2] : X + (size_t)RL * 1024, X, modl + (f == 0 ? 2 : 8) * 1024, 0.5f};
        gemm_phase(HID, DFF, (const bf16_t*)(ws + OFF_WD + (l * 2 + f) * SZ_WD), 1024, 1024, DFF, e, smem, !(l == 1 && f == 1));
    } break;
    case 2: phase_ln(P, l, 0, l, 3, false); break;
    case 3: {
        if (l == 0) {
            EpiEvIn e{(bf16_t*)(hid + HOFF_QN), (bf16_t*)(hid + HOFF_QB), (bf16_t*)(ob + OOFF_KVN), (bf16_t*)(hid + HOFF_KA), (bf16_t*)(ob + OOFF_KB), (bf16_t*)(ob + OOFF_VB),
                      (const f32x2*)(ws + OFF_TAR), (const f32x2*)(ws + OFF_TAC), (const f32x2*)(ws + OFF_TBR), (const f32x2*)(ws + OFF_TBC)};
            gemm_phase(XM, 1024, (const bf16_t*)(ws + OFF_EVIN), 2048, 2048, 1024, e, smem);
        } else {
            EpiOdIn e{(bf16_t*)(hid + HOFF_U), (bf16_t*)(hid + HOFF_QD), (bf16_t*)(hid + HOFF_KD), (bf16_t*)(hid + HOFF_VD)};
            gemm_phase(XM, 1024, (const bf16_t*)(ws + OFF_ODIN), 2048, 2048, 1024, e, smem);
        }
    } break;
    case 4: if (l == 0) phase_ev_rms(P); else phase_od_pool(P); break;
    case 5: {
        if (l == 0) {
            EpiUQ e1{(bf16_t*)(hid + HOFF_QA), (const f32x2*)(ws + OFF_TAR), (const f32x2*)(ws + OFF_TAC)};
            gemm_phase((const bf16_t*)(hid + HOFF_QN), 256, (const bf16_t*)(ws + OFF_UQ), 768, 768, 256, e1, smem);
            EpiUKV e2{(bf16_t*)(hid + HOFF_KA), (bf16_t*)(hid + HOFF_VA)};
            gemm_phase((const bf16_t*)(ob + OOFF_KVN), 128, (const bf16_t*)(ws + OFF_UKV), 1024, 1024, 128, e2, smem);
        } else {
            odd_attention_phase(P, smem);
            EpiPool e{XM, P.in[22], 0};
            gemm_phase((const bf16_t*)(hid + HOFF_PL), 512, (const bf16_t*)(ws + OFF_POOL), 512, 512, 512, e, smem);
        }
    } break;
    case 6: even_attention_phase(P, smem); break;
    case 7: {
        EpiResid e{X, X + (size_t)RL * 1024, X, modl + 5 * 1024, 1.f};
        gemm_phase(XM, 1024, (const bf16_t*)(ws + (l == 0 ? OFF_EVOUT : OFF_ODOUT)), 1024, 1024, 1024, e, smem, l == 0);
    } break;
    case 8: phase_ln(P, l, 1, l, 6, false, l == 1); break;
    case 11: if (l == 0) phase_ln(P, 0, 2, 1, 0, false); else phase_ln(P, 1, 2, 1, 0, true); break;
    default: break;
    }
}

DI void grid_barrier(unsigned* ctr, unsigned target) {
    __syncthreads();
    if (threadIdx.x == 0) {
        __builtin_amdgcn_fence(__ATOMIC_RELEASE, "agent");
        __hip_atomic_fetch_add(ctr, 1u, __ATOMIC_RELAXED, __HIP_MEMORY_SCOPE_AGENT);
        while (__hip_atomic_load(ctr, __ATOMIC_RELAXED, __HIP_MEMORY_SCOPE_AGENT) < target) __builtin_amdgcn_s_sleep(2);
        __builtin_amdgcn_fence(__ATOMIC_ACQUIRE, "agent");
    }
    __syncthreads();
}

__global__ void __launch_bounds__(NTHR, 2) mega(Params P, int ph_lo, int ph_hi) {
    extern __shared__ __attribute__((aligned(16))) char smem[];
    unsigned nsync = 0;
    for (int ph = ph_lo; ph < ph_hi; ++ph) {
        run_phase(P, ph, smem);
        if (ph + 1 < ph_hi) {
            if (ph == ph_lo) cg::this_grid().sync();
            else { ++nsync; grid_barrier((unsigned*)(P.ws + OFF_BAR), nsync * gridDim.x); }
        }
    }
}

extern "C" void kernel_launch(void* const* d_in, const int* in_sizes, int n_in, void* d_out, int out_size, void* d_ws, size_t ws_size, hipStream_t stream) {
    if (ws_size < WS_NEED) { fprintf(stderr, "workspace too small: %zu < %zu\n", ws_size, (size_t)WS_NEED); return; }
    Params P{};
    for (int i = 0; i < 24; ++i) P.in[i] = (const float*)d_in[i];
    P.out = (float*)d_out; P.ws = (char*)d_ws;
    static int grid_blocks = 0;
    if (!grid_blocks) {
        int dev = 0, cus = 0, per_cu = 0;
        hipGetDevice(&dev);
        hipDeviceGetAttribute(&cus, hipDeviceAttributeMultiprocessorCount, dev);
        hipFuncSetAttribute((const void*)mega, hipFuncAttributeMaxDynamicSharedMemorySize, SMEM_BYTES);
        hipOccupancyMaxActiveBlocksPerMultiprocessor(&per_cu, mega, NTHR, SMEM_BYTES);
        if (per_cu < 1) per_cu = 1;
        if (per_cu > 1) per_cu = 1;
        grid_blocks = cus * per_cu;
    }
#if COOP
    hipMemsetAsync((char*)d_ws + OFF_BAR, 0, 256, stream);
    int lo = 0, hi = NPHASE;
    void* args[] = {&P, &lo, &hi};
    hipError_t e = hipLaunchCooperativeKernel((void*)mega, dim3(grid_blocks), dim3(NTHR), args, SMEM_BYTES, stream);
    if (e != hipSuccess) fprintf(stderr, "cooperative launch failed: %s (grid %d)\n", hipGetErrorString(e), grid_blocks);
#else
    for (int ph = 0; ph < NPHASE; ++ph) mega<<<grid_blocks, NTHR, SMEM_BYTES, stream>>>(P, ph, ph + 1);
#endif
}
```

```cpp
#include <hip/hip_runtime.h>
#include <hip/hip_cooperative_groups.h>
#include <cstdio>
#include <cstdint>
namespace cg = cooperative_groups;

#ifndef COOP
#define COOP 1
#endif

#define DI __device__ __forceinline__
typedef unsigned short bf16_t;
typedef short bf16x8 __attribute__((ext_vector_type(8)));
typedef short s16x4 __attribute__((ext_vector_type(4)));
typedef __bf16 bfx4 __attribute__((ext_vector_type(4)));
typedef __bf16 bfx2 __attribute__((ext_vector_type(2)));
typedef float f32x2 __attribute__((ext_vector_type(2)));
typedef float f32x4 __attribute__((ext_vector_type(4)));
typedef float f32x16 __attribute__((ext_vector_type(16)));
typedef unsigned u32x2 __attribute__((ext_vector_type(2)));
typedef unsigned u32x4 __attribute__((ext_vector_type(4)));
#define LDS_AS __attribute__((address_space(3)))

constexpr int DM = 1024, NB = 4, SEQ = 8192, CTX = 256, DFF = 2816;
constexpr int RL = NB * SEQ, RC = NB * CTX, RT = RL + RC;
constexpr int NK = SEQ + CTX;
constexpr float ALPHA = 1.41421356237f;
constexpr float LOG2E = 1.4426950408889634f;
constexpr float QA_SCALE = 0.10206207261596575f * LOG2E;
constexpr float QB_SCALE = 0.125f * LOG2E;
constexpr float QD_SCALE = 0.125f * LOG2E;
constexpr int NTHR = 512, NWAVE = NTHR / 64;

constexpr size_t SZ_WGU = 1024ull * 5632 * 2, SZ_WD = 2816ull * 1024 * 2;
constexpr size_t OFF_WGU = 0;
constexpr size_t OFF_WD = OFF_WGU + 4 * SZ_WGU;
constexpr size_t OFF_EVIN = OFF_WD + 4 * SZ_WD;
constexpr size_t OFF_EVOUT = OFF_EVIN + 1024ull * 2048 * 2;
constexpr size_t OFF_UQ = OFF_EVOUT + 1024ull * 1024 * 2;
constexpr size_t OFF_UKV = OFF_UQ + 256ull * 768 * 2;
constexpr size_t OFF_ODIN = OFF_UKV + 128ull * 1024 * 2;
constexpr size_t OFF_ODOUT = OFF_ODIN + 1024ull * 2048 * 2;
constexpr size_t OFF_POOL = OFF_ODOUT + 1024ull * 1024 * 2;
constexpr size_t OFF_MOD = OFF_POOL + 512ull * 512 * 2;
constexpr size_t OFF_TAR = OFF_MOD + 2ull * 5 * 9216 * 4;
constexpr size_t OFF_TAC = OFF_TAR + 128 * 8 * 8;
constexpr size_t OFF_TBR = OFF_TAC + 64 * 8 * 8;
constexpr size_t OFF_TBC = OFF_TBR + 128 * 16 * 8;
constexpr size_t OFF_LAM = OFF_TBC + 64 * 16 * 8;
constexpr size_t OFF_BAR = OFF_LAM + 256;
constexpr size_t OFF_X = OFF_BAR + 256;
constexpr size_t OFF_XM = OFF_X + (size_t)RT * 1024 * 4;
constexpr size_t OFF_HID = OFF_XM + (size_t)RT * 1024 * 2;
constexpr size_t WS_NEED = OFF_HID + (size_t)RT * DFF * 2;
constexpr size_t SZ_H96 = (size_t)NB * 8 * NK * 96 * 2, SZ_H64 = (size_t)NB * 8 * NK * 64 * 2;
constexpr size_t HOFF_QA = 0, HOFF_KA = SZ_H96, HOFF_VA = 2 * SZ_H96, HOFF_QB = HOFF_VA + SZ_H64, HOFF_QN = HOFF_QB + SZ_H64;
static_assert(HOFF_QN + (size_t)RT * 256 * 2 <= (size_t)RT * DFF * 2, "HID region overflow");
constexpr size_t HOFF_U = 0, HOFF_PL = SZ_H64, HOFF_QD = 2 * SZ_H64, HOFF_KD = 3 * SZ_H64, HOFF_VD = 4 * SZ_H64;
constexpr size_t OOFF_KB = 0, OOFF_VB = SZ_H64, OOFF_KVN = 2 * SZ_H64;
static_assert(OOFF_KVN + (size_t)RT * 128 * 2 <= (size_t)RL * 1024 * 4, "d_out region overflow");

struct Params {
    const float* in[24];
    float* out;
    char* ws;
};

DI int ltid() { int t = threadIdx.x; asm volatile("" : "+v"(t)); return t; }
DI int lbid() { int t = blockIdx.x; asm volatile("" : "+s"(t)); return t; }
DI unsigned pk2(float a, float b) { f32x2 v = {a, b}; bfx2 r = __builtin_convertvector(v, bfx2); return __builtin_bit_cast(unsigned, r); }
DI float bf2f(unsigned short u) { return __uint_as_float(((unsigned)u) << 16); }
DI float bflo(unsigned u) { return __uint_as_float(u << 16); }
DI float bfhi(unsigned u) { return __uint_as_float(u & 0xffff0000u); }
DI float silu_f(float x) { return x * __builtin_amdgcn_rcpf(1.f + __expf(-x)); }
DI f32x16 mfma32(bf16x8 a, bf16x8 b, f32x16 c) { return __builtin_amdgcn_mfma_f32_32x32x16_bf16(a, b, c, 0, 0, 0); }
DI s16x4 tr_read(const char* p) { bfx4 r = __builtin_amdgcn_ds_read_tr16_b64_v4bf16((LDS_AS bfx4*)p); return __builtin_bit_cast(s16x4, r); }
DI float xor32_max(float x) { const unsigned u = __float_as_uint(x); auto r = __builtin_amdgcn_permlane32_swap(u, u, false, false); return fmaxf(__uint_as_float(r[0]), __uint_as_float(r[1])); }
DI float xor32_sum(float x) { const unsigned u = __float_as_uint(x); auto r = __builtin_amdgcn_permlane32_swap(u, u, false, false); return __uint_as_float(r[0]) + __uint_as_float(r[1]); }
DI bf16x8 cat8(s16x4 lo, s16x4 hi) { return __builtin_shufflevector(lo, hi, 0, 1, 2, 3, 4, 5, 6, 7); }

struct RowInfo { int b, j, s; bool lat; };
DI RowInfo rowinfo(int row) {
    RowInfo r;
    if (row < RL) { r.b = row >> 13; r.j = row & 8191; r.s = r.b; r.lat = true; }
    else { int rc = row - RL; r.b = rc >> 8; r.j = 8192 + (rc & 255); r.s = 4; r.lat = false; }
    return r;
}
DI void store16(bf16_t* dst32, const f32x16& v, float sc, int hh) {
#pragma unroll
    for (int q4 = 0; q4 < 4; ++q4) {
        u32x2 w; w.x = pk2(v[4 * q4] * sc, v[4 * q4 + 1] * sc); w.y = pk2(v[4 * q4 + 2] * sc, v[4 * q4 + 3] * sc);
        *(u32x2*)(dst32 + 8 * q4 + 4 * hh) = w;
    }
}
DI f32x16 ropeB(const f32x16& v, const f32x2* tab, int hh) {
    f32x16 o;
#pragma unroll
    for (int r = 0; r < 8; ++r) {
        const int i = (r & 3) + 8 * (r >> 2) + 4 * hh;
        const f32x2 cs = tab[i];
        o[r] = v[r] * cs.x - v[r + 8] * cs.y;
        o[r + 8] = v[r + 8] * cs.x + v[r] * cs.y;
    }
    return o;
}
DI f32x16 ropeA(const f32x16& v, const f32x2* tr, const f32x2* tc, int hh) {
    f32x16 o;
#pragma unroll
    for (int r = 0; r < 4; ++r) {
        const int i = 4 * hh + r;
        const f32x2 a = tr[i], c = tc[i];
        o[r] = v[r] * a.x - v[r + 4] * a.y;
        o[r + 4] = v[r + 4] * a.x + v[r] * a.y;
        o[8 + r] = v[8 + r] * c.x - v[12 + r] * c.y;
        o[12 + r] = v[12 + r] * c.x + v[8 + r] * c.y;
    }
    return o;
}

constexpr int GA_S = 144, GB_S = 576;
constexpr int GSTAGE = 256 * GA_S + 64 * GB_S;
constexpr int GEMM_LDS = 2 * GSTAGE;

template <int BM, class Epi>
DI void gemm_tile(const bf16_t* __restrict__ A, int lda, const bf16_t* __restrict__ B, int ldb, int K, int row0, int col0, const Epi& epi, char* smem) {
    constexpr int MI = BM / 64, NA_ = BM / 64;
    const int tid = ltid(), lane = tid & 63, wave = tid >> 6, wm = wave >> 2, wn = wave & 3;
    const int l31 = lane & 31, hh = lane >> 5, q = (lane & 15) >> 2, p = lane & 3, nblk = (lane >> 4) & 1;
    f32x16 acc[MI][2];
#pragma unroll
    for (int i = 0; i < MI; ++i)
#pragma unroll
        for (int j = 0; j < 2; ++j)
#pragma unroll
            for (int r = 0; r < 16; ++r) acc[i][j][r] = 0.f;
    u32x4 ra[NA_], rb[4];
    const bf16_t* ag = A + (size_t)(row0 + (tid >> 3)) * lda + (tid & 7) * 8;
    const bf16_t* bg = B + (size_t)(tid >> 5) * ldb + col0 + (tid & 31) * 8;
    const int aw = (tid >> 3) * GA_S + (tid & 7) * 16, bw = BM * GA_S + (tid >> 5) * GB_S + (tid & 31) * 16;
    const int nk = K >> 6;
    const int xoff = (wm * (BM / 2) + l31) * GA_S + hh * 16;
    const int woff = BM * GA_S + (hh * 8 + q) * GB_S + (wn * 64 + nblk * 16 + 4 * p) * 2;
#pragma unroll
    for (int i = 0; i < NA_; ++i) ra[i] = *(const u32x4*)(ag + (size_t)(64 * i) * lda);
#pragma unroll
    for (int i = 0; i < 4; ++i) rb[i] = *(const u32x4*)(bg + (size_t)(16 * i) * ldb);
    __syncthreads();
#pragma unroll
    for (int i = 0; i < NA_; ++i) *(u32x4*)(smem + aw + 64 * i * GA_S) = ra[i];
#pragma unroll
    for (int i = 0; i < 4; ++i) *(u32x4*)(smem + bw + 16 * i * GB_S) = rb[i];
    if (nk > 1) {
#pragma unroll
        for (int i = 0; i < NA_; ++i) ra[i] = *(const u32x4*)(ag + 64 + (size_t)(64 * i) * lda);
#pragma unroll
        for (int i = 0; i < 4; ++i) rb[i] = *(const u32x4*)(bg + (size_t)(64 + 16 * i) * ldb);
    }
    __syncthreads();
    for (int kt = 0; kt < nk; ++kt) {
        const char* cur = smem + (kt & 1) * GSTAGE;
        char* nxt = smem + ((kt & 1) ^ 1) * GSTAGE;
        const bool w1 = kt + 1 < nk, l2 = kt + 2 < nk;
        const bf16_t* a2 = ag + (size_t)(kt + 2) * 64; const bf16_t* b2 = bg + (size_t)(kt + 2) * 64 * ldb;
#pragma unroll
        for (int s = 0; s < 4; ++s) {
            bf16x8 xf[MI], wf[2];
#pragma unroll
            for (int mi = 0; mi < MI; ++mi) xf[mi] = *(const bf16x8*)(cur + xoff + mi * 32 * GA_S + s * 32);
#pragma unroll
            for (int ni = 0; ni < 2; ++ni) {
                const char* wp = cur + woff + s * 16 * GB_S + ni * 64;
                wf[ni] = cat8(tr_read(wp), tr_read(wp + 4 * GB_S));
            }
#pragma unroll
            for (int mi = 0; mi < MI; ++mi)
#pragma unroll
                for (int ni = 0; ni < 2; ++ni) acc[mi][ni] = mfma32(wf[ni], xf[mi], acc[mi][ni]);
            if (w1) {
                if (s < NA_) *(u32x4*)(nxt + aw + 64 * s * GA_S) = ra[s];
                *(u32x4*)(nxt + bw + 16 * s * GB_S) = rb[s];
            }
            if (l2) {
                if (s < NA_) ra[s] = *(const u32x4*)(a2 + (size_t)(64 * s) * lda);
                rb[s] = *(const u32x4*)(b2 + (size_t)(16 * s) * ldb);
            }
        }
        __syncthreads();
    }
#pragma unroll
    for (int mi = 0; mi < MI; ++mi) epi(acc[mi][0], acc[mi][1], row0 + wm * (BM / 2) + mi * 32 + l31, col0 + wn * 64, hh);
}

template <class Epi>
DI void gemm_phase(const bf16_t* A, int lda, const bf16_t* B, int ldb, int N, int K, const Epi& epi, char* smem, bool do_ctx = true) {
    const int nt = N >> 8, small = do_ctx ? (RC / 128) * nt : 0;
    const int bid = lbid(), G = gridDim.x;
    if ((G & 7) == 0) {
        const int xcd = bid & 7, loc = bid >> 3, per = G >> 3, mine = (RL / 256 / 8) * nt;
        for (int i = loc; i < mine; i += per) {
            const int cg = i >> 7, rem = i & 127, cw = min(8, nt - cg * 8);
            int pg, w;
            if (cw == 8) { pg = rem >> 5; w = rem & 31; } else { const int rr = i - cg * 128; pg = rr / (4 * cw); w = rr - pg * 4 * cw; }
            const int pl = pg * 4 + (w & 3), cl = cg * 8 + (w >> 2);
            gemm_tile<256>(A, lda, B, ldb, K, (pl * 8 + xcd) * 256, cl * 256, epi, smem);
        }
    } else {
        const int big = (RL / 256) * nt;
        for (int t = bid; t < big; t += G) gemm_tile<256>(A, lda, B, ldb, K, (t / nt) * 256, (t % nt) * 256, epi, smem);
    }
    for (int u = bid; u < small; u += G) gemm_tile<128>(A, lda, B, ldb, K, RL + (u / nt) * 128, (u % nt) * 256, epi, smem);
}

struct EpiSwiglu {
    bf16_t* hid;
    DI void operator()(const f32x16& a0, const f32x16& a1, int row, int cbase, int hh) const {
        bf16_t* dst = hid + (size_t)row * DFF + (cbase >> 1) + 4 * hh;
#pragma unroll
        for (int q4 = 0; q4 < 4; ++q4) {
            float h[4];
#pragma unroll
            for (int j = 0; j < 4; ++j) h[j] = silu_f(a0[4 * q4 + j]) * a1[4 * q4 + j];
            u32x2 w; w.x = pk2(h[0], h[1]); w.y = pk2(h[2], h[3]);
            *(u32x2*)(dst + 8 * q4) = w;
        }
    }
};
struct EpiResid {
    const float* res_lat; const float* res_ctx; float* X; const float* gate; float coef;
    DI void operator()(const f32x16& a0, const f32x16& a1, int row, int cbase, int hh) const {
        const int s = row < RL ? (row >> 13) : 4;
        const float* rp = row < RL ? res_lat + (size_t)row * 1024 : res_ctx + (size_t)(row - RL) * 1024;
        const float* gp = gate + s * 9216;
        float* xp = X + (size_t)row * 1024;
#pragma unroll
        for (int ni = 0; ni < 2; ++ni)
#pragma unroll
            for (int q4 = 0; q4 < 4; ++q4) {
                const int c = cbase + ni * 32 + 8 * q4 + 4 * hh;
                const f32x4 r = *(const f32x4*)(rp + c), g = *(const f32x4*)(gp + c);
                f32x4 z;
#pragma unroll
                for (int j = 0; j < 4; ++j) z[j] = ALPHA * r[j] + coef * g[j] * (ni ? a1[4 * q4 + j] : a0[4 * q4 + j]);
                *(f32x4*)(xp + c) = z;
            }
    }
};
struct EpiY {
    static constexpr bool kSwap = false;
    bf16_t* Y; const float* gate; float coef;
    DI void operator()(const f32x16& a0, const f32x16& a1, int row, int cbase, int hh) const {
        const int s = row < RL ? (row >> 13) : 4;
        const float* gp = gate + s * 9216;
        bf16_t* yp = Y + (size_t)row * 1024;
#pragma unroll
        for (int ni = 0; ni < 2; ++ni)
#pragma unroll
            for (int q4 = 0; q4 < 4; ++q4) {
                const int c = cbase + ni * 32 + 8 * q4 + 4 * hh;
                const f32x4 g = *(const f32x4*)(gp + c);
                const f32x16& v = ni ? a1 : a0;
                u32x2 w; w.x = pk2(coef * g[0] * v[4 * q4], coef * g[1] * v[4 * q4 + 1]); w.y = pk2(coef * g[2] * v[4 * q4 + 2], coef * g[3] * v[4 * q4 + 3]);
                *(u32x2*)(yp + c) = w;
            }
    }
};
struct EpiEvIn {
    bf16_t *QN, *QB, *KVN, *KA, *KB, *VB; const f32x2 *tAr, *tAc, *tBr, *tBc;
    DI void operator()(const f32x16& a0, const f32x16& a1, int row, int cbase, int hh) const {
        const RowInfo ri = rowinfo(row);
        const int gr = (ri.j >> 6) & 127, gc = ri.j & 63;
#pragma unroll
        for (int ni = 0; ni < 2; ++ni) {
            const int g = (cbase >> 5) + ni;
            const f32x16& v = ni ? a1 : a0;
            if (g < 8) store16(QN + (size_t)row * 256 + g * 32, v, 1.f, hh);
            else if (g < 24) {
                const int hv = (g - 8) >> 1, half = (g - 8) & 1;
                f32x16 w = v; if (ri.lat) w = ropeB(v, half ? tBc + gc * 16 : tBr + gr * 16, hh);
                store16(QB + ((size_t)(ri.b * 8 + hv) * NK + ri.j) * 64 + half * 32, w, QB_SCALE, hh);
            } else if (g < 28) store16(KVN + (size_t)row * 128 + (g - 24) * 32, v, 1.f, hh);
            else if (g == 28) {
                f32x16 w = v; if (ri.lat) w = ropeA(v, tAr + gr * 8, tAc + gc * 8, hh);
                for (int h = 0; h < 8; ++h) store16(KA + ((size_t)(ri.b * 8 + h) * NK + ri.j) * 96 + 64, w, 1.f, hh);
            } else if (g < 45) {
                const int hv = (g - 29) >> 1, half = (g - 29) & 1;
                f32x16 w = v; if (ri.lat) w = ropeB(v, half ? tBc + gc * 16 : tBr + gr * 16, hh);
                store16(KB + ((size_t)(ri.b * 8 + hv) * NK + ri.j) * 64 + half * 32, w, 1.f, hh);
            } else if (g < 61) {
                const int idx = g - 45, h = idx >> 2, part = idx & 3;
                store16(VB + ((size_t)(ri.b * 4 + h) * NK + ri.j) * 128 + part * 32, v, 1.f, hh);
            }
        }
    }
};
struct EpiUQ {
    bf16_t* QA; const f32x2 *tAr, *tAc;
    DI void operator()(const f32x16& a0, const f32x16& a1, int row, int cbase, int hh) const {
        const RowInfo ri = rowinfo(row);
        const int gr = (ri.j >> 6) & 127, gc = ri.j & 63;
#pragma unroll
        for (int ni = 0; ni < 2; ++ni) {
            const int g = (cbase >> 5) + ni, h = g / 3, part = g - 3 * h;
            f32x16 w = ni ? a1 : a0;
            if (part == 2 && ri.lat) w = ropeA(ni ? a1 : a0, tAr + gr * 8, tAc + gc * 8, hh);
            store16(QA + ((size_t)(ri.b * 8 + h) * NK + ri.j) * 96 + part * 32, w, QA_SCALE, hh);
        }
    }
};
struct EpiUKV {
    bf16_t *KA, *VA;
    DI void operator()(const f32x16& a0, const f32x16& a1, int row, int cbase, int hh) const {
        const RowInfo ri = rowinfo(row);
#pragma unroll
        for (int ni = 0; ni < 2; ++ni) {
            const int g = (cbase >> 5) + ni, h = g >> 2, part = g & 3;
            const size_t tk = (size_t)(ri.b * 8 + h) * NK + ri.j;
            if (part < 2) store16(KA + tk * 96 + part * 32, ni ? a1 : a0, 1.f, hh);
            else store16(VA + tk * 64 + (part - 2) * 32, ni ? a1 : a0, 1.f, hh);
        }
    }
};
struct EpiOdIn {
    bf16_t *U, *QD, *KD, *VD;
    DI void operator()(const f32x16& a0, const f32x16& a1, int row, int cbase, int hh) const {
        const RowInfo ri = rowinfo(row);
#pragma unroll
        for (int ni = 0; ni < 2; ++ni) {
            const int g = (cbase >> 5) + ni;
            const f32x16& v = ni ? a1 : a0;
            if (g < 16) store16(U + (size_t)row * 512 + g * 32, v, 1.f, hh);
            else {
                const int gg = (g - 16) & 15, h = gg >> 1, half = gg & 1;
                const size_t off = ((size_t)(ri.b * 8 + h) * NK + ri.j) * 64 + half * 32;
                if (g < 32) store16(QD + off, v, QD_SCALE, hh);
                else if (g < 48) store16(KD + off, v, 1.f, hh);
                else store16(VD + off, v, 1.f, hh);
            }
        }
    }
};
struct EpiPool {
    bf16_t* CC; const float* pscale; int gidx;
    DI void operator()(const f32x16& a0, const f32x16& a1, int row, int cbase, int hh) const {
#pragma unroll
        for (int ni = 0; ni < 2; ++ni)
#pragma unroll
            for (int q4 = 0; q4 < 4; ++q4) {
                const int c = gidx * 128 + cbase + ni * 32 + 8 * q4 + 4 * hh;
                const f32x4 s = *(const f32x4*)(pscale + c);
                const f32x16& v = ni ? a1 : a0;
                u32x2 w; w.x = pk2(v[4 * q4] * s[0], v[4 * q4 + 1] * s[1]); w.y = pk2(v[4 * q4 + 2] * s[2], v[4 * q4 + 3] * s[3]);
                *(u32x2*)(CC + (size_t)row * 1024 + c) = w;
            }
    }
};

constexpr int ATT_LDS = 64 * (96 + 8) * 2 + 64 * (128 * 2 + 64);
constexpr int RPB_OFF = 2 * ATT_LDS;
constexpr int SMEM_BYTES = GEMM_LDS;

struct NAInfo { int qr; int kstart; };

template <int DQK, int DV, bool NA>
DI void attend(const bf16_t* __restrict__ Q, int q0, const bf16_t* __restrict__ Kb, const bf16_t* __restrict__ Vb,
               int s0, int n0, int s1, int n1, f32x16 (&o)[DV / 32], char* smem, NAInfo na) {
    constexpr int KS = (DQK + 8) * 2, VS = DV * 2 + 64;
    constexpr int KCH = DQK / 8, KN = (64 * KCH + NTHR - 1) / NTHR, VCH = DV / 8, VN = (64 * VCH + NTHR - 1) / NTHR;
    constexpr int NS = DQK / 16, NDT = DV / 32;
    const int tid = ltid(), lane = tid & 63, wave = tid >> 6;
    const int l31 = lane & 31, hh = lane >> 5, q = (lane & 15) >> 2, p = lane & 3, dblk = (lane >> 4) & 1;
    bf16x8 qf[NS];
    {
        const bf16_t* qp = Q + (size_t)(q0 + wave * 32 + l31) * DQK + hh * 8;
#pragma unroll
        for (int s = 0; s < NS; ++s) qf[s] = *(const bf16x8*)(qp + s * 16);
    }
#pragma unroll
    for (int d = 0; d < NDT; ++d)
#pragma unroll
        for (int r = 0; r < 16; ++r) o[d][r] = 0.f;
    float m = NA ? -INFINITY : 0.f, l = 0.f;
    f32x16 cinit;
#pragma unroll
    for (int r = 0; r < 16; ++r) cinit[r] = 0.f;
    u32x4 rk[KN], rv[VN];
    const int nt = n0 + n1;
    auto gload = [&](int t) {
        const int j0 = t < n0 ? s0 + t * 64 : s1 + (t - n0) * 64;
#pragma unroll
        for (int i = 0; i < KN; ++i) { int id = tid + NTHR * i; if (id >= 64 * KCH) id -= 64 * KCH; const int row = id / KCH, ch = id - row * KCH; rk[i] = *(const u32x4*)(Kb + (size_t)(j0 + row) * DQK + ch * 8); }
#pragma unroll
        for (int i = 0; i < VN; ++i) { int id = tid + NTHR * i; if (id >= 64 * VCH) id -= 64 * VCH; const int row = id / VCH, ch = id - row * VCH; rv[i] = *(const u32x4*)(Vb + (size_t)(j0 + row) * DV + ch * 8); }
    };
    gload(0);
    int qc = 0, cs = 0, rs = 0;
    if (NA) { qc = (wave & 1) * 32 + l31; cs = min(max(qc - 8, 0), 48); rs = min(max(na.qr - 4, 0), 120); }
    const float* rpb = (const float*)(smem + RPB_OFF);
    auto lwrite = [&](char* stg) {
#pragma unroll
        for (int i = 0; i < KN; ++i) { int id = tid + NTHR * i; if (id >= 64 * KCH) id -= 64 * KCH; const int row = id / KCH, ch = id - row * KCH; *(u32x4*)(stg + row * KS + ch * 16) = rk[i]; }
#pragma unroll
        for (int i = 0; i < VN; ++i) { int id = tid + NTHR * i; if (id >= 64 * VCH) id -= 64 * VCH; const int row = id / VCH, ch = id - row * VCH; *(u32x4*)(stg + 64 * KS + row * VS + ch * 16) = rv[i]; }
    };
    __syncthreads();
    lwrite(smem);
    if (nt > 1) gload(1);
    __syncthreads();
    for (int t = 0; t < nt; ++t) {
        const char* sK = smem + (t & 1) * ATT_LDS; const char* sV = sK + 64 * KS;
        bool active = true; int kr = 0;
        if (NA && t < n0) { kr = na.kstart + t; active = (kr >= rs) && (kr < rs + 8); }
        if (active) {
#pragma unroll
            for (int sub = 0; sub < 2; ++sub) {
                f32x16 st;
                if (NA) {
#pragma unroll
                    for (int r = 0; r < 16; ++r) st[r] = 0.f;
                } else st = cinit;
                {
                    bf16x8 kf[NS];
#pragma unroll
                    for (int s = 0; s < NS; ++s) kf[s] = *(const bf16x8*)(sK + (sub * 32 + l31) * KS + (s * 16 + hh * 8) * 2);
                    __builtin_amdgcn_sched_barrier(0);
#pragma unroll
                    for (int s = 0; s < NS; ++s) st = mfma32(kf[s], qf[s], st);
                }
                if (NA && t < n0) {
                    const float* brow = rpb + (kr - na.qr + 7) * 31 + 15 - qc;
#pragma unroll
                    for (int r = 0; r < 16; ++r) {
                        const int kc = sub * 32 + (r & 3) + 8 * (r >> 2) + 4 * hh;
                        const bool valid = (kc >= cs) && (kc < cs + 16);
                        const int bi = valid ? kc : cs;
                        const float bias = brow[bi];
                        st[r] = valid ? st[r] + bias : -INFINITY;
                    }
                }
                float mx = st[0];
#pragma unroll
                for (int r = 1; r < 16; ++r) mx = fmaxf(mx, st[r]);
                mx = xor32_max(mx);
                float rsum = 0.f;
                if (NA) {
                    const float mnew = fmaxf(m, mx);
                    const float muse = (mnew == -INFINITY) ? 0.f : mnew;
                    const float alpha = __builtin_amdgcn_exp2f(m - muse);
                    m = mnew;
                    l *= alpha;
#pragma unroll
                    for (int d = 0; d < NDT; ++d)
#pragma unroll
                        for (int r = 0; r < 16; ++r) o[d][r] *= alpha;
#pragma unroll
                    for (int r = 0; r < 16; ++r) { st[r] = __builtin_amdgcn_exp2f(st[r] - muse); rsum += st[r]; }
                } else {
                    const bool first = (t == 0) && (sub == 0);
                    if (first || __builtin_amdgcn_ballot_w64(mx > 8.f) != 0) {
                        const float delta = first ? mx : fmaxf(mx, 0.f);
                        const float alpha = first ? 1.f : __builtin_amdgcn_exp2f(-delta);
                        m += delta;
                        l *= alpha;
#pragma unroll
                        for (int d = 0; d < NDT; ++d)
#pragma unroll
                            for (int r = 0; r < 16; ++r) o[d][r] *= alpha;
#pragma unroll
                        for (int r = 0; r < 16; ++r) { st[r] -= delta; cinit[r] = -m; }
                    }
#pragma unroll
                    for (int r = 0; r < 16; ++r) { st[r] = __builtin_amdgcn_exp2f(st[r]); rsum += st[r]; }
                }
                l += rsum;
                bf16x8 pf[2];
#pragma unroll
                for (int s2 = 0; s2 < 2; ++s2) {
                    u32x4 w;
                    w.x = pk2(st[8 * s2], st[8 * s2 + 1]); w.y = pk2(st[8 * s2 + 2], st[8 * s2 + 3]);
                    w.z = pk2(st[8 * s2 + 4], st[8 * s2 + 5]); w.w = pk2(st[8 * s2 + 6], st[8 * s2 + 7]);
                    pf[s2] = __builtin_bit_cast(bf16x8, w);
                }
#pragma unroll
                for (int d = 0; d < NDT; ++d)
#pragma unroll
                    for (int s2 = 0; s2 < 2; ++s2) {
                        const char* vp = sV + (sub * 32 + 16 * s2 + 4 * hh + q) * VS + (d * 32 + dblk * 16 + 4 * p) * 2;
                        const bf16x8 vf = cat8(tr_read(vp), tr_read(vp + 8 * VS));
                        o[d] = mfma32(vf, pf[s2], o[d]);
                    }
            }
        }
        if (t + 1 < nt) lwrite(smem + ((t & 1) ^ 1) * ATT_LDS);
        if (t + 2 < nt) gload(t + 2);
        __syncthreads();
    }
    l = xor32_sum(l);
    const float inv = 1.f / l;
#pragma unroll
    for (int d = 0; d < NDT; ++d)
#pragma unroll
        for (int r = 0; r < 16; ++r) o[d][r] *= inv;
}

DI int qrow_of(int b, int j) { return j < SEQ ? b * SEQ + j : RL + b * CTX + (j - SEQ); }

DI void even_attention_phase(const Params& P, char* smem) {
    char* ws = P.ws; char* hid = ws + OFF_HID; char* ob = (char*)P.out;
    const bf16_t* QA = (const bf16_t*)(hid + HOFF_QA); const bf16_t* KA = (const bf16_t*)(hid + HOFF_KA); const bf16_t* VA = (const bf16_t*)(hid + HOFF_VA);
    const bf16_t* QB = (const bf16_t*)(hid + HOFF_QB); const bf16_t* KB = (const bf16_t*)(ob + OOFF_KB); const bf16_t* VB = (const bf16_t*)(ob + OOFF_VB);
    bf16_t* CC = (bf16_t*)(ws + OFF_XM);
    const float lam = *(const float*)(ws + OFF_LAM);
    const float* gsub = P.in[18];
    const int lane = ltid() & 63, wave = ltid() >> 6, l31 = lane & 31, hh = lane >> 5;
    constexpr int NQT = 33, NDIFF = NB * 4 * NQT, NMLA = NB * 8 * NQT;
    NAInfo na; na.qr = 0; na.kstart = 0;
    unsigned* wq = (unsigned*)(ws + OFF_BAR + 128);
    volatile int* slot = (volatile int*)(smem + 2 * ATT_LDS + 2048);
    for (;;) {
        __syncthreads();
        if (ltid() == 0) *slot = (int)atomicAdd(wq, 1u);
        __syncthreads();
        const int u = *slot;
        if (u >= NDIFF + NMLA) break;
        if (u < NDIFF) {
            const int qt = u % NQT, bh = u / NQT, h = bh & 3, b = bh >> 2;
            const int q0 = qt < 32 ? qt * 256 : SEQ;
            const int s0 = qt < 32 ? 0 : SEQ, n0 = qt < 32 ? NK / 64 : CTX / 64;
            const bf16_t* V = VB + (size_t)(b * 4 + h) * NK * 128;
            f32x16 o[4];
            attend<64, 128, false>(QB + (size_t)(b * 8 + 2 * h) * NK * 64, q0, KB + (size_t)(b * 8 + 2 * h) * NK * 64, V, s0, n0, 0, 0, o, smem, na);
            const int row = qrow_of(b, q0 + wave * 32 + l31);
            bf16_t* dst = CC + (size_t)row * 1024 + 512 + h * 128;
#pragma unroll
            for (int d = 0; d < 4; ++d) store16(dst + d * 32, o[d], 1.f, hh);
            f32x16 o2[4];
            attend<64, 128, false>(QB + (size_t)(b * 8 + 2 * h + 1) * NK * 64, q0, KB + (size_t)(b * 8 + 2 * h + 1) * NK * 64, V, s0, n0, 0, 0, o2, smem, na);
            float ss = 0.f;
#pragma unroll
            for (int d = 0; d < 4; ++d)
#pragma unroll
                for (int q4 = 0; q4 < 4; ++q4) {
                    const u32x2 w = *(const volatile u32x2*)(dst + d * 32 + 8 * q4 + 4 * hh);
                    const float a0 = bflo(w.x) - lam * o2[d][4 * q4], a1 = bfhi(w.x) - lam * o2[d][4 * q4 + 1], a2 = bflo(w.y) - lam * o2[d][4 * q4 + 2], a3 = bfhi(w.y) - lam * o2[d][4 * q4 + 3];
                    o[d][4 * q4] = a0; o[d][4 * q4 + 1] = a1; o[d][4 * q4 + 2] = a2; o[d][4 * q4 + 3] = a3;
                    ss += (a0 * a0 + a1 * a1) + (a2 * a2 + a3 * a3);
                }
            ss = xor32_sum(ss);
            const float rn = rsqrtf(ss * (1.f / 128.f) + 1e-5f) * 0.8f;
#pragma unroll
            for (int d = 0; d < 4; ++d)
#pragma unroll
                for (int q4 = 0; q4 < 4; ++q4) {
                    const int c = d * 32 + 8 * q4 + 4 * hh;
                    const f32x4 g = *(const f32x4*)(gsub + c);
                    u32x2 w; w.x = pk2(o[d][4 * q4] * rn * g[0], o[d][4 * q4 + 1] * rn * g[1]); w.y = pk2(o[d][4 * q4 + 2] * rn * g[2], o[d][4 * q4 + 3] * rn * g[3]);
                    *(u32x2*)(dst + c) = w;
                }
        } else {
            const int v = u - NDIFF, qt = v % NQT, bh = v / NQT, h = bh & 7, b = bh >> 3;
            const int q0 = qt < 32 ? qt * 256 : SEQ;
            const int s0 = qt < 32 ? 0 : SEQ, n0 = qt < 32 ? NK / 64 : CTX / 64;
            f32x16 o[2];
            attend<96, 64, false>(QA + (size_t)(b * 8 + h) * NK * 96, q0, KA + (size_t)(b * 8 + h) * NK * 96, VA + (size_t)(b * 8 + h) * NK * 64, s0, n0, 0, 0, o, smem, na);
            const int row = qrow_of(b, q0 + wave * 32 + l31);
            bf16_t* dst = CC + (size_t)row * 1024 + h * 64;
#pragma unroll
            for (int d = 0; d < 2; ++d) store16(dst + d * 32, o[d], 1.f, hh);
        }
    }
}

DI void odd_attention_phase(const Params& P, char* smem) {
    char* ws = P.ws; char* hid = ws + OFF_HID;
    const bf16_t* QD = (const bf16_t*)(hid + HOFF_QD); const bf16_t* KD = (const bf16_t*)(hid + HOFF_KD); const bf16_t* VD = (const bf16_t*)(hid + HOFF_VD);
    bf16_t* CC = (bf16_t*)(ws + OFF_XM);
    const float* rpbg = P.in[23];
    const int lane = ltid() & 63, wave = ltid() >> 6, l31 = lane & 31, hh = lane >> 5;
    float* rpbl = (float*)(smem + RPB_OFF);
    constexpr int NU = NB * 8 * 32;
    for (int u = lbid(); u < NU; u += gridDim.x) {
        const int rp = u & 31, bh = u >> 5, h = bh & 7, b = bh >> 3;
        __syncthreads();
        for (int i = ltid(); i < 465; i += NTHR) rpbl[i] = rpbg[h * 465 + i] * LOG2E;
        const int r0 = rp * 4;
        NAInfo na; na.qr = r0 + (wave >> 1);
        const int rs0 = min(max(r0 - 4, 0), 120);
        na.kstart = min(rs0, 117);
        f32x16 o[2];
        const size_t hb = (size_t)(b * 8 + h) * NK * 64;
        attend<64, 64, true>(QD + hb, r0 * 64, KD + hb, VD + hb, na.kstart * 64, 11, SEQ, CTX / 64, o, smem, na);
        const int row = b * SEQ + r0 * 64 + wave * 32 + l31;
        bf16_t* dst = CC + (size_t)row * 1024 + 512 + h * 64;
#pragma unroll
        for (int d = 0; d < 2; ++d) store16(dst + d * 32, o[d], 1.f, hh);
    }
}

DI void cvt8(bf16_t* dst, const float* src, float sc) {
    const f32x4 a = *(const f32x4*)src, b = *(const f32x4*)(src + 4);
    u32x4 w; w.x = pk2(a[0] * sc, a[1] * sc); w.y = pk2(a[2] * sc, a[3] * sc); w.z = pk2(b[0] * sc, b[1] * sc); w.w = pk2(b[2] * sc, b[3] * sc);
    *(u32x4*)dst = w;
}
DI void cvt_rows(bf16_t* dst, int ldd, const float* src, int lds_, int rows, int cols_src, const float* rowscale, size_t gtid, size_t gstride) {
    const int c8 = ldd >> 3; const size_t n = (size_t)rows * c8;
    for (size_t i0 = gtid; i0 < n; i0 += 4 * gstride) {
        f32x4 a[4], b[4]; float sc[4];
#pragma unroll
        for (int u = 0; u < 4; ++u) {
            const size_t i = i0 + u * gstride;
            const int k = (int)(i / c8), c = (int)(i % c8) * 8;
            const bool ok = i < n && c < cols_src;
            const float* p = src + (ok ? (size_t)k * lds_ + c : 0);
            a[u] = *(const f32x4*)p; b[u] = *(const f32x4*)(p + 4);
            sc[u] = !ok ? 0.f : (rowscale ? rowscale[k] : 1.f);
        }
#pragma unroll
        for (int u = 0; u < 4; ++u) {
            const size_t i = i0 + u * gstride;
            if (i < n) {
                const int k = (int)(i / c8), c = (int)(i % c8) * 8;
                u32x4 w; w.x = pk2(a[u][0] * sc[u], a[u][1] * sc[u]); w.y = pk2(a[u][2] * sc[u], a[u][3] * sc[u]); w.z = pk2(b[u][0] * sc[u], b[u][1] * sc[u]); w.w = pk2(b[u][2] * sc[u], b[u][3] * sc[u]);
                *(u32x4*)(dst + (size_t)k * ldd + c) = w;
            }
        }
    }
}

DI void phase_pro_a(const Params& P, char* smem) {
    char* ws = P.ws;
    const size_t gtid = (size_t)lbid() * NTHR + ltid(), gstride = (size_t)gridDim.x * NTHR;
    for (int lf = 0; lf < 4; ++lf) {
        const float* sg = P.in[8] + (size_t)lf * 1024 * DFF; const float* su = P.in[9] + (size_t)lf * 1024 * DFF;
        bf16_t* dst = (bf16_t*)(ws + OFF_WGU + lf * SZ_WGU);
        for (size_t i0 = gtid; i0 < 1024ull * 704; i0 += 4 * gstride) {
            f32x4 a[4], b[4];
#pragma unroll
            for (int u = 0; u < 4; ++u) {
                const size_t i = i0 + u * gstride < 1024ull * 704 ? i0 + u * gstride : i0;
                const int k = (int)(i / 704), n = (int)(i % 704) * 8, grp = n >> 6, w = n & 63;
                const float* src = ((w < 32) ? sg : su) + (size_t)k * DFF + grp * 32 + (w & 31);
                a[u] = *(const f32x4*)src; b[u] = *(const f32x4*)(src + 4);
            }
#pragma unroll
            for (int u = 0; u < 4; ++u) {
                const size_t i = i0 + u * gstride;
                if (i < 1024ull * 704) {
                    const int k = (int)(i / 704), n = (int)(i % 704) * 8;
                    u32x4 w; w.x = pk2(a[u][0], a[u][1]); w.y = pk2(a[u][2], a[u][3]); w.z = pk2(b[u][0], b[u][1]); w.w = pk2(b[u][2], b[u][3]);
                    *(u32x4*)(dst + (size_t)k * 5632 + n) = w;
                }
            }
        }
        cvt_rows((bf16_t*)(ws + OFF_WD + lf * SZ_WD), 1024, P.in[10] + (size_t)lf * DFF * 1024, 1024, DFF, 1024, nullptr, gtid, gstride);
    }
    cvt_rows((bf16_t*)(ws + OFF_EVIN), 2048, P.in[11], 1952, 1024, 1952, nullptr, gtid, gstride);
    cvt_rows((bf16_t*)(ws + OFF_EVOUT), 1024, P.in[12], 1024, 1024, 1024, nullptr, gtid, gstride);
    cvt_rows((bf16_t*)(ws + OFF_UQ), 768, P.in[15], 768, 256, 768, P.in[13], gtid, gstride);
    cvt_rows((bf16_t*)(ws + OFF_UKV), 1024, P.in[16], 1024, 128, 1024, P.in[14], gtid, gstride);
    cvt_rows((bf16_t*)(ws + OFF_ODIN), 2048, P.in[19], 2048, 1024, 2048, nullptr, gtid, gstride);
    cvt_rows((bf16_t*)(ws + OFF_ODOUT), 1024, P.in[20], 1024, 1024, 1024, nullptr, gtid, gstride);
    for (size_t i = gtid; i < 512ull * 64; i += gstride) {
        const int k = (int)(i >> 6), n = (int)(i & 63) * 8;
        bf16_t* d = (bf16_t*)(ws + OFF_POOL) + (size_t)k * 512 + n;
        if ((k >> 7) == (n >> 7)) cvt8(d, P.in[21] + (size_t)k * 128 + (n & 127), 1.f);
        else { u32x4 z = {0u, 0u, 0u, 0u}; *(u32x4*)d = z; }
    }
    if (gtid < 128 * 8) { const int r = (int)gtid >> 3, i = (int)gtid & 7; const float inv = exp2f(-(float)i * (13.287712379549449f / 8.f)); float rev = (float)r * inv * 0.15915494309189535f; rev -= floorf(rev);
        f32x2 v = {__builtin_amdgcn_cosf(rev), __builtin_amdgcn_sinf(rev)}; ((f32x2*)(ws + OFF_TAR))[gtid] = v; if (r < 64) ((f32x2*)(ws + OFF_TAC))[gtid] = v; }
    if (gtid < 128 * 16) { const int r = (int)gtid >> 4, i = (int)gtid & 15; const float inv = exp2f(-(float)i * (13.287712379549449f / 16.f)); float rev = (float)r * inv * 0.15915494309189535f; rev -= floorf(rev);
        f32x2 v = {__builtin_amdgcn_cosf(rev), __builtin_amdgcn_sinf(rev)}; ((f32x2*)(ws + OFF_TBR))[gtid] = v; if (r < 64) ((f32x2*)(ws + OFF_TBC))[gtid] = v; }
    if (gtid == 0) {
        const float* lv = P.in[17]; float a = 0.f, b = 0.f;
        for (int i = 0; i < 64; ++i) { a += lv[i] * lv[64 + i]; b += lv[128 + i] * lv[192 + i]; }
        *(float*)(ws + OFF_LAM) = expf(a) - expf(b) + 0.2f;
    }
    float* sc = (float*)smem;
    float* red = sc + 5 * 1024;
    const int tid = ltid(), jj = tid & 31, ig = tid >> 5;
    __syncthreads();
    for (int i = tid; i < 5 * 1024; i += NTHR) { const float v = i < 4096 ? P.in[1][i] : P.in[3][i - 4096]; sc[i] = v / (1.f + expf(-v)); }
    __syncthreads();
    for (int u = lbid(); u < 576; u += gridDim.x) {
        const int l = u / 288, j0 = (u % 288) * 32;
        float a[5] = {0.f, 0.f, 0.f, 0.f, 0.f};
        const float* w = P.in[4] + (size_t)l * 1024 * 9216 + (size_t)(ig * 64) * 9216 + j0 + jj;
        for (int i0 = 0; i0 < 64; i0 += 8) {
            float wv[8];
#pragma unroll
            for (int k = 0; k < 8; ++k) wv[k] = w[(size_t)(i0 + k) * 9216];
#pragma unroll
            for (int k = 0; k < 8; ++k)
#pragma unroll
                for (int s2 = 0; s2 < 5; ++s2) a[s2] += sc[s2 * 1024 + ig * 64 + i0 + k] * wv[k];
        }
#pragma unroll
        for (int s2 = 0; s2 < 5; ++s2) red[(ig * 5 + s2) * 32 + jj] = a[s2];
        __syncthreads();
        if (tid < 160) {
            const int s2 = tid >> 5, j = tid & 31;
            float v = P.in[5][l * 9216 + j0 + j];
#pragma unroll
            for (int g = 0; g < 16; ++g) v += red[(g * 5 + s2) * 32 + j];
            ((float*)(ws + OFF_MOD))[(size_t)(l * 5 + s2) * 9216 + j0 + j] = v;
        }
        __syncthreads();
    }
}

DI void phase_pro_b(const Params& P) {
    char* ws = P.ws; bf16_t* XM = (bf16_t*)(ws + OFF_XM); const float* MOD = (const float*)(ws + OFF_MOD);
    const size_t gtid = (size_t)lbid() * NTHR + ltid(), gstride = (size_t)gridDim.x * NTHR;
    for (size_t i = gtid; i < (size_t)RT * 128; i += gstride) {
        const int row = (int)(i >> 7), c = (int)(i & 127) * 8;
        const float* src = row < RL ? P.in[0] + (size_t)row * 1024 + c : P.in[2] + (size_t)(row - RL) * 1024 + c;
        const int s = row < RL ? (row >> 13) : 4;
        const float* sh = MOD + (size_t)s * 9216 + c; const float* scl = sh + 1024;
        unsigned w[4];
#pragma unroll
        for (int hf = 0; hf < 2; ++hf) {
            const f32x4 x = *(const f32x4*)(src + 4 * hf), a = *(const f32x4*)(sh + 4 * hf), g = *(const f32x4*)(scl + 4 * hf);
            w[2 * hf] = pk2(x[0] * (1.f + g[0]) + a[0], x[1] * (1.f + g[1]) + a[1]);
            w[2 * hf + 1] = pk2(x[2] * (1.f + g[2]) + a[2], x[3] * (1.f + g[3]) + a[3]);
        }
        u32x4 o = {w[0], w[1], w[2], w[3]};
        *(u32x4*)(XM + (size_t)row * 1024 + c) = o;
    }
}

struct LnSpec { int l, which, lnext, mshift; bool final_; unsigned* cnt; const bf16_t* Y; const float* res_lat; const float* res_ctx; };
template <int NR>
DI void ln_rows(const Params& P, const LnSpec& sp, int row, int stride, int lane) {
    char* ws = P.ws; float* X = (float*)(ws + OFF_X); bf16_t* XM = (bf16_t*)(ws + OFF_XM); const float* MOD = (const float*)(ws + OFF_MOD);
    const float* g = P.in[6] + (sp.l * 3 + sp.which) * 1024; const float* bb = P.in[7] + (sp.l * 3 + sp.which) * 1024;
    f32x4 v[NR][4]; float s[NR], qv[NR];
#pragma unroll
    for (int k = 0; k < NR; ++k) {
        const int r = row + k * stride;
        const float* xp = r < RL ? sp.res_lat + (size_t)r * 1024 : sp.res_ctx + (size_t)(r - RL) * 1024;
        const bf16_t* yp = sp.Y + (size_t)r * 1024;
#pragma unroll
        for (int i = 0; i < 4; ++i) {
            const f32x4 x = *(const f32x4*)(xp + (i * 64 + lane) * 4);
            const u32x2 y = *(const u32x2*)(yp + (i * 64 + lane) * 4);
            v[k][i][0] = ALPHA * x[0] + bflo(y.x); v[k][i][1] = ALPHA * x[1] + bfhi(y.x);
            v[k][i][2] = ALPHA * x[2] + bflo(y.y); v[k][i][3] = ALPHA * x[3] + bfhi(y.y);
        }
    }
#pragma unroll
    for (int k = 0; k < NR; ++k) {
        s[k] = 0.f;
#pragma unroll
        for (int i = 0; i < 4; ++i) s[k] += (v[k][i][0] + v[k][i][1]) + (v[k][i][2] + v[k][i][3]);
    }
#pragma unroll
    for (int o = 32; o >= 1; o >>= 1)
#pragma unroll
        for (int k = 0; k < NR; ++k) s[k] += __shfl_xor(s[k], o);
#pragma unroll
    for (int k = 0; k < NR; ++k) {
        s[k] *= (1.f / 1024.f); qv[k] = 0.f;
#pragma unroll
        for (int i = 0; i < 4; ++i)
#pragma unroll
            for (int j = 0; j < 4; ++j) { const float d = v[k][i][j] - s[k]; qv[k] += d * d; }
    }
#pragma unroll
    for (int o = 32; o >= 1; o >>= 1)
#pragma unroll
        for (int k = 0; k < NR; ++k) qv[k] += __shfl_xor(qv[k], o);
#pragma unroll
    for (int k = 0; k < NR; ++k) {
        const int r = row + k * stride;
        const float mu = s[k], rstd = rsqrtf(qv[k] * (1.f / 1024.f) + 1e-6f);
        const int sidx = r < RL ? (r >> 13) : 4;
        const float* sh = MOD + (size_t)(sp.lnext * 5 + sidx) * 9216 + sp.mshift * 1024; const float* scl = sh + 1024;
        float* xp = X + (size_t)r * 1024;
#pragma unroll
        for (int i = 0; i < 4; ++i) {
            const int c = (i * 64 + lane) * 4;
            const f32x4 gg = *(const f32x4*)(g + c), b4 = *(const f32x4*)(bb + c);
            f32x4 y;
#pragma unroll
            for (int j = 0; j < 4; ++j) y[j] = (v[k][i][j] - mu) * rstd * gg[j] + b4[j];
            if (sp.final_) { *(f32x4*)(P.out + (size_t)r * 1024 + c) = y; }
            else {
                *(f32x4*)(xp + c) = y;
                const f32x4 a = *(const f32x4*)(sh + c), sg = *(const f32x4*)(scl + c);
                u32x2 w; w.x = pk2(y[0] * (1.f + sg[0]) + a[0], y[1] * (1.f + sg[1]) + a[1]); w.y = pk2(y[2] * (1.f + sg[2]) + a[2], y[3] * (1.f + sg[3]) + a[3]);
                *(u32x2*)(XM + (size_t)r * 1024 + c) = w;
            }
        }
    }
}
DI void phase_ln(const Params& P, int l, int which, int lnext, int mshift, bool final_, bool lat_only, const bf16_t* Y, bool first) {
    float* X = (float*)(P.ws + OFF_X);
    const LnSpec sp{l, which, lnext, mshift, final_, nullptr, Y, first ? P.in[0] : X, first ? P.in[2] : X + (size_t)RL * 1024};
    const int lane = ltid() & 63, wave = ltid() >> 6;
    const int nq = ((final_ || lat_only) ? RL : RT) / 4;
    for (int q = lbid() * NWAVE + wave; q < nq; q += gridDim.x * NWAVE) ln_rows<4>(P, sp, 4 * q, 1, lane);
}

DI void phase_ev_rms(const Params& P) {
    char* ws = P.ws; bf16_t* QN = (bf16_t*)(ws + OFF_HID + HOFF_QN); bf16_t* KVN = (bf16_t*)((char*)P.out + OOFF_KVN);
    const int lane = ltid() & 63, wave = ltid() >> 6;
    for (int row = lbid() * NWAVE + wave; row < RT; row += gridDim.x * NWAVE) {
        {
            u32x2* p = (u32x2*)(QN + (size_t)row * 256 + lane * 4); const u32x2 w = *p;
            float a = bflo(w.x), b = bfhi(w.x), c = bflo(w.y), d = bfhi(w.y);
            float s = a * a + b * b + c * c + d * d;
#pragma unroll
            for (int o = 32; o >= 1; o >>= 1) s += __shfl_xor(s, o);
            const float r = rsqrtf(s * (1.f / 256.f) + 1e-6f);
            u32x2 o2; o2.x = pk2(a * r, b * r); o2.y = pk2(c * r, d * r); *p = o2;
        }
        {
            unsigned* p = (unsigned*)(KVN + (size_t)row * 128 + lane * 2); const unsigned w = *p;
            float a = bflo(w), b = bfhi(w);
            float s = a * a + b * b;
#pragma unroll
            for (int o = 32; o >= 1; o >>= 1) s += __shfl_xor(s, o);
            const float r = rsqrtf(s * (1.f / 128.f) + 1e-6f);
            *p = pk2(a * r, b * r);
        }
    }
}

DI void phase_od_pool(const Params& P) {
    char* ws = P.ws; const bf16_t* U = (const bf16_t*)(ws + OFF_HID + HOFF_U); bf16_t* PL = (bf16_t*)(ws + OFF_HID + HOFF_PL);
    const size_t gtid = (size_t)lbid() * NTHR + ltid(), gstride = (size_t)gridDim.x * NTHR;
    for (size_t i = gtid; i < (size_t)RT * 64; i += gstride) {
        const int row = (int)(i >> 6), c = (int)(i & 63) * 8, grp = c >> 7;
        const int w = 2 << grp, left = w >> 1, right = w - 1 - left;
        int base, n, t;
        if (row < RL) { base = row & ~8191; n = SEQ; t = row & 8191; } else { const int rc = row - RL; base = RL + (rc & ~255); n = CTX; t = rc & 255; }
        const int lo = max(t - left, 0), hi = min(t + right + 1, n);
        float acc[8] = {0.f, 0.f, 0.f, 0.f, 0.f, 0.f, 0.f, 0.f};
        for (int tt = lo; tt < hi; ++tt) {
            const u32x4 v = *(const u32x4*)(U + (size_t)(base + tt) * 512 + c);
            acc[0] += bflo(v.x); acc[1] += bfhi(v.x); acc[2] += bflo(v.y); acc[3] += bfhi(v.y); acc[4] += bflo(v.z); acc[5] += bfhi(v.z); acc[6] += bflo(v.w); acc[7] += bfhi(v.w);
        }
        const float ic = 1.f / (float)(hi - lo);
        const u32x4 s = *(const u32x4*)(U + (size_t)row * 512 + c);
        u32x4 o;
        o.x = pk2(acc[0] * ic - bflo(s.x), acc[1] * ic - bfhi(s.x)); o.y = pk2(acc[2] * ic - bflo(s.y), acc[3] * ic - bfhi(s.y));
        o.z = pk2(acc[4] * ic - bflo(s.z), acc[5] * ic - bfhi(s.z)); o.w = pk2(acc[6] * ic - bflo(s.w), acc[7] * ic - bfhi(s.w));
        *(u32x4*)(PL + (size_t)row * 512 + c) = o;
    }
}

constexpr int NPHASE = 25;

DI void run_phase(const Params& P, int ph, char* smem) {
    char* ws = P.ws; char* hid = ws + OFF_HID; char* ob = (char*)P.out;
    float* X = (float*)(ws + OFF_X); bf16_t* XM = (bf16_t*)(ws + OFF_XM); bf16_t* HID = (bf16_t*)hid;
    const float* MOD = (const float*)(ws + OFF_MOD);
    if (ph == 0) { phase_pro_a(P, smem); return; }
    if (ph == 1) { phase_pro_b(P); return; }
    int l, op;
    if (ph < 14) { l = 0; op = ph - 2; } else { l = 1; op = ph - 14; if (op >= 6) op += 1; }
    const float* modl = MOD + (size_t)l * 5 * 9216;
    switch (op) {
    case 0: case 9: {
        const int f = op == 0 ? 0 : 1;
        EpiSwiglu e{HID};
        gemm_phase(XM, 1024, (const bf16_t*)(ws + OFF_WGU + (l * 2 + f) * SZ_WGU), 5632, 5632, 1024, e, smem, !(l == 1 && f == 1));
    } break;
    case 1: case 10: {
        const int f = op == 1 ? 0 : 1;
        EpiY e{XM, modl + (f == 0 ? 2 : 8) * 1024, 0.5f};
        gemm_phase(HID, DFF, (const bf16_t*)(ws + OFF_WD + (l * 2 + f) * SZ_WD), 1024, 1024, DFF, e, smem, !(l == 1 && f == 1));
    } break;
    case 2: phase_ln(P, l, 0, l, 3, false, false, XM, l == 0); break;
    case 3: {
        if (l == 0) {
            EpiEvIn e{(bf16_t*)(hid + HOFF_QN), (bf16_t*)(hid + HOFF_QB), (bf16_t*)(ob + OOFF_KVN), (bf16_t*)(hid + HOFF_KA), (bf16_t*)(ob + OOFF_KB), (bf16_t*)(ob + OOFF_VB),
                      (const f32x2*)(ws + OFF_TAR), (const f32x2*)(ws + OFF_TAC), (const f32x2*)(ws + OFF_TBR), (const f32x2*)(ws + OFF_TBC)};
            gemm_phase(XM, 1024, (const bf16_t*)(ws + OFF_EVIN), 2048, 2048, 1024, e, smem);
        } else {
            EpiOdIn e{(bf16_t*)(hid + HOFF_U), (bf16_t*)(hid + HOFF_QD), (bf16_t*)(hid + HOFF_KD), (bf16_t*)(hid + HOFF_VD)};
            gemm_phase(XM, 1024, (const bf16_t*)(ws + OFF_ODIN), 2048, 2048, 1024, e, smem);
        }
    } break;
    case 4: if (l == 0) phase_ev_rms(P); else phase_od_pool(P); break;
    case 5: {
        if (l == 0) {
            EpiUQ e1{(bf16_t*)(hid + HOFF_QA), (const f32x2*)(ws + OFF_TAR), (const f32x2*)(ws + OFF_TAC)};
            gemm_phase((const bf16_t*)(hid + HOFF_QN), 256, (const bf16_t*)(ws + OFF_UQ), 768, 768, 256, e1, smem);
            EpiUKV e2{(bf16_t*)(hid + HOFF_KA), (bf16_t*)(hid + HOFF_VA)};
            gemm_phase((const bf16_t*)(ob + OOFF_KVN), 128, (const bf16_t*)(ws + OFF_UKV), 1024, 1024, 128, e2, smem);
        } else {
            odd_attention_phase(P, smem);
            EpiPool e{XM, P.in[22], 0};
            gemm_phase((const bf16_t*)(hid + HOFF_PL), 512, (const bf16_t*)(ws + OFF_POOL), 512, 512, 512, e, smem);
        }
    } break;
    case 6: even_attention_phase(P, smem); break;
    case 7: {
        EpiY e{HID, modl + 5 * 1024, 1.f};
        gemm_phase(XM, 1024, (const bf16_t*)(ws + (l == 0 ? OFF_EVOUT : OFF_ODOUT)), 1024, 1024, 1024, e, smem, l == 0);
    } break;
    case 8: phase_ln(P, l, 1, l, 6, false, l == 1, HID, false); break;
    case 11: if (l == 0) phase_ln(P, 0, 2, 1, 0, false, false, XM, false); else phase_ln(P, 1, 2, 1, 0, true, true, XM, false); break;
    default: break;
    }
}

DI void grid_barrier(unsigned* ctr, unsigned target) {
    __syncthreads();
    if (threadIdx.x == 0) {
        __builtin_amdgcn_fence(__ATOMIC_RELEASE, "agent");
        __hip_atomic_fetch_add(ctr, 1u, __ATOMIC_RELAXED, __HIP_MEMORY_SCOPE_AGENT);
        while (__hip_atomic_load(ctr, __ATOMIC_RELAXED, __HIP_MEMORY_SCOPE_AGENT) < target) __builtin_amdgcn_s_sleep(2);
        __builtin_amdgcn_fence(__ATOMIC_ACQUIRE, "agent");
    }
    __syncthreads();
}

__global__ void __launch_bounds__(NTHR, 2) mega(Params P, int ph_lo, int ph_hi) {
    extern __shared__ __attribute__((aligned(16))) char smem[];
    unsigned nsync = 0;
    for (int ph = ph_lo; ph < ph_hi; ++ph) {
        run_phase(P, ph, smem);
        if (ph + 1 < ph_hi) {
            if (ph == ph_lo) cg::this_grid().sync();
            else { ++nsync; grid_barrier((unsigned*)(P.ws + OFF_BAR), nsync * gridDim.x); }
        }
    }
}

extern "C" void kernel_launch(void* const* d_in, const int* in_sizes, int n_in, void* d_out, int out_size, void* d_ws, size_t ws_size, hipStream_t stream) {
    if (ws_size < WS_NEED) { fprintf(stderr, "workspace too small: %zu < %zu\n", ws_size, (size_t)WS_NEED); return; }
    Params P{};
    for (int i = 0; i < 24; ++i) P.in[i] = (const float*)d_in[i];
    P.out = (float*)d_out; P.ws = (char*)d_ws;
    static int grid_blocks = 0;
    if (!grid_blocks) {
        int dev = 0, cus = 0, per_cu = 0;
        hipGetDevice(&dev);
        hipDeviceGetAttribute(&cus, hipDeviceAttributeMultiprocessorCount, dev);
        hipFuncSetAttribute((const void*)mega, hipFuncAttributeMaxDynamicSharedMemorySize, SMEM_BYTES);
        hipOccupancyMaxActiveBlocksPerMultiprocessor(&per_cu, mega, NTHR, SMEM_BYTES);
        if (per_cu < 1) per_cu = 1;
        if (per_cu > 1) per_cu = 1;
        grid_blocks = cus * per_cu;
    }
#if COOP
    hipMemsetAsync((char*)d_ws + OFF_BAR, 0, 256, stream);
    int lo = 0, hi = NPHASE;
    void* args[] = {&P, &lo, &hi};
    hipError_t e = hipLaunchCooperativeKernel((void*)mega, dim3(grid_blocks), dim3(NTHR), args, SMEM_BYTES, stream);
    if (e != hipSuccess) fprintf(stderr, "cooperative launch failed: %s (grid %d)\n", hipGetErrorString(e), grid_blocks);
#else
    for (int ph = 0; ph < NPHASE; ++ph) mega<<<grid_blocks, NTHR, SMEM_BYTES, stream>>>(P, ph, ph + 1);
#endif
}
```

```cpp
#include <hip/hip_runtime.h>
#include <hip/hip_cooperative_groups.h>
#include <cstdio>
#include <cstdint>
namespace cg = cooperative_groups;

#ifndef COOP
#define COOP 1
#endif

#define DI __device__ __forceinline__
typedef unsigned short bf16_t;
typedef short bf16x8 __attribute__((ext_vector_type(8)));
typedef short s16x4 __attribute__((ext_vector_type(4)));
typedef __bf16 bfx4 __attribute__((ext_vector_type(4)));
typedef __bf16 bfx2 __attribute__((ext_vector_type(2)));
typedef float f32x2 __attribute__((ext_vector_type(2)));
typedef float f32x4 __attribute__((ext_vector_type(4)));
typedef float f32x16 __attribute__((ext_vector_type(16)));
typedef unsigned u32x2 __attribute__((ext_vector_type(2)));
typedef unsigned u32x4 __attribute__((ext_vector_type(4)));
#define LDS_AS __attribute__((address_space(3)))

constexpr int DM = 1024, NB = 4, SEQ = 8192, CTX = 256, DFF = 2816;
constexpr int RL = NB * SEQ, RC = NB * CTX, RT = RL + RC;
constexpr int NK = SEQ + CTX;
constexpr float ALPHA = 1.41421356237f;
constexpr float LOG2E = 1.4426950408889634f;
constexpr float QA_SCALE = 0.10206207261596575f * LOG2E;
constexpr float QB_SCALE = 0.125f * LOG2E;
constexpr float QD_SCALE = 0.125f * LOG2E;
constexpr int NTHR = 512, NWAVE = NTHR / 64;

constexpr size_t SZ_WGU = 1024ull * 5632 * 2, SZ_WD = 2816ull * 1024 * 2;
constexpr size_t OFF_WGU = 0;
constexpr size_t OFF_WD = OFF_WGU + 4 * SZ_WGU;
constexpr size_t OFF_EVIN = OFF_WD + 4 * SZ_WD;
constexpr size_t OFF_EVOUT = OFF_EVIN + 1024ull * 2048 * 2;
constexpr size_t OFF_UQ = OFF_EVOUT + 1024ull * 1024 * 2;
constexpr size_t OFF_UKV = OFF_UQ + 256ull * 768 * 2;
constexpr size_t OFF_ODIN = OFF_UKV + 128ull * 1024 * 2;
constexpr size_t OFF_ODOUT = OFF_ODIN + 1024ull * 2048 * 2;
constexpr size_t OFF_POOL = OFF_ODOUT + 1024ull * 1024 * 2;
constexpr size_t OFF_MOD = OFF_POOL + 512ull * 512 * 2;
constexpr size_t OFF_TAR = OFF_MOD + 2ull * 5 * 9216 * 4;
constexpr size_t OFF_TAC = OFF_TAR + 128 * 8 * 8;
constexpr size_t OFF_TBR = OFF_TAC + 64 * 8 * 8;
constexpr size_t OFF_TBC = OFF_TBR + 128 * 16 * 8;
constexpr size_t OFF_LAM = OFF_TBC + 64 * 16 * 8;
constexpr size_t OFF_BAR = OFF_LAM + 256;
constexpr size_t OFF_X = OFF_BAR + 256;
constexpr size_t OFF_XM = OFF_X + (size_t)RT * 1024 * 4;
constexpr size_t OFF_HID = OFF_XM + (size_t)RT * 1024 * 2;
constexpr size_t WS_NEED = OFF_HID + (size_t)RT * DFF * 2;
constexpr size_t SZ_H96 = (size_t)NB * 8 * NK * 96 * 2, SZ_H64 = (size_t)NB * 8 * NK * 64 * 2;
constexpr size_t HOFF_QA = 0, HOFF_KA = SZ_H96, HOFF_VA = 2 * SZ_H96, HOFF_QB = HOFF_VA + SZ_H64, HOFF_QN = HOFF_QB + SZ_H64;
static_assert(HOFF_QN + (size_t)RT * 256 * 2 <= (size_t)RT * DFF * 2, "HID region overflow");
constexpr size_t HOFF_U = 0, HOFF_PL = SZ_H64, HOFF_QD = 2 * SZ_H64, HOFF_KD = 3 * SZ_H64, HOFF_VD = 4 * SZ_H64;
constexpr size_t OOFF_KB = 0, OOFF_VB = SZ_H64, OOFF_KVN = 2 * SZ_H64;
static_assert(OOFF_KVN + (size_t)RT * 128 * 2 <= (size_t)RL * 1024 * 4, "d_out region overflow");

struct Params {
    const float* in[24];
    float* out;
    char* ws;
};

DI int ltid() { int t = threadIdx.x; asm volatile("" : "+v"(t)); return t; }
DI int lbid() { int t = blockIdx.x; asm volatile("" : "+s"(t)); return t; }
DI unsigned pk2(float a, float b) { f32x2 v = {a, b}; bfx2 r = __builtin_convertvector(v, bfx2); return __builtin_bit_cast(unsigned, r); }
DI float bf2f(unsigned short u) { return __uint_as_float(((unsigned)u) << 16); }
DI float bflo(unsigned u) { return __uint_as_float(u << 16); }
DI float bfhi(unsigned u) { return __uint_as_float(u & 0xffff0000u); }
DI float silu_f(float x) { return x * __builtin_amdgcn_rcpf(1.f + __expf(-x)); }
DI f32x16 mfma32(bf16x8 a, bf16x8 b, f32x16 c) { return __builtin_amdgcn_mfma_f32_32x32x16_bf16(a, b, c, 0, 0, 0); }
DI s16x4 tr_read(const char* p) { bfx4 r = __builtin_amdgcn_ds_read_tr16_b64_v4bf16((LDS_AS bfx4*)p); return __builtin_bit_cast(s16x4, r); }
DI float xor32_max(float x) { const unsigned u = __float_as_uint(x); auto r = __builtin_amdgcn_permlane32_swap(u, u, false, false); return fmaxf(__uint_as_float(r[0]), __uint_as_float(r[1])); }
DI float xor32_sum(float x) { const unsigned u = __float_as_uint(x); auto r = __builtin_amdgcn_permlane32_swap(u, u, false, false); return __uint_as_float(r[0]) + __uint_as_float(r[1]); }
DI bf16x8 cat8(s16x4 lo, s16x4 hi) { return __builtin_shufflevector(lo, hi, 0, 1, 2, 3, 4, 5, 6, 7); }

struct RowInfo { int b, j, s; bool lat; };
DI RowInfo rowinfo(int row) {
    RowInfo r;
    if (row < RL) { r.b = row >> 13; r.j = row & 8191; r.s = r.b; r.lat = true; }
    else { int rc = row - RL; r.b = rc >> 8; r.j = 8192 + (rc & 255); r.s = 4; r.lat = false; }
    return r;
}
DI void store16(bf16_t* dst32, const f32x16& v, float sc, int hh) {
#pragma unroll
    for (int q4 = 0; q4 < 4; ++q4) {
        u32x2 w; w.x = pk2(v[4 * q4] * sc, v[4 * q4 + 1] * sc); w.y = pk2(v[4 * q4 + 2] * sc, v[4 * q4 + 3] * sc);
        *(u32x2*)(dst32 + 8 * q4 + 4 * hh) = w;
    }
}
DI f32x16 ropeB(const f32x16& v, const f32x2* tab, int hh) {
    f32x16 o;
#pragma unroll
    for (int r = 0; r < 8; ++r) {
        const int i = (r & 3) + 8 * (r >> 2) + 4 * hh;
        const f32x2 cs = tab[i];
        o[r] = v[r] * cs.x - v[r + 8] * cs.y;
        o[r + 8] = v[r + 8] * cs.x + v[r] * cs.y;
    }
    return o;
}
DI f32x16 ropeA(const f32x16& v, const f32x2* tr, const f32x2* tc, int hh) {
    f32x16 o;
#pragma unroll
    for (int r = 0; r < 4; ++r) {
        const int i = 4 * hh + r;
        const f32x2 a = tr[i], c = tc[i];
        o[r] = v[r] * a.x - v[r + 4] * a.y;
        o[r + 4] = v[r + 4] * a.x + v[r] * a.y;
        o[8 + r] = v[8 + r] * c.x - v[12 + r] * c.y;
        o[12 + r] = v[12 + r] * c.x + v[8 + r] * c.y;
    }
    return o;
}

constexpr int GA_S = 144, GB_S = 576;
constexpr int GSTAGE = 256 * GA_S + 64 * GB_S;
constexpr int GEMM_LDS = 2 * GSTAGE;

template <int BM, class Epi>
DI void gemm_tile(const bf16_t* __restrict__ A, int lda, const bf16_t* __restrict__ B, int ldb, int K, int row0, int col0, const Epi& epi, char* smem) {
    constexpr int MI = BM / 64, NA_ = BM / 64;
    const int tid = ltid(), lane = tid & 63, wave = tid >> 6, wm = wave >> 2, wn = wave & 3;
    const int l31 = lane & 31, hh = lane >> 5, q = (lane & 15) >> 2, p = lane & 3, nblk = (lane >> 4) & 1;
    f32x16 acc[MI][2];
#pragma unroll
    for (int i = 0; i < MI; ++i)
#pragma unroll
        for (int j = 0; j < 2; ++j)
#pragma unroll
            for (int r = 0; r < 16; ++r) acc[i][j][r] = 0.f;
    u32x4 ra[NA_], rb[4];
    const bf16_t* ag = A + (size_t)(row0 + (tid >> 3)) * lda + (tid & 7) * 8;
    const bf16_t* bg = B + (size_t)(tid >> 5) * ldb + col0 + (tid & 31) * 8;
    const int aw = (tid >> 3) * GA_S + (tid & 7) * 16, bw = BM * GA_S + (tid >> 5) * GB_S + (tid & 31) * 16;
    const int nk = K >> 6;
    const int xoff = (wm * (BM / 2) + l31) * GA_S + hh * 16;
    const int woff = BM * GA_S + (hh * 8 + q) * GB_S + (wn * 64 + nblk * 16 + 4 * p) * 2;
#pragma unroll
    for (int i = 0; i < NA_; ++i) ra[i] = *(const u32x4*)(ag + (size_t)(64 * i) * lda);
#pragma unroll
    for (int i = 0; i < 4; ++i) rb[i] = *(const u32x4*)(bg + (size_t)(16 * i) * ldb);
    __syncthreads();
#pragma unroll
    for (int i = 0; i < NA_; ++i) *(u32x4*)(smem + aw + 64 * i * GA_S) = ra[i];
#pragma unroll
    for (int i = 0; i < 4; ++i) *(u32x4*)(smem + bw + 16 * i * GB_S) = rb[i];
    if (nk > 1) {
#pragma unroll
        for (int i = 0; i < NA_; ++i) ra[i] = *(const u32x4*)(ag + 64 + (size_t)(64 * i) * lda);
#pragma unroll
        for (int i = 0; i < 4; ++i) rb[i] = *(const u32x4*)(bg + (size_t)(64 + 16 * i) * ldb);
    }
    __syncthreads();
    for (int kt = 0; kt < nk; ++kt) {
        const char* cur = smem + (kt & 1) * GSTAGE;
        char* nxt = smem + ((kt & 1) ^ 1) * GSTAGE;
        const bool w1 = kt + 1 < nk, l2 = kt + 2 < nk;
        const bf16_t* a2 = ag + (size_t)(kt + 2) * 64; const bf16_t* b2 = bg + (size_t)(kt + 2) * 64 * ldb;
#pragma unroll
        for (int s = 0; s < 4; ++s) {
            bf16x8 xf[MI], wf[2];
#pragma unroll
            for (int mi = 0; mi < MI; ++mi) xf[mi] = *(const bf16x8*)(cur + xoff + mi * 32 * GA_S + s * 32);
#pragma unroll
            for (int ni = 0; ni < 2; ++ni) {
                const char* wp = cur + woff + s * 16 * GB_S + ni * 64;
                wf[ni] = cat8(tr_read(wp), tr_read(wp + 4 * GB_S));
            }
#pragma unroll
            for (int mi = 0; mi < MI; ++mi)
#pragma unroll
                for (int ni = 0; ni < 2; ++ni) acc[mi][ni] = mfma32(wf[ni], xf[mi], acc[mi][ni]);
            if (w1) {
                if (s < NA_) *(u32x4*)(nxt + aw + 64 * s * GA_S) = ra[s];
                *(u32x4*)(nxt + bw + 16 * s * GB_S) = rb[s];
            }
            if (l2) {
                if (s < NA_) ra[s] = *(const u32x4*)(a2 + (size_t)(64 * s) * lda);
                rb[s] = *(const u32x4*)(b2 + (size_t)(16 * s) * ldb);
            }
        }
        __syncthreads();
    }
#pragma unroll
    for (int mi = 0; mi < MI; ++mi) epi(acc[mi][0], acc[mi][1], row0 + wm * (BM / 2) + mi * 32 + l31, col0 + wn * 64, hh);
}

template <class Epi>
DI void gemm_phase(const bf16_t* A, int lda, const bf16_t* B, int ldb, int N, int K, const Epi& epi, char* smem, bool do_ctx = true) {
    const int nt = N >> 8, small = do_ctx ? (RC / 128) * nt : 0;
    const int bid = lbid(), G = gridDim.x;
    if ((G & 7) == 0) {
        const int xcd = bid & 7, loc = bid >> 3, per = G >> 3, mine = (RL / 256 / 8) * nt;
        for (int i = loc; i < mine; i += per) {
            const int cg = i >> 7, rem = i & 127, cw = min(8, nt - cg * 8);
            int pg, w;
            if (cw == 8) { pg = rem >> 5; w = rem & 31; } else { const int rr = i - cg * 128; pg = rr / (4 * cw); w = rr - pg * 4 * cw; }
            const int pl = pg * 4 + (w & 3), cl = cg * 8 + (w >> 2);
            gemm_tile<256>(A, lda, B, ldb, K, (pl * 8 + xcd) * 256, cl * 256, epi, smem);
        }
    } else {
        const int big = (RL / 256) * nt;
        for (int t = bid; t < big; t += G) gemm_tile<256>(A, lda, B, ldb, K, (t / nt) * 256, (t % nt) * 256, epi, smem);
    }
    for (int u = bid; u < small; u += G) gemm_tile<128>(A, lda, B, ldb, K, RL + (u / nt) * 128, (u % nt) * 256, epi, smem);
}

struct EpiSwiglu {
    bf16_t* hid;
    DI void operator()(const f32x16& a0, const f32x16& a1, int row, int cbase, int hh) const {
        bf16_t* dst = hid + (size_t)row * DFF + (cbase >> 1) + 4 * hh;
#pragma unroll
        for (int q4 = 0; q4 < 4; ++q4) {
            float h[4];
#pragma unroll
            for (int j = 0; j < 4; ++j) h[j] = silu_f(a0[4 * q4 + j]) * a1[4 * q4 + j];
            u32x2 w; w.x = pk2(h[0], h[1]); w.y = pk2(h[2], h[3]);
            *(u32x2*)(dst + 8 * q4) = w;
        }
    }
};
struct EpiResid {
    const float* res_lat; const float* res_ctx; float* X; const float* gate; float coef;
    DI void operator()(const f32x16& a0, const f32x16& a1, int row, int cbase, int hh) const {
        const int s = row < RL ? (row >> 13) : 4;
        const float* rp = row < RL ? res_lat + (size_t)row * 1024 : res_ctx + (size_t)(row - RL) * 1024;
        const float* gp = gate + s * 9216;
        float* xp = X + (size_t)row * 1024;
#pragma unroll
        for (int ni = 0; ni < 2; ++ni)
#pragma unroll
            for (int q4 = 0; q4 < 4; ++q4) {
                const int c = cbase + ni * 32 + 8 * q4 + 4 * hh;
                const f32x4 r = *(const f32x4*)(rp + c), g = *(const f32x4*)(gp + c);
                f32x4 z;
#pragma unroll
                for (int j = 0; j < 4; ++j) z[j] = ALPHA * r[j] + coef * g[j] * (ni ? a1[4 * q4 + j] : a0[4 * q4 + j]);
                *(f32x4*)(xp + c) = z;
            }
    }
};
struct EpiY {
    static constexpr bool kSwap = false;
    bf16_t* Y; const float* gate; float coef;
    DI void operator()(const f32x16& a0, const f32x16& a1, int row, int cbase, int hh) const {
        const int s = row < RL ? (row >> 13) : 4;
        const float* gp = gate + s * 9216;
        bf16_t* yp = Y + (size_t)row * 1024;
#pragma unroll
        for (int ni = 0; ni < 2; ++ni)
#pragma unroll
            for (int q4 = 0; q4 < 4; ++q4) {
                const int c = cbase + ni * 32 + 8 * q4 + 4 * hh;
                const f32x4 g = *(const f32x4*)(gp + c);
                const f32x16& v = ni ? a1 : a0;
                u32x2 w; w.x = pk2(coef * g[0] * v[4 * q4], coef * g[1] * v[4 * q4 + 1]); w.y = pk2(coef * g[2] * v[4 * q4 + 2], coef * g[3] * v[4 * q4 + 3]);
                *(u32x2*)(yp + c) = w;
            }
    }
};
struct EpiEvIn {
    bf16_t *QN, *QB, *KVN, *KA, *KB, *VB; const f32x2 *tAr, *tAc, *tBr, *tBc;
    DI void operator()(const f32x16& a0, const f32x16& a1, int row, int cbase, int hh) const {
        const RowInfo ri = rowinfo(row);
        const int gr = (ri.j >> 6) & 127, gc = ri.j & 63;
#pragma unroll
        for (int ni = 0; ni < 2; ++ni) {
            const int g = (cbase >> 5) + ni;
            const f32x16& v = ni ? a1 : a0;
            if (g < 8) store16(QN + (size_t)row * 256 + g * 32, v, 1.f, hh);
            else if (g < 24) {
                const int hv = (g - 8) >> 1, half = (g - 8) & 1;
                f32x16 w = v; if (ri.lat) w = ropeB(v, half ? tBc + gc * 16 : tBr + gr * 16, hh);
                store16(QB + ((size_t)(ri.b * 8 + hv) * NK + ri.j) * 64 + half * 32, w, QB_SCALE, hh);
            } else if (g < 28) store16(KVN + (size_t)row * 128 + (g - 24) * 32, v, 1.f, hh);
            else if (g == 28) {
                f32x16 w = v; if (ri.lat) w = ropeA(v, tAr + gr * 8, tAc + gc * 8, hh);
                for (int h = 0; h < 8; ++h) store16(KA + ((size_t)(ri.b * 8 + h) * NK + ri.j) * 96 + 64, w, 1.f, hh);
            } else if (g < 45) {
                const int hv = (g - 29) >> 1, half = (g - 29) & 1;
                f32x16 w = v; if (ri.lat) w = ropeB(v, half ? tBc + gc * 16 : tBr + gr * 16, hh);
                store16(KB + ((size_t)(ri.b * 8 + hv) * NK + ri.j) * 64 + half * 32, w, 1.f, hh);
            } else if (g < 61) {
                const int idx = g - 45, h = idx >> 2, part = idx & 3;
                store16(VB + ((size_t)(ri.b * 4 + h) * NK + ri.j) * 128 + part * 32, v, 1.f, hh);
            }
        }
    }
};
struct EpiUQ {
    bf16_t* QA; const f32x2 *tAr, *tAc;
    DI void operator()(const f32x16& a0, const f32x16& a1, int row, int cbase, int hh) const {
        const RowInfo ri = rowinfo(row);
        const int gr = (ri.j >> 6) & 127, gc = ri.j & 63;
#pragma unroll
        for (int ni = 0; ni < 2; ++ni) {
            const int g = (cbase >> 5) + ni, h = g / 3, part = g - 3 * h;
            f32x16 w = ni ? a1 : a0;
            if (part == 2 && ri.lat) w = ropeA(ni ? a1 : a0, tAr + gr * 8, tAc + gc * 8, hh);
            store16(QA + ((size_t)(ri.b * 8 + h) * NK + ri.j) * 96 + part * 32, w, QA_SCALE, hh);
        }
    }
};
struct EpiUKV {
    bf16_t *KA, *VA;
    DI void operator()(const f32x16& a0, const f32x16& a1, int row, int cbase, int hh) const {
        const RowInfo ri = rowinfo(row);
#pragma unroll
        for (int ni = 0; ni < 2; ++ni) {
            const int g = (cbase >> 5) + ni, h = g >> 2, part = g & 3;
            const size_t tk = (size_t)(ri.b * 8 + h) * NK + ri.j;
            if (part < 2) store16(KA + tk * 96 + part * 32, ni ? a1 : a0, 1.f, hh);
            else store16(VA + tk * 64 + (part - 2) * 32, ni ? a1 : a0, 1.f, hh);
        }
    }
};
struct EpiOdIn {
    bf16_t *U, *QD, *KD, *VD;
    DI void operator()(const f32x16& a0, const f32x16& a1, int row, int cbase, int hh) const {
        const RowInfo ri = rowinfo(row);
#pragma unroll
        for (int ni = 0; ni < 2; ++ni) {
            const int g = (cbase >> 5) + ni;
            const f32x16& v = ni ? a1 : a0;
            if (g < 16) store16(U + (size_t)row * 512 + g * 32, v, 1.f, hh);
            else {
                const int gg = (g - 16) & 15, h = gg >> 1, half = gg & 1;
                const size_t off = ((size_t)(ri.b * 8 + h) * NK + ri.j) * 64 + half * 32;
                if (g < 32) store16(QD + off, v, QD_SCALE, hh);
                else if (g < 48) store16(KD + off, v, 1.f, hh);
                else store16(VD + off, v, 1.f, hh);
            }
        }
    }
};
struct EpiPool {
    bf16_t* CC; const float* pscale; int gidx;
    DI void operator()(const f32x16& a0, const f32x16& a1, int row, int cbase, int hh) const {
#pragma unroll
        for (int ni = 0; ni < 2; ++ni)
#pragma unroll
            for (int q4 = 0; q4 < 4; ++q4) {
                const int c = gidx * 128 + cbase + ni * 32 + 8 * q4 + 4 * hh;
                const f32x4 s = *(const f32x4*)(pscale + c);
                const f32x16& v = ni ? a1 : a0;
                u32x2 w; w.x = pk2(v[4 * q4] * s[0], v[4 * q4 + 1] * s[1]); w.y = pk2(v[4 * q4 + 2] * s[2], v[4 * q4 + 3] * s[3]);
                *(u32x2*)(CC + (size_t)row * 1024 + c) = w;
            }
    }
};

constexpr int ATT_LDS = 64 * (96 + 8) * 2 + 64 * (128 * 2 + 64);
constexpr int RPB_OFF = 2 * ATT_LDS;
constexpr int SMEM_BYTES = GEMM_LDS;

struct NAInfo { int qr; int kstart; };

template <int DQK, int DV, bool NA>
DI void attend(const bf16_t* __restrict__ Q, int q0, const bf16_t* __restrict__ Kb, const bf16_t* __restrict__ Vb,
               int s0, int n0, int s1, int n1, f32x16 (&o)[DV / 32], char* smem, NAInfo na) {
    constexpr int KS = (DQK + 8) * 2, VS = DV * 2 + 64;
    constexpr int KCH = DQK / 8, KN = (64 * KCH + NTHR - 1) / NTHR, VCH = DV / 8, VN = (64 * VCH + NTHR - 1) / NTHR;
    constexpr int NS = DQK / 16, NDT = DV / 32;
    const int tid = ltid(), lane = tid & 63, wave = tid >> 6;
    const int l31 = lane & 31, hh = lane >> 5, q = (lane & 15) >> 2, p = lane & 3, dblk = (lane >> 4) & 1;
    bf16x8 qf[NS];
    {
        const bf16_t* qp = Q + (size_t)(q0 + wave * 32 + l31) * DQK + hh * 8;
#pragma unroll
        for (int s = 0; s < NS; ++s) qf[s] = *(const bf16x8*)(qp + s * 16);
    }
#pragma unroll
    for (int d = 0; d < NDT; ++d)
#pragma unroll
        for (int r = 0; r < 16; ++r) o[d][r] = 0.f;
    float m = NA ? -INFINITY : 0.f, l = 0.f;
    f32x16 cinit;
#pragma unroll
    for (int r = 0; r < 16; ++r) cinit[r] = 0.f;
    u32x4 rk[KN], rv[VN];
    const int nt = n0 + n1;
    auto gload = [&](int t) {
        const int j0 = t < n0 ? s0 + t * 64 : s1 + (t - n0) * 64;
#pragma unroll
        for (int i = 0; i < KN; ++i) { int id = tid + NTHR * i; if (id >= 64 * KCH) id -= 64 * KCH; const int row = id / KCH, ch = id - row * KCH; rk[i] = *(const u32x4*)(Kb + (size_t)(j0 + row) * DQK + ch * 8); }
#pragma unroll
        for (int i = 0; i < VN; ++i) { int id = tid + NTHR * i; if (id >= 64 * VCH) id -= 64 * VCH; const int row = id / VCH, ch = id - row * VCH; rv[i] = *(const u32x4*)(Vb + (size_t)(j0 + row) * DV + ch * 8); }
    };
    gload(0);
    int qc = 0, cs = 0, rs = 0;
    if (NA) { qc = (wave & 1) * 32 + l31; cs = min(max(qc - 8, 0), 48); rs = min(max(na.qr - 4, 0), 120); }
    const float* rpb = (const float*)(smem + RPB_OFF);
    auto lwrite = [&](char* stg) {
#pragma unroll
        for (int i = 0; i < KN; ++i) { int id = tid + NTHR * i; if (id >= 64 * KCH) id -= 64 * KCH; const int row = id / KCH, ch = id - row * KCH; *(u32x4*)(stg + row * KS + ch * 16) = rk[i]; }
#pragma unroll
        for (int i = 0; i < VN; ++i) { int id = tid + NTHR * i; if (id >= 64 * VCH) id -= 64 * VCH; const int row = id / VCH, ch = id - row * VCH; *(u32x4*)(stg + 64 * KS + row * VS + ch * 16) = rv[i]; }
    };
    __syncthreads();
    lwrite(smem);
    if (nt > 1) gload(1);
    __syncthreads();
    for (int t = 0; t < nt; ++t) {
        const char* sK = smem + (t & 1) * ATT_LDS; const char* sV = sK + 64 * KS;
        bool active = true; int kr = 0;
        if (NA && t < n0) { kr = na.kstart + t; active = (kr >= rs) && (kr < rs + 8); }
        if (active) {
#pragma unroll
            for (int sub = 0; sub < 2; ++sub) {
                f32x16 st;
                if (NA) {
#pragma unroll
                    for (int r = 0; r < 16; ++r) st[r] = 0.f;
                } else st = cinit;
                {
                    bf16x8 kf[NS];
#pragma unroll
                    for (int s = 0; s < NS; ++s) kf[s] = *(const bf16x8*)(sK + (sub * 32 + l31) * KS + (s * 16 + hh * 8) * 2);
                    __builtin_amdgcn_sched_barrier(0);
#pragma unroll
                    for (int s = 0; s < NS; ++s) st = mfma32(kf[s], qf[s], st);
                }
                if (NA && t < n0) {
                    const float* brow = rpb + (kr - na.qr + 7) * 31 + 15 - qc;
#pragma unroll
                    for (int r = 0; r < 16; ++r) {
                        const int kc = sub * 32 + (r & 3) + 8 * (r >> 2) + 4 * hh;
                        const bool valid = (kc >= cs) && (kc < cs + 16);
                        const int bi = valid ? kc : cs;
                        const float bias = brow[bi];
                        st[r] = valid ? st[r] + bias : -INFINITY;
                    }
                }
                float mx = st[0];
#pragma unroll
                for (int r = 1; r < 16; ++r) mx = fmaxf(mx, st[r]);
                mx = xor32_max(mx);
                float rsum = 0.f;
                if (NA) {
                    const float mnew = fmaxf(m, mx);
                    const float muse = (mnew == -INFINITY) ? 0.f : mnew;
                    const float alpha = __builtin_amdgcn_exp2f(m - muse);
                    m = mnew;
                    l *= alpha;
#pragma unroll
                    for (int d = 0; d < NDT; ++d)
#pragma unroll
                        for (int r = 0; r < 16; ++r) o[d][r] *= alpha;
#pragma unroll
                    for (int r = 0; r < 16; ++r) { st[r] = __builtin_amdgcn_exp2f(st[r] - muse); rsum += st[r]; }
                } else {
                    const bool first = (t == 0) && (sub == 0);
                    if (first || __builtin_amdgcn_ballot_w64(mx > 8.f) != 0) {
                        const float delta = first ? mx : fmaxf(mx, 0.f);
                        const float alpha = first ? 1.f : __builtin_amdgcn_exp2f(-delta);
                        m += delta;
                        l *= alpha;
#pragma unroll
                        for (int d = 0; d < NDT; ++d)
#pragma unroll
                            for (int r = 0; r < 16; ++r) o[d][r] *= alpha;
#pragma unroll
                        for (int r = 0; r < 16; ++r) { st[r] -= delta; cinit[r] = -m; }
                    }
#pragma unroll
                    for (int r = 0; r < 16; ++r) { st[r] = __builtin_amdgcn_exp2f(st[r]); rsum += st[r]; }
                }
                l += rsum;
                bf16x8 pf[2];
#pragma unroll
                for (int s2 = 0; s2 < 2; ++s2) {
                    u32x4 w;
                    w.x = pk2(st[8 * s2], st[8 * s2 + 1]); w.y = pk2(st[8 * s2 + 2], st[8 * s2 + 3]);
                    w.z = pk2(st[8 * s2 + 4], st[8 * s2 + 5]); w.w = pk2(st[8 * s2 + 6], st[8 * s2 + 7]);
                    pf[s2] = __builtin_bit_cast(bf16x8, w);
                }
#pragma unroll
                for (int d = 0; d < NDT; ++d)
#pragma unroll
                    for (int s2 = 0; s2 < 2; ++s2) {
                        const char* vp = sV + (sub * 32 + 16 * s2 + 4 * hh + q) * VS + (d * 32 + dblk * 16 + 4 * p) * 2;
                        const bf16x8 vf = cat8(tr_read(vp), tr_read(vp + 8 * VS));
                        o[d] = mfma32(vf, pf[s2], o[d]);
                    }
            }
        }
        if (t + 1 < nt) lwrite(smem + ((t & 1) ^ 1) * ATT_LDS);
        if (t + 2 < nt) gload(t + 2);
        __syncthreads();
    }
    l = xor32_sum(l);
    const float inv = 1.f / l;
#pragma unroll
    for (int d = 0; d < NDT; ++d)
#pragma unroll
        for (int r = 0; r < 16; ++r) o[d][r] *= inv;
}

DI int qrow_of(int b, int j) { return j < SEQ ? b * SEQ + j : RL + b * CTX + (j - SEQ); }

DI void even_attention_phase(const Params& P, char* smem) {
    char* ws = P.ws; char* hid = ws + OFF_HID; char* ob = (char*)P.out;
    const bf16_t* QA = (const bf16_t*)(hid + HOFF_QA); const bf16_t* KA = (const bf16_t*)(hid + HOFF_KA); const bf16_t* VA = (const bf16_t*)(hid + HOFF_VA);
    const bf16_t* QB = (const bf16_t*)(hid + HOFF_QB); const bf16_t* KB = (const bf16_t*)(ob + OOFF_KB); const bf16_t* VB = (const bf16_t*)(ob + OOFF_VB);
    bf16_t* CC = (bf16_t*)(ws + OFF_XM);
    const float lam = *(const float*)(ws + OFF_LAM);
    const float* gsub = P.in[18];
    const int lane = ltid() & 63, wave = ltid() >> 6, l31 = lane & 31, hh = lane >> 5;
    constexpr int NQT = 33, NDIFF = NB * 4 * NQT, NMLA = NB * 8 * NQT;
    NAInfo na; na.qr = 0; na.kstart = 0;
    unsigned* wq = (unsigned*)(ws + OFF_BAR + 128);
    volatile int* slot = (volatile int*)(smem + 2 * ATT_LDS + 2048);
    for (;;) {
        __syncthreads();
        if (ltid() == 0) *slot = (int)atomicAdd(wq, 1u);
        __syncthreads();
        const int u = *slot;
        if (u >= NDIFF + NMLA) break;
        if (u < NDIFF) {
            const int qt = u % NQT, bh = u / NQT, h = bh & 3, b = bh >> 2;
            const int q0 = qt < 32 ? qt * 256 : SEQ;
            const int s0 = qt < 32 ? 0 : SEQ, n0 = qt < 32 ? NK / 64 : CTX / 64;
            const bf16_t* V = VB + (size_t)(b * 4 + h) * NK * 128;
            f32x16 o[4];
            attend<64, 128, false>(QB + (size_t)(b * 8 + 2 * h) * NK * 64, q0, KB + (size_t)(b * 8 + 2 * h) * NK * 64, V, s0, n0, 0, 0, o, smem, na);
            const int row = qrow_of(b, q0 + wave * 32 + l31);
            bf16_t* dst = CC + (size_t)row * 1024 + 512 + h * 128;
#pragma unroll
            for (int d = 0; d < 4; ++d) store16(dst + d * 32, o[d], 1.f, hh);
            f32x16 o2[4];
            attend<64, 128, false>(QB + (size_t)(b * 8 + 2 * h + 1) * NK * 64, q0, KB + (size_t)(b * 8 + 2 * h + 1) * NK * 64, V, s0, n0, 0, 0, o2, smem, na);
            float ss = 0.f;
#pragma unroll
            for (int d = 0; d < 4; ++d)
#pragma unroll
                for (int q4 = 0; q4 < 4; ++q4) {
                    const u32x2 w = *(const volatile u32x2*)(dst + d * 32 + 8 * q4 + 4 * hh);
                    const float a0 = bflo(w.x) - lam * o2[d][4 * q4], a1 = bfhi(w.x) - lam * o2[d][4 * q4 + 1], a2 = bflo(w.y) - lam * o2[d][4 * q4 + 2], a3 = bfhi(w.y) - lam * o2[d][4 * q4 + 3];
                    o[d][4 * q4] = a0; o[d][4 * q4 + 1] = a1; o[d][4 * q4 + 2] = a2; o[d][4 * q4 + 3] = a3;
                    ss += (a0 * a0 + a1 * a1) + (a2 * a2 + a3 * a3);
                }
            ss = xor32_sum(ss);
            const float rn = rsqrtf(ss * (1.f / 128.f) + 1e-5f) * 0.8f;
#pragma unroll
            for (int d = 0; d < 4; ++d)
#pragma unroll
                for (int q4 = 0; q4 < 4; ++q4) {
                    const int c = d * 32 + 8 * q4 + 4 * hh;
                    const f32x4 g = *(const f32x4*)(gsub + c);
                    u32x2 w; w.x = pk2(o[d][4 * q4] * rn * g[0], o[d][4 * q4 + 1] * rn * g[1]); w.y = pk2(o[d][4 * q4 + 2] * rn * g[2], o[d][4 * q4 + 3] * rn * g[3]);
                    *(u32x2*)(dst + c) = w;
                }
        } else {
            const int v = u - NDIFF, qt = v % NQT, bh = v / NQT, h = bh & 7, b = bh >> 3;
            const int q0 = qt < 32 ? qt * 256 : SEQ;
            const int s0 = qt < 32 ? 0 : SEQ, n0 = qt < 32 ? NK / 64 : CTX / 64;
            f32x16 o[2];
            attend<96, 64, false>(QA + (size_t)(b * 8 + h) * NK * 96, q0, KA + (size_t)(b * 8 + h) * NK * 96, VA + (size_t)(b * 8 + h) * NK * 64, s0, n0, 0, 0, o, smem, na);
            const int row = qrow_of(b, q0 + wave * 32 + l31);
            bf16_t* dst = CC + (size_t)row * 1024 + h * 64;
#pragma unroll
            for (int d = 0; d < 2; ++d) store16(dst + d * 32, o[d], 1.f, hh);
        }
    }
}

DI void odd_attention_phase(const Params& P, char* smem) {
    char* ws = P.ws; char* hid = ws + OFF_HID;
    const bf16_t* QD = (const bf16_t*)(hid + HOFF_QD); const bf16_t* KD = (const bf16_t*)(hid + HOFF_KD); const bf16_t* VD = (const bf16_t*)(hid + HOFF_VD);
    bf16_t* CC = (bf16_t*)(ws + OFF_XM);
    const float* rpbg = P.in[23];
    const int lane = ltid() & 63, wave = ltid() >> 6, l31 = lane & 31, hh = lane >> 5;
    float* rpbl = (float*)(smem + RPB_OFF);
    constexpr int NU = NB * 8 * 32;
    for (int u = lbid(); u < NU; u += gridDim.x) {
        const int rp = u & 31, bh = u >> 5, h = bh & 7, b = bh >> 3;
        __syncthreads();
        for (int i = ltid(); i < 465; i += NTHR) rpbl[i] = rpbg[h * 465 + i] * LOG2E;
        const int r0 = rp * 4;
        NAInfo na; na.qr = r0 + (wave >> 1);
        const int rs0 = min(max(r0 - 4, 0), 120);
        na.kstart = min(rs0, 117);
        f32x16 o[2];
        const size_t hb = (size_t)(b * 8 + h) * NK * 64;
        attend<64, 64, true>(QD + hb, r0 * 64, KD + hb, VD + hb, na.kstart * 64, 11, SEQ, CTX / 64, o, smem, na);
        const int row = b * SEQ + r0 * 64 + wave * 32 + l31;
        bf16_t* dst = CC + (size_t)row * 1024 + 512 + h * 64;
#pragma unroll
        for (int d = 0; d < 2; ++d) store16(dst + d * 32, o[d], 1.f, hh);
    }
}

DI void cvt8(bf16_t* dst, const float* src, float sc) {
    const f32x4 a = *(const f32x4*)src, b = *(const f32x4*)(src + 4);
    u32x4 w; w.x = pk2(a[0] * sc, a[1] * sc); w.y = pk2(a[2] * sc, a[3] * sc); w.z = pk2(b[0] * sc, b[1] * sc); w.w = pk2(b[2] * sc, b[3] * sc);
    *(u32x4*)dst = w;
}
DI void cvt_rows(bf16_t* dst, int ldd, const float* src, int lds_, int rows, int cols_src, const float* rowscale, size_t gtid, size_t gstride) {
    const int c8 = ldd >> 3; const size_t n = (size_t)rows * c8;
    for (size_t i0 = gtid; i0 < n; i0 += 4 * gstride) {
        f32x4 a[4], b[4]; float sc[4];
#pragma unroll
        for (int u = 0; u < 4; ++u) {
            const size_t i = i0 + u * gstride;
            const int k = (int)(i / c8), c = (int)(i % c8) * 8;
            const bool ok = i < n && c < cols_src;
            const float* p = src + (ok ? (size_t)k * lds_ + c : 0);
            a[u] = *(const f32x4*)p; b[u] = *(const f32x4*)(p + 4);
            sc[u] = !ok ? 0.f : (rowscale ? rowscale[k] : 1.f);
        }
#pragma unroll
        for (int u = 0; u < 4; ++u) {
            const size_t i = i0 + u * gstride;
            if (i < n) {
                const int k = (int)(i / c8), c = (int)(i % c8) * 8;
                u32x4 w; w.x = pk2(a[u][0] * sc[u], a[u][1] * sc[u]); w.y = pk2(a[u][2] * sc[u], a[u][3] * sc[u]); w.z = pk2(b[u][0] * sc[u], b[u][1] * sc[u]); w.w = pk2(b[u][2] * sc[u], b[u][3] * sc[u]);
                *(u32x4*)(dst + (size_t)k * ldd + c) = w;
            }
        }
    }
}

DI void phase_pro_a(const Params& P, char* smem) {
    char* ws = P.ws;
    const size_t gtid = (size_t)lbid() * NTHR + ltid(), gstride = (size_t)gridDim.x * NTHR;
    for (int lf = 0; lf < 4; ++lf) {
        const float* sg = P.in[8] + (size_t)lf * 1024 * DFF; const float* su = P.in[9] + (size_t)lf * 1024 * DFF;
        bf16_t* dst = (bf16_t*)(ws + OFF_WGU + lf * SZ_WGU);
        for (size_t i0 = gtid; i0 < 1024ull * 704; i0 += 4 * gstride) {
            f32x4 a[4], b[4];
#pragma unroll
            for (int u = 0; u < 4; ++u) {
                const size_t i = i0 + u * gstride < 1024ull * 704 ? i0 + u * gstride : i0;
                const int k = (int)(i / 704), n = (int)(i % 704) * 8, grp = n >> 6, w = n & 63;
                const float* src = ((w < 32) ? sg : su) + (size_t)k * DFF + grp * 32 + (w & 31);
                a[u] = *(const f32x4*)src; b[u] = *(const f32x4*)(src + 4);
            }
#pragma unroll
            for (int u = 0; u < 4; ++u) {
                const size_t i = i0 + u * gstride;
                if (i < 1024ull * 704) {
                    const int k = (int)(i / 704), n = (int)(i % 704) * 8;
                    u32x4 w; w.x = pk2(a[u][0], a[u][1]); w.y = pk2(a[u][2], a[u][3]); w.z = pk2(b[u][0], b[u][1]); w.w = pk2(b[u][2], b[u][3]);
                    *(u32x4*)(dst + (size_t)k * 5632 + n) = w;
                }
            }
        }
        cvt_rows((bf16_t*)(ws + OFF_WD + lf * SZ_WD), 1024, P.in[10] + (size_t)lf * DFF * 1024, 1024, DFF, 1024, nullptr, gtid, gstride);
    }
    cvt_rows((bf16_t*)(ws + OFF_EVIN), 2048, P.in[11], 1952, 1024, 1952, nullptr, gtid, gstride);
    cvt_rows((bf16_t*)(ws + OFF_EVOUT), 1024, P.in[12], 1024, 1024, 1024, nullptr, gtid, gstride);
    cvt_rows((bf16_t*)(ws + OFF_UQ), 768, P.in[15], 768, 256, 768, P.in[13], gtid, gstride);
    cvt_rows((bf16_t*)(ws + OFF_UKV), 1024, P.in[16], 1024, 128, 1024, P.in[14], gtid, gstride);
    cvt_rows((bf16_t*)(ws + OFF_ODIN), 2048, P.in[19], 2048, 1024, 2048, nullptr, gtid, gstride);
    cvt_rows((bf16_t*)(ws + OFF_ODOUT), 1024, P.in[20], 1024, 1024, 1024, nullptr, gtid, gstride);
    for (size_t i = gtid; i < 512ull * 64; i += gstride) {
        const int k = (int)(i >> 6), n = (int)(i & 63) * 8;
        bf16_t* d = (bf16_t*)(ws + OFF_POOL) + (size_t)k * 512 + n;
        if ((k >> 7) == (n >> 7)) cvt8(d, P.in[21] + (size_t)k * 128 + (n & 127), 1.f);
        else { u32x4 z = {0u, 0u, 0u, 0u}; *(u32x4*)d = z; }
    }
    if (gtid < 128 * 8) { const int r = (int)gtid >> 3, i = (int)gtid & 7; const float inv = exp2f(-(float)i * (13.287712379549449f / 8.f)); float rev = (float)r * inv * 0.15915494309189535f; rev -= floorf(rev);
        f32x2 v = {__builtin_amdgcn_cosf(rev), __builtin_amdgcn_sinf(rev)}; ((f32x2*)(ws + OFF_TAR))[gtid] = v; if (r < 64) ((f32x2*)(ws + OFF_TAC))[gtid] = v; }
    if (gtid < 128 * 16) { const int r = (int)gtid >> 4, i = (int)gtid & 15; const float inv = exp2f(-(float)i * (13.287712379549449f / 16.f)); float rev = (float)r * inv * 0.15915494309189535f; rev -= floorf(rev);
        f32x2 v = {__builtin_amdgcn_cosf(rev), __builtin_amdgcn_sinf(rev)}; ((f32x2*)(ws + OFF_TBR))[gtid] = v; if (r < 64) ((f32x2*)(ws + OFF_TBC))[gtid] = v; }
    if (gtid == 0) {
        const float* lv = P.in[17]; float a = 0.f, b = 0.f;
        for (int i = 0; i < 64; ++i) { a += lv[i] * lv[64 + i]; b += lv[128 + i] * lv[192 + i]; }
        *(float*)(ws + OFF_LAM) = expf(a) - expf(b) + 0.2f;
    }
    float* sc = (float*)smem;
    float* red = sc + 5 * 1024;
    const int tid = ltid(), jj = tid & 31, ig = tid >> 5;
    __syncthreads();
    for (int i = tid; i < 5 * 1024; i += NTHR) { const float v = i < 4096 ? P.in[1][i] : P.in[3][i - 4096]; sc[i] = v / (1.f + expf(-v)); }
    __syncthreads();
    for (int u = lbid(); u < 576; u += gridDim.x) {
        const int l = u / 288, j0 = (u % 288) * 32;
        float a[5] = {0.f, 0.f, 0.f, 0.f, 0.f};
        const float* w = P.in[4] + (size_t)l * 1024 * 9216 + (size_t)(ig * 64) * 9216 + j0 + jj;
        for (int i0 = 0; i0 < 64; i0 += 8) {
            float wv[8];
#pragma unroll
            for (int k = 0; k < 8; ++k) wv[k] = w[(size_t)(i0 + k) * 9216];
#pragma unroll
            for (int k = 0; k < 8; ++k)
#pragma unroll
                for (int s2 = 0; s2 < 5; ++s2) a[s2] += sc[s2 * 1024 + ig * 64 + i0 + k] * wv[k];
        }
#pragma unroll
        for (int s2 = 0; s2 < 5; ++s2) red[(ig * 5 + s2) * 32 + jj] = a[s2];
        __syncthreads();
        if (tid < 160) {
            const int s2 = tid >> 5, j = tid & 31;
            float v = P.in[5][l * 9216 + j0 + j];
#pragma unroll
            for (int g = 0; g < 16; ++g) v += red[(g * 5 + s2) * 32 + j];
            ((float*)(ws + OFF_MOD))[(size_t)(l * 5 + s2) * 9216 + j0 + j] = v;
        }
        __syncthreads();
    }
}

DI void phase_pro_b(const Params& P) {
    char* ws = P.ws; bf16_t* XM = (bf16_t*)(ws + OFF_XM); const float* MOD = (const float*)(ws + OFF_MOD);
    const size_t gtid = (size_t)lbid() * NTHR + ltid(), gstride = (size_t)gridDim.x * NTHR;
    for (size_t i = gtid; i < (size_t)RT * 128; i += gstride) {
        const int row = (int)(i >> 7), c = (int)(i & 127) * 8;
        const float* src = row < RL ? P.in[0] + (size_t)row * 1024 + c : P.in[2] + (size_t)(row - RL) * 1024 + c;
        const int s = row < RL ? (row >> 13) : 4;
        const float* sh = MOD + (size_t)s * 9216 + c; const float* scl = sh + 1024;
        unsigned w[4];
#pragma unroll
        for (int hf = 0; hf < 2; ++hf) {
            const f32x4 x = *(const f32x4*)(src + 4 * hf), a = *(const f32x4*)(sh + 4 * hf), g = *(const f32x4*)(scl + 4 * hf);
            w[2 * hf] = pk2(x[0] * (1.f + g[0]) + a[0], x[1] * (1.f + g[1]) + a[1]);
            w[2 * hf + 1] = pk2(x[2] * (1.f + g[2]) + a[2], x[3] * (1.f + g[3]) + a[3]);
        }
        u32x4 o = {w[0], w[1], w[2], w[3]};
        *(u32x4*)(XM + (size_t)row * 1024 + c) = o;
    }
}

struct LnSpec { int l, which, lnext, mshift; bool final_; unsigned* cnt; const bf16_t* Y; const float* res_lat; const float* res_ctx; };
template <int NR>
DI void ln_rows(const Params& P, const LnSpec& sp, int row, int stride, int lane) {
    char* ws = P.ws; float* X = (float*)(ws + OFF_X); bf16_t* XM = (bf16_t*)(ws + OFF_XM); const float* MOD = (const float*)(ws + OFF_MOD);
    const float* g = P.in[6] + (sp.l * 3 + sp.which) * 1024; const float* bb = P.in[7] + (sp.l * 3 + sp.which) * 1024;
    f32x4 v[NR][4]; float s[NR], qv[NR];
#pragma unroll
    for (int k = 0; k < NR; ++k) {
        const int r = row + k * stride;
        const float* xp = r < RL ? sp.res_lat + (size_t)r * 1024 : sp.res_ctx + (size_t)(r - RL) * 1024;
        const bf16_t* yp = sp.Y + (size_t)r * 1024;
#pragma unroll
        for (int i = 0; i < 4; ++i) {
            const f32x4 x = *(const f32x4*)(xp + (i * 64 + lane) * 4);
            const u32x2 y = *(const u32x2*)(yp + (i * 64 + lane) * 4);
            v[k][i][0] = ALPHA * x[0] + bflo(y.x); v[k][i][1] = ALPHA * x[1] + bfhi(y.x);
            v[k][i][2] = ALPHA * x[2] + bflo(y.y); v[k][i][3] = ALPHA * x[3] + bfhi(y.y);
        }
    }
#pragma unroll
    for (int k = 0; k < NR; ++k) {
        s[k] = 0.f;
#pragma unroll
        for (int i = 0; i < 4; ++i) s[k] += (v[k][i][0] + v[k][i][1]) + (v[k][i][2] + v[k][i][3]);
    }
#pragma unroll
    for (int o = 32; o >= 1; o >>= 1)
#pragma unroll
        for (int k = 0; k < NR; ++k) s[k] += __shfl_xor(s[k], o);
#pragma unroll
    for (int k = 0; k < NR; ++k) {
        s[k] *= (1.f / 1024.f); qv[k] = 0.f;
#pragma unroll
        for (int i = 0; i < 4; ++i)
#pragma unroll
            for (int j = 0; j < 4; ++j) { const float d = v[k][i][j] - s[k]; qv[k] += d * d; }
    }
#pragma unroll
    for (int o = 32; o >= 1; o >>= 1)
#pragma unroll
        for (int k = 0; k < NR; ++k) qv[k] += __shfl_xor(qv[k], o);
#pragma unroll
    for (int k = 0; k < NR; ++k) {
        const int r = row + k * stride;
        const float mu = s[k], rstd = rsqrtf(qv[k] * (1.f / 1024.f) + 1e-6f);
        const int sidx = r < RL ? (r >> 13) : 4;
        const float* sh = MOD + (size_t)(sp.lnext * 5 + sidx) * 9216 + sp.mshift * 1024; const float* scl = sh + 1024;
        float* xp = X + (size_t)r * 1024;
#pragma unroll
        for (int i = 0; i < 4; ++i) {
            const int c = (i * 64 + lane) * 4;
            const f32x4 gg = *(const f32x4*)(g + c), b4 = *(const f32x4*)(bb + c);
            f32x4 y;
#pragma unroll
            for (int j = 0; j < 4; ++j) y[j] = (v[k][i][j] - mu) * rstd * gg[j] + b4[j];
            if (sp.final_) { *(f32x4*)(P.out + (size_t)r * 1024 + c) = y; }
            else {
                *(f32x4*)(xp + c) = y;
                const f32x4 a = *(const f32x4*)(sh + c), sg = *(const f32x4*)(scl + c);
                u32x2 w; w.x = pk2(y[0] * (1.f + sg[0]) + a[0], y[1] * (1.f + sg[1]) + a[1]); w.y = pk2(y[2] * (1.f + sg[2]) + a[2], y[3] * (1.f + sg[3]) + a[3]);
                *(u32x2*)(XM + (size_t)r * 1024 + c) = w;
            }
        }
    }
}
DI void phase_ln(const Params& P, int l, int which, int lnext, int mshift, bool final_, bool lat_only, const bf16_t* Y, bool first) {
    float* X = (float*)(P.ws + OFF_X);
    const LnSpec sp{l, which, lnext, mshift, final_, nullptr, Y, first ? P.in[0] : X, first ? P.in[2] : X + (size_t)RL * 1024};
    const int lane = ltid() & 63, wave = ltid() >> 6;
    const int nq = ((final_ || lat_only) ? RL : RT) / 4;
    for (int q = lbid() * NWAVE + wave; q < nq; q += gridDim.x * NWAVE) ln_rows<4>(P, sp, 4 * q, 1, lane);
}

DI void phase_ev_rms(const Params& P) {
    char* ws = P.ws; bf16_t* QN = (bf16_t*)(ws + OFF_HID + HOFF_QN); bf16_t* KVN = (bf16_t*)((char*)P.out + OOFF_KVN);
    const int lane = ltid() & 63, wave = ltid() >> 6;
    for (int row = (lbid() * NWAVE + wave) * 4; row < RT; row += gridDim.x * NWAVE * 4) {
        u32x2 wq[4]; unsigned wk[4]; float sq[4], sk[4];
#pragma unroll
        for (int k = 0; k < 4; ++k) { wq[k] = *(const u32x2*)(QN + (size_t)(row + k) * 256 + lane * 4); wk[k] = *(const unsigned*)(KVN + (size_t)(row + k) * 128 + lane * 2); }
#pragma unroll
        for (int k = 0; k < 4; ++k) {
            const float a = bflo(wq[k].x), b = bfhi(wq[k].x), c = bflo(wq[k].y), d = bfhi(wq[k].y);
            sq[k] = a * a + b * b + c * c + d * d;
            const float e = bflo(wk[k]), f = bfhi(wk[k]);
            sk[k] = e * e + f * f;
        }
#pragma unroll
        for (int o = 32; o >= 1; o >>= 1)
#pragma unroll
            for (int k = 0; k < 4; ++k) { sq[k] += __shfl_xor(sq[k], o); sk[k] += __shfl_xor(sk[k], o); }
#pragma unroll
        for (int k = 0; k < 4; ++k) {
            const float rq = rsqrtf(sq[k] * (1.f / 256.f) + 1e-6f), rk = rsqrtf(sk[k] * (1.f / 128.f) + 1e-6f);
            u32x2 o2; o2.x = pk2(bflo(wq[k].x) * rq, bfhi(wq[k].x) * rq); o2.y = pk2(bflo(wq[k].y) * rq, bfhi(wq[k].y) * rq);
            *(u32x2*)(QN + (size_t)(row + k) * 256 + lane * 4) = o2;
            *(unsigned*)(KVN + (size_t)(row + k) * 128 + lane * 2) = pk2(bflo(wk[k]) * rk, bfhi(wk[k]) * rk);
        }
    }
}

DI void phase_od_pool(const Params& P) {
    char* ws = P.ws; const bf16_t* U = (const bf16_t*)(ws + OFF_HID + HOFF_U); bf16_t* PL = (bf16_t*)(ws + OFF_HID + HOFF_PL);
    const size_t gtid = (size_t)lbid() * NTHR + ltid(), gstride = (size_t)gridDim.x * NTHR;
    for (size_t i = gtid; i < (size_t)RT * 64; i += gstride) {
        const int row = (int)(i >> 6), c = (int)(i & 63) * 8, grp = c >> 7;
        const int w = 2 << grp, left = w >> 1, right = w - 1 - left;
        int base, n, t;
        if (row < RL) { base = row & ~8191; n = SEQ; t = row & 8191; } else { const int rc = row - RL; base = RL + (rc & ~255); n = CTX; t = rc & 255; }
        const int lo = max(t - left, 0), hi = min(t + right + 1, n);
        float acc[8] = {0.f, 0.f, 0.f, 0.f, 0.f, 0.f, 0.f, 0.f};
#pragma unroll 4
        for (int tt = lo; tt < hi; ++tt) {
            const u32x4 v = *(const u32x4*)(U + (size_t)(base + tt) * 512 + c);
            acc[0] += bflo(v.x); acc[1] += bfhi(v.x); acc[2] += bflo(v.y); acc[3] += bfhi(v.y); acc[4] += bflo(v.z); acc[5] += bfhi(v.z); acc[6] += bflo(v.w); acc[7] += bfhi(v.w);
        }
        const float ic = 1.f / (float)(hi - lo);
        const u32x4 s = *(const u32x4*)(U + (size_t)row * 512 + c);
        u32x4 o;
        o.x = pk2(acc[0] * ic - bflo(s.x), acc[1] * ic - bfhi(s.x)); o.y = pk2(acc[2] * ic - bflo(s.y), acc[3] * ic - bfhi(s.y));
        o.z = pk2(acc[4] * ic - bflo(s.z), acc[5] * ic - bfhi(s.z)); o.w = pk2(acc[6] * ic - bflo(s.w), acc[7] * ic - bfhi(s.w));
        *(u32x4*)(PL + (size_t)row * 512 + c) = o;
    }
}

constexpr int NPHASE = 25;

DI void run_phase(const Params& P, int ph, char* smem) {
    char* ws = P.ws; char* hid = ws + OFF_HID; char* ob = (char*)P.out;
    float* X = (float*)(ws + OFF_X); bf16_t* XM = (bf16_t*)(ws + OFF_XM); bf16_t* HID = (bf16_t*)hid;
    const float* MOD = (const float*)(ws + OFF_MOD);
    if (ph == 0) { phase_pro_a(P, smem); return; }
    if (ph == 1) { phase_pro_b(P); return; }
    int l, op;
    if (ph < 14) { l = 0; op = ph - 2; } else { l = 1; op = ph - 14; if (op >= 6) op += 1; }
    const float* modl = MOD + (size_t)l * 5 * 9216;
    switch (op) {
    case 0: case 9: {
        const int f = op == 0 ? 0 : 1;
        EpiSwiglu e{HID};
        gemm_phase(XM, 1024, (const bf16_t*)(ws + OFF_WGU + (l * 2 + f) * SZ_WGU), 5632, 5632, 1024, e, smem, !(l == 1 && f == 1));
    } break;
    case 1: case 10: {
        const int f = op == 1 ? 0 : 1;
        EpiY e{XM, modl + (f == 0 ? 2 : 8) * 1024, 0.5f};
        gemm_phase(HID, DFF, (const bf16_t*)(ws + OFF_WD + (l * 2 + f) * SZ_WD), 1024, 1024, DFF, e, smem, !(l == 1 && f == 1));
    } break;
    case 2: phase_ln(P, l, 0, l, 3, false, false, XM, l == 0); break;
    case 3: {
        if (l == 0) {
            EpiEvIn e{(bf16_t*)(hid + HOFF_QN), (bf16_t*)(hid + HOFF_QB), (bf16_t*)(ob + OOFF_KVN), (bf16_t*)(hid + HOFF_KA), (bf16_t*)(ob + OOFF_KB), (bf16_t*)(ob + OOFF_VB),
                      (const f32x2*)(ws + OFF_TAR), (const f32x2*)(ws + OFF_TAC), (const f32x2*)(ws + OFF_TBR), (const f32x2*)(ws + OFF_TBC)};
            gemm_phase(XM, 1024, (const bf16_t*)(ws + OFF_EVIN), 2048, 2048, 1024, e, smem);
        } else {
            EpiOdIn e{(bf16_t*)(hid + HOFF_U), (bf16_t*)(hid + HOFF_QD), (bf16_t*)(hid + HOFF_KD), (bf16_t*)(hid + HOFF_VD)};
            gemm_phase(XM, 1024, (const bf16_t*)(ws + OFF_ODIN), 2048, 2048, 1024, e, smem);
        }
    } break;
    case 4: if (l == 0) phase_ev_rms(P); else phase_od_pool(P); break;
    case 5: {
        if (l == 0) {
            EpiUQ e1{(bf16_t*)(hid + HOFF_QA), (const f32x2*)(ws + OFF_TAR), (const f32x2*)(ws + OFF_TAC)};
            gemm_phase((const bf16_t*)(hid + HOFF_QN), 256, (const bf16_t*)(ws + OFF_UQ), 768, 768, 256, e1, smem);
            EpiUKV e2{(bf16_t*)(hid + HOFF_KA), (bf16_t*)(hid + HOFF_VA)};
            gemm_phase((const bf16_t*)(ob + OOFF_KVN), 128, (const bf16_t*)(ws + OFF_UKV), 1024, 1024, 128, e2, smem);
        } else {
            odd_attention_phase(P, smem);
            EpiPool e{XM, P.in[22], 0};
            gemm_phase((const bf16_t*)(hid + HOFF_PL), 512, (const bf16_t*)(ws + OFF_POOL), 512, 512, 512, e, smem);
        }
    } break;
    case 6: even_attention_phase(P, smem); break;
    case 7: {
        EpiY e{HID, modl + 5 * 1024, 1.f};
        gemm_phase(XM, 1024, (const bf16_t*)(ws + (l == 0 ? OFF_EVOUT : OFF_ODOUT)), 1024, 1024, 1024, e, smem, l == 0);
    } break;
    case 8: phase_ln(P, l, 1, l, 6, false, l == 1, HID, false); break;
    case 11: if (l == 0) phase_ln(P, 0, 2, 1, 0, false, false, XM, false); else phase_ln(P, 1, 2, 1, 0, true, true, XM, false); break;
    default: break;
    }
}

DI void grid_barrier(unsigned* ctr, unsigned target) {
    __syncthreads();
    if (threadIdx.x == 0) {
        __builtin_amdgcn_fence(__ATOMIC_RELEASE, "agent");
        __hip_atomic_fetch_add(ctr, 1u, __ATOMIC_RELAXED, __HIP_MEMORY_SCOPE_AGENT);
        while (__hip_atomic_load(ctr, __ATOMIC_RELAXED, __HIP_MEMORY_SCOPE_AGENT) < target) __builtin_amdgcn_s_sleep(2);
        __builtin_amdgcn_fence(__ATOMIC_ACQUIRE, "agent");
    }
    __syncthreads();
}

__global__ void __launch_bounds__(NTHR, 2) mega(Params P, int ph_lo, int ph_hi) {
    extern __shared__ __attribute__((aligned(16))) char smem[];
    unsigned nsync = 0;
    for (int ph = ph_lo; ph < ph_hi; ++ph) {
        run_phase(P, ph, smem);
        if (ph + 1 < ph_hi) {
            if (ph == ph_lo) cg::this_grid().sync();
            else { ++nsync; grid_barrier((unsigned*)(P.ws + OFF_BAR), nsync * gridDim.x); }
        }
    }
}

extern "C" void kernel_launch(void* const* d_in, const int* in_sizes, int n_in, void* d_out, int out_size, void* d_ws, size_t ws_size, hipStream_t stream) {
    if (ws_size < WS_NEED) { fprintf(stderr, "workspace too small: %zu < %zu\n", ws_size, (size_t)WS_NEED); return; }
    Params P{};
    for (int i = 0; i < 24; ++i) P.in[i] = (const float*)d_in[i];
    P.out = (float*)d_out; P.ws = (char*)d_ws;
    static int grid_blocks = 0;
    if (!grid_blocks) {
        int dev = 0, cus = 0, per_cu = 0;
        hipGetDevice(&dev);
        hipDeviceGetAttribute(&cus, hipDeviceAttributeMultiprocessorCount, dev);
        hipFuncSetAttribute((const void*)mega, hipFuncAttributeMaxDynamicSharedMemorySize, SMEM_BYTES);
        hipOccupancyMaxActiveBlocksPerMultiprocessor(&per_cu, mega, NTHR, SMEM_BYTES);
        if (per_cu < 1) per_cu = 1;
        if (per_cu > 1) per_cu = 1;
        grid_blocks = cus * per_cu;
    }
#if COOP
    hipMemsetAsync((char*)d_ws + OFF_BAR, 0, 256, stream);
    int lo = 0, hi = NPHASE;
    void* args[] = {&P, &lo, &hi};
    hipError_t e = hipLaunchCooperativeKernel((void*)mega, dim3(grid_blocks), dim3(NTHR), args, SMEM_BYTES, stream);
    if (e != hipSuccess) fprintf(stderr, "cooperative launch failed: %s (grid %d)\n", hipGetErrorString(e), grid_blocks);
#else
    for (int ph = 0; ph < NPHASE; ++ph) mega<<<grid_blocks, NTHR, SMEM_BYTES, stream>>>(P, ph, ph + 1);
#endif
}
```

```cpp
#include <hip/hip_runtime.h>
#include <hip/hip_cooperative_groups.h>
#include <cstdio>
#include <cstdint>
namespace cg = cooperative_groups;

#ifndef COOP
#define COOP 1
#endif

#define DI __device__ __forceinline__
typedef unsigned short bf16_t;
typedef short bf16x8 __attribute__((ext_vector_type(8)));
typedef short s16x4 __attribute__((ext_vector_type(4)));
typedef __bf16 bfx4 __attribute__((ext_vector_type(4)));
typedef __bf16 bfx2 __attribute__((ext_vector_type(2)));
typedef float f32x2 __attribute__((ext_vector_type(2)));
typedef float f32x4 __attribute__((ext_vector_type(4)));
typedef float f32x16 __attribute__((ext_vector_type(16)));
typedef unsigned u32x2 __attribute__((ext_vector_type(2)));
typedef unsigned u32x4 __attribute__((ext_vector_type(4)));
#define LDS_AS __attribute__((address_space(3)))

constexpr int DM = 1024, NB = 4, SEQ = 8192, CTX = 256, DFF = 2816;
constexpr int RL = NB * SEQ, RC = NB * CTX, RT = RL + RC;
constexpr int NK = SEQ + CTX;
constexpr float ALPHA = 1.41421356237f;
constexpr float LOG2E = 1.4426950408889634f;
constexpr float QA_SCALE = 0.10206207261596575f * LOG2E;
constexpr float QB_SCALE = 0.125f * LOG2E;
constexpr float QD_SCALE = 0.125f * LOG2E;
constexpr int NTHR = 512, NWAVE = NTHR / 64;

constexpr size_t SZ_WGU = 1024ull * 5632 * 2, SZ_WD = 2816ull * 1024 * 2;
constexpr size_t OFF_WGU = 0;
constexpr size_t OFF_WD = OFF_WGU + 4 * SZ_WGU;
constexpr size_t OFF_EVIN = OFF_WD + 4 * SZ_WD;
constexpr size_t OFF_EVOUT = OFF_EVIN + 1024ull * 2048 * 2;
constexpr size_t OFF_UQ = OFF_EVOUT + 1024ull * 1024 * 2;
constexpr size_t OFF_UKV = OFF_UQ + 256ull * 768 * 2;
constexpr size_t OFF_ODIN = OFF_UKV + 128ull * 1024 * 2;
constexpr size_t OFF_ODOUT = OFF_ODIN + 1024ull * 2048 * 2;
constexpr size_t OFF_POOL = OFF_ODOUT + 1024ull * 1024 * 2;
constexpr size_t OFF_MOD = OFF_POOL + 512ull * 512 * 2;
constexpr size_t OFF_TAR = OFF_MOD + 2ull * 5 * 9216 * 4;
constexpr size_t OFF_TAC = OFF_TAR + 128 * 8 * 8;
constexpr size_t OFF_TBR = OFF_TAC + 64 * 8 * 8;
constexpr size_t OFF_TBC = OFF_TBR + 128 * 16 * 8;
constexpr size_t OFF_LAM = OFF_TBC + 64 * 16 * 8;
constexpr size_t OFF_BAR = OFF_LAM + 256;
constexpr size_t OFF_X = OFF_BAR + 256;
constexpr size_t OFF_XM = OFF_X + (size_t)RT * 1024 * 4;
constexpr size_t OFF_HID = OFF_XM + (size_t)RT * 1024 * 2;
constexpr size_t WS_NEED = OFF_HID + (size_t)RT * DFF * 2;
constexpr size_t SZ_H96 = (size_t)NB * 8 * NK * 96 * 2, SZ_H64 = (size_t)NB * 8 * NK * 64 * 2;
constexpr size_t HOFF_QA = 0, HOFF_KA = SZ_H96, HOFF_VA = 2 * SZ_H96, HOFF_QB = HOFF_VA + SZ_H64, HOFF_QN = HOFF_QB + SZ_H64;
static_assert(HOFF_QN + (size_t)RT * 256 * 2 <= (size_t)RT * DFF * 2, "HID region overflow");
constexpr size_t HOFF_U = 0, HOFF_PL = SZ_H64, HOFF_QD = 2 * SZ_H64, HOFF_KD = 3 * SZ_H64, HOFF_VD = 4 * SZ_H64;
constexpr size_t OOFF_KB = 0, OOFF_VB = SZ_H64, OOFF_KVN = 2 * SZ_H64;
static_assert(OOFF_KVN + (size_t)RT * 128 * 2 <= (size_t)RL * 1024 * 4, "d_out region overflow");

struct Params {
    const float* in[24];
    float* out;
    char* ws;
};

DI int ltid() { int t = threadIdx.x; asm volatile("" : "+v"(t)); return t; }
DI int lbid() { int t = blockIdx.x; asm volatile("" : "+s"(t)); return t; }
DI unsigned pk2(float a, float b) { f32x2 v = {a, b}; bfx2 r = __builtin_convertvector(v, bfx2); return __builtin_bit_cast(unsigned, r); }
DI float bf2f(unsigned short u) { return __uint_as_float(((unsigned)u) << 16); }
DI float bflo(unsigned u) { return __uint_as_float(u << 16); }
DI float bfhi(unsigned u) { return __uint_as_float(u & 0xffff0000u); }
DI float silu_f(float x) { return x * __builtin_amdgcn_rcpf(1.f + __expf(-x)); }
DI f32x16 mfma32(bf16x8 a, bf16x8 b, f32x16 c) { return __builtin_amdgcn_mfma_f32_32x32x16_bf16(a, b, c, 0, 0, 0); }
DI s16x4 tr_read(const char* p) { bfx4 r = __builtin_amdgcn_ds_read_tr16_b64_v4bf16((LDS_AS bfx4*)p); return __builtin_bit_cast(s16x4, r); }
DI float xor32_max(float x) { const unsigned u = __float_as_uint(x); auto r = __builtin_amdgcn_permlane32_swap(u, u, false, false); return fmaxf(__uint_as_float(r[0]), __uint_as_float(r[1])); }
DI float xor32_sum(float x) { const unsigned u = __float_as_uint(x); auto r = __builtin_amdgcn_permlane32_swap(u, u, false, false); return __uint_as_float(r[0]) + __uint_as_float(r[1]); }
DI bf16x8 cat8(s16x4 lo, s16x4 hi) { return __builtin_shufflevector(lo, hi, 0, 1, 2, 3, 4, 5, 6, 7); }

struct RowInfo { int b, j, s; bool lat; };
DI RowInfo rowinfo(int row) {
    RowInfo r;
    if (row < RL) { r.b = row >> 13; r.j = row & 8191; r.s = r.b; r.lat = true; }
    else { int rc = row - RL; r.b = rc >> 8; r.j = 8192 + (rc & 255); r.s = 4; r.lat = false; }
    return r;
}
DI void store16(bf16_t* dst32, const f32x16& v, float sc, int hh) {
#pragma unroll
    for (int q4 = 0; q4 < 4; ++q4) {
        u32x2 w; w.x = pk2(v[4 * q4] * sc, v[4 * q4 + 1] * sc); w.y = pk2(v[4 * q4 + 2] * sc, v[4 * q4 + 3] * sc);
        *(u32x2*)(dst32 + 8 * q4 + 4 * hh) = w;
    }
}
DI f32x16 ropeB(const f32x16& v, const f32x2* tab, int hh) {
    f32x16 o;
#pragma unroll
    for (int r = 0; r < 8; ++r) {
        const int i = (r & 3) + 8 * (r >> 2) + 4 * hh;
        const f32x2 cs = tab[i];
        o[r] = v[r] * cs.x - v[r + 8] * cs.y;
        o[r + 8] = v[r + 8] * cs.x + v[r] * cs.y;
    }
    return o;
}
DI f32x16 ropeA(const f32x16& v, const f32x2* tr, const f32x2* tc, int hh) {
    f32x16 o;
#pragma unroll
    for (int r = 0; r < 4; ++r) {
        const int i = 4 * hh + r;
        const f32x2 a = tr[i], c = tc[i];
        o[r] = v[r] * a.x - v[r + 4] * a.y;
        o[r + 4] = v[r + 4] * a.x + v[r] * a.y;
        o[8 + r] = v[8 + r] * c.x - v[12 + r] * c.y;
        o[12 + r] = v[12 + r] * c.x + v[8 + r] * c.y;
    }
    return o;
}

constexpr int GA_S = 144, GB_S = 576;
constexpr int GSTAGE = 256 * GA_S + 64 * GB_S;
constexpr int GEMM_LDS = 2 * GSTAGE;

template <int BM, class Epi>
DI void gemm_tile(const bf16_t* __restrict__ A, int lda, const bf16_t* __restrict__ B, int ldb, int K, int row0, int col0, const Epi& epi, char* smem) {
    constexpr int MI = BM / 64, NA_ = BM / 64;
    const int tid = ltid(), lane = tid & 63, wave = tid >> 6, wm = wave >> 2, wn = wave & 3;
    const int l31 = lane & 31, hh = lane >> 5, q = (lane & 15) >> 2, p = lane & 3, nblk = (lane >> 4) & 1;
    f32x16 acc[MI][2];
#pragma unroll
    for (int i = 0; i < MI; ++i)
#pragma unroll
        for (int j = 0; j < 2; ++j)
#pragma unroll
            for (int r = 0; r < 16; ++r) acc[i][j][r] = 0.f;
    u32x4 ra[NA_], rb[4];
    const bf16_t* ag = A + (size_t)(row0 + (tid >> 3)) * lda + (tid & 7) * 8;
    const bf16_t* bg = B + (size_t)(tid >> 5) * ldb + col0 + (tid & 31) * 8;
    const int aw = (tid >> 3) * GA_S + (tid & 7) * 16, bw = BM * GA_S + (tid >> 5) * GB_S + (tid & 31) * 16;
    const int nk = K >> 6;
    const int xoff = (wm * (BM / 2) + l31) * GA_S + hh * 16;
    const int woff = BM * GA_S + (hh * 8 + q) * GB_S + (wn * 64 + nblk * 16 + 4 * p) * 2;
#pragma unroll
    for (int i = 0; i < NA_; ++i) ra[i] = *(const u32x4*)(ag + (size_t)(64 * i) * lda);
#pragma unroll
    for (int i = 0; i < 4; ++i) rb[i] = *(const u32x4*)(bg + (size_t)(16 * i) * ldb);
    __syncthreads();
#pragma unroll
    for (int i = 0; i < NA_; ++i) *(u32x4*)(smem + aw + 64 * i * GA_S) = ra[i];
#pragma unroll
    for (int i = 0; i < 4; ++i) *(u32x4*)(smem + bw + 16 * i * GB_S) = rb[i];
    if (nk > 1) {
#pragma unroll
        for (int i = 0; i < NA_; ++i) ra[i] = *(const u32x4*)(ag + 64 + (size_t)(64 * i) * lda);
#pragma unroll
        for (int i = 0; i < 4; ++i) rb[i] = *(const u32x4*)(bg + (size_t)(64 + 16 * i) * ldb);
    }
    __syncthreads();
    for (int kt = 0; kt < nk; ++kt) {
        const char* cur = smem + (kt & 1) * GSTAGE;
        char* nxt = smem + ((kt & 1) ^ 1) * GSTAGE;
        const bool w1 = kt + 1 < nk, l2 = kt + 2 < nk;
        const bf16_t* a2 = ag + (size_t)(kt + 2) * 64; const bf16_t* b2 = bg + (size_t)(kt + 2) * 64 * ldb;
#pragma unroll
        for (int s = 0; s < 4; ++s) {
            bf16x8 xf[MI], wf[2];
#pragma unroll
            for (int mi = 0; mi < MI; ++mi) xf[mi] = *(const bf16x8*)(cur + xoff + mi * 32 * GA_S + s * 32);
#pragma unroll
            for (int ni = 0; ni < 2; ++ni) {
                const char* wp = cur + woff + s * 16 * GB_S + ni * 64;
                wf[ni] = cat8(tr_read(wp), tr_read(wp + 4 * GB_S));
            }
#pragma unroll
            for (int mi = 0; mi < MI; ++mi)
#pragma unroll
                for (int ni = 0; ni < 2; ++ni) acc[mi][ni] = mfma32(wf[ni], xf[mi], acc[mi][ni]);
            if (w1) {
                if (s < NA_) *(u32x4*)(nxt + aw + 64 * s * GA_S) = ra[s];
                *(u32x4*)(nxt + bw + 16 * s * GB_S) = rb[s];
            }
            if (l2) {
                if (s < NA_) ra[s] = *(const u32x4*)(a2 + (size_t)(64 * s) * lda);
                rb[s] = *(const u32x4*)(b2 + (size_t)(16 * s) * ldb);
            }
        }
        __syncthreads();
    }
#pragma unroll
    for (int mi = 0; mi < MI; ++mi) epi(acc[mi][0], acc[mi][1], row0 + wm * (BM / 2) + mi * 32 + l31, col0 + wn * 64, hh);
}

template <class Epi>
DI void gemm_phase(const bf16_t* A, int lda, const bf16_t* B, int ldb, int N, int K, const Epi& epi, char* smem, bool do_ctx = true) {
    const int nt = N >> 8, small = do_ctx ? (RC / 128) * nt : 0;
    const int bid = lbid(), G = gridDim.x;
    if ((G & 7) == 0) {
        const int xcd = bid & 7, loc = bid >> 3, per = G >> 3, mine = (RL / 256 / 8) * nt;
        for (int i = loc; i < mine; i += per) {
            const int cg = i >> 7, rem = i & 127, cw = min(8, nt - cg * 8);
            int pg, w;
            if (cw == 8) { pg = rem >> 5; w = rem & 31; } else { const int rr = i - cg * 128; pg = rr / (4 * cw); w = rr - pg * 4 * cw; }
            const int pl = pg * 4 + (w & 3), cl = cg * 8 + (w >> 2);
            gemm_tile<256>(A, lda, B, ldb, K, (pl * 8 + xcd) * 256, cl * 256, epi, smem);
        }
    } else {
        const int big = (RL / 256) * nt;
        for (int t = bid; t < big; t += G) gemm_tile<256>(A, lda, B, ldb, K, (t / nt) * 256, (t % nt) * 256, epi, smem);
    }
    for (int u = bid; u < small; u += G) gemm_tile<128>(A, lda, B, ldb, K, RL + (u / nt) * 128, (u % nt) * 256, epi, smem);
}

struct EpiSwiglu {
    bf16_t* hid;
    DI void operator()(const f32x16& a0, const f32x16& a1, int row, int cbase, int hh) const {
        bf16_t* dst = hid + (size_t)row * DFF + (cbase >> 1) + 4 * hh;
#pragma unroll
        for (int q4 = 0; q4 < 4; ++q4) {
            float h[4];
#pragma unroll
            for (int j = 0; j < 4; ++j) h[j] = silu_f(a0[4 * q4 + j]) * a1[4 * q4 + j];
            u32x2 w; w.x = pk2(h[0], h[1]); w.y = pk2(h[2], h[3]);
            *(u32x2*)(dst + 8 * q4) = w;
        }
    }
};
struct EpiResid {
    const float* res_lat; const float* res_ctx; float* X; const float* gate; float coef;
    DI void operator()(const f32x16& a0, const f32x16& a1, int row, int cbase, int hh) const {
        const int s = row < RL ? (row >> 13) : 4;
        const float* rp = row < RL ? res_lat + (size_t)row * 1024 : res_ctx + (size_t)(row - RL) * 1024;
        const float* gp = gate + s * 9216;
        float* xp = X + (size_t)row * 1024;
#pragma unroll
        for (int ni = 0; ni < 2; ++ni)
#pragma unroll
            for (int q4 = 0; q4 < 4; ++q4) {
                const int c = cbase + ni * 32 + 8 * q4 + 4 * hh;
                const f32x4 r = *(const f32x4*)(rp + c), g = *(const f32x4*)(gp + c);
                f32x4 z;
#pragma unroll
                for (int j = 0; j < 4; ++j) z[j] = ALPHA * r[j] + coef * g[j] * (ni ? a1[4 * q4 + j] : a0[4 * q4 + j]);
                *(f32x4*)(xp + c) = z;
            }
    }
};
struct EpiY {
    static constexpr bool kSwap = false;
    bf16_t* Y; const float* gate; float coef;
    DI void operator()(const f32x16& a0, const f32x16& a1, int row, int cbase, int hh) const {
        const int s = row < RL ? (row >> 13) : 4;
        const float* gp = gate + s * 9216;
        bf16_t* yp = Y + (size_t)row * 1024;
#pragma unroll
        for (int ni = 0; ni < 2; ++ni)
#pragma unroll
            for (int q4 = 0; q4 < 4; ++q4) {
                const int c = cbase + ni * 32 + 8 * q4 + 4 * hh;
                const f32x4 g = *(const f32x4*)(gp + c);
                const f32x16& v = ni ? a1 : a0;
                u32x2 w; w.x = pk2(coef * g[0] * v[4 * q4], coef * g[1] * v[4 * q4 + 1]); w.y = pk2(coef * g[2] * v[4 * q4 + 2], coef * g[3] * v[4 * q4 + 3]);
                *(u32x2*)(yp + c) = w;
            }
    }
};
struct EpiEvIn {
    bf16_t *QN, *QB, *KVN, *KA, *KB, *VB; const f32x2 *tAr, *tAc, *tBr, *tBc;
    DI void operator()(const f32x16& a0, const f32x16& a1, int row, int cbase, int hh) const {
        const RowInfo ri = rowinfo(row);
        const int gr = (ri.j >> 6) & 127, gc = ri.j & 63;
#pragma unroll
        for (int ni = 0; ni < 2; ++ni) {
            const int g = (cbase >> 5) + ni;
            const f32x16& v = ni ? a1 : a0;
            if (g < 8) store16(QN + (size_t)row * 256 + g * 32, v, 1.f, hh);
            else if (g < 24) {
                const int hv = (g - 8) >> 1, half = (g - 8) & 1;
                f32x16 w = v; if (ri.lat) w = ropeB(v, half ? tBc + gc * 16 : tBr + gr * 16, hh);
                store16(QB + ((size_t)(ri.b * 8 + hv) * NK + ri.j) * 64 + half * 32, w, QB_SCALE, hh);
            } else if (g < 28) store16(KVN + (size_t)row * 128 + (g - 24) * 32, v, 1.f, hh);
            else if (g == 28) {
                f32x16 w = v; if (ri.lat) w = ropeA(v, tAr + gr * 8, tAc + gc * 8, hh);
                for (int h = 0; h < 8; ++h) store16(KA + ((size_t)(ri.b * 8 + h) * NK + ri.j) * 96 + 64, w, 1.f, hh);
            } else if (g < 45) {
                const int hv = (g - 29) >> 1, half = (g - 29) & 1;
                f32x16 w = v; if (ri.lat) w = ropeB(v, half ? tBc + gc * 16 : tBr + gr * 16, hh);
                store16(KB + ((size_t)(ri.b * 8 + hv) * NK + ri.j) * 64 + half * 32, w, 1.f, hh);
            } else if (g < 61) {
                const int idx = g - 45, h = idx >> 2, part = idx & 3;
                store16(VB + ((size_t)(ri.b * 4 + h) * NK + ri.j) * 128 + part * 32, v, 1.f, hh);
            }
        }
    }
};
struct EpiUQ {
    bf16_t* QA; const f32x2 *tAr, *tAc;
    DI void operator()(const f32x16& a0, const f32x16& a1, int row, int cbase, int hh) const {
        const RowInfo ri = rowinfo(row);
        const int gr = (ri.j >> 6) & 127, gc = ri.j & 63;
#pragma unroll
        for (int ni = 0; ni < 2; ++ni) {
            const int g = (cbase >> 5) + ni, h = g / 3, part = g - 3 * h;
            f32x16 w = ni ? a1 : a0;
            if (part == 2 && ri.lat) w = ropeA(ni ? a1 : a0, tAr + gr * 8, tAc + gc * 8, hh);
            store16(QA + ((size_t)(ri.b * 8 + h) * NK + ri.j) * 96 + part * 32, w, QA_SCALE, hh);
        }
    }
};
struct EpiUKV {
    bf16_t *KA, *VA;
    DI void operator()(const f32x16& a0, const f32x16& a1, int row, int cbase, int hh) const {
        const RowInfo ri = rowinfo(row);
#pragma unroll
        for (int ni = 0; ni < 2; ++ni) {
            const int g = (cbase >> 5) + ni, h = g >> 2, part = g & 3;
            const size_t tk = (size_t)(ri.b * 8 + h) * NK + ri.j;
            if (part < 2) store16(KA + tk * 96 + part * 32, ni ? a1 : a0, 1.f, hh);
            else store16(VA + tk * 64 + (part - 2) * 32, ni ? a1 : a0, 1.f, hh);
        }
    }
};
struct EpiOdIn {
    bf16_t *U, *QD, *KD, *VD;
    DI void operator()(const f32x16& a0, const f32x16& a1, int row, int cbase, int hh) const {
        const RowInfo ri = rowinfo(row);
#pragma unroll
        for (int ni = 0; ni < 2; ++ni) {
            const int g = (cbase >> 5) + ni;
            const f32x16& v = ni ? a1 : a0;
            if (g < 16) store16(U + (size_t)row * 512 + g * 32, v, 1.f, hh);
            else {
                const int gg = (g - 16) & 15, h = gg >> 1, half = gg & 1;
                const size_t off = ((size_t)(ri.b * 8 + h) * NK + ri.j) * 64 + half * 32;
                if (g < 32) store16(QD + off, v, QD_SCALE, hh);
                else if (g < 48) store16(KD + off, v, 1.f, hh);
                else store16(VD + off, v, 1.f, hh);
            }
        }
    }
};
struct EpiPool {
    bf16_t* CC; const float* pscale; int gidx;
    DI void operator()(const f32x16& a0, const f32x16& a1, int row, int cbase, int hh) const {
#pragma unroll
        for (int ni = 0; ni < 2; ++ni)
#pragma unroll
            for (int q4 = 0; q4 < 4; ++q4) {
                const int c = gidx * 128 + cbase + ni * 32 + 8 * q4 + 4 * hh;
                const f32x4 s = *(const f32x4*)(pscale + c);
                const f32x16& v = ni ? a1 : a0;
                u32x2 w; w.x = pk2(v[4 * q4] * s[0], v[4 * q4 + 1] * s[1]); w.y = pk2(v[4 * q4 + 2] * s[2], v[4 * q4 + 3] * s[3]);
                *(u32x2*)(CC + (size_t)row * 1024 + c) = w;
            }
    }
};

constexpr int ATT_LDS = 64 * (96 + 8) * 2 + 64 * (128 * 2 + 64);
constexpr int RPB_OFF = 2 * ATT_LDS;
constexpr int SMEM_BYTES = GEMM_LDS;

struct NAInfo { int qr; int kstart; };

template <int DQK, int DV, bool NA>
DI void attend(const bf16_t* __restrict__ Q, int q0, const bf16_t* __restrict__ Kb, const bf16_t* __restrict__ Vb,
               int s0, int n0, int s1, int n1, f32x16 (&o)[DV / 32], char* smem, NAInfo na) {
    constexpr int KS = (DQK + 8) * 2, VS = DV * 2 + 64;
    constexpr int KCH = DQK / 8, KN = (64 * KCH + NTHR - 1) / NTHR, VCH = DV / 8, VN = (64 * VCH + NTHR - 1) / NTHR;
    constexpr int NS = DQK / 16, NDT = DV / 32;
    const int tid = ltid(), lane = tid & 63, wave = tid >> 6;
    const int l31 = lane & 31, hh = lane >> 5, q = (lane & 15) >> 2, p = lane & 3, dblk = (lane >> 4) & 1;
    bf16x8 qf[NS];
    {
        const bf16_t* qp = Q + (size_t)(q0 + wave * 32 + l31) * DQK + hh * 8;
#pragma unroll
        for (int s = 0; s < NS; ++s) qf[s] = *(const bf16x8*)(qp + s * 16);
    }
#pragma unroll
    for (int d = 0; d < NDT; ++d)
#pragma unroll
        for (int r = 0; r < 16; ++r) o[d][r] = 0.f;
    float m = NA ? -INFINITY : 0.f, l = 0.f;
    f32x16 cinit;
#pragma unroll
    for (int r = 0; r < 16; ++r) cinit[r] = 0.f;
    u32x4 rk[KN], rv[VN];
    const int nt = n0 + n1;
    auto gload = [&](int t) {
        const int j0 = t < n0 ? s0 + t * 64 : s1 + (t - n0) * 64;
#pragma unroll
        for (int i = 0; i < KN; ++i) { int id = tid + NTHR * i; if (id >= 64 * KCH) id -= 64 * KCH; const int row = id / KCH, ch = id - row * KCH; rk[i] = *(const u32x4*)(Kb + (size_t)(j0 + row) * DQK + ch * 8); }
#pragma unroll
        for (int i = 0; i < VN; ++i) { int id = tid + NTHR * i; if (id >= 64 * VCH) id -= 64 * VCH; const int row = id / VCH, ch = id - row * VCH; rv[i] = *(const u32x4*)(Vb + (size_t)(j0 + row) * DV + ch * 8); }
    };
    gload(0);
    int qc = 0, cs = 0, rs = 0;
    if (NA) { qc = (wave & 1) * 32 + l31; cs = min(max(qc - 8, 0), 48); rs = min(max(na.qr - 4, 0), 120); }
    const float* rpb = (const float*)(smem + RPB_OFF);
    auto lwrite = [&](char* stg) {
#pragma unroll
        for (int i = 0; i < KN; ++i) { int id = tid + NTHR * i; if (id >= 64 * KCH) id -= 64 * KCH; const int row = id / KCH, ch = id - row * KCH; *(u32x4*)(stg + row * KS + ch * 16) = rk[i]; }
#pragma unroll
        for (int i = 0; i < VN; ++i) { int id = tid + NTHR * i; if (id >= 64 * VCH) id -= 64 * VCH; const int row = id / VCH, ch = id - row * VCH; *(u32x4*)(stg + 64 * KS + row * VS + ch * 16) = rv[i]; }
    };
    __syncthreads();
    lwrite(smem);
    if (nt > 1) gload(1);
    __syncthreads();
    for (int t = 0; t < nt; ++t) {
        const char* sK = smem + (t & 1) * ATT_LDS; const char* sV = sK + 64 * KS;
        bool active = true; int kr = 0;
        if (NA && t < n0) { kr = na.kstart + t; active = (kr >= rs) && (kr < rs + 8); }
        if (active) {
#pragma unroll
            for (int sub = 0; sub < 2; ++sub) {
                f32x16 st;
                if (NA) {
#pragma unroll
                    for (int r = 0; r < 16; ++r) st[r] = 0.f;
                } else st = cinit;
                {
                    bf16x8 kf[NS];
#pragma unroll
                    for (int s = 0; s < NS; ++s) kf[s] = *(const bf16x8*)(sK + (sub * 32 + l31) * KS + (s * 16 + hh * 8) * 2);
                    __builtin_amdgcn_sched_barrier(0);
#pragma unroll
                    for (int s = 0; s < NS; ++s) st = mfma32(kf[s], qf[s], st);
                }
                if (NA && t < n0) {
                    const float* brow = rpb + (kr - na.qr + 7) * 31 + 15 - qc;
#pragma unroll
                    for (int r = 0; r < 16; ++r) {
                        const int kc = sub * 32 + (r & 3) + 8 * (r >> 2) + 4 * hh;
                        const bool valid = (kc >= cs) && (kc < cs + 16);
                        const int bi = valid ? kc : cs;
                        const float bias = brow[bi];
                        st[r] = valid ? st[r] + bias : -INFINITY;
                    }
                }
                float mx = st[0];
#pragma unroll
                for (int r = 1; r < 16; ++r) mx = fmaxf(mx, st[r]);
                mx = xor32_max(mx);
                float rsum = 0.f;
                if (NA) {
                    const float mnew = fmaxf(m, mx);
                    const float muse = (mnew == -INFINITY) ? 0.f : mnew;
                    const float alpha = __builtin_amdgcn_exp2f(m - muse);
                    m = mnew;
                    l *= alpha;
#pragma unroll
                    for (int d = 0; d < NDT; ++d)
#pragma unroll
                        for (int r = 0; r < 16; ++r) o[d][r] *= alpha;
#pragma unroll
                    for (int r = 0; r < 16; ++r) { st[r] = __builtin_amdgcn_exp2f(st[r] - muse); rsum += st[r]; }
                } else {
                    const bool first = (t == 0) && (sub == 0);
                    if (first || __builtin_amdgcn_ballot_w64(mx > 8.f) != 0) {
                        const float delta = first ? mx : fmaxf(mx, 0.f);
                        const float alpha = first ? 1.f : __builtin_amdgcn_exp2f(-delta);
                        m += delta;
                        l *= alpha;
#pragma unroll
                        for (int d = 0; d < NDT; ++d)
#pragma unroll
                            for (int r = 0; r < 16; ++r) o[d][r] *= alpha;
#pragma unroll
                        for (int r = 0; r < 16; ++r) { st[r] -= delta; cinit[r] = -m; }
                    }
#pragma unroll
                    for (int r = 0; r < 16; ++r) { st[r] = __builtin_amdgcn_exp2f(st[r]); rsum += st[r]; }
                }
                l += rsum;
                bf16x8 pf[2];
#pragma unroll
                for (int s2 = 0; s2 < 2; ++s2) {
                    u32x4 w;
                    w.x = pk2(st[8 * s2], st[8 * s2 + 1]); w.y = pk2(st[8 * s2 + 2], st[8 * s2 + 3]);
                    w.z = pk2(st[8 * s2 + 4], st[8 * s2 + 5]); w.w = pk2(st[8 * s2 + 6], st[8 * s2 + 7]);
                    pf[s2] = __builtin_bit_cast(bf16x8, w);
                }
                {
                    bf16x8 vf[NDT][2];
#pragma unroll
                    for (int d = 0; d < NDT; ++d)
#pragma unroll
                        for (int s2 = 0; s2 < 2; ++s2) {
                            const char* vp = sV + (sub * 32 + 16 * s2 + 4 * hh + q) * VS + (d * 32 + dblk * 16 + 4 * p) * 2;
                            vf[d][s2] = cat8(tr_read(vp), tr_read(vp + 8 * VS));
                        }
#pragma unroll
                    for (int d = 0; d < NDT; ++d)
#pragma unroll
                        for (int s2 = 0; s2 < 2; ++s2) o[d] = mfma32(vf[d][s2], pf[s2], o[d]);
                }
            }
        }
        if (t + 1 < nt) lwrite(smem + ((t & 1) ^ 1) * ATT_LDS);
        if (t + 2 < nt) gload(t + 2);
        __syncthreads();
    }
    l = xor32_sum(l);
    const float inv = 1.f / l;
#pragma unroll
    for (int d = 0; d < NDT; ++d)
#pragma unroll
        for (int r = 0; r < 16; ++r) o[d][r] *= inv;
}

DI int qrow_of(int b, int j) { return j < SEQ ? b * SEQ + j : RL + b * CTX + (j - SEQ); }

DI void even_attention_phase(const Params& P, char* smem) {
    char* ws = P.ws; char* hid = ws + OFF_HID; char* ob = (char*)P.out;
    const bf16_t* QA = (const bf16_t*)(hid + HOFF_QA); const bf16_t* KA = (const bf16_t*)(hid + HOFF_KA); const bf16_t* VA = (const bf16_t*)(hid + HOFF_VA);
    const bf16_t* QB = (const bf16_t*)(hid + HOFF_QB); const bf16_t* KB = (const bf16_t*)(ob + OOFF_KB); const bf16_t* VB = (const bf16_t*)(ob + OOFF_VB);
    bf16_t* CC = (bf16_t*)(ws + OFF_XM);
    const float lam = *(const float*)(ws + OFF_LAM);
    const float* gsub = P.in[18];
    const int lane = ltid() & 63, wave = ltid() >> 6, l31 = lane & 31, hh = lane >> 5;
    constexpr int NQT = 33, NDIFF = NB * 4 * NQT, NMLA = NB * 8 * NQT;
    NAInfo na; na.qr = 0; na.kstart = 0;
    unsigned* wq = (unsigned*)(ws + OFF_BAR + 128);
    volatile int* slot = (volatile int*)(smem + 2 * ATT_LDS + 2048);
    for (;;) {
        __syncthreads();
        if (ltid() == 0) *slot = (int)atomicAdd(wq, 1u);
        __syncthreads();
        const int u = *slot;
        if (u >= NDIFF + NMLA) break;
        if (u < NDIFF) {
            const int qt = u % NQT, bh = u / NQT, h = bh & 3, b = bh >> 2;
            const int q0 = qt < 32 ? qt * 256 : SEQ;
            const int s0 = qt < 32 ? 0 : SEQ, n0 = qt < 32 ? NK / 64 : CTX / 64;
            const bf16_t* V = VB + (size_t)(b * 4 + h) * NK * 128;
            f32x16 o[4];
            attend<64, 128, false>(QB + (size_t)(b * 8 + 2 * h) * NK * 64, q0, KB + (size_t)(b * 8 + 2 * h) * NK * 64, V, s0, n0, 0, 0, o, smem, na);
            const int row = qrow_of(b, q0 + wave * 32 + l31);
            bf16_t* dst = CC + (size_t)row * 1024 + 512 + h * 128;
#pragma unroll
            for (int d = 0; d < 4; ++d) store16(dst + d * 32, o[d], 1.f, hh);
            f32x16 o2[4];
            attend<64, 128, false>(QB + (size_t)(b * 8 + 2 * h + 1) * NK * 64, q0, KB + (size_t)(b * 8 + 2 * h + 1) * NK * 64, V, s0, n0, 0, 0, o2, smem, na);
            float ss = 0.f;
#pragma unroll
            for (int d = 0; d < 4; ++d)
#pragma unroll
                for (int q4 = 0; q4 < 4; ++q4) {
                    const u32x2 w = *(const volatile u32x2*)(dst + d * 32 + 8 * q4 + 4 * hh);
                    const float a0 = bflo(w.x) - lam * o2[d][4 * q4], a1 = bfhi(w.x) - lam * o2[d][4 * q4 + 1], a2 = bflo(w.y) - lam * o2[d][4 * q4 + 2], a3 = bfhi(w.y) - lam * o2[d][4 * q4 + 3];
                    o[d][4 * q4] = a0; o[d][4 * q4 + 1] = a1; o[d][4 * q4 + 2] = a2; o[d][4 * q4 + 3] = a3;
                    ss += (a0 * a0 + a1 * a1) + (a2 * a2 + a3 * a3);
                }
            ss = xor32_sum(ss);
            const float rn = rsqrtf(ss * (1.f / 128.f) + 1e-5f) * 0.8f;
#pragma unroll
            for (int d = 0; d < 4; ++d)
#pragma unroll
                for (int q4 = 0; q4 < 4; ++q4) {
                    const int c = d * 32 + 8 * q4 + 4 * hh;
                    const f32x4 g = *(const f32x4*)(gsub + c);
                    u32x2 w; w.x = pk2(o[d][4 * q4] * rn * g[0], o[d][4 * q4 + 1] * rn * g[1]); w.y = pk2(o[d][4 * q4 + 2] * rn * g[2], o[d][4 * q4 + 3] * rn * g[3]);
                    *(u32x2*)(dst + c) = w;
                }
        } else {
            const int v = u - NDIFF, qt = v % NQT, bh = v / NQT, h = bh & 7, b = bh >> 3;
            const int q0 = qt < 32 ? qt * 256 : SEQ;
            const int s0 = qt < 32 ? 0 : SEQ, n0 = qt < 32 ? NK / 64 : CTX / 64;
            f32x16 o[2];
            attend<96, 64, false>(QA + (size_t)(b * 8 + h) * NK * 96, q0, KA + (size_t)(b * 8 + h) * NK * 96, VA + (size_t)(b * 8 + h) * NK * 64, s0, n0, 0, 0, o, smem, na);
            const int row = qrow_of(b, q0 + wave * 32 + l31);
            bf16_t* dst = CC + (size_t)row * 1024 + h * 64;
#pragma unroll
            for (int d = 0; d < 2; ++d) store16(dst + d * 32, o[d], 1.f, hh);
        }
    }
}

DI void odd_attention_phase(const Params& P, char* smem) {
    char* ws = P.ws; char* hid = ws + OFF_HID;
    const bf16_t* QD = (const bf16_t*)(hid + HOFF_QD); const bf16_t* KD = (const bf16_t*)(hid + HOFF_KD); const bf16_t* VD = (const bf16_t*)(hid + HOFF_VD);
    bf16_t* CC = (bf16_t*)(ws + OFF_XM);
    const float* rpbg = P.in[23];
    const int lane = ltid() & 63, wave = ltid() >> 6, l31 = lane & 31, hh = lane >> 5;
    float* rpbl = (float*)(smem + RPB_OFF);
    constexpr int NU = NB * 8 * 32;
    for (int u = lbid(); u < NU; u += gridDim.x) {
        const int rp = u & 31, bh = u >> 5, h = bh & 7, b = bh >> 3;
        __syncthreads();
        for (int i = ltid(); i < 465; i += NTHR) rpbl[i] = rpbg[h * 465 + i] * LOG2E;
        const int r0 = rp * 4;
        NAInfo na; na.qr = r0 + (wave >> 1);
        const int rs0 = min(max(r0 - 4, 0), 120);
        na.kstart = min(rs0, 117);
        f32x16 o[2];
        const size_t hb = (size_t)(b * 8 + h) * NK * 64;
        attend<64, 64, true>(QD + hb, r0 * 64, KD + hb, VD + hb, na.kstart * 64, 11, SEQ, CTX / 64, o, smem, na);
        const int row = b * SEQ + r0 * 64 + wave * 32 + l31;
        bf16_t* dst = CC + (size_t)row * 1024 + 512 + h * 64;
#pragma unroll
        for (int d = 0; d < 2; ++d) store16(dst + d * 32, o[d], 1.f, hh);
    }
}

DI void cvt8(bf16_t* dst, const float* src, float sc) {
    const f32x4 a = *(const f32x4*)src, b = *(const f32x4*)(src + 4);
    u32x4 w; w.x = pk2(a[0] * sc, a[1] * sc); w.y = pk2(a[2] * sc, a[3] * sc); w.z = pk2(b[0] * sc, b[1] * sc); w.w = pk2(b[2] * sc, b[3] * sc);
    *(u32x4*)dst = w;
}
DI void cvt_rows(bf16_t* dst, int ldd, const float* src, int lds_, int rows, int cols_src, const float* rowscale, size_t gtid, size_t gstride) {
    const int c8 = ldd >> 3; const size_t n = (size_t)rows * c8;
    for (size_t i0 = gtid; i0 < n; i0 += 4 * gstride) {
        f32x4 a[4], b[4]; float sc[4];
#pragma unroll
        for (int u = 0; u < 4; ++u) {
            const size_t i = i0 + u * gstride;
            const int k = (int)(i / c8), c = (int)(i % c8) * 8;
            const bool ok = i < n && c < cols_src;
            const float* p = src + (ok ? (size_t)k * lds_ + c : 0);
            a[u] = *(const f32x4*)p; b[u] = *(const f32x4*)(p + 4);
            sc[u] = !ok ? 0.f : (rowscale ? rowscale[k] : 1.f);
        }
#pragma unroll
        for (int u = 0; u < 4; ++u) {
            const size_t i = i0 + u * gstride;
            if (i < n) {
                const int k = (int)(i / c8), c = (int)(i % c8) * 8;
                u32x4 w; w.x = pk2(a[u][0] * sc[u], a[u][1] * sc[u]); w.y = pk2(a[u][2] * sc[u], a[u][3] * sc[u]); w.z = pk2(b[u][0] * sc[u], b[u][1] * sc[u]); w.w = pk2(b[u][2] * sc[u], b[u][3] * sc[u]);
                *(u32x4*)(dst + (size_t)k * ldd + c) = w;
            }
        }
    }
}

DI void phase_pro_a(const Params& P, char* smem) {
    char* ws = P.ws;
    const size_t gtid = (size_t)lbid() * NTHR + ltid(), gstride = (size_t)gridDim.x * NTHR;
    for (int lf = 0; lf < 4; ++lf) {
        const float* sg = P.in[8] + (size_t)lf * 1024 * DFF; const float* su = P.in[9] + (size_t)lf * 1024 * DFF;
        bf16_t* dst = (bf16_t*)(ws + OFF_WGU + lf * SZ_WGU);
        for (size_t i0 = gtid; i0 < 1024ull * 704; i0 += 4 * gstride) {
            f32x4 a[4], b[4];
#pragma unroll
            for (int u = 0; u < 4; ++u) {
                const size_t i = i0 + u * gstride < 1024ull * 704 ? i0 + u * gstride : i0;
                const int k = (int)(i / 704), n = (int)(i % 704) * 8, grp = n >> 6, w = n & 63;
                const float* src = ((w < 32) ? sg : su) + (size_t)k * DFF + grp * 32 + (w & 31);
                a[u] = *(const f32x4*)src; b[u] = *(const f32x4*)(src + 4);
            }
#pragma unroll
            for (int u = 0; u < 4; ++u) {
                const size_t i = i0 + u * gstride;
                if (i < 1024ull * 704) {
                    const int k = (int)(i / 704), n = (int)(i % 704) * 8;
                    u32x4 w; w.x = pk2(a[u][0], a[u][1]); w.y = pk2(a[u][2], a[u][3]); w.z = pk2(b[u][0], b[u][1]); w.w = pk2(b[u][2], b[u][3]);
                    *(u32x4*)(dst + (size_t)k * 5632 + n) = w;
                }
            }
        }
        cvt_rows((bf16_t*)(ws + OFF_WD + lf * SZ_WD), 1024, P.in[10] + (size_t)lf * DFF * 1024, 1024, DFF, 1024, nullptr, gtid, gstride);
    }
    cvt_rows((bf16_t*)(ws + OFF_EVIN), 2048, P.in[11], 1952, 1024, 1952, nullptr, gtid, gstride);
    cvt_rows((bf16_t*)(ws + OFF_EVOUT), 1024, P.in[12], 1024, 1024, 1024, nullptr, gtid, gstride);
    cvt_rows((bf16_t*)(ws + OFF_UQ), 768, P.in[15], 768, 256, 768, P.in[13], gtid, gstride);
    cvt_rows((bf16_t*)(ws + OFF_UKV), 1024, P.in[16], 1024, 128, 1024, P.in[14], gtid, gstride);
    cvt_rows((bf16_t*)(ws + OFF_ODIN), 2048, P.in[19], 2048, 1024, 2048, nullptr, gtid, gstride);
    cvt_rows((bf16_t*)(ws + OFF_ODOUT), 1024, P.in[20], 1024, 1024, 1024, nullptr, gtid, gstride);
    for (size_t i = gtid; i < 512ull * 64; i += gstride) {
        const int k = (int)(i >> 6), n = (int)(i & 63) * 8;
        bf16_t* d = (bf16_t*)(ws + OFF_POOL) + (size_t)k * 512 + n;
        if ((k >> 7) == (n >> 7)) cvt8(d, P.in[21] + (size_t)k * 128 + (n & 127), 1.f);
        else { u32x4 z = {0u, 0u, 0u, 0u}; *(u32x4*)d = z; }
    }
    if (gtid < 128 * 8) { const int r = (int)gtid >> 3, i = (int)gtid & 7; const float inv = exp2f(-(float)i * (13.287712379549449f / 8.f)); float rev = (float)r * inv * 0.15915494309189535f; rev -= floorf(rev);
        f32x2 v = {__builtin_amdgcn_cosf(rev), __builtin_amdgcn_sinf(rev)}; ((f32x2*)(ws + OFF_TAR))[gtid] = v; if (r < 64) ((f32x2*)(ws + OFF_TAC))[gtid] = v; }
    if (gtid < 128 * 16) { const int r = (int)gtid >> 4, i = (int)gtid & 15; const float inv = exp2f(-(float)i * (13.287712379549449f / 16.f)); float rev = (float)r * inv * 0.15915494309189535f; rev -= floorf(rev);
        f32x2 v = {__builtin_amdgcn_cosf(rev), __builtin_amdgcn_sinf(rev)}; ((f32x2*)(ws + OFF_TBR))[gtid] = v; if (r < 64) ((f32x2*)(ws + OFF_TBC))[gtid] = v; }
    if (gtid == 0) {
        const float* lv = P.in[17]; float a = 0.f, b = 0.f;
        for (int i = 0; i < 64; ++i) { a += lv[i] * lv[64 + i]; b += lv[128 + i] * lv[192 + i]; }
        *(float*)(ws + OFF_LAM) = expf(a) - expf(b) + 0.2f;
    }
    float* sc = (float*)smem;
    float* red = sc + 5 * 1024;
    const int tid = ltid(), jj = tid & 31, ig = tid >> 5;
    __syncthreads();
    for (int i = tid; i < 5 * 1024; i += NTHR) { const float v = i < 4096 ? P.in[1][i] : P.in[3][i - 4096]; sc[i] = v / (1.f + expf(-v)); }
    __syncthreads();
    for (int u = lbid(); u < 576; u += gridDim.x) {
        const int l = u / 288, j0 = (u % 288) * 32;
        float a[5] = {0.f, 0.f, 0.f, 0.f, 0.f};
        const float* w = P.in[4] + (size_t)l * 1024 * 9216 + (size_t)(ig * 64) * 9216 + j0 + jj;
        for (int i0 = 0; i0 < 64; i0 += 8) {
            float wv[8];
#pragma unroll
            for (int k = 0; k < 8; ++k) wv[k] = w[(size_t)(i0 + k) * 9216];
#pragma unroll
            for (int k = 0; k < 8; ++k)
#pragma unroll
                for (int s2 = 0; s2 < 5; ++s2) a[s2] += sc[s2 * 1024 + ig * 64 + i0 + k] * wv[k];
        }
#pragma unroll
        for (int s2 = 0; s2 < 5; ++s2) red[(ig * 5 + s2) * 32 + jj] = a[s2];
        __syncthreads();
        if (tid < 160) {
            const int s2 = tid >> 5, j = tid & 31;
            float v = P.in[5][l * 9216 + j0 + j];
#pragma unroll
            for (int g = 0; g < 16; ++g) v += red[(g * 5 + s2) * 32 + j];
            ((float*)(ws + OFF_MOD))[(size_t)(l * 5 + s2) * 9216 + j0 + j] = v;
        }
        __syncthreads();
    }
}

DI void phase_pro_b(const Params& P) {
    char* ws = P.ws; bf16_t* XM = (bf16_t*)(ws + OFF_XM); const float* MOD = (const float*)(ws + OFF_MOD);
    const size_t gtid = (size_t)lbid() * NTHR + ltid(), gstride = (size_t)gridDim.x * NTHR;
    for (size_t i = gtid; i < (size_t)RT * 128; i += gstride) {
        const int row = (int)(i >> 7), c = (int)(i & 127) * 8;
        const float* src = row < RL ? P.in[0] + (size_t)row * 1024 + c : P.in[2] + (size_t)(row - RL) * 1024 + c;
        const int s = row < RL ? (row >> 13) : 4;
        const float* sh = MOD + (size_t)s * 9216 + c; const float* scl = sh + 1024;
        unsigned w[4];
#pragma unroll
        for (int hf = 0; hf < 2; ++hf) {
            const f32x4 x = *(const f32x4*)(src + 4 * hf), a = *(const f32x4*)(sh + 4 * hf), g = *(const f32x4*)(scl + 4 * hf);
            w[2 * hf] = pk2(x[0] * (1.f + g[0]) + a[0], x[1] * (1.f + g[1]) + a[1]);
            w[2 * hf + 1] = pk2(x[2] * (1.f + g[2]) + a[2], x[3] * (1.f + g[3]) + a[3]);
        }
        u32x4 o = {w[0], w[1], w[2], w[3]};
        *(u32x4*)(XM + (size_t)row * 1024 + c) = o;
    }
}

struct LnSpec { int l, which, lnext, mshift; bool final_; unsigned* cnt; const bf16_t* Y; const float* res_lat; const float* res_ctx; };
template <int NR>
DI void ln_rows(const Params& P, const LnSpec& sp, int row, int stride, int lane) {
    char* ws = P.ws; float* X = (float*)(ws + OFF_X); bf16_t* XM = (bf16_t*)(ws + OFF_XM); const float* MOD = (const float*)(ws + OFF_MOD);
    const float* g = P.in[6] + (sp.l * 3 + sp.which) * 1024; const float* bb = P.in[7] + (sp.l * 3 + sp.which) * 1024;
    f32x4 v[NR][4]; float s[NR], qv[NR];
#pragma unroll
    for (int k = 0; k < NR; ++k) {
        const int r = row + k * stride;
        const float* xp = r < RL ? sp.res_lat + (size_t)r * 1024 : sp.res_ctx + (size_t)(r - RL) * 1024;
        const bf16_t* yp = sp.Y + (size_t)r * 1024;
#pragma unroll
        for (int i = 0; i < 4; ++i) {
            const f32x4 x = *(const f32x4*)(xp + (i * 64 + lane) * 4);
            const u32x2 y = *(const u32x2*)(yp + (i * 64 + lane) * 4);
            v[k][i][0] = ALPHA * x[0] + bflo(y.x); v[k][i][1] = ALPHA * x[1] + bfhi(y.x);
            v[k][i][2] = ALPHA * x[2] + bflo(y.y); v[k][i][3] = ALPHA * x[3] + bfhi(y.y);
        }
    }
#pragma unroll
    for (int k = 0; k < NR; ++k) {
        s[k] = 0.f;
#pragma unroll
        for (int i = 0; i < 4; ++i) s[k] += (v[k][i][0] + v[k][i][1]) + (v[k][i][2] + v[k][i][3]);
    }
#pragma unroll
    for (int o = 32; o >= 1; o >>= 1)
#pragma unroll
        for (int k = 0; k < NR; ++k) s[k] += __shfl_xor(s[k], o);
#pragma unroll
    for (int k = 0; k < NR; ++k) {
        s[k] *= (1.f / 1024.f); qv[k] = 0.f;
#pragma unroll
        for (int i = 0; i < 4; ++i)
#pragma unroll
            for (int j = 0; j < 4; ++j) { const float d = v[k][i][j] - s[k]; qv[k] += d * d; }
    }
#pragma unroll
    for (int o = 32; o >= 1; o >>= 1)
#pragma unroll
        for (int k = 0; k < NR; ++k) qv[k] += __shfl_xor(qv[k], o);
#pragma unroll
    for (int k = 0; k < NR; ++k) {
        const int r = row + k * stride;
        const float mu = s[k], rstd = rsqrtf(qv[k] * (1.f / 1024.f) + 1e-6f);
        const int sidx = r < RL ? (r >> 13) : 4;
        const float* sh = MOD + (size_t)(sp.lnext * 5 + sidx) * 9216 + sp.mshift * 1024; const float* scl = sh + 1024;
        float* xp = X + (size_t)r * 1024;
#pragma unroll
        for (int i = 0; i < 4; ++i) {
            const int c = (i * 64 + lane) * 4;
            const f32x4 gg = *(const f32x4*)(g + c), b4 = *(const f32x4*)(bb + c);
            f32x4 y;
#pragma unroll
            for (int j = 0; j < 4; ++j) y[j] = (v[k][i][j] - mu) * rstd * gg[j] + b4[j];
            if (sp.final_) { *(f32x4*)(P.out + (size_t)r * 1024 + c) = y; }
            else {
                *(f32x4*)(xp + c) = y;
                const f32x4 a = *(const f32x4*)(sh + c), sg = *(const f32x4*)(scl + c);
                u32x2 w; w.x = pk2(y[0] * (1.f + sg[0]) + a[0], y[1] * (1.f + sg[1]) + a[1]); w.y = pk2(y[2] * (1.f + sg[2]) + a[2], y[3] * (1.f + sg[3]) + a[3]);
                *(u32x2*)(XM + (size_t)r * 1024 + c) = w;
            }
        }
    }
}
DI void phase_ln(const Params& P, int l, int which, int lnext, int mshift, bool final_, bool lat_only, const bf16_t* Y, bool first) {
    float* X = (float*)(P.ws + OFF_X);
    const LnSpec sp{l, which, lnext, mshift, final_, nullptr, Y, first ? P.in[0] : X, first ? P.in[2] : X + (size_t)RL * 1024};
    const int lane = ltid() & 63, wave = ltid() >> 6;
    const int nq = ((final_ || lat_only) ? RL : RT) / 4;
    for (int q = lbid() * NWAVE + wave; q < nq; q += gridDim.x * NWAVE) ln_rows<4>(P, sp, 4 * q, 1, lane);
}

DI void phase_ev_rms(const Params& P) {
    char* ws = P.ws; bf16_t* QN = (bf16_t*)(ws + OFF_HID + HOFF_QN); bf16_t* KVN = (bf16_t*)((char*)P.out + OOFF_KVN);
    const int lane = ltid() & 63, wave = ltid() >> 6;
    for (int row = (lbid() * NWAVE + wave) * 4; row < RT; row += gridDim.x * NWAVE * 4) {
        u32x2 wq[4]; unsigned wk[4]; float sq[4], sk[4];
#pragma unroll
        for (int k = 0; k < 4; ++k) { wq[k] = *(const u32x2*)(QN + (size_t)(row + k) * 256 + lane * 4); wk[k] = *(const unsigned*)(KVN + (size_t)(row + k) * 128 + lane * 2); }
#pragma unroll
        for (int k = 0; k < 4; ++k) {
            const float a = bflo(wq[k].x), b = bfhi(wq[k].x), c = bflo(wq[k].y), d = bfhi(wq[k].y);
            sq[k] = a * a + b * b + c * c + d * d;
            const float e = bflo(wk[k]), f = bfhi(wk[k]);
            sk[k] = e * e + f * f;
        }
#pragma unroll
        for (int o = 32; o >= 1; o >>= 1)
#pragma unroll
            for (int k = 0; k < 4; ++k) { sq[k] += __shfl_xor(sq[k], o); sk[k] += __shfl_xor(sk[k], o); }
#pragma unroll
        for (int k = 0; k < 4; ++k) {
            const float rq = rsqrtf(sq[k] * (1.f / 256.f) + 1e-6f), rk = rsqrtf(sk[k] * (1.f / 128.f) + 1e-6f);
            u32x2 o2; o2.x = pk2(bflo(wq[k].x) * rq, bfhi(wq[k].x) * rq); o2.y = pk2(bflo(wq[k].y) * rq, bfhi(wq[k].y) * rq);
            *(u32x2*)(QN + (size_t)(row + k) * 256 + lane * 4) = o2;
            *(unsigned*)(KVN + (size_t)(row + k) * 128 + lane * 2) = pk2(bflo(wk[k]) * rk, bfhi(wk[k]) * rk);
        }
    }
}

DI void phase_od_pool(const Params& P) {
    char* ws = P.ws; const bf16_t* U = (const bf16_t*)(ws + OFF_HID + HOFF_U); bf16_t* PL = (bf16_t*)(ws + OFF_HID + HOFF_PL);
    const size_t gtid = (size_t)lbid() * NTHR + ltid(), gstride = (size_t)gridDim.x * NTHR;
    for (size_t i = gtid; i < (size_t)RT * 64; i += gstride) {
        const int row = (int)(i >> 6), c = (int)(i & 63) * 8, grp = c >> 7;
        const int w = 2 << grp, left = w >> 1, right = w - 1 - left;
        int base, n, t;
        if (row < RL) { base = row & ~8191; n = SEQ; t = row & 8191; } else { const int rc = row - RL; base = RL + (rc & ~255); n = CTX; t = rc & 255; }
        const int lo = max(t - left, 0), hi = min(t + right + 1, n);
        float acc[8] = {0.f, 0.f, 0.f, 0.f, 0.f, 0.f, 0.f, 0.f};
#pragma unroll 4
        for (int tt = lo; tt < hi; ++tt) {
            const u32x4 v = *(const u32x4*)(U + (size_t)(base + tt) * 512 + c);
            acc[0] += bflo(v.x); acc[1] += bfhi(v.x); acc[2] += bflo(v.y); acc[3] += bfhi(v.y); acc[4] += bflo(v.z); acc[5] += bfhi(v.z); acc[6] += bflo(v.w); acc[7] += bfhi(v.w);
        }
        const float ic = 1.f / (float)(hi - lo);
        const u32x4 s = *(const u32x4*)(U + (size_t)row * 512 + c);
        u32x4 o;
        o.x = pk2(acc[0] * ic - bflo(s.x), acc[1] * ic - bfhi(s.x)); o.y = pk2(acc[2] * ic - bflo(s.y), acc[3] * ic - bfhi(s.y));
        o.z = pk2(acc[4] * ic - bflo(s.z), acc[5] * ic - bfhi(s.z)); o.w = pk2(acc[6] * ic - bflo(s.w), acc[7] * ic - bfhi(s.w));
        *(u32x4*)(PL + (size_t)row * 512 + c) = o;
    }
}

constexpr int NPHASE = 25;

DI void run_phase(const Params& P, int ph, char* smem) {
    char* ws = P.ws; char* hid = ws + OFF_HID; char* ob = (char*)P.out;
    float* X = (float*)(ws + OFF_X); bf16_t* XM = (bf16_t*)(ws + OFF_XM); bf16_t* HID = (bf16_t*)hid;
    const float* MOD = (const float*)(ws + OFF_MOD);
    if (ph == 0) { phase_pro_a(P, smem); return; }
    if (ph == 1) { phase_pro_b(P); return; }
    int l, op;
    if (ph < 14) { l = 0; op = ph - 2; } else { l = 1; op = ph - 14; if (op >= 6) op += 1; }
    const float* modl = MOD + (size_t)l * 5 * 9216;
    switch (op) {
    case 0: case 9: {
        const int f = op == 0 ? 0 : 1;
        EpiSwiglu e{HID};
        gemm_phase(XM, 1024, (const bf16_t*)(ws + OFF_WGU + (l * 2 + f) * SZ_WGU), 5632, 5632, 1024, e, smem, !(l == 1 && f == 1));
    } break;
    case 1: case 10: {
        const int f = op == 1 ? 0 : 1;
        EpiY e{XM, modl + (f == 0 ? 2 : 8) * 1024, 0.5f};
        gemm_phase(HID, DFF, (const bf16_t*)(ws + OFF_WD + (l * 2 + f) * SZ_WD), 1024, 1024, DFF, e, smem, !(l == 1 && f == 1));
    } break;
    case 2: phase_ln(P, l, 0, l, 3, false, false, XM, l == 0); break;
    case 3: {
        if (l == 0) {
            EpiEvIn e{(bf16_t*)(hid + HOFF_QN), (bf16_t*)(hid + HOFF_QB), (bf16_t*)(ob + OOFF_KVN), (bf16_t*)(hid + HOFF_KA), (bf16_t*)(ob + OOFF_KB), (bf16_t*)(ob + OOFF_VB),
                      (const f32x2*)(ws + OFF_TAR), (const f32x2*)(ws + OFF_TAC), (const f32x2*)(ws + OFF_TBR), (const f32x2*)(ws + OFF_TBC)};
            gemm_phase(XM, 1024, (const bf16_t*)(ws + OFF_EVIN), 2048, 2048, 1024, e, smem);
        } else {
            EpiOdIn e{(bf16_t*)(hid + HOFF_U), (bf16_t*)(hid + HOFF_QD), (bf16_t*)(hid + HOFF_KD), (bf16_t*)(hid + HOFF_VD)};
            gemm_phase(XM, 1024, (const bf16_t*)(ws + OFF_ODIN), 2048, 2048, 1024, e, smem);
        }
    } break;
    case 4: if (l == 0) phase_ev_rms(P); else phase_od_pool(P); break;
    case 5: {
        if (l == 0) {
            EpiUQ e1{(bf16_t*)(hid + HOFF_QA), (const f32x2*)(ws + OFF_TAR), (const f32x2*)(ws + OFF_TAC)};
            gemm_phase((const bf16_t*)(hid + HOFF_QN), 256, (const bf16_t*)(ws + OFF_UQ), 768, 768, 256, e1, smem);
            EpiUKV e2{(bf16_t*)(hid + HOFF_KA), (bf16_t*)(hid + HOFF_VA)};
            gemm_phase((const bf16_t*)(ob + OOFF_KVN), 128, (const bf16_t*)(ws + OFF_UKV), 1024, 1024, 128, e2, smem);
        } else {
            odd_attention_phase(P, smem);
            EpiPool e{XM, P.in[22], 0};
            gemm_phase((const bf16_t*)(hid + HOFF_PL), 512, (const bf16_t*)(ws + OFF_POOL), 512, 512, 512, e, smem);
        }
    } break;
    case 6: even_attention_phase(P, smem); break;
    case 7: {
        EpiY e{HID, modl + 5 * 1024, 1.f};
        gemm_phase(XM, 1024, (const bf16_t*)(ws + (l == 0 ? OFF_EVOUT : OFF_ODOUT)), 1024, 1024, 1024, e, smem, l == 0);
    } break;
    case 8: phase_ln(P, l, 1, l, 6, false, l == 1, HID, false); break;
    case 11: if (l == 0) phase_ln(P, 0, 2, 1, 0, false, false, XM, false); else phase_ln(P, 1, 2, 1, 0, true, true, XM, false); break;
    default: break;
    }
}

DI void grid_barrier(unsigned* ctr, unsigned target) {
    __syncthreads();
    if (threadIdx.x == 0) {
        __builtin_amdgcn_fence(__ATOMIC_RELEASE, "agent");
        __hip_atomic_fetch_add(ctr, 1u, __ATOMIC_RELAXED, __HIP_MEMORY_SCOPE_AGENT);
        while (__hip_atomic_load(ctr, __ATOMIC_RELAXED, __HIP_MEMORY_SCOPE_AGENT) < target) __builtin_amdgcn_s_sleep(2);
        __builtin_amdgcn_fence(__ATOMIC_ACQUIRE, "agent");
    }
    __syncthreads();
}

__global__ void __launch_bounds__(NTHR, 2) mega(Params P, int ph_lo, int ph_hi) {
    extern __shared__ __attribute__((aligned(16))) char smem[];
    unsigned nsync = 0;
    for (int ph = ph_lo; ph < ph_hi; ++ph) {
        run_phase(P, ph, smem);
        if (ph + 1 < ph_hi) {
            if (ph == ph_lo) cg::this_grid().sync();
            else { ++nsync; grid_barrier((unsigned*)(P.ws + OFF_BAR), nsync * gridDim.x); }
        }
    }
}

extern "C" void kernel_launch(void* const* d_in, const int* in_sizes, int n_in, void* d_out, int out_size, void* d_ws, size_t ws_size, hipStream_t stream) {
    if (ws_size < WS_NEED) { fprintf(stderr, "workspace too small: %zu < %zu\n", ws_size, (size_t)WS_NEED); return; }
    Params P{};
    for (int i = 0; i < 24; ++i) P.in[i] = (const float*)d_in[i];
    P.out = (float*)d_out; P.ws = (char*)d_ws;
    static int grid_blocks = 0;
    if (!grid_blocks) {
        int dev = 0, cus = 0, per_cu = 0;
        hipGetDevice(&dev);
        hipDeviceGetAttribute(&cus, hipDeviceAttributeMultiprocessorCount, dev);
        hipFuncSetAttribute((const void*)mega, hipFuncAttributeMaxDynamicSharedMemorySize, SMEM_BYTES);
        hipOccupancyMaxActiveBlocksPerMultiprocessor(&per_cu, mega, NTHR, SMEM_BYTES);
        if (per_cu < 1) per_cu = 1;
        if (per_cu > 1) per_cu = 1;
        grid_blocks = cus * per_cu;
    }
#if COOP
    hipMemsetAsync((char*)d_ws + OFF_BAR, 0, 256, stream);
    int lo = 0, hi = NPHASE;
    void* args[] = {&P, &lo, &hi};
    hipError_t e = hipLaunchCooperativeKernel((void*)mega, dim3(grid_blocks), dim3(NTHR), args, SMEM_BYTES, stream);
    if (e != hipSuccess) fprintf(stderr, "cooperative launch failed: %s (grid %d)\n", hipGetErrorString(e), grid_blocks);
#else
    for (int ph = 0; ph < NPHASE; ++ph) mega<<<grid_blocks, NTHR, SMEM_BYTES, stream>>>(P, ph, ph + 1);
#endif
}
```

```cpp
#include <hip/hip_runtime.h>
#include <hip/hip_cooperative_groups.h>
#include <cstdio>
#include <cstdint>
namespace cg = cooperative_groups;

#ifndef COOP
#define COOP 1
#endif

#define DI __device__ __forceinline__
typedef unsigned short bf16_t;
typedef short bf16x8 __attribute__((ext_vector_type(8)));
typedef short s16x4 __attribute__((ext_vector_type(4)));
typedef __bf16 bfx4 __attribute__((ext_vector_type(4)));
typedef __bf16 bfx2 __attribute__((ext_vector_type(2)));
typedef float f32x2 __attribute__((ext_vector_type(2)));
typedef float f32x4 __attribute__((ext_vector_type(4)));
typedef float f32x16 __attribute__((ext_vector_type(16)));
typedef unsigned u32x2 __attribute__((ext_vector_type(2)));
typedef unsigned u32x4 __attribute__((ext_vector_type(4)));
#define LDS_AS __attribute__((address_space(3)))

constexpr int DM = 1024, NB = 4, SEQ = 8192, CTX = 256, DFF = 2816;
constexpr int RL = NB * SEQ, RC = NB * CTX, RT = RL + RC;
constexpr int NK = SEQ + CTX;
constexpr float ALPHA = 1.41421356237f;
constexpr float LOG2E = 1.4426950408889634f;
constexpr float QA_SCALE = 0.10206207261596575f * LOG2E;
constexpr float QB_SCALE = 0.125f * LOG2E;
constexpr float QD_SCALE = 0.125f * LOG2E;
constexpr int NTHR = 512, NWAVE = NTHR / 64;

constexpr size_t SZ_WGU = 1024ull * 5632 * 2, SZ_WD = 2816ull * 1024 * 2;
constexpr size_t OFF_WGU = 0;
constexpr size_t OFF_WD = OFF_WGU + 4 * SZ_WGU;
constexpr size_t OFF_EVIN = OFF_WD + 4 * SZ_WD;
constexpr size_t OFF_EVOUT = OFF_EVIN + 1024ull * 2048 * 2;
constexpr size_t OFF_UQ = OFF_EVOUT + 1024ull * 1024 * 2;
constexpr size_t OFF_UKV = OFF_UQ + 256ull * 768 * 2;
constexpr size_t OFF_ODIN = OFF_UKV + 128ull * 1024 * 2;
constexpr size_t OFF_ODOUT = OFF_ODIN + 1024ull * 2048 * 2;
constexpr size_t OFF_POOL = OFF_ODOUT + 1024ull * 1024 * 2;
constexpr size_t OFF_MOD = OFF_POOL + 512ull * 512 * 2;
constexpr size_t OFF_TAR = OFF_MOD + 2ull * 5 * 9216 * 4;
constexpr size_t OFF_TAC = OFF_TAR + 128 * 8 * 8;
constexpr size_t OFF_TBR = OFF_TAC + 64 * 8 * 8;
constexpr size_t OFF_TBC = OFF_TBR + 128 * 16 * 8;
constexpr size_t OFF_LAM = OFF_TBC + 64 * 16 * 8;
constexpr size_t OFF_BAR = OFF_LAM + 256;
constexpr size_t OFF_X = OFF_BAR + 256;
constexpr size_t OFF_XM = OFF_X + (size_t)RT * 1024 * 4;
constexpr size_t OFF_HID = OFF_XM + (size_t)RT * 1024 * 2;
constexpr size_t WS_NEED = OFF_HID + (size_t)RT * DFF * 2;
constexpr size_t SZ_H96 = (size_t)NB * 8 * NK * 96 * 2, SZ_H64 = (size_t)NB * 8 * NK * 64 * 2;
constexpr size_t HOFF_QA = 0, HOFF_KA = SZ_H96, HOFF_VA = 2 * SZ_H96, HOFF_QB = HOFF_VA + SZ_H64, HOFF_QN = HOFF_QB + SZ_H64;
static_assert(HOFF_QN + (size_t)RT * 256 * 2 <= (size_t)RT * DFF * 2, "HID region overflow");
constexpr size_t HOFF_U = 0, HOFF_PL = SZ_H64, HOFF_QD = 2 * SZ_H64, HOFF_KD = 3 * SZ_H64, HOFF_VD = 4 * SZ_H64;
constexpr size_t OOFF_KB = 0, OOFF_VB = SZ_H64, OOFF_KVN = 2 * SZ_H64;
static_assert(OOFF_KVN + (size_t)RT * 128 * 2 <= (size_t)RL * 1024 * 4, "d_out region overflow");

struct Params {
    const float* in[24];
    float* out;
    char* ws;
};

DI int ltid() { int t = threadIdx.x; asm volatile("" : "+v"(t)); return t; }
DI int lbid() { int t = blockIdx.x; asm volatile("" : "+s"(t)); return t; }
DI unsigned pk2(float a, float b) { f32x2 v = {a, b}; bfx2 r = __builtin_convertvector(v, bfx2); return __builtin_bit_cast(unsigned, r); }
DI float bf2f(unsigned short u) { return __uint_as_float(((unsigned)u) << 16); }
DI float bflo(unsigned u) { return __uint_as_float(u << 16); }
DI float bfhi(unsigned u) { return __uint_as_float(u & 0xffff0000u); }
DI float silu_f(float x) { return x * __builtin_amdgcn_rcpf(1.f + __expf(-x)); }
DI f32x16 mfma32(bf16x8 a, bf16x8 b, f32x16 c) { return __builtin_amdgcn_mfma_f32_32x32x16_bf16(a, b, c, 0, 0, 0); }
DI s16x4 tr_read(const char* p) { bfx4 r = __builtin_amdgcn_ds_read_tr16_b64_v4bf16((LDS_AS bfx4*)p); return __builtin_bit_cast(s16x4, r); }
DI float xor32_max(float x) { const unsigned u = __float_as_uint(x); auto r = __builtin_amdgcn_permlane32_swap(u, u, false, false); return fmaxf(__uint_as_float(r[0]), __uint_as_float(r[1])); }
DI float xor32_sum(float x) { const unsigned u = __float_as_uint(x); auto r = __builtin_amdgcn_permlane32_swap(u, u, false, false); return __uint_as_float(r[0]) + __uint_as_float(r[1]); }
DI bf16x8 cat8(s16x4 lo, s16x4 hi) { return __builtin_shufflevector(lo, hi, 0, 1, 2, 3, 4, 5, 6, 7); }

struct RowInfo { int b, j, s; bool lat; };
DI RowInfo rowinfo(int row) {
    RowInfo r;
    if (row < RL) { r.b = row >> 13; r.j = row & 8191; r.s = r.b; r.lat = true; }
    else { int rc = row - RL; r.b = rc >> 8; r.j = 8192 + (rc & 255); r.s = 4; r.lat = false; }
    return r;
}
DI void store16(bf16_t* dst32, const f32x16& v, float sc, int hh) {
#pragma unroll
    for (int q4 = 0; q4 < 4; ++q4) {
        u32x2 w; w.x = pk2(v[4 * q4] * sc, v[4 * q4 + 1] * sc); w.y = pk2(v[4 * q4 + 2] * sc, v[4 * q4 + 3] * sc);
        *(u32x2*)(dst32 + 8 * q4 + 4 * hh) = w;
    }
}
DI f32x16 ropeB(const f32x16& v, const f32x2* tab, int hh) {
    f32x16 o;
#pragma unroll
    for (int r = 0; r < 8; ++r) {
        const int i = (r & 3) + 8 * (r >> 2) + 4 * hh;
        const f32x2 cs = tab[i];
        o[r] = v[r] * cs.x - v[r + 8] * cs.y;
        o[r + 8] = v[r + 8] * cs.x + v[r] * cs.y;
    }
    return o;
}
DI f32x16 ropeA(const f32x16& v, const f32x2* tr, const f32x2* tc, int hh) {
    f32x16 o;
#pragma unroll
    for (int r = 0; r < 4; ++r) {
        const int i = 4 * hh + r;
        const f32x2 a = tr[i], c = tc[i];
        o[r] = v[r] * a.x - v[r + 4] * a.y;
        o[r + 4] = v[r + 4] * a.x + v[r] * a.y;
        o[8 + r] = v[8 + r] * c.x - v[12 + r] * c.y;
        o[12 + r] = v[12 + r] * c.x + v[8 + r] * c.y;
    }
    return o;
}

constexpr int GA_S = 144, GB_S = 576;
constexpr int GSTAGE = 256 * GA_S + 64 * GB_S;
constexpr int GEMM_LDS = 2 * GSTAGE;

template <int BM, class Epi>
DI void gemm_tile(const bf16_t* __restrict__ A, int lda, const bf16_t* __restrict__ B, int ldb, int K, int row0, int col0, const Epi& epi, char* smem) {
    constexpr int MI = BM / 64, NA_ = BM / 64;
    const int tid = ltid(), lane = tid & 63, wave = tid >> 6, wm = wave >> 2, wn = wave & 3;
    const int l31 = lane & 31, hh = lane >> 5, q = (lane & 15) >> 2, p = lane & 3, nblk = (lane >> 4) & 1;
    f32x16 acc[MI][2];
#pragma unroll
    for (int i = 0; i < MI; ++i)
#pragma unroll
        for (int j = 0; j < 2; ++j)
#pragma unroll
            for (int r = 0; r < 16; ++r) acc[i][j][r] = 0.f;
    u32x4 ra[NA_], rb[4];
    const bf16_t* ag = A + (size_t)(row0 + (tid >> 3)) * lda + (tid & 7) * 8;
    const bf16_t* bg = B + (size_t)(tid >> 5) * ldb + col0 + (tid & 31) * 8;
    const int aw = (tid >> 3) * GA_S + (tid & 7) * 16, bw = BM * GA_S + (tid >> 5) * GB_S + (tid & 31) * 16;
    const int nk = K >> 6;
    const int xoff = (wm * (BM / 2) + l31) * GA_S + hh * 16;
    const int woff = BM * GA_S + (hh * 8 + q) * GB_S + (wn * 64 + nblk * 16 + 4 * p) * 2;
#pragma unroll
    for (int i = 0; i < NA_; ++i) ra[i] = *(const u32x4*)(ag + (size_t)(64 * i) * lda);
#pragma unroll
    for (int i = 0; i < 4; ++i) rb[i] = *(const u32x4*)(bg + (size_t)(16 * i) * ldb);
    __syncthreads();
#pragma unroll
    for (int i = 0; i < NA_; ++i) *(u32x4*)(smem + aw + 64 * i * GA_S) = ra[i];
#pragma unroll
    for (int i = 0; i < 4; ++i) *(u32x4*)(smem + bw + 16 * i * GB_S) = rb[i];
    if (nk > 1) {
#pragma unroll
        for (int i = 0; i < NA_; ++i) ra[i] = *(const u32x4*)(ag + 64 + (size_t)(64 * i) * lda);
#pragma unroll
        for (int i = 0; i < 4; ++i) rb[i] = *(const u32x4*)(bg + (size_t)(64 + 16 * i) * ldb);
    }
    __syncthreads();
    for (int kt = 0; kt < nk; ++kt) {
        const char* cur = smem + (kt & 1) * GSTAGE;
        char* nxt = smem + ((kt & 1) ^ 1) * GSTAGE;
        const bool w1 = kt + 1 < nk, l2 = kt + 2 < nk;
        const bf16_t* a2 = ag + (size_t)(kt + 2) * 64; const bf16_t* b2 = bg + (size_t)(kt + 2) * 64 * ldb;
#pragma unroll
        for (int s = 0; s < 4; ++s) {
            bf16x8 xf[MI], wf[2];
#pragma unroll
            for (int mi = 0; mi < MI; ++mi) xf[mi] = *(const bf16x8*)(cur + xoff + mi * 32 * GA_S + s * 32);
#pragma unroll
            for (int ni = 0; ni < 2; ++ni) {
                const char* wp = cur + woff + s * 16 * GB_S + ni * 64;
                wf[ni] = cat8(tr_read(wp), tr_read(wp + 4 * GB_S));
            }
#pragma unroll
            for (int mi = 0; mi < MI; ++mi)
#pragma unroll
                for (int ni = 0; ni < 2; ++ni) acc[mi][ni] = mfma32(wf[ni], xf[mi], acc[mi][ni]);
            if (w1) {
                if (s < NA_) *(u32x4*)(nxt + aw + 64 * s * GA_S) = ra[s];
                *(u32x4*)(nxt + bw + 16 * s * GB_S) = rb[s];
            }
            if (l2) {
                if (s < NA_) ra[s] = *(const u32x4*)(a2 + (size_t)(64 * s) * lda);
                rb[s] = *(const u32x4*)(b2 + (size_t)(16 * s) * ldb);
            }
        }
        __syncthreads();
    }
#pragma unroll
    for (int mi = 0; mi < MI; ++mi) epi(acc[mi][0], acc[mi][1], row0 + wm * (BM / 2) + mi * 32 + l31, col0 + wn * 64, hh);
}

template <class Epi>
DI void gemm_phase(const bf16_t* A, int lda, const bf16_t* B, int ldb, int N, int K, const Epi& epi, char* smem, bool do_ctx = true) {
    const int nt = N >> 8, small = do_ctx ? (RC / 128) * nt : 0;
    const int bid = lbid(), G = gridDim.x;
    if ((G & 7) == 0) {
        const int xcd = bid & 7, loc = bid >> 3, per = G >> 3, mine = (RL / 256 / 8) * nt;
        for (int i = loc; i < mine; i += per) {
            const int cg = i >> 7, rem = i & 127, cw = min(8, nt - cg * 8);
            int pg, w;
            if (cw == 8) { pg = rem >> 5; w = rem & 31; } else { const int rr = i - cg * 128; pg = rr / (4 * cw); w = rr - pg * 4 * cw; }
            const int pl = pg * 4 + (w & 3), cl = cg * 8 + (w >> 2);
            gemm_tile<256>(A, lda, B, ldb, K, (pl * 8 + xcd) * 256, cl * 256, epi, smem);
        }
    } else {
        const int big = (RL / 256) * nt;
        for (int t = bid; t < big; t += G) gemm_tile<256>(A, lda, B, ldb, K, (t / nt) * 256, (t % nt) * 256, epi, smem);
    }
    for (int u = bid; u < small; u += G) gemm_tile<128>(A, lda, B, ldb, K, RL + (u / nt) * 128, (u % nt) * 256, epi, smem);
}

struct EpiSwiglu {
    bf16_t* hid;
    DI void operator()(const f32x16& a0, const f32x16& a1, int row, int cbase, int hh) const {
        bf16_t* dst = hid + (size_t)row * DFF + (cbase >> 1) + 4 * hh;
#pragma unroll
        for (int q4 = 0; q4 < 4; ++q4) {
            float h[4];
#pragma unroll
            for (int j = 0; j < 4; ++j) h[j] = silu_f(a0[4 * q4 + j]) * a1[4 * q4 + j];
            u32x2 w; w.x = pk2(h[0], h[1]); w.y = pk2(h[2], h[3]);
            *(u32x2*)(dst + 8 * q4) = w;
        }
    }
};
struct EpiResid {
    const float* res_lat; const float* res_ctx; float* X; const float* gate; float coef;
    DI void operator()(const f32x16& a0, const f32x16& a1, int row, int cbase, int hh) const {
        const int s = row < RL ? (row >> 13) : 4;
        const float* rp = row < RL ? res_lat + (size_t)row * 1024 : res_ctx + (size_t)(row - RL) * 1024;
        const float* gp = gate + s * 9216;
        float* xp = X + (size_t)row * 1024;
#pragma unroll
        for (int ni = 0; ni < 2; ++ni)
#pragma unroll
            for (int q4 = 0; q4 < 4; ++q4) {
                const int c = cbase + ni * 32 + 8 * q4 + 4 * hh;
                const f32x4 r = *(const f32x4*)(rp + c), g = *(const f32x4*)(gp + c);
                f32x4 z;
#pragma unroll
                for (int j = 0; j < 4; ++j) z[j] = ALPHA * r[j] + coef * g[j] * (ni ? a1[4 * q4 + j] : a0[4 * q4 + j]);
                *(f32x4*)(xp + c) = z;
            }
    }
};
struct EpiY {
    static constexpr bool kSwap = false;
    bf16_t* Y; const float* gate; float coef;
    DI void operator()(const f32x16& a0, const f32x16& a1, int row, int cbase, int hh) const {
        const int s = row < RL ? (row >> 13) : 4;
        const float* gp = gate + s * 9216;
        bf16_t* yp = Y + (size_t)row * 1024;
#pragma unroll
        for (int ni = 0; ni < 2; ++ni)
#pragma unroll
            for (int q4 = 0; q4 < 4; ++q4) {
                const int c = cbase + ni * 32 + 8 * q4 + 4 * hh;
                const f32x4 g = *(const f32x4*)(gp + c);
                const f32x16& v = ni ? a1 : a0;
                u32x2 w; w.x = pk2(coef * g[0] * v[4 * q4], coef * g[1] * v[4 * q4 + 1]); w.y = pk2(coef * g[2] * v[4 * q4 + 2], coef * g[3] * v[4 * q4 + 3]);
                *(u32x2*)(yp + c) = w;
            }
    }
};
struct EpiEvIn {
    bf16_t *QN, *QB, *KVN, *KA, *KB, *VB; const f32x2 *tAr, *tAc, *tBr, *tBc;
    DI void operator()(const f32x16& a0, const f32x16& a1, int row, int cbase, int hh) const {
        const RowInfo ri = rowinfo(row);
        const int gr = (ri.j >> 6) & 127, gc = ri.j & 63;
#pragma unroll
        for (int ni = 0; ni < 2; ++ni) {
            const int g = (cbase >> 5) + ni;
            const f32x16& v = ni ? a1 : a0;
            if (g < 8) store16(QN + (size_t)row * 256 + g * 32, v, 1.f, hh);
            else if (g < 24) {
                const int hv = (g - 8) >> 1, half = (g - 8) & 1;
                f32x16 w = v; if (ri.lat) w = ropeB(v, half ? tBc + gc * 16 : tBr + gr * 16, hh);
                store16(QB + ((size_t)(ri.b * 8 + hv) * NK + ri.j) * 64 + half * 32, w, QB_SCALE, hh);
            } else if (g < 28) store16(KVN + (size_t)row * 128 + (g - 24) * 32, v, 1.f, hh);
            else if (g == 28) {
                f32x16 w = v; if (ri.lat) w = ropeA(v, tAr + gr * 8, tAc + gc * 8, hh);
                for (int h = 0; h < 8; ++h) store16(KA + ((size_t)(ri.b * 8 + h) * NK + ri.j) * 96 + 64, w, 1.f, hh);
            } else if (g < 45) {
                const int hv = (g - 29) >> 1, half = (g - 29) & 1;
                f32x16 w = v; if (ri.lat) w = ropeB(v, half ? tBc + gc * 16 : tBr + gr * 16, hh);
                store16(KB + ((size_t)(ri.b * 8 + hv) * NK + ri.j) * 64 + half * 32, w, 1.f, hh);
            } else if (g < 61) {
                const int idx = g - 45, h = idx >> 2, part = idx & 3;
                store16(VB + ((size_t)(ri.b * 4 + h) * NK + ri.j) * 128 + part * 32, v, 1.f, hh);
            }
        }
    }
};
struct EpiUQ {
    bf16_t* QA; const f32x2 *tAr, *tAc;
    DI void operator()(const f32x16& a0, const f32x16& a1, int row, int cbase, int hh) const {
        const RowInfo ri = rowinfo(row);
        const int gr = (ri.j >> 6) & 127, gc = ri.j & 63;
#pragma unroll
        for (int ni = 0; ni < 2; ++ni) {
            const int g = (cbase >> 5) + ni, h = g / 3, part = g - 3 * h;
            f32x16 w = ni ? a1 : a0;
            if (part == 2 && ri.lat) w = ropeA(ni ? a1 : a0, tAr + gr * 8, tAc + gc * 8, hh);
            store16(QA + ((size_t)(ri.b * 8 + h) * NK + ri.j) * 96 + part * 32, w, QA_SCALE, hh);
        }
    }
};
struct EpiUKV {
    bf16_t *KA, *VA;
    DI void operator()(const f32x16& a0, const f32x16& a1, int row, int cbase, int hh) const {
        const RowInfo ri = rowinfo(row);
#pragma unroll
        for (int ni = 0; ni < 2; ++ni) {
            const int g = (cbase >> 5) + ni, h = g >> 2, part = g & 3;
            const size_t tk = (size_t)(ri.b * 8 + h) * NK + ri.j;
            if (part < 2) store16(KA + tk * 96 + part * 32, ni ? a1 : a0, 1.f, hh);
            else store16(VA + tk * 64 + (part - 2) * 32, ni ? a1 : a0, 1.f, hh);
        }
    }
};
struct EpiOdIn {
    bf16_t *U, *QD, *KD, *VD;
    DI void operator()(const f32x16& a0, const f32x16& a1, int row, int cbase, int hh) const {
        const RowInfo ri = rowinfo(row);
#pragma unroll
        for (int ni = 0; ni < 2; ++ni) {
            const int g = (cbase >> 5) + ni;
            const f32x16& v = ni ? a1 : a0;
            if (g < 16) store16(U + (size_t)row * 512 + g * 32, v, 1.f, hh);
            else {
                const int gg = (g - 16) & 15, h = gg >> 1, half = gg & 1;
                const size_t off = ((size_t)(ri.b * 8 + h) * NK + ri.j) * 64 + half * 32;
                if (g < 32) store16(QD + off, v, QD_SCALE, hh);
                else if (g < 48) store16(KD + off, v, 1.f, hh);
                else store16(VD + off, v, 1.f, hh);
            }
        }
    }
};
struct EpiPool {
    bf16_t* CC; const float* pscale; int gidx;
    DI void operator()(const f32x16& a0, const f32x16& a1, int row, int cbase, int hh) const {
#pragma unroll
        for (int ni = 0; ni < 2; ++ni)
#pragma unroll
            for (int q4 = 0; q4 < 4; ++q4) {
                const int c = gidx * 128 + cbase + ni * 32 + 8 * q4 + 4 * hh;
                const f32x4 s = *(const f32x4*)(pscale + c);
                const f32x16& v = ni ? a1 : a0;
                u32x2 w; w.x = pk2(v[4 * q4] * s[0], v[4 * q4 + 1] * s[1]); w.y = pk2(v[4 * q4 + 2] * s[2], v[4 * q4 + 3] * s[3]);
                *(u32x2*)(CC + (size_t)row * 1024 + c) = w;
            }
    }
};

constexpr int ATT_LDS = 64 * (96 + 8) * 2 + 64 * (128 * 2 + 64);
constexpr int RPB_OFF = 2 * ATT_LDS;
constexpr int SMEM_BYTES = GEMM_LDS;

struct NAInfo { int qr; int kstart; };

template <int DQK, int DV, bool NA>
DI void attend(const bf16_t* __restrict__ Q, int q0, const bf16_t* __restrict__ Kb, const bf16_t* __restrict__ Vb,
               int s0, int n0, int s1, int n1, f32x16 (&o)[DV / 32], char* smem, NAInfo na) {
    constexpr int KS = (DQK + 8) * 2, VS = DV * 2 + 64;
    constexpr int KCH = DQK / 8, KN = (64 * KCH + NTHR - 1) / NTHR, VCH = DV / 8, VN = (64 * VCH + NTHR - 1) / NTHR;
    constexpr int NS = DQK / 16, NDT = DV / 32;
    const int tid = ltid(), lane = tid & 63, wave = tid >> 6;
    const int l31 = lane & 31, hh = lane >> 5, q = (lane & 15) >> 2, p = lane & 3, dblk = (lane >> 4) & 1;
    bf16x8 qf[NS];
    {
        const bf16_t* qp = Q + (size_t)(q0 + wave * 32 + l31) * DQK + hh * 8;
#pragma unroll
        for (int s = 0; s < NS; ++s) qf[s] = *(const bf16x8*)(qp + s * 16);
    }
#pragma unroll
    for (int d = 0; d < NDT; ++d)
#pragma unroll
        for (int r = 0; r < 16; ++r) o[d][r] = 0.f;
    float m = NA ? -INFINITY : 0.f, l = 0.f;
    f32x16 cinit;
#pragma unroll
    for (int r = 0; r < 16; ++r) cinit[r] = 0.f;
    u32x4 rk[KN], rv[VN];
    const int nt = n0 + n1;
    auto gload = [&](int t) {
        const int j0 = t < n0 ? s0 + t * 64 : s1 + (t - n0) * 64;
#pragma unroll
        for (int i = 0; i < KN; ++i) { int id = tid + NTHR * i; if (id >= 64 * KCH) id -= 64 * KCH; const int row = id / KCH, ch = id - row * KCH; rk[i] = *(const u32x4*)(Kb + (size_t)(j0 + row) * DQK + ch * 8); }
#pragma unroll
        for (int i = 0; i < VN; ++i) { int id = tid + NTHR * i; if (id >= 64 * VCH) id -= 64 * VCH; const int row = id / VCH, ch = id - row * VCH; rv[i] = *(const u32x4*)(Vb + (size_t)(j0 + row) * DV + ch * 8); }
    };
    gload(0);
    int qc = 0, cs = 0, rs = 0;
    if (NA) { qc = (wave & 1) * 32 + l31; cs = min(max(qc - 8, 0), 48); rs = min(max(na.qr - 4, 0), 120); }
    const float* rpb = (const float*)(smem + RPB_OFF);
    auto lwrite = [&](char* stg) {
#pragma unroll
        for (int i = 0; i < KN; ++i) { int id = tid + NTHR * i; if (id >= 64 * KCH) id -= 64 * KCH; const int row = id / KCH, ch = id - row * KCH; *(u32x4*)(stg + row * KS + ch * 16) = rk[i]; }
#pragma unroll
        for (int i = 0; i < VN; ++i) { int id = tid + NTHR * i; if (id >= 64 * VCH) id -= 64 * VCH; const int row = id / VCH, ch = id - row * VCH; *(u32x4*)(stg + 64 * KS + row * VS + ch * 16) = rv[i]; }
    };
    __syncthreads();
    lwrite(smem);
    if (nt > 1) gload(1);
    __syncthreads();
    for (int t = 0; t < nt; ++t) {
        const char* sK = smem + (t & 1) * ATT_LDS; const char* sV = sK + 64 * KS;
        bool active = true; int kr = 0;
        if (NA && t < n0) { kr = na.kstart + t; active = (kr >= rs) && (kr < rs + 8); }
        if (active) {
#pragma unroll
            for (int sub = 0; sub < 2; ++sub) {
                f32x16 st;
                if (NA) {
#pragma unroll
                    for (int r = 0; r < 16; ++r) st[r] = 0.f;
                } else st = cinit;
                {
                    bf16x8 kf[NS];
#pragma unroll
                    for (int s = 0; s < NS; ++s) kf[s] = *(const bf16x8*)(sK + (sub * 32 + l31) * KS + (s * 16 + hh * 8) * 2);
                    __builtin_amdgcn_sched_barrier(0);
#pragma unroll
                    for (int s = 0; s < NS; ++s) st = mfma32(kf[s], qf[s], st);
                }
                bf16x8 vf[NDT][2];
#pragma unroll
                for (int d = 0; d < NDT; ++d)
#pragma unroll
                    for (int s2 = 0; s2 < 2; ++s2) {
                        const char* vp = sV + (sub * 32 + 16 * s2 + 4 * hh + q) * VS + (d * 32 + dblk * 16 + 4 * p) * 2;
                        vf[d][s2] = cat8(tr_read(vp), tr_read(vp + 8 * VS));
                    }
                if (NA && t < n0) {
                    const float* brow = rpb + (kr - na.qr + 7) * 31 + 15 - qc;
#pragma unroll
                    for (int r = 0; r < 16; ++r) {
                        const int kc = sub * 32 + (r & 3) + 8 * (r >> 2) + 4 * hh;
                        const bool valid = (kc >= cs) && (kc < cs + 16);
                        const int bi = valid ? kc : cs;
                        const float bias = brow[bi];
                        st[r] = valid ? st[r] + bias : -INFINITY;
                    }
                }
                float mx = st[0];
#pragma unroll
                for (int r = 1; r < 16; ++r) mx = fmaxf(mx, st[r]);
                mx = xor32_max(mx);
                float rsum = 0.f;
                if (NA) {
                    const float mnew = fmaxf(m, mx);
                    const float muse = (mnew == -INFINITY) ? 0.f : mnew;
                    const float alpha = __builtin_amdgcn_exp2f(m - muse);
                    m = mnew;
                    l *= alpha;
#pragma unroll
                    for (int d = 0; d < NDT; ++d)
#pragma unroll
                        for (int r = 0; r < 16; ++r) o[d][r] *= alpha;
#pragma unroll
                    for (int r = 0; r < 16; ++r) { st[r] = __builtin_amdgcn_exp2f(st[r] - muse); rsum += st[r]; }
                } else {
                    const bool first = (t == 0) && (sub == 0);
                    if (first || __builtin_amdgcn_ballot_w64(mx > 8.f) != 0) {
                        const float delta = first ? mx : fmaxf(mx, 0.f);
                        const float alpha = first ? 1.f : __builtin_amdgcn_exp2f(-delta);
                        m += delta;
                        l *= alpha;
#pragma unroll
                        for (int d = 0; d < NDT; ++d)
#pragma unroll
                            for (int r = 0; r < 16; ++r) o[d][r] *= alpha;
#pragma unroll
                        for (int r = 0; r < 16; ++r) { st[r] -= delta; cinit[r] = -m; }
                    }
#pragma unroll
                    for (int r = 0; r < 16; ++r) { st[r] = __builtin_amdgcn_exp2f(st[r]); rsum += st[r]; }
                }
                l += rsum;
                bf16x8 pf[2];
#pragma unroll
                for (int s2 = 0; s2 < 2; ++s2) {
                    u32x4 w;
                    w.x = pk2(st[8 * s2], st[8 * s2 + 1]); w.y = pk2(st[8 * s2 + 2], st[8 * s2 + 3]);
                    w.z = pk2(st[8 * s2 + 4], st[8 * s2 + 5]); w.w = pk2(st[8 * s2 + 6], st[8 * s2 + 7]);
                    pf[s2] = __builtin_bit_cast(bf16x8, w);
                }
#pragma unroll
                for (int d = 0; d < NDT; ++d)
#pragma unroll
                    for (int s2 = 0; s2 < 2; ++s2) o[d] = mfma32(vf[d][s2], pf[s2], o[d]);
            }
        }
        if (t + 1 < nt) lwrite(smem + ((t & 1) ^ 1) * ATT_LDS);
        if (t + 2 < nt) gload(t + 2);
        __syncthreads();
    }
    l = xor32_sum(l);
    const float inv = 1.f / l;
#pragma unroll
    for (int d = 0; d < NDT; ++d)
#pragma unroll
        for (int r = 0; r < 16; ++r) o[d][r] *= inv;
}

DI int qrow_of(int b, int j) { return j < SEQ ? b * SEQ + j : RL + b * CTX + (j - SEQ); }

DI void even_attention_phase(const Params& P, char* smem) {
    char* ws = P.ws; char* hid = ws + OFF_HID; char* ob = (char*)P.out;
    const bf16_t* QA = (const bf16_t*)(hid + HOFF_QA); const bf16_t* KA = (const bf16_t*)(hid + HOFF_KA); const bf16_t* VA = (const bf16_t*)(hid + HOFF_VA);
    const bf16_t* QB = (const bf16_t*)(hid + HOFF_QB); const bf16_t* KB = (const bf16_t*)(ob + OOFF_KB); const bf16_t* VB = (const bf16_t*)(ob + OOFF_VB);
    bf16_t* CC = (bf16_t*)(ws + OFF_XM);
    const float lam = *(const float*)(ws + OFF_LAM);
    const float* gsub = P.in[18];
    const int lane = ltid() & 63, wave = ltid() >> 6, l31 = lane & 31, hh = lane >> 5;
    constexpr int NQT = 33, NDIFF = NB * 4 * NQT, NMLA = NB * 8 * NQT;
    NAInfo na; na.qr = 0; na.kstart = 0;
    unsigned* wq = (unsigned*)(ws + OFF_BAR + 128);
    volatile int* slot = (volatile int*)(smem + 2 * ATT_LDS + 2048);
    for (;;) {
        __syncthreads();
        if (ltid() == 0) *slot = (int)atomicAdd(wq, 1u);
        __syncthreads();
        const int u = *slot;
        if (u >= NDIFF + NMLA) break;
        if (u < NDIFF) {
            const int qt = u % NQT, bh = u / NQT, h = bh & 3, b = bh >> 2;
            const int q0 = qt < 32 ? qt * 256 : SEQ;
            const int s0 = qt < 32 ? 0 : SEQ, n0 = qt < 32 ? NK / 64 : CTX / 64;
            const bf16_t* V = VB + (size_t)(b * 4 + h) * NK * 128;
            f32x16 o[4];
            attend<64, 128, false>(QB + (size_t)(b * 8 + 2 * h) * NK * 64, q0, KB + (size_t)(b * 8 + 2 * h) * NK * 64, V, s0, n0, 0, 0, o, smem, na);
            const int row = qrow_of(b, q0 + wave * 32 + l31);
            bf16_t* dst = CC + (size_t)row * 1024 + 512 + h * 128;
#pragma unroll
            for (int d = 0; d < 4; ++d) store16(dst + d * 32, o[d], 1.f, hh);
            f32x16 o2[4];
            attend<64, 128, false>(QB + (size_t)(b * 8 + 2 * h + 1) * NK * 64, q0, KB + (size_t)(b * 8 + 2 * h + 1) * NK * 64, V, s0, n0, 0, 0, o2, smem, na);
            float ss = 0.f;
#pragma unroll
            for (int d = 0; d < 4; ++d)
#pragma unroll
                for (int q4 = 0; q4 < 4; ++q4) {
                    const u32x2 w = *(const volatile u32x2*)(dst + d * 32 + 8 * q4 + 4 * hh);
                    const float a0 = bflo(w.x) - lam * o2[d][4 * q4], a1 = bfhi(w.x) - lam * o2[d][4 * q4 + 1], a2 = bflo(w.y) - lam * o2[d][4 * q4 + 2], a3 = bfhi(w.y) - lam * o2[d][4 * q4 + 3];
                    o[d][4 * q4] = a0; o[d][4 * q4 + 1] = a1; o[d][4 * q4 + 2] = a2; o[d][4 * q4 + 3] = a3;
                    ss += (a0 * a0 + a1 * a1) + (a2 * a2 + a3 * a3);
                }
            ss = xor32_sum(ss);
            const float rn = rsqrtf(ss * (1.f / 128.f) + 1e-5f) * 0.8f;
#pragma unroll
            for (int d = 0; d < 4; ++d)
#pragma unroll
                for (int q4 = 0; q4 < 4; ++q4) {
                    const int c = d * 32 + 8 * q4 + 4 * hh;
                    const f32x4 g = *(const f32x4*)(gsub + c);
                    u32x2 w; w.x = pk2(o[d][4 * q4] * rn * g[0], o[d][4 * q4 + 1] * rn * g[1]); w.y = pk2(o[d][4 * q4 + 2] * rn * g[2], o[d][4 * q4 + 3] * rn * g[3]);
                    *(u32x2*)(dst + c) = w;
                }
        } else {
            const int v = u - NDIFF, qt = v % NQT, bh = v / NQT, h = bh & 7, b = bh >> 3;
            const int q0 = qt < 32 ? qt * 256 : SEQ;
            const int s0 = qt < 32 ? 0 : SEQ, n0 = qt < 32 ? NK / 64 : CTX / 64;
            f32x16 o[2];
            attend<96, 64, false>(QA + (size_t)(b * 8 + h) * NK * 96, q0, KA + (size_t)(b * 8 + h) * NK * 96, VA + (size_t)(b * 8 + h) * NK * 64, s0, n0, 0, 0, o, smem, na);
            const int row = qrow_of(b, q0 + wave * 32 + l31);
            bf16_t* dst = CC + (size_t)row * 1024 + h * 64;
#pragma unroll
            for (int d = 0; d < 2; ++d) store16(dst + d * 32, o[d], 1.f, hh);
        }
    }
}

DI void odd_attention_phase(const Params& P, char* smem) {
    char* ws = P.ws; char* hid = ws + OFF_HID;
    const bf16_t* QD = (const bf16_t*)(hid + HOFF_QD); const bf16_t* KD = (const bf16_t*)(hid + HOFF_KD); const bf16_t* VD = (const bf16_t*)(hid + HOFF_VD);
    bf16_t* CC = (bf16_t*)(ws + OFF_XM);
    const float* rpbg = P.in[23];
    const int lane = ltid() & 63, wave = ltid() >> 6, l31 = lane & 31, hh = lane >> 5;
    float* rpbl = (float*)(smem + RPB_OFF);
    constexpr int NU = NB * 8 * 32;
    for (int u = lbid(); u < NU; u += gridDim.x) {
        const int rp = u & 31, bh = u >> 5, h = bh & 7, b = bh >> 3;
        __syncthreads();
        for (int i = ltid(); i < 465; i += NTHR) rpbl[i] = rpbg[h * 465 + i] * LOG2E;
        const int r0 = rp * 4;
        NAInfo na; na.qr = r0 + (wave >> 1);
        const int rs0 = min(max(r0 - 4, 0), 120);
        na.kstart = min(rs0, 117);
        f32x16 o[2];
        const size_t hb = (size_t)(b * 8 + h) * NK * 64;
        attend<64, 64, true>(QD + hb, r0 * 64, KD + hb, VD + hb, na.kstart * 64, 11, SEQ, CTX / 64, o, smem, na);
        const int row = b * SEQ + r0 * 64 + wave * 32 + l31;
        bf16_t* dst = CC + (size_t)row * 1024 + 512 + h * 64;
#pragma unroll
        for (int d = 0; d < 2; ++d) store16(dst + d * 32, o[d], 1.f, hh);
    }
}

DI void cvt8(bf16_t* dst, const float* src, float sc) {
    const f32x4 a = *(const f32x4*)src, b = *(const f32x4*)(src + 4);
    u32x4 w; w.x = pk2(a[0] * sc, a[1] * sc); w.y = pk2(a[2] * sc, a[3] * sc); w.z = pk2(b[0] * sc, b[1] * sc); w.w = pk2(b[2] * sc, b[3] * sc);
    *(u32x4*)dst = w;
}
DI void cvt_rows(bf16_t* dst, int ldd, const float* src, int lds_, int rows, int cols_src, const float* rowscale, size_t gtid, size_t gstride) {
    const int c8 = ldd >> 3; const size_t n = (size_t)rows * c8;
    for (size_t i0 = gtid; i0 < n; i0 += 4 * gstride) {
        f32x4 a[4], b[4]; float sc[4];
#pragma unroll
        for (int u = 0; u < 4; ++u) {
            const size_t i = i0 + u * gstride;
            const int k = (int)(i / c8), c = (int)(i % c8) * 8;
            const bool ok = i < n && c < cols_src;
            const float* p = src + (ok ? (size_t)k * lds_ + c : 0);
            a[u] = *(const f32x4*)p; b[u] = *(const f32x4*)(p + 4);
            sc[u] = !ok ? 0.f : (rowscale ? rowscale[k] : 1.f);
        }
#pragma unroll
        for (int u = 0; u < 4; ++u) {
            const size_t i = i0 + u * gstride;
            if (i < n) {
                const int k = (int)(i / c8), c = (int)(i % c8) * 8;
                u32x4 w; w.x = pk2(a[u][0] * sc[u], a[u][1] * sc[u]); w.y = pk2(a[u][2] * sc[u], a[u][3] * sc[u]); w.z = pk2(b[u][0] * sc[u], b[u][1] * sc[u]); w.w = pk2(b[u][2] * sc[u], b[u][3] * sc[u]);
                *(u32x4*)(dst + (size_t)k * ldd + c) = w;
            }
        }
    }
}

DI void phase_pro_a(const Params& P, char* smem) {
    char* ws = P.ws;
    const size_t gtid = (size_t)lbid() * NTHR + ltid(), gstride = (size_t)gridDim.x * NTHR;
    for (int lf = 0; lf < 4; ++lf) {
        const float* sg = P.in[8] + (size_t)lf * 1024 * DFF; const float* su = P.in[9] + (size_t)lf * 1024 * DFF;
        bf16_t* dst = (bf16_t*)(ws + OFF_WGU + lf * SZ_WGU);
        for (size_t i0 = gtid; i0 < 1024ull * 704; i0 += 4 * gstride) {
            f32x4 a[4], b[4];
#pragma unroll
            for (int u = 0; u < 4; ++u) {
                const size_t i = i0 + u * gstride < 1024ull * 704 ? i0 + u * gstride : i0;
                const int k = (int)(i / 704), n = (int)(i % 704) * 8, grp = n >> 6, w = n & 63;
                const float* src = ((w < 32) ? sg : su) + (size_t)k * DFF + grp * 32 + (w & 31);
                a[u] = *(const f32x4*)src; b[u] = *(const f32x4*)(src + 4);
            }
#pragma unroll
            for (int u = 0; u < 4; ++u) {
                const size_t i = i0 + u * gstride;
                if (i < 1024ull * 704) {
                    const int k = (int)(i / 704), n = (int)(i % 704) * 8;
                    u32x4 w; w.x = pk2(a[u][0], a[u][1]); w.y = pk2(a[u][2], a[u][3]); w.z = pk2(b[u][0], b[u][1]); w.w = pk2(b[u][2], b[u][3]);
                    *(u32x4*)(dst + (size_t)k * 5632 + n) = w;
                }
            }
        }
        cvt_rows((bf16_t*)(ws + OFF_WD + lf * SZ_WD), 1024, P.in[10] + (size_t)lf * DFF * 1024, 1024, DFF, 1024, nullptr, gtid, gstride);
    }
    cvt_rows((bf16_t*)(ws + OFF_EVIN), 2048, P.in[11], 1952, 1024, 1952, nullptr, gtid, gstride);
    cvt_rows((bf16_t*)(ws + OFF_EVOUT), 1024, P.in[12], 1024, 1024, 1024, nullptr, gtid, gstride);
    cvt_rows((bf16_t*)(ws + OFF_UQ), 768, P.in[15], 768, 256, 768, P.in[13], gtid, gstride);
    cvt_rows((bf16_t*)(ws + OFF_UKV), 1024, P.in[16], 1024, 128, 1024, P.in[14], gtid, gstride);
    cvt_rows((bf16_t*)(ws + OFF_ODIN), 2048, P.in[19], 2048, 1024, 2048, nullptr, gtid, gstride);
    cvt_rows((bf16_t*)(ws + OFF_ODOUT), 1024, P.in[20], 1024, 1024, 1024, nullptr, gtid, gstride);
    for (size_t i = gtid; i < 512ull * 64; i += gstride) {
        const int k = (int)(i >> 6), n = (int)(i & 63) * 8;
        bf16_t* d = (bf16_t*)(ws + OFF_POOL) + (size_t)k * 512 + n;
        if ((k >> 7) == (n >> 7)) cvt8(d, P.in[21] + (size_t)k * 128 + (n & 127), 1.f);
        else { u32x4 z = {0u, 0u, 0u, 0u}; *(u32x4*)d = z; }
    }
    if (gtid < 128 * 8) { const int r = (int)gtid >> 3, i = (int)gtid & 7; const float inv = exp2f(-(float)i * (13.287712379549449f / 8.f)); float rev = (float)r * inv * 0.15915494309189535f; rev -= floorf(rev);
        f32x2 v = {__builtin_amdgcn_cosf(rev), __builtin_amdgcn_sinf(rev)}; ((f32x2*)(ws + OFF_TAR))[gtid] = v; if (r < 64) ((f32x2*)(ws + OFF_TAC))[gtid] = v; }
    if (gtid < 128 * 16) { const int r = (int)gtid >> 4, i = (int)gtid & 15; const float inv = exp2f(-(float)i * (13.287712379549449f / 16.f)); float rev = (float)r * inv * 0.15915494309189535f; rev -= floorf(rev);
        f32x2 v = {__builtin_amdgcn_cosf(rev), __builtin_amdgcn_sinf(rev)}; ((f32x2*)(ws + OFF_TBR))[gtid] = v; if (r < 64) ((f32x2*)(ws + OFF_TBC))[gtid] = v; }
    if (gtid == 0) {
        const float* lv = P.in[17]; float a = 0.f, b = 0.f;
        for (int i = 0; i < 64; ++i) { a += lv[i] * lv[64 + i]; b += lv[128 + i] * lv[192 + i]; }
        *(float*)(ws + OFF_LAM) = expf(a) - expf(b) + 0.2f;
    }
    float* sc = (float*)smem;
    float* red = sc + 5 * 1024;
    const int tid = ltid(), jj = tid & 31, ig = tid >> 5;
    __syncthreads();
    for (int i = tid; i < 5 * 1024; i += NTHR) { const float v = i < 4096 ? P.in[1][i] : P.in[3][i - 4096]; sc[i] = v / (1.f + expf(-v)); }
    __syncthreads();
    for (int u = lbid(); u < 576; u += gridDim.x) {
        const int l = u / 288, j0 = (u % 288) * 32;
        float a[5] = {0.f, 0.f, 0.f, 0.f, 0.f};
        const float* w = P.in[4] + (size_t)l * 1024 * 9216 + (size_t)(ig * 64) * 9216 + j0 + jj;
        for (int i0 = 0; i0 < 64; i0 += 8) {
            float wv[8];
#pragma unroll
            for (int k = 0; k < 8; ++k) wv[k] = w[(size_t)(i0 + k) * 9216];
#pragma unroll
            for (int k = 0; k < 8; ++k)
#pragma unroll
                for (int s2 = 0; s2 < 5; ++s2) a[s2] += sc[s2 * 1024 + ig * 64 + i0 + k] * wv[k];
        }
#pragma unroll
        for (int s2 = 0; s2 < 5; ++s2) red[(ig * 5 + s2) * 32 + jj] = a[s2];
        __syncthreads();
        if (tid < 160) {
            const int s2 = tid >> 5, j = tid & 31;
            float v = P.in[5][l * 9216 + j0 + j];
#pragma unroll
            for (int g = 0; g < 16; ++g) v += red[(g * 5 + s2) * 32 + j];
            ((float*)(ws + OFF_MOD))[(size_t)(l * 5 + s2) * 9216 + j0 + j] = v;
        }
        __syncthreads();
    }
}

DI void phase_pro_b(const Params& P) {
    char* ws = P.ws; bf16_t* XM = (bf16_t*)(ws + OFF_XM); const float* MOD = (const float*)(ws + OFF_MOD);
    const size_t gtid = (size_t)lbid() * NTHR + ltid(), gstride = (size_t)gridDim.x * NTHR;
    for (size_t i = gtid; i < (size_t)RT * 128; i += gstride) {
        const int row = (int)(i >> 7), c = (int)(i & 127) * 8;
        const float* src = row < RL ? P.in[0] + (size_t)row * 1024 + c : P.in[2] + (size_t)(row - RL) * 1024 + c;
        const int s = row < RL ? (row >> 13) : 4;
        const float* sh = MOD + (size_t)s * 9216 + c; const float* scl = sh + 1024;
        unsigned w[4];
#pragma unroll
        for (int hf = 0; hf < 2; ++hf) {
            const f32x4 x = *(const f32x4*)(src + 4 * hf), a = *(const f32x4*)(sh + 4 * hf), g = *(const f32x4*)(scl + 4 * hf);
            w[2 * hf] = pk2(x[0] * (1.f + g[0]) + a[0], x[1] * (1.f + g[1]) + a[1]);
            w[2 * hf + 1] = pk2(x[2] * (1.f + g[2]) + a[2], x[3] * (1.f + g[3]) + a[3]);
        }
        u32x4 o = {w[0], w[1], w[2], w[3]};
        *(u32x4*)(XM + (size_t)row * 1024 + c) = o;
    }
}

struct LnSpec { int l, which, lnext, mshift; bool final_; unsigned* cnt; const bf16_t* Y; const float* res_lat; const float* res_ctx; };
template <int NR>
DI void ln_rows(const Params& P, const LnSpec& sp, int row, int stride, int lane) {
    char* ws = P.ws; float* X = (float*)(ws + OFF_X); bf16_t* XM = (bf16_t*)(ws + OFF_XM); const float* MOD = (const float*)(ws + OFF_MOD);
    const float* g = P.in[6] + (sp.l * 3 + sp.which) * 1024; const float* bb = P.in[7] + (sp.l * 3 + sp.which) * 1024;
    f32x4 v[NR][4]; float s[NR], qv[NR];
#pragma unroll
    for (int k = 0; k < NR; ++k) {
        const int r = row + k * stride;
        const float* xp = r < RL ? sp.res_lat + (size_t)r * 1024 : sp.res_ctx + (size_t)(r - RL) * 1024;
        const bf16_t* yp = sp.Y + (size_t)r * 1024;
#pragma unroll
        for (int i = 0; i < 4; ++i) {
            const f32x4 x = *(const f32x4*)(xp + (i * 64 + lane) * 4);
            const u32x2 y = *(const u32x2*)(yp + (i * 64 + lane) * 4);
            v[k][i][0] = ALPHA * x[0] + bflo(y.x); v[k][i][1] = ALPHA * x[1] + bfhi(y.x);
            v[k][i][2] = ALPHA * x[2] + bflo(y.y); v[k][i][3] = ALPHA * x[3] + bfhi(y.y);
        }
    }
#pragma unroll
    for (int k = 0; k < NR; ++k) {
        s[k] = 0.f;
#pragma unroll
        for (int i = 0; i < 4; ++i) s[k] += (v[k][i][0] + v[k][i][1]) + (v[k][i][2] + v[k][i][3]);
    }
#pragma unroll
    for (int o = 32; o >= 1; o >>= 1)
#pragma unroll
        for (int k = 0; k < NR; ++k) s[k] += __shfl_xor(s[k], o);
#pragma unroll
    for (int k = 0; k < NR; ++k) {
        s[k] *= (1.f / 1024.f); qv[k] = 0.f;
#pragma unroll
        for (int i = 0; i < 4; ++i)
#pragma unroll
            for (int j = 0; j < 4; ++j) { const float d = v[k][i][j] - s[k]; qv[k] += d * d; }
    }
#pragma unroll
    for (int o = 32; o >= 1; o >>= 1)
#pragma unroll
        for (int k = 0; k < NR; ++k) qv[k] += __shfl_xor(qv[k], o);
#pragma unroll
    for (int k = 0; k < NR; ++k) {
        const int r = row + k * stride;
        const float mu = s[k], rstd = rsqrtf(qv[k] * (1.f / 1024.f) + 1e-6f);
        const int sidx = r < RL ? (r >> 13) : 4;
        const float* sh = MOD + (size_t)(sp.lnext * 5 + sidx) * 9216 + sp.mshift * 1024; const float* scl = sh + 1024;
        float* xp = X + (size_t)r * 1024;
#pragma unroll
        for (int i = 0; i < 4; ++i) {
            const int c = (i * 64 + lane) * 4;
            const f32x4 gg = *(const f32x4*)(g + c), b4 = *(const f32x4*)(bb + c);
            f32x4 y;
#pragma unroll
            for (int j = 0; j < 4; ++j) y[j] = (v[k][i][j] - mu) * rstd * gg[j] + b4[j];
            if (sp.final_) { *(f32x4*)(P.out + (size_t)r * 1024 + c) = y; }
            else {
                *(f32x4*)(xp + c) = y;
                const f32x4 a = *(const f32x4*)(sh + c), sg = *(const f32x4*)(scl + c);
                u32x2 w; w.x = pk2(y[0] * (1.f + sg[0]) + a[0], y[1] * (1.f + sg[1]) + a[1]); w.y = pk2(y[2] * (1.f + sg[2]) + a[2], y[3] * (1.f + sg[3]) + a[3]);
                *(u32x2*)(XM + (size_t)r * 1024 + c) = w;
            }
        }
    }
}
DI void phase_ln(const Params& P, int l, int which, int lnext, int mshift, bool final_, bool lat_only, const bf16_t* Y, bool first) {
    float* X = (float*)(P.ws + OFF_X);
    const LnSpec sp{l, which, lnext, mshift, final_, nullptr, Y, first ? P.in[0] : X, first ? P.in[2] : X + (size_t)RL * 1024};
    const int lane = ltid() & 63, wave = ltid() >> 6;
    const int nq = ((final_ || lat_only) ? RL : RT) / 4;
    for (int q = lbid() * NWAVE + wave; q < nq; q += gridDim.x * NWAVE) ln_rows<4>(P, sp, 4 * q, 1, lane);
}

DI void phase_ev_rms(const Params& P) {
    char* ws = P.ws; bf16_t* QN = (bf16_t*)(ws + OFF_HID + HOFF_QN); bf16_t* KVN = (bf16_t*)((char*)P.out + OOFF_KVN);
    const int lane = ltid() & 63, wave = ltid() >> 6;
    for (int row = (lbid() * NWAVE + wave) * 4; row < RT; row += gridDim.x * NWAVE * 4) {
        u32x2 wq[4]; unsigned wk[4]; float sq[4], sk[4];
#pragma unroll
        for (int k = 0; k < 4; ++k) { wq[k] = *(const u32x2*)(QN + (size_t)(row + k) * 256 + lane * 4); wk[k] = *(const unsigned*)(KVN + (size_t)(row + k) * 128 + lane * 2); }
#pragma unroll
        for (int k = 0; k < 4; ++k) {
            const float a = bflo(wq[k].x), b = bfhi(wq[k].x), c = bflo(wq[k].y), d = bfhi(wq[k].y);
            sq[k] = a * a + b * b + c * c + d * d;
            const float e = bflo(wk[k]), f = bfhi(wk[k]);
            sk[k] = e * e + f * f;
        }
#pragma unroll
        for (int o = 32; o >= 1; o >>= 1)
#pragma unroll
            for (int k = 0; k < 4; ++k) { sq[k] += __shfl_xor(sq[k], o); sk[k] += __shfl_xor(sk[k], o); }
#pragma unroll
        for (int k = 0; k < 4; ++k) {
            const float rq = rsqrtf(sq[k] * (1.f / 256.f) + 1e-6f), rk = rsqrtf(sk[k] * (1.f / 128.f) + 1e-6f);
            u32x2 o2; o2.x = pk2(bflo(wq[k].x) * rq, bfhi(wq[k].x) * rq); o2.y = pk2(bflo(wq[k].y) * rq, bfhi(wq[k].y) * rq);
            *(u32x2*)(QN + (size_t)(row + k) * 256 + lane * 4) = o2;
            *(unsigned*)(KVN + (size_t)(row + k) * 128 + lane * 2) = pk2(bflo(wk[k]) * rk, bfhi(wk[k]) * rk);
        }
    }
}

DI void phase_od_pool(const Params& P) {
    char* ws = P.ws; const bf16_t* U = (const bf16_t*)(ws + OFF_HID + HOFF_U); bf16_t* PL = (bf16_t*)(ws + OFF_HID + HOFF_PL);
    const size_t gtid = (size_t)lbid() * NTHR + ltid(), gstride = (size_t)gridDim.x * NTHR;
    for (size_t i = gtid; i < (size_t)RT * 64; i += gstride) {
        const int row = (int)(i >> 6), c = (int)(i & 63) * 8, grp = c >> 7;
        const int w = 2 << grp, left = w >> 1, right = w - 1 - left;
        int base, n, t;
        if (row < RL) { base = row & ~8191; n = SEQ; t = row & 8191; } else { const int rc = row - RL; base = RL + (rc & ~255); n = CTX; t = rc & 255; }
        const int lo = max(t - left, 0), hi = min(t + right + 1, n);
        float acc[8] = {0.f, 0.f, 0.f, 0.f, 0.f, 0.f, 0.f, 0.f};
#pragma unroll 4
        for (int tt = lo; tt < hi; ++tt) {
            const u32x4 v = *(const u32x4*)(U + (size_t)(base + tt) * 512 + c);
            acc[0] += bflo(v.x); acc[1] += bfhi(v.x); acc[2] += bflo(v.y); acc[3] += bfhi(v.y); acc[4] += bflo(v.z); acc[5] += bfhi(v.z); acc[6] += bflo(v.w); acc[7] += bfhi(v.w);
        }
        const float ic = 1.f / (float)(hi - lo);
        const u32x4 s = *(const u32x4*)(U + (size_t)row * 512 + c);
        u32x4 o;
        o.x = pk2(acc[0] * ic - bflo(s.x), acc[1] * ic - bfhi(s.x)); o.y = pk2(acc[2] * ic - bflo(s.y), acc[3] * ic - bfhi(s.y));
        o.z = pk2(acc[4] * ic - bflo(s.z), acc[5] * ic - bfhi(s.z)); o.w = pk2(acc[6] * ic - bflo(s.w), acc[7] * ic - bfhi(s.w));
        *(u32x4*)(PL + (size_t)row * 512 + c) = o;
    }
}

constexpr int NPHASE = 25;

DI void run_phase(const Params& P, int ph, char* smem) {
    char* ws = P.ws; char* hid = ws + OFF_HID; char* ob = (char*)P.out;
    float* X = (float*)(ws + OFF_X); bf16_t* XM = (bf16_t*)(ws + OFF_XM); bf16_t* HID = (bf16_t*)hid;
    const float* MOD = (const float*)(ws + OFF_MOD);
    if (ph == 0) { phase_pro_a(P, smem); return; }
    if (ph == 1) { phase_pro_b(P); return; }
    int l, op;
    if (ph < 14) { l = 0; op = ph - 2; } else { l = 1; op = ph - 14; if (op >= 6) op += 1; }
    const float* modl = MOD + (size_t)l * 5 * 9216;
    switch (op) {
    case 0: case 9: {
        const int f = op == 0 ? 0 : 1;
        EpiSwiglu e{HID};
        gemm_phase(XM, 1024, (const bf16_t*)(ws + OFF_WGU + (l * 2 + f) * SZ_WGU), 5632, 5632, 1024, e, smem, !(l == 1 && f == 1));
    } break;
    case 1: case 10: {
        const int f = op == 1 ? 0 : 1;
        EpiY e{XM, modl + (f == 0 ? 2 : 8) * 1024, 0.5f};
        gemm_phase(HID, DFF, (const bf16_t*)(ws + OFF_WD + (l * 2 + f) * SZ_WD), 1024, 1024, DFF, e, smem, !(l == 1 && f == 1));
    } break;
    case 2: phase_ln(P, l, 0, l, 3, false, false, XM, l == 0); break;
    case 3: {
        if (l == 0) {
            EpiEvIn e{(bf16_t*)(hid + HOFF_QN), (bf16_t*)(hid + HOFF_QB), (bf16_t*)(ob + OOFF_KVN), (bf16_t*)(hid + HOFF_KA), (bf16_t*)(ob + OOFF_KB), (bf16_t*)(ob + OOFF_VB),
                      (const f32x2*)(ws + OFF_TAR), (const f32x2*)(ws + OFF_TAC), (const f32x2*)(ws + OFF_TBR), (const f32x2*)(ws + OFF_TBC)};
            gemm_phase(XM, 1024, (const bf16_t*)(ws + OFF_EVIN), 2048, 2048, 1024, e, smem);
        } else {
            EpiOdIn e{(bf16_t*)(hid + HOFF_U), (bf16_t*)(hid + HOFF_QD), (bf16_t*)(hid + HOFF_KD), (bf16_t*)(hid + HOFF_VD)};
            gemm_phase(XM, 1024, (const bf16_t*)(ws + OFF_ODIN), 2048, 2048, 1024, e, smem);
        }
    } break;
    case 4: if (l == 0) phase_ev_rms(P); else phase_od_pool(P); break;
    case 5: {
        if (l == 0) {
            EpiUQ e1{(bf16_t*)(hid + HOFF_QA), (const f32x2*)(ws + OFF_TAR), (const f32x2*)(ws + OFF_TAC)};
            gemm_phase((const bf16_t*)(hid + HOFF_QN), 256, (const bf16_t*)(ws + OFF_UQ), 768, 768, 256, e1, smem);
            EpiUKV e2{(bf16_t*)(hid + HOFF_KA), (bf16_t*)(hid + HOFF_VA)};
            gemm_phase((const bf16_t*)(ob + OOFF_KVN), 128, (const bf16_t*)(ws + OFF_UKV), 1024, 1024, 128, e2, smem);
        } else {
            odd_attention_phase(P, smem);
            EpiPool e{XM, P.in[22], 0};
            gemm_phase((const bf16_t*)(hid + HOFF_PL), 512, (const bf16_t*)(ws + OFF_POOL), 512, 512, 512, e, smem);
        }
    } break;
    case 6: even_attention_phase(P, smem); break;
    case 7: {
        EpiY e{HID, modl + 5 * 1024, 1.f};
        gemm_phase(XM, 1024, (const bf16_t*)(ws + (l == 0 ? OFF_EVOUT : OFF_ODOUT)), 1024, 1024, 1024, e, smem, l == 0);
    } break;
    case 8: phase_ln(P, l, 1, l, 6, false, l == 1, HID, false); break;
    case 11: if (l == 0) phase_ln(P, 0, 2, 1, 0, false, false, XM, false); else phase_ln(P, 1, 2, 1, 0, true, true, XM, false); break;
    default: break;
    }
}

DI void grid_barrier(unsigned* ctr, unsigned target) {
    __syncthreads();
    if (threadIdx.x == 0) {
        __builtin_amdgcn_fence(__ATOMIC_RELEASE, "agent");
        __hip_atomic_fetch_add(ctr, 1u, __ATOMIC_RELAXED, __HIP_MEMORY_SCOPE_AGENT);
        while (__hip_atomic_load(ctr, __ATOMIC_RELAXED, __HIP_MEMORY_SCOPE_AGENT) < target) __builtin_amdgcn_s_sleep(2);
        __builtin_amdgcn_fence(__ATOMIC_ACQUIRE, "agent");
    }
    __syncthreads();
}

__global__ void __launch_bounds__(NTHR, 2) mega(Params P, int ph_lo, int ph_hi) {
    extern __shared__ __attribute__((aligned(16))) char smem[];
    unsigned nsync = 0;
    for (int ph = ph_lo; ph < ph_hi; ++ph) {
        run_phase(P, ph, smem);
        if (ph + 1 < ph_hi) {
            if (ph == ph_lo) cg::this_grid().sync();
            else { ++nsync; grid_barrier((unsigned*)(P.ws + OFF_BAR), nsync * gridDim.x); }
        }
    }
}

extern "C" void kernel_launch(void* const* d_in, const int* in_sizes, int n_in, void* d_out, int out_size, void* d_ws, size_t ws_size, hipStream_t stream) {
    if (ws_size < WS_NEED) { fprintf(stderr, "workspace too small: %zu < %zu\n", ws_size, (size_t)WS_NEED); return; }
    Params P{};
    for (int i = 0; i < 24; ++i) P.in[i] = (const float*)d_in[i];
    P.out = (float*)d_out; P.ws = (char*)d_ws;
    static int grid_blocks = 0;
    if (!grid_blocks) {
        int dev = 0, cus = 0, per_cu = 0;
        hipGetDevice(&dev);
        hipDeviceGetAttribute(&cus, hipDeviceAttributeMultiprocessorCount, dev);
        hipFuncSetAttribute((const void*)mega, hipFuncAttributeMaxDynamicSharedMemorySize, SMEM_BYTES);
        hipOccupancyMaxActiveBlocksPerMultiprocessor(&per_cu, mega, NTHR, SMEM_BYTES);
        if (per_cu < 1) per_cu = 1;
        if (per_cu > 1) per_cu = 1;
        grid_blocks = cus * per_cu;
    }
#if COOP
    hipMemsetAsync((char*)d_ws + OFF_BAR, 0, 256, stream);
    int lo = 0, hi = NPHASE;
    void* args[] = {&P, &lo, &hi};
    hipError_t e = hipLaunchCooperativeKernel((void*)mega, dim3(grid_blocks), dim3(NTHR), args, SMEM_BYTES, stream);
    if (e != hipSuccess) fprintf(stderr, "cooperative launch failed: %s (grid %d)\n", hipGetErrorString(e), grid_blocks);
#else
    for (int ph = 0; ph < NPHASE; ++ph) mega<<<grid_blocks, NTHR, SMEM_BYTES, stream>>>(P, ph, ph + 1);
#endif
}
```

```cpp
#include <hip/hip_runtime.h>
#include <hip/hip_cooperative_groups.h>
#include <cstdio>
#include <cstdint>
namespace cg = cooperative_groups;

#ifndef COOP
#define COOP 1
#endif

#define DI __device__ __forceinline__
typedef unsigned short bf16_t;
typedef short bf16x8 __attribute__((ext_vector_type(8)));
typedef short s16x4 __attribute__((ext_vector_type(4)));
typedef __bf16 bfx4 __attribute__((ext_vector_type(4)));
typedef __bf16 bfx2 __attribute__((ext_vector_type(2)));
typedef float f32x2 __attribute__((ext_vector_type(2)));
typedef float f32x4 __attribute__((ext_vector_type(4)));
typedef float f32x16 __attribute__((ext_vector_type(16)));
typedef unsigned u32x2 __attribute__((ext_vector_type(2)));
typedef unsigned u32x4 __attribute__((ext_vector_type(4)));
#define LDS_AS __attribute__((address_space(3)))

constexpr int DM = 1024, NB = 4, SEQ = 8192, CTX = 256, DFF = 2816;
constexpr int RL = NB * SEQ, RC = NB * CTX, RT = RL + RC;
constexpr int NK = SEQ + CTX;
constexpr float ALPHA = 1.41421356237f;
constexpr float LOG2E = 1.4426950408889634f;
constexpr float QA_SCALE = 0.10206207261596575f * LOG2E;
constexpr float QB_SCALE = 0.125f * LOG2E;
constexpr float QD_SCALE = 0.125f * LOG2E;
constexpr int NTHR = 512, NWAVE = NTHR / 64;

constexpr size_t SZ_WGU = 1024ull * 5632 * 2, SZ_WD = 2816ull * 1024 * 2;
constexpr size_t OFF_WGU = 0;
constexpr size_t OFF_WD = OFF_WGU + 4 * SZ_WGU;
constexpr size_t OFF_EVIN = OFF_WD + 4 * SZ_WD;
constexpr size_t OFF_EVOUT = OFF_EVIN + 1024ull * 2048 * 2;
constexpr size_t OFF_UQ = OFF_EVOUT + 1024ull * 1024 * 2;
constexpr size_t OFF_UKV = OFF_UQ + 256ull * 768 * 2;
constexpr size_t OFF_ODIN = OFF_UKV + 128ull * 1024 * 2;
constexpr size_t OFF_ODOUT = OFF_ODIN + 1024ull * 2048 * 2;
constexpr size_t OFF_POOL = OFF_ODOUT + 1024ull * 1024 * 2;
constexpr size_t OFF_MOD = OFF_POOL + 512ull * 512 * 2;
constexpr size_t OFF_TAR = OFF_MOD + 2ull * 5 * 9216 * 4;
constexpr size_t OFF_TAC = OFF_TAR + 128 * 8 * 8;
constexpr size_t OFF_TBR = OFF_TAC + 64 * 8 * 8;
constexpr size_t OFF_TBC = OFF_TBR + 128 * 16 * 8;
constexpr size_t OFF_LAM = OFF_TBC + 64 * 16 * 8;
constexpr size_t OFF_BAR = OFF_LAM + 256;
constexpr size_t OFF_X = OFF_BAR + 256;
constexpr size_t OFF_XM = OFF_X + (size_t)RT * 1024 * 4;
constexpr size_t OFF_HID = OFF_XM + (size_t)RT * 1024 * 2;
constexpr size_t WS_NEED = OFF_HID + (size_t)RT * DFF * 2;
constexpr size_t SZ_H96 = (size_t)NB * 8 * NK * 96 * 2, SZ_H64 = (size_t)NB * 8 * NK * 64 * 2;
constexpr size_t HOFF_QA = 0, HOFF_KA = SZ_H96, HOFF_VA = 2 * SZ_H96, HOFF_QB = HOFF_VA + SZ_H64, HOFF_QN = HOFF_QB + SZ_H64;
static_assert(HOFF_QN + (size_t)RT * 256 * 2 <= (size_t)RT * DFF * 2, "HID region overflow");
constexpr size_t HOFF_U = 0, HOFF_PL = SZ_H64, HOFF_QD = 2 * SZ_H64, HOFF_KD = 3 * SZ_H64, HOFF_VD = 4 * SZ_H64;
constexpr size_t OOFF_KB = 0, OOFF_VB = SZ_H64, OOFF_KVN = 2 * SZ_H64;
static_assert(OOFF_KVN + (size_t)RT * 128 * 2 <= (size_t)RL * 1024 * 4, "d_out region overflow");

struct Params {
    const float* in[24];
    float* out;
    char* ws;
};

DI int ltid() { int t = threadIdx.x; asm volatile("" : "+v"(t)); return t; }
DI int lbid() { int t = blockIdx.x; asm volatile("" : "+s"(t)); return t; }
DI unsigned pk2(float a, float b) { f32x2 v = {a, b}; bfx2 r = __builtin_convertvector(v, bfx2); return __builtin_bit_cast(unsigned, r); }
DI float bf2f(unsigned short u) { return __uint_as_float(((unsigned)u) << 16); }
DI float bflo(unsigned u) { return __uint_as_float(u << 16); }
DI float bfhi(unsigned u) { return __uint_as_float(u & 0xffff0000u); }
DI float silu_f(float x) { return x * __builtin_amdgcn_rcpf(1.f + __expf(-x)); }
DI f32x16 mfma32(bf16x8 a, bf16x8 b, f32x16 c) { return __builtin_amdgcn_mfma_f32_32x32x16_bf16(a, b, c, 0, 0, 0); }
DI s16x4 tr_read(const char* p) { bfx4 r = __builtin_amdgcn_ds_read_tr16_b64_v4bf16((LDS_AS bfx4*)p); return __builtin_bit_cast(s16x4, r); }
DI float xor32_max(float x) { const unsigned u = __float_as_uint(x); auto r = __builtin_amdgcn_permlane32_swap(u, u, false, false); return fmaxf(__uint_as_float(r[0]), __uint_as_float(r[1])); }
DI float xor32_sum(float x) { const unsigned u = __float_as_uint(x); auto r = __builtin_amdgcn_permlane32_swap(u, u, false, false); return __uint_as_float(r[0]) + __uint_as_float(r[1]); }
DI bf16x8 cat8(s16x4 lo, s16x4 hi) { return __builtin_shufflevector(lo, hi, 0, 1, 2, 3, 4, 5, 6, 7); }

struct RowInfo { int b, j, s; bool lat; };
DI RowInfo rowinfo(int row) {
    RowInfo r;
    if (row < RL) { r.b = row >> 13; r.j = row & 8191; r.s = r.b; r.lat = true; }
    else { int rc = row - RL; r.b = rc >> 8; r.j = 8192 + (rc & 255); r.s = 4; r.lat = false; }
    return r;
}
DI void store16(bf16_t* dst32, const f32x16& v, float sc, int hh) {
#pragma unroll
    for (int q4 = 0; q4 < 4; ++q4) {
        u32x2 w; w.x = pk2(v[4 * q4] * sc, v[4 * q4 + 1] * sc); w.y = pk2(v[4 * q4 + 2] * sc, v[4 * q4 + 3] * sc);
        *(u32x2*)(dst32 + 8 * q4 + 4 * hh) = w;
    }
}
DI f32x16 ropeB(const f32x16& v, const f32x2* tab, int hh) {
    f32x16 o;
#pragma unroll
    for (int r = 0; r < 8; ++r) {
        const int i = (r & 3) + 8 * (r >> 2) + 4 * hh;
        const f32x2 cs = tab[i];
        o[r] = v[r] * cs.x - v[r + 8] * cs.y;
        o[r + 8] = v[r + 8] * cs.x + v[r] * cs.y;
    }
    return o;
}
DI f32x16 ropeA(const f32x16& v, const f32x2* tr, const f32x2* tc, int hh) {
    f32x16 o;
#pragma unroll
    for (int r = 0; r < 4; ++r) {
        const int i = 4 * hh + r;
        const f32x2 a = tr[i], c = tc[i];
        o[r] = v[r] * a.x - v[r + 4] * a.y;
        o[r + 4] = v[r + 4] * a.x + v[r] * a.y;
        o[8 + r] = v[8 + r] * c.x - v[12 + r] * c.y;
        o[12 + r] = v[12 + r] * c.x + v[8 + r] * c.y;
    }
    return o;
}

constexpr int GA_S = 144, GB_S = 576;
constexpr int GSTAGE = 256 * GA_S + 64 * GB_S;
constexpr int GEMM_LDS = 2 * GSTAGE;

template <int BM, class Epi>
DI void gemm_tile(const bf16_t* __restrict__ A, int lda, const bf16_t* __restrict__ B, int ldb, int K, int row0, int col0, const Epi& epi, char* smem) {
    constexpr int MI = BM / 64, NA_ = BM / 64;
    const int tid = ltid(), lane = tid & 63, wave = tid >> 6, wm = wave >> 2, wn = wave & 3;
    const int l31 = lane & 31, hh = lane >> 5, q = (lane & 15) >> 2, p = lane & 3, nblk = (lane >> 4) & 1;
    f32x16 acc[MI][2];
#pragma unroll
    for (int i = 0; i < MI; ++i)
#pragma unroll
        for (int j = 0; j < 2; ++j)
#pragma unroll
            for (int r = 0; r < 16; ++r) acc[i][j][r] = 0.f;
    u32x4 ra[NA_], rb[4];
    const bf16_t* ag = A + (size_t)(row0 + (tid >> 3)) * lda + (tid & 7) * 8;
    const bf16_t* bg = B + (size_t)(tid >> 5) * ldb + col0 + (tid & 31) * 8;
    const int aw = (tid >> 3) * GA_S + (tid & 7) * 16, bw = BM * GA_S + (tid >> 5) * GB_S + (tid & 31) * 16;
    const int nk = K >> 6;
    const int xoff = (wm * (BM / 2) + l31) * GA_S + hh * 16;
    const int woff = BM * GA_S + (hh * 8 + q) * GB_S + (wn * 64 + nblk * 16 + 4 * p) * 2;
#pragma unroll
    for (int i = 0; i < NA_; ++i) ra[i] = *(const u32x4*)(ag + (size_t)(64 * i) * lda);
#pragma unroll
    for (int i = 0; i < 4; ++i) rb[i] = *(const u32x4*)(bg + (size_t)(16 * i) * ldb);
    __syncthreads();
#pragma unroll
    for (int i = 0; i < NA_; ++i) *(u32x4*)(smem + aw + 64 * i * GA_S) = ra[i];
#pragma unroll
    for (int i = 0; i < 4; ++i) *(u32x4*)(smem + bw + 16 * i * GB_S) = rb[i];
    if (nk > 1) {
#pragma unroll
        for (int i = 0; i < NA_; ++i) ra[i] = *(const u32x4*)(ag + 64 + (size_t)(64 * i) * lda);
#pragma unroll
        for (int i = 0; i < 4; ++i) rb[i] = *(const u32x4*)(bg + (size_t)(64 + 16 * i) * ldb);
    }
    __syncthreads();
    for (int kt = 0; kt < nk; ++kt) {
        const char* cur = smem + (kt & 1) * GSTAGE;
        char* nxt = smem + ((kt & 1) ^ 1) * GSTAGE;
        const bool w1 = kt + 1 < nk, l2 = kt + 2 < nk;
        const bf16_t* a2 = ag + (size_t)(kt + 2) * 64; const bf16_t* b2 = bg + (size_t)(kt + 2) * 64 * ldb;
#pragma unroll
        for (int s = 0; s < 4; ++s) {
            bf16x8 xf[MI], wf[2];
#pragma unroll
            for (int mi = 0; mi < MI; ++mi) xf[mi] = *(const bf16x8*)(cur + xoff + mi * 32 * GA_S + s * 32);
#pragma unroll
            for (int ni = 0; ni < 2; ++ni) {
                const char* wp = cur + woff + s * 16 * GB_S + ni * 64;
                wf[ni] = cat8(tr_read(wp), tr_read(wp + 4 * GB_S));
            }
#pragma unroll
            for (int mi = 0; mi < MI; ++mi)
#pragma unroll
                for (int ni = 0; ni < 2; ++ni) acc[mi][ni] = mfma32(wf[ni], xf[mi], acc[mi][ni]);
            if (w1) {
                if (s < NA_) *(u32x4*)(nxt + aw + 64 * s * GA_S) = ra[s];
                *(u32x4*)(nxt + bw + 16 * s * GB_S) = rb[s];
            }
            if (l2) {
                if (s < NA_) ra[s] = *(const u32x4*)(a2 + (size_t)(64 * s) * lda);
                rb[s] = *(const u32x4*)(b2 + (size_t)(16 * s) * ldb);
            }
        }
        __syncthreads();
    }
#pragma unroll
    for (int mi = 0; mi < MI; ++mi) epi(acc[mi][0], acc[mi][1], row0 + wm * (BM / 2) + mi * 32 + l31, col0 + wn * 64, hh);
}

template <class Epi>
DI void gemm_phase(const bf16_t* A, int lda, const bf16_t* B, int ldb, int N, int K, const Epi& epi, char* smem, bool do_ctx = true) {
    const int nt = N >> 8, small = do_ctx ? (RC / 128) * nt : 0;
    const int bid = lbid(), G = gridDim.x;
    if ((G & 7) == 0) {
        const int xcd = bid & 7, loc = bid >> 3, per = G >> 3, mine = (RL / 256 / 8) * nt;
        for (int i = loc; i < mine; i += per) {
            const int cg = i >> 7, rem = i & 127, cw = min(8, nt - cg * 8);
            int pg, w;
            if (cw == 8) { pg = rem >> 5; w = rem & 31; } else { const int rr = i - cg * 128; pg = rr / (4 * cw); w = rr - pg * 4 * cw; }
            const int pl = pg * 4 + (w & 3), cl = cg * 8 + (w >> 2);
            gemm_tile<256>(A, lda, B, ldb, K, (pl * 8 + xcd) * 256, cl * 256, epi, smem);
        }
    } else {
        const int big = (RL / 256) * nt;
        for (int t = bid; t < big; t += G) gemm_tile<256>(A, lda, B, ldb, K, (t / nt) * 256, (t % nt) * 256, epi, smem);
    }
    for (int u = bid; u < small; u += G) gemm_tile<128>(A, lda, B, ldb, K, RL + (u / nt) * 128, (u % nt) * 256, epi, smem);
}

struct EpiSwiglu {
    bf16_t* hid;
    DI void operator()(const f32x16& a0, const f32x16& a1, int row, int cbase, int hh) const {
        bf16_t* dst = hid + (size_t)row * DFF + (cbase >> 1) + 4 * hh;
#pragma unroll
        for (int q4 = 0; q4 < 4; ++q4) {
            float h[4];
#pragma unroll
            for (int j = 0; j < 4; ++j) h[j] = silu_f(a0[4 * q4 + j]) * a1[4 * q4 + j];
            u32x2 w; w.x = pk2(h[0], h[1]); w.y = pk2(h[2], h[3]);
            *(u32x2*)(dst + 8 * q4) = w;
        }
    }
};
struct EpiResid {
    const float* res_lat; const float* res_ctx; float* X; const float* gate; float coef;
    DI void operator()(const f32x16& a0, const f32x16& a1, int row, int cbase, int hh) const {
        const int s = row < RL ? (row >> 13) : 4;
        const float* rp = row < RL ? res_lat + (size_t)row * 1024 : res_ctx + (size_t)(row - RL) * 1024;
        const float* gp = gate + s * 9216;
        float* xp = X + (size_t)row * 1024;
#pragma unroll
        for (int ni = 0; ni < 2; ++ni)
#pragma unroll
            for (int q4 = 0; q4 < 4; ++q4) {
                const int c = cbase + ni * 32 + 8 * q4 + 4 * hh;
                const f32x4 r = *(const f32x4*)(rp + c), g = *(const f32x4*)(gp + c);
                f32x4 z;
#pragma unroll
                for (int j = 0; j < 4; ++j) z[j] = ALPHA * r[j] + coef * g[j] * (ni ? a1[4 * q4 + j] : a0[4 * q4 + j]);
                *(f32x4*)(xp + c) = z;
            }
    }
};
struct EpiY {
    static constexpr bool kSwap = false;
    bf16_t* Y; const float* gate; float coef;
    DI void operator()(const f32x16& a0, const f32x16& a1, int row, int cbase, int hh) const {
        const int s = row < RL ? (row >> 13) : 4;
        const float* gp = gate + s * 9216;
        bf16_t* yp = Y + (size_t)row * 1024;
#pragma unroll
        for (int ni = 0; ni < 2; ++ni)
#pragma unroll
            for (int q4 = 0; q4 < 4; ++q4) {
                const int c = cbase + ni * 32 + 8 * q4 + 4 * hh;
                const f32x4 g = *(const f32x4*)(gp + c);
                const f32x16& v = ni ? a1 : a0;
                u32x2 w; w.x = pk2(coef * g[0] * v[4 * q4], coef * g[1] * v[4 * q4 + 1]); w.y = pk2(coef * g[2] * v[4 * q4 + 2], coef * g[3] * v[4 * q4 + 3]);
                *(u32x2*)(yp + c) = w;
            }
    }
};
struct EpiEvIn {
    bf16_t *QN, *QB, *KVN, *KA, *KB, *VB; const f32x2 *tAr, *tAc, *tBr, *tBc;
    DI void operator()(const f32x16& a0, const f32x16& a1, int row, int cbase, int hh) const {
        const RowInfo ri = rowinfo(row);
        const int gr = (ri.j >> 6) & 127, gc = ri.j & 63;
#pragma unroll
        for (int ni = 0; ni < 2; ++ni) {
            const int g = (cbase >> 5) + ni;
            const f32x16& v = ni ? a1 : a0;
            if (g < 8) store16(QN + (size_t)row * 256 + g * 32, v, 1.f, hh);
            else if (g < 24) {
                const int hv = (g - 8) >> 1, half = (g - 8) & 1;
                f32x16 w = v; if (ri.lat) w = ropeB(v, half ? tBc + gc * 16 : tBr + gr * 16, hh);
                store16(QB + ((size_t)(ri.b * 8 + hv) * NK + ri.j) * 64 + half * 32, w, QB_SCALE, hh);
            } else if (g < 28) store16(KVN + (size_t)row * 128 + (g - 24) * 32, v, 1.f, hh);
            else if (g == 28) {
                f32x16 w = v; if (ri.lat) w = ropeA(v, tAr + gr * 8, tAc + gc * 8, hh);
                for (int h = 0; h < 8; ++h) store16(KA + ((size_t)(ri.b * 8 + h) * NK + ri.j) * 96 + 64, w, 1.f, hh);
            } else if (g < 45) {
                const int hv = (g - 29) >> 1, half = (g - 29) & 1;
                f32x16 w = v; if (ri.lat) w = ropeB(v, half ? tBc + gc * 16 : tBr + gr * 16, hh);
                store16(KB + ((size_t)(ri.b * 8 + hv) * NK + ri.j) * 64 + half * 32, w, 1.f, hh);
            } else if (g < 61) {
                const int idx = g - 45, h = idx >> 2, part = idx & 3;
                store16(VB + ((size_t)(ri.b * 4 + h) * NK + ri.j) * 128 + part * 32, v, 1.f, hh);
            }
        }
    }
};
struct EpiUQ {
    bf16_t* QA; const f32x2 *tAr, *tAc;
    DI void operator()(const f32x16& a0, const f32x16& a1, int row, int cbase, int hh) const {
        const RowInfo ri = rowinfo(row);
        const int gr = (ri.j >> 6) & 127, gc = ri.j & 63;
#pragma unroll
        for (int ni = 0; ni < 2; ++ni) {
            const int g = (cbase >> 5) + ni, h = g / 3, part = g - 3 * h;
            f32x16 w = ni ? a1 : a0;
            if (part == 2 && ri.lat) w = ropeA(ni ? a1 : a0, tAr + gr * 8, tAc + gc * 8, hh);
            store16(QA + ((size_t)(ri.b * 8 + h) * NK + ri.j) * 96 + part * 32, w, QA_SCALE, hh);
        }
    }
};
struct EpiUKV {
    bf16_t *KA, *VA;
    DI void operator()(const f32x16& a0, const f32x16& a1, int row, int cbase, int hh) const {
        const RowInfo ri = rowinfo(row);
#pragma unroll
        for (int ni = 0; ni < 2; ++ni) {
            const int g = (cbase >> 5) + ni, h = g >> 2, part = g & 3;
            const size_t tk = (size_t)(ri.b * 8 + h) * NK + ri.j;
            if (part < 2) store16(KA + tk * 96 + part * 32, ni ? a1 : a0, 1.f, hh);
            else store16(VA + tk * 64 + (part - 2) * 32, ni ? a1 : a0, 1.f, hh);
        }
    }
};
struct EpiOdIn {
    bf16_t *U, *QD, *KD, *VD;
    DI void operator()(const f32x16& a0, const f32x16& a1, int row, int cbase, int hh) const {
        const RowInfo ri = rowinfo(row);
#pragma unroll
        for (int ni = 0; ni < 2; ++ni) {
            const int g = (cbase >> 5) + ni;
            const f32x16& v = ni ? a1 : a0;
            if (g < 16) store16(U + (size_t)row * 512 + g * 32, v, 1.f, hh);
            else {
                const int gg = (g - 16) & 15, h = gg >> 1, half = gg & 1;
                const size_t off = ((size_t)(ri.b * 8 + h) * NK + ri.j) * 64 + half * 32;
                if (g < 32) store16(QD + off, v, QD_SCALE, hh);
                else if (g < 48) store16(KD + off, v, 1.f, hh);
                else store16(VD + off, v, 1.f, hh);
            }
        }
    }
};
struct EpiPool {
    bf16_t* CC; const float* pscale; int gidx;
    DI void operator()(const f32x16& a0, const f32x16& a1, int row, int cbase, int hh) const {
#pragma unroll
        for (int ni = 0; ni < 2; ++ni)
#pragma unroll
            for (int q4 = 0; q4 < 4; ++q4) {
                const int c = gidx * 128 + cbase + ni * 32 + 8 * q4 + 4 * hh;
                const f32x4 s = *(const f32x4*)(pscale + c);
                const f32x16& v = ni ? a1 : a0;
                u32x2 w; w.x = pk2(v[4 * q4] * s[0], v[4 * q4 + 1] * s[1]); w.y = pk2(v[4 * q4 + 2] * s[2], v[4 * q4 + 3] * s[3]);
                *(u32x2*)(CC + (size_t)row * 1024 + c) = w;
            }
    }
};

constexpr int ATT_LDS = 64 * (96 + 8) * 2 + 64 * (128 * 2 + 64);
constexpr int RPB_OFF = 2 * ATT_LDS;
constexpr int SMEM_BYTES = GEMM_LDS;

struct NAInfo { int qr; int kstart; };

template <int DQK, int DV, bool NA>
DI void attend(const bf16_t* __restrict__ Q, int q0, const bf16_t* __restrict__ Kb, const bf16_t* __restrict__ Vb,
               int s0, int n0, int s1, int n1, f32x16 (&o)[DV / 32], char* smem, NAInfo na) {
    constexpr int KS = (DQK + 8) * 2, VS = DV * 2 + 64;
    constexpr int KCH = DQK / 8, KN = (64 * KCH + NTHR - 1) / NTHR, VCH = DV / 8, VN = (64 * VCH + NTHR - 1) / NTHR;
    constexpr int NS = DQK / 16, NDT = DV / 32;
    const int tid = ltid(), lane = tid & 63, wave = tid >> 6;
    const int l31 = lane & 31, hh = lane >> 5, q = (lane & 15) >> 2, p = lane & 3, dblk = (lane >> 4) & 1;
    bf16x8 qf[NS];
    {
        const bf16_t* qp = Q + (size_t)(q0 + wave * 32 + l31) * DQK + hh * 8;
#pragma unroll
        for (int s = 0; s < NS; ++s) qf[s] = *(const bf16x8*)(qp + s * 16);
    }
#pragma unroll
    for (int d = 0; d < NDT; ++d)
#pragma unroll
        for (int r = 0; r < 16; ++r) o[d][r] = 0.f;
    float m = NA ? -INFINITY : 0.f, l = 0.f;
    f32x16 cinit;
#pragma unroll
    for (int r = 0; r < 16; ++r) cinit[r] = 0.f;
    u32x4 rk[KN], rv[VN];
    const int nt = n0 + n1;
    auto gload = [&](int t) {
        const int j0 = t < n0 ? s0 + t * 64 : s1 + (t - n0) * 64;
#pragma unroll
        for (int i = 0; i < KN; ++i) { int id = tid + NTHR * i; if (id >= 64 * KCH) id -= 64 * KCH; const int row = id / KCH, ch = id - row * KCH; rk[i] = *(const u32x4*)(Kb + (size_t)(j0 + row) * DQK + ch * 8); }
#pragma unroll
        for (int i = 0; i < VN; ++i) { int id = tid + NTHR * i; if (id >= 64 * VCH) id -= 64 * VCH; const int row = id / VCH, ch = id - row * VCH; rv[i] = *(const u32x4*)(Vb + (size_t)(j0 + row) * DV + ch * 8); }
    };
    gload(0);
    int qc = 0, cs = 0, rs = 0;
    if (NA) { qc = (wave & 1) * 32 + l31; cs = min(max(qc - 8, 0), 48); rs = min(max(na.qr - 4, 0), 120); }
    const float* rpb = (const float*)(smem + RPB_OFF);
    auto lwrite = [&](char* stg) {
#pragma unroll
        for (int i = 0; i < KN; ++i) { int id = tid + NTHR * i; if (id >= 64 * KCH) id -= 64 * KCH; const int row = id / KCH, ch = id - row * KCH; *(u32x4*)(stg + row * KS + ch * 16) = rk[i]; }
#pragma unroll
        for (int i = 0; i < VN; ++i) { int id = tid + NTHR * i; if (id >= 64 * VCH) id -= 64 * VCH; const int row = id / VCH, ch = id - row * VCH; *(u32x4*)(stg + 64 * KS + row * VS + ch * 16) = rv[i]; }
    };
    __syncthreads();
    lwrite(smem);
    if (nt > 1) gload(1);
    __syncthreads();
    for (int t = 0; t < nt; ++t) {
        const char* sK = smem + (t & 1) * ATT_LDS; const char* sV = sK + 64 * KS;
        bool active = true; int kr = 0;
        if (NA && t < n0) { kr = na.kstart + t; active = (kr >= rs) && (kr < rs + 8); }
        if (active) {
#pragma unroll
            for (int sub = 0; sub < 2; ++sub) {
                f32x16 st;
                if (NA) {
#pragma unroll
                    for (int r = 0; r < 16; ++r) st[r] = 0.f;
                } else st = cinit;
                {
                    bf16x8 kf[NS];
#pragma unroll
                    for (int s = 0; s < NS; ++s) kf[s] = *(const bf16x8*)(sK + (sub * 32 + l31) * KS + (s * 16 + hh * 8) * 2);
                    __builtin_amdgcn_sched_barrier(0);
#pragma unroll
                    for (int s = 0; s < NS; ++s) st = mfma32(kf[s], qf[s], st);
                }
                bf16x8 vf[NDT][2];
#pragma unroll
                for (int d = 0; d < NDT; ++d)
#pragma unroll
                    for (int s2 = 0; s2 < 2; ++s2) {
                        const char* vp = sV + (sub * 32 + 16 * s2 + 4 * hh + q) * VS + (d * 32 + dblk * 16 + 4 * p) * 2;
                        vf[d][s2] = cat8(tr_read(vp), tr_read(vp + 8 * VS));
                    }
                if (NA && t < n0) {
                    const float* brow = rpb + (kr - na.qr + 7) * 31 + 15 - qc;
#pragma unroll
                    for (int r = 0; r < 16; ++r) {
                        const int kc = sub * 32 + (r & 3) + 8 * (r >> 2) + 4 * hh;
                        const bool valid = (kc >= cs) && (kc < cs + 16);
                        const int bi = valid ? kc : cs;
                        const float bias = brow[bi];
                        st[r] = valid ? st[r] + bias : -INFINITY;
                    }
                }
                float mx = st[0];
#pragma unroll
                for (int r = 1; r < 16; ++r) mx = fmaxf(mx, st[r]);
                mx = xor32_max(mx);
                float rsum = 0.f;
                if (NA) {
                    const float mnew = fmaxf(m, mx);
                    const float muse = (mnew == -INFINITY) ? 0.f : mnew;
                    const float alpha = __builtin_amdgcn_exp2f(m - muse);
                    m = mnew;
                    l *= alpha;
#pragma unroll
                    for (int d = 0; d < NDT; ++d)
#pragma unroll
                        for (int r = 0; r < 16; ++r) o[d][r] *= alpha;
#pragma unroll
                    for (int r = 0; r < 16; ++r) { st[r] = __builtin_amdgcn_exp2f(st[r] - muse); rsum += st[r]; }
                } else {
                    const bool first = (t == 0) && (sub == 0);
                    if (first || __builtin_amdgcn_ballot_w64(mx > 8.f) != 0) {
                        const float delta = first ? mx : fmaxf(mx, 0.f);
                        const float alpha = first ? 1.f : __builtin_amdgcn_exp2f(-delta);
                        m += delta;
                        l *= alpha;
#pragma unroll
                        for (int d = 0; d < NDT; ++d)
#pragma unroll
                            for (int r = 0; r < 16; ++r) o[d][r] *= alpha;
#pragma unroll
                        for (int r = 0; r < 16; ++r) { st[r] -= delta; cinit[r] = -m; }
                    }
#pragma unroll
                    for (int r = 0; r < 16; ++r) { st[r] = __builtin_amdgcn_exp2f(st[r]); rsum += st[r]; }
                }
                l += rsum;
                bf16x8 pf[2];
#pragma unroll
                for (int s2 = 0; s2 < 2; ++s2) {
                    u32x4 w;
                    w.x = pk2(st[8 * s2], st[8 * s2 + 1]); w.y = pk2(st[8 * s2 + 2], st[8 * s2 + 3]);
                    w.z = pk2(st[8 * s2 + 4], st[8 * s2 + 5]); w.w = pk2(st[8 * s2 + 6], st[8 * s2 + 7]);
                    pf[s2] = __builtin_bit_cast(bf16x8, w);
                }
#pragma unroll
                for (int d = 0; d < NDT; ++d)
#pragma unroll
                    for (int s2 = 0; s2 < 2; ++s2) o[d] = mfma32(vf[d][s2], pf[s2], o[d]);
            }
        }
        if (t + 1 < nt) lwrite(smem + ((t & 1) ^ 1) * ATT_LDS);
        if (t + 2 < nt) gload(t + 2);
        __syncthreads();
    }
    l = xor32_sum(l);
    const float inv = 1.f / l;
#pragma unroll
    for (int d = 0; d < NDT; ++d)
#pragma unroll
        for (int r = 0; r < 16; ++r) o[d][r] *= inv;
}

DI int qrow_of(int b, int j) { return j < SEQ ? b * SEQ + j : RL + b * CTX + (j - SEQ); }

DI void even_attention_phase(const Params& P, char* smem) {
    char* ws = P.ws; char* hid = ws + OFF_HID; char* ob = (char*)P.out;
    const bf16_t* QA = (const bf16_t*)(hid + HOFF_QA); const bf16_t* KA = (const bf16_t*)(hid + HOFF_KA); const bf16_t* VA = (const bf16_t*)(hid + HOFF_VA);
    const bf16_t* QB = (const bf16_t*)(hid + HOFF_QB); const bf16_t* KB = (const bf16_t*)(ob + OOFF_KB); const bf16_t* VB = (const bf16_t*)(ob + OOFF_VB);
    bf16_t* CC = (bf16_t*)(ws + OFF_XM);
    const float lam = *(const float*)(ws + OFF_LAM);
    const float* gsub = P.in[18];
    const int lane = ltid() & 63, wave = ltid() >> 6, l31 = lane & 31, hh = lane >> 5;
    constexpr int NQT = 33, NDIFF = NB * 4 * NQT, NMLA = NB * 8 * NQT;
    NAInfo na; na.qr = 0; na.kstart = 0;
    unsigned* wq = (unsigned*)(ws + OFF_BAR + 128);
    volatile int* slot = (volatile int*)(smem + 2 * ATT_LDS + 2048);
    for (;;) {
        __syncthreads();
        if (ltid() == 0) *slot = (int)atomicAdd(wq, 1u);
        __syncthreads();
        const int u = *slot;
        if (u >= NDIFF + NMLA) break;
        if (u < NDIFF) {
            const int qt = u % NQT, bh = u / NQT, h = bh & 3, b = bh >> 2;
            const int q0 = qt < 32 ? qt * 256 : SEQ;
            const int s0 = qt < 32 ? 0 : SEQ, n0 = qt < 32 ? NK / 64 : CTX / 64;
            const bf16_t* V = VB + (size_t)(b * 4 + h) * NK * 128;
            f32x16 o[4];
            attend<64, 128, false>(QB + (size_t)(b * 8 + 2 * h) * NK * 64, q0, KB + (size_t)(b * 8 + 2 * h) * NK * 64, V, s0, n0, 0, 0, o, smem, na);
            const int row = qrow_of(b, q0 + wave * 32 + l31);
            bf16_t* dst = CC + (size_t)row * 1024 + 512 + h * 128;
#pragma unroll
            for (int d = 0; d < 4; ++d) store16(dst + d * 32, o[d], 1.f, hh);
            f32x16 o2[4];
            attend<64, 128, false>(QB + (size_t)(b * 8 + 2 * h + 1) * NK * 64, q0, KB + (size_t)(b * 8 + 2 * h + 1) * NK * 64, V, s0, n0, 0, 0, o2, smem, na);
            float ss = 0.f;
#pragma unroll
            for (int d = 0; d < 4; ++d)
#pragma unroll
                for (int q4 = 0; q4 < 4; ++q4) {
                    const u32x2 w = *(const volatile u32x2*)(dst + d * 32 + 8 * q4 + 4 * hh);
                    const float a0 = bflo(w.x) - lam * o2[d][4 * q4], a1 = bfhi(w.x) - lam * o2[d][4 * q4 + 1], a2 = bflo(w.y) - lam * o2[d][4 * q4 + 2], a3 = bfhi(w.y) - lam * o2[d][4 * q4 + 3];
                    o[d][4 * q4] = a0; o[d][4 * q4 + 1] = a1; o[d][4 * q4 + 2] = a2; o[d][4 * q4 + 3] = a3;
                    ss += (a0 * a0 + a1 * a1) + (a2 * a2 + a3 * a3);
                }
            ss = xor32_sum(ss);
            const float rn = rsqrtf(ss * (1.f / 128.f) + 1e-5f) * 0.8f;
#pragma unroll
            for (int d = 0; d < 4; ++d)
#pragma unroll
                for (int q4 = 0; q4 < 4; ++q4) {
                    const int c = d * 32 + 8 * q4 + 4 * hh;
                    const f32x4 g = *(const f32x4*)(gsub + c);
                    u32x2 w; w.x = pk2(o[d][4 * q4] * rn * g[0], o[d][4 * q4 + 1] * rn * g[1]); w.y = pk2(o[d][4 * q4 + 2] * rn * g[2], o[d][4 * q4 + 3] * rn * g[3]);
                    *(u32x2*)(dst + c) = w;
                }
        } else {
            const int v = u - NDIFF, qt = v % NQT, bh = v / NQT, h = bh & 7, b = bh >> 3;
            const int q0 = qt < 32 ? qt * 256 : SEQ;
            const int s0 = qt < 32 ? 0 : SEQ, n0 = qt < 32 ? NK / 64 : CTX / 64;
            f32x16 o[2];
            attend<96, 64, false>(QA + (size_t)(b * 8 + h) * NK * 96, q0, KA + (size_t)(b * 8 + h) * NK * 96, VA + (size_t)(b * 8 + h) * NK * 64, s0, n0, 0, 0, o, smem, na);
            const int row = qrow_of(b, q0 + wave * 32 + l31);
            bf16_t* dst = CC + (size_t)row * 1024 + h * 64;
#pragma unroll
            for (int d = 0; d < 2; ++d) store16(dst + d * 32, o[d], 1.f, hh);
        }
    }
}

DI void odd_attention_phase(const Params& P, char* smem) {
    char* ws = P.ws; char* hid = ws + OFF_HID;
    const bf16_t* QD = (const bf16_t*)(hid + HOFF_QD); const bf16_t* KD = (const bf16_t*)(hid + HOFF_KD); const bf16_t* VD = (const bf16_t*)(hid + HOFF_VD);
    bf16_t* CC = (bf16_t*)(ws + OFF_XM);
    const float* rpbg = P.in[23];
    const int lane = ltid() & 63, wave = ltid() >> 6, l31 = lane & 31, hh = lane >> 5;
    float* rpbl = (float*)(smem + RPB_OFF);
    constexpr int NU = NB * 8 * 32;
    for (int u = lbid(); u < NU; u += gridDim.x) {
        const int rp = u & 31, bh = u >> 5, h = bh & 7, b = bh >> 3;
        __syncthreads();
        for (int i = ltid(); i < 465; i += NTHR) rpbl[i] = rpbg[h * 465 + i] * LOG2E;
        const int r0 = rp * 4;
        NAInfo na; na.qr = r0 + (wave >> 1);
        const int rs0 = min(max(r0 - 4, 0), 120);
        na.kstart = min(rs0, 117);
        f32x16 o[2];
        const size_t hb = (size_t)(b * 8 + h) * NK * 64;
        attend<64, 64, true>(QD + hb, r0 * 64, KD + hb, VD + hb, na.kstart * 64, 11, SEQ, CTX / 64, o, smem, na);
        const int row = b * SEQ + r0 * 64 + wave * 32 + l31;
        bf16_t* dst = CC + (size_t)row * 1024 + 512 + h * 64;
#pragma unroll
        for (int d = 0; d < 2; ++d) store16(dst + d * 32, o[d], 1.f, hh);
    }
}

DI void cvt8(bf16_t* dst, const float* src, float sc) {
    const f32x4 a = *(const f32x4*)src, b = *(const f32x4*)(src + 4);
    u32x4 w; w.x = pk2(a[0] * sc, a[1] * sc); w.y = pk2(a[2] * sc, a[3] * sc); w.z = pk2(b[0] * sc, b[1] * sc); w.w = pk2(b[2] * sc, b[3] * sc);
    *(u32x4*)dst = w;
}
DI void cvt_rows(bf16_t* dst, int ldd, const float* src, int lds_, int rows, int cols_src, const float* rowscale, size_t gtid, size_t gstride) {
    const int c8 = ldd >> 3; const size_t n = (size_t)rows * c8;
    for (size_t i0 = gtid; i0 < n; i0 += 4 * gstride) {
        f32x4 a[4], b[4]; float sc[4];
#pragma unroll
        for (int u = 0; u < 4; ++u) {
            const size_t i = i0 + u * gstride;
            const int k = (int)(i / c8), c = (int)(i % c8) * 8;
            const bool ok = i < n && c < cols_src;
            const float* p = src + (ok ? (size_t)k * lds_ + c : 0);
            a[u] = *(const f32x4*)p; b[u] = *(const f32x4*)(p + 4);
            sc[u] = !ok ? 0.f : (rowscale ? rowscale[k] : 1.f);
        }
#pragma unroll
        for (int u = 0; u < 4; ++u) {
            const size_t i = i0 + u * gstride;
            if (i < n) {
                const int k = (int)(i / c8), c = (int)(i % c8) * 8;
                u32x4 w; w.x = pk2(a[u][0] * sc[u], a[u][1] * sc[u]); w.y = pk2(a[u][2] * sc[u], a[u][3] * sc[u]); w.z = pk2(b[u][0] * sc[u], b[u][1] * sc[u]); w.w = pk2(b[u][2] * sc[u], b[u][3] * sc[u]);
                *(u32x4*)(dst + (size_t)k * ldd + c) = w;
            }
        }
    }
}

DI void phase_pro_a(const Params& P, char* smem) {
    char* ws = P.ws;
    const size_t gtid = (size_t)lbid() * NTHR + ltid(), gstride = (size_t)gridDim.x * NTHR;
    for (int lf = 0; lf < 4; ++lf) {
        const float* sg = P.in[8] + (size_t)lf * 1024 * DFF; const float* su = P.in[9] + (size_t)lf * 1024 * DFF;
        bf16_t* dst = (bf16_t*)(ws + OFF_WGU + lf * SZ_WGU);
        for (size_t i0 = gtid; i0 < 1024ull * 704; i0 += 4 * gstride) {
            f32x4 a[4], b[4];
#pragma unroll
            for (int u = 0; u < 4; ++u) {
                const size_t i = i0 + u * gstride < 1024ull * 704 ? i0 + u * gstride : i0;
                const int k = (int)(i / 704), n = (int)(i % 704) * 8, grp = n >> 6, w = n & 63;
                const float* src = ((w < 32) ? sg : su) + (size_t)k * DFF + grp * 32 + (w & 31);
                a[u] = *(const f32x4*)src; b[u] = *(const f32x4*)(src + 4);
            }
#pragma unroll
            for (int u = 0; u < 4; ++u) {
                const size_t i = i0 + u * gstride;
                if (i < 1024ull * 704) {
                    const int k = (int)(i / 704), n = (int)(i % 704) * 8;
                    u32x4 w; w.x = pk2(a[u][0], a[u][1]); w.y = pk2(a[u][2], a[u][3]); w.z = pk2(b[u][0], b[u][1]); w.w = pk2(b[u][2], b[u][3]);
                    *(u32x4*)(dst + (size_t)k * 5632 + n) = w;
                }
            }
        }
        cvt_rows((bf16_t*)(ws + OFF_WD + lf * SZ_WD), 1024, P.in[10] + (size_t)lf * DFF * 1024, 1024, DFF, 1024, nullptr, gtid, gstride);
    }
    cvt_rows((bf16_t*)(ws + OFF_EVIN), 2048, P.in[11], 1952, 1024, 1952, nullptr, gtid, gstride);
    cvt_rows((bf16_t*)(ws + OFF_EVOUT), 1024, P.in[12], 1024, 1024, 1024, nullptr, gtid, gstride);
    cvt_rows((bf16_t*)(ws + OFF_UQ), 768, P.in[15], 768, 256, 768, P.in[13], gtid, gstride);
    cvt_rows((bf16_t*)(ws + OFF_UKV), 1024, P.in[16], 1024, 128, 1024, P.in[14], gtid, gstride);
    cvt_rows((bf16_t*)(ws + OFF_ODIN), 2048, P.in[19], 2048, 1024, 2048, nullptr, gtid, gstride);
    cvt_rows((bf16_t*)(ws + OFF_ODOUT), 1024, P.in[20], 1024, 1024, 1024, nullptr, gtid, gstride);
    for (size_t i = gtid; i < 512ull * 64; i += gstride) {
        const int k = (int)(i >> 6), n = (int)(i & 63) * 8;
        bf16_t* d = (bf16_t*)(ws + OFF_POOL) + (size_t)k * 512 + n;
        if ((k >> 7) == (n >> 7)) cvt8(d, P.in[21] + (size_t)k * 128 + (n & 127), 1.f);
        else { u32x4 z = {0u, 0u, 0u, 0u}; *(u32x4*)d = z; }
    }
    if (gtid < 128 * 8) { const int r = (int)gtid >> 3, i = (int)gtid & 7; const float inv = exp2f(-(float)i * (13.287712379549449f / 8.f)); float rev = (float)r * inv * 0.15915494309189535f; rev -= floorf(rev);
        f32x2 v = {__builtin_amdgcn_cosf(rev), __builtin_amdgcn_sinf(rev)}; ((f32x2*)(ws + OFF_TAR))[gtid] = v; if (r < 64) ((f32x2*)(ws + OFF_TAC))[gtid] = v; }
    if (gtid < 128 * 16) { const int r = (int)gtid >> 4, i = (int)gtid & 15; const float inv = exp2f(-(float)i * (13.287712379549449f / 16.f)); float rev = (float)r * inv * 0.15915494309189535f; rev -= floorf(rev);
        f32x2 v = {__builtin_amdgcn_cosf(rev), __builtin_amdgcn_sinf(rev)}; ((f32x2*)(ws + OFF_TBR))[gtid] = v; if (r < 64) ((f32x2*)(ws + OFF_TBC))[gtid] = v; }
    if (gtid == 0) {
        const float* lv = P.in[17]; float a = 0.f, b = 0.f;
        for (int i = 0; i < 64; ++i) { a += lv[i] * lv[64 + i]; b += lv[128 + i] * lv[192 + i]; }
        *(float*)(ws + OFF_LAM) = expf(a) - expf(b) + 0.2f;
    }
    float* sc = (float*)smem;
    float* red = sc + 5 * 1024;
    const int tid = ltid(), jj = tid & 31, ig = tid >> 5;
    __syncthreads();
    for (int i = tid; i < 5 * 1024; i += NTHR) { const float v = i < 4096 ? P.in[1][i] : P.in[3][i - 4096]; sc[i] = v / (1.f + expf(-v)); }
    __syncthreads();
    for (int u = lbid(); u < 576; u += gridDim.x) {
        const int l = u / 288, j0 = (u % 288) * 32;
        float a[5] = {0.f, 0.f, 0.f, 0.f, 0.f};
        const float* w = P.in[4] + (size_t)l * 1024 * 9216 + (size_t)(ig * 64) * 9216 + j0 + jj;
        for (int i0 = 0; i0 < 64; i0 += 8) {
            float wv[8];
#pragma unroll
            for (int k = 0; k < 8; ++k) wv[k] = w[(size_t)(i0 + k) * 9216];
#pragma unroll
            for (int k = 0; k < 8; ++k)
#pragma unroll
                for (int s2 = 0; s2 < 5; ++s2) a[s2] += sc[s2 * 1024 + ig * 64 + i0 + k] * wv[k];
        }
#pragma unroll
        for (int s2 = 0; s2 < 5; ++s2) red[(ig * 5 + s2) * 32 + jj] = a[s2];
        __syncthreads();
        if (tid < 160) {
            const int s2 = tid >> 5, j = tid & 31;
            float v = P.in[5][l * 9216 + j0 + j];
#pragma unroll
            for (int g = 0; g < 16; ++g) v += red[(g * 5 + s2) * 32 + j];
            ((float*)(ws + OFF_MOD))[(size_t)(l * 5 + s2) * 9216 + j0 + j] = v;
        }
        __syncthreads();
    }
}

DI void phase_pro_b(const Params& P) {
    char* ws = P.ws; bf16_t* XM = (bf16_t*)(ws + OFF_XM); const float* MOD = (const float*)(ws + OFF_MOD);
    const size_t gtid = (size_t)lbid() * NTHR + ltid(), gstride = (size_t)gridDim.x * NTHR;
    for (size_t i = gtid; i < (size_t)RT * 128; i += gstride) {
        const int row = (int)(i >> 7), c = (int)(i & 127) * 8;
        const float* src = row < RL ? P.in[0] + (size_t)row * 1024 + c : P.in[2] + (size_t)(row - RL) * 1024 + c;
        const int s = row < RL ? (row >> 13) : 4;
        const float* sh = MOD + (size_t)s * 9216 + c; const float* scl = sh + 1024;
        unsigned w[4];
#pragma unroll
        for (int hf = 0; hf < 2; ++hf) {
            const f32x4 x = *(const f32x4*)(src + 4 * hf), a = *(const f32x4*)(sh + 4 * hf), g = *(const f32x4*)(scl + 4 * hf);
            w[2 * hf] = pk2(x[0] * (1.f + g[0]) + a[0], x[1] * (1.f + g[1]) + a[1]);
            w[2 * hf + 1] = pk2(x[2] * (1.f + g[2]) + a[2], x[3] * (1.f + g[3]) + a[3]);
        }
        u32x4 o = {w[0], w[1], w[2], w[3]};
        *(u32x4*)(XM + (size_t)row * 1024 + c) = o;
    }
}

struct LnSpec { int l, which, lnext, mshift; bool final_; unsigned* cnt; const bf16_t* Y; const float* res_lat; const float* res_ctx; };
template <int NR>
DI void ln_rows(const Params& P, const LnSpec& sp, int row, int stride, int lane) {
    char* ws = P.ws; float* X = (float*)(ws + OFF_X); bf16_t* XM = (bf16_t*)(ws + OFF_XM); const float* MOD = (const float*)(ws + OFF_MOD);
    const float* g = P.in[6] + (sp.l * 3 + sp.which) * 1024; const float* bb = P.in[7] + (sp.l * 3 + sp.which) * 1024;
    f32x4 v[NR][4]; float s[NR], qv[NR];
#pragma unroll
    for (int k = 0; k < NR; ++k) {
        const int r = row + k * stride;
        const float* xp = r < RL ? sp.res_lat + (size_t)r * 1024 : sp.res_ctx + (size_t)(r - RL) * 1024;
        const bf16_t* yp = sp.Y + (size_t)r * 1024;
#pragma unroll
        for (int i = 0; i < 4; ++i) {
            const f32x4 x = __builtin_nontemporal_load((const f32x4*)(xp + (i * 64 + lane) * 4));
            const u32x2 y = __builtin_nontemporal_load((const u32x2*)(yp + (i * 64 + lane) * 4));
            v[k][i][0] = ALPHA * x[0] + bflo(y.x); v[k][i][1] = ALPHA * x[1] + bfhi(y.x);
            v[k][i][2] = ALPHA * x[2] + bflo(y.y); v[k][i][3] = ALPHA * x[3] + bfhi(y.y);
        }
    }
#pragma unroll
    for (int k = 0; k < NR; ++k) {
        s[k] = 0.f;
#pragma unroll
        for (int i = 0; i < 4; ++i) s[k] += (v[k][i][0] + v[k][i][1]) + (v[k][i][2] + v[k][i][3]);
    }
#pragma unroll
    for (int o = 32; o >= 1; o >>= 1)
#pragma unroll
        for (int k = 0; k < NR; ++k) s[k] += __shfl_xor(s[k], o);
#pragma unroll
    for (int k = 0; k < NR; ++k) {
        s[k] *= (1.f / 1024.f); qv[k] = 0.f;
#pragma unroll
        for (int i = 0; i < 4; ++i)
#pragma unroll
            for (int j = 0; j < 4; ++j) { const float d = v[k][i][j] - s[k]; qv[k] += d * d; }
    }
#pragma unroll
    for (int o = 32; o >= 1; o >>= 1)
#pragma unroll
        for (int k = 0; k < NR; ++k) qv[k] += __shfl_xor(qv[k], o);
#pragma unroll
    for (int k = 0; k < NR; ++k) {
        const int r = row + k * stride;
        const float mu = s[k], rstd = rsqrtf(qv[k] * (1.f / 1024.f) + 1e-6f);
        const int sidx = r < RL ? (r >> 13) : 4;
        const float* sh = MOD + (size_t)(sp.lnext * 5 + sidx) * 9216 + sp.mshift * 1024; const float* scl = sh + 1024;
        float* xp = X + (size_t)r * 1024;
#pragma unroll
        for (int i = 0; i < 4; ++i) {
            const int c = (i * 64 + lane) * 4;
            const f32x4 gg = *(const f32x4*)(g + c), b4 = *(const f32x4*)(bb + c);
            f32x4 y;
#pragma unroll
            for (int j = 0; j < 4; ++j) y[j] = (v[k][i][j] - mu) * rstd * gg[j] + b4[j];
            if (sp.final_) { __builtin_nontemporal_store(y, (f32x4*)(P.out + (size_t)r * 1024 + c)); }
            else {
                __builtin_nontemporal_store(y, (f32x4*)(xp + c));
                const f32x4 a = *(const f32x4*)(sh + c), sg = *(const f32x4*)(scl + c);
                u32x2 w; w.x = pk2(y[0] * (1.f + sg[0]) + a[0], y[1] * (1.f + sg[1]) + a[1]); w.y = pk2(y[2] * (1.f + sg[2]) + a[2], y[3] * (1.f + sg[3]) + a[3]);
                *(u32x2*)(XM + (size_t)r * 1024 + c) = w;
            }
        }
    }
}
DI void phase_ln(const Params& P, int l, int which, int lnext, int mshift, bool final_, bool lat_only, const bf16_t* Y, bool first) {
    float* X = (float*)(P.ws + OFF_X);
    const LnSpec sp{l, which, lnext, mshift, final_, nullptr, Y, first ? P.in[0] : X, first ? P.in[2] : X + (size_t)RL * 1024};
    const int lane = ltid() & 63, wave = ltid() >> 6;
    const int nq = ((final_ || lat_only) ? RL : RT) / 4;
    for (int q = lbid() * NWAVE + wave; q < nq; q += gridDim.x * NWAVE) ln_rows<4>(P, sp, 4 * q, 1, lane);
}

DI void phase_ev_rms(const Params& P) {
    char* ws = P.ws; bf16_t* QN = (bf16_t*)(ws + OFF_HID + HOFF_QN); bf16_t* KVN = (bf16_t*)((char*)P.out + OOFF_KVN);
    const int lane = ltid() & 63, wave = ltid() >> 6;
    for (int row = (lbid() * NWAVE + wave) * 4; row < RT; row += gridDim.x * NWAVE * 4) {
        u32x2 wq[4]; unsigned wk[4]; float sq[4], sk[4];
#pragma unroll
        for (int k = 0; k < 4; ++k) { wq[k] = *(const u32x2*)(QN + (size_t)(row + k) * 256 + lane * 4); wk[k] = *(const unsigned*)(KVN + (size_t)(row + k) * 128 + lane * 2); }
#pragma unroll
        for (int k = 0; k < 4; ++k) {
            const float a = bflo(wq[k].x), b = bfhi(wq[k].x), c = bflo(wq[k].y), d = bfhi(wq[k].y);
            sq[k] = a * a + b * b + c * c + d * d;
            const float e = bflo(wk[k]), f = bfhi(wk[k]);
            sk[k] = e * e + f * f;
        }
#pragma unroll
        for (int o = 32; o >= 1; o >>= 1)
#pragma unroll
            for (int k = 0; k < 4; ++k) { sq[k] += __shfl_xor(sq[k], o); sk[k] += __shfl_xor(sk[k], o); }
#pragma unroll
        for (int k = 0; k < 4; ++k) {
            const float rq = rsqrtf(sq[k] * (1.f / 256.f) + 1e-6f), rk = rsqrtf(sk[k] * (1.f / 128.f) + 1e-6f);
            u32x2 o2; o2.x = pk2(bflo(wq[k].x) * rq, bfhi(wq[k].x) * rq); o2.y = pk2(bflo(wq[k].y) * rq, bfhi(wq[k].y) * rq);
            *(u32x2*)(QN + (size_t)(row + k) * 256 + lane * 4) = o2;
            *(unsigned*)(KVN + (size_t)(row + k) * 128 + lane * 2) = pk2(bflo(wk[k]) * rk, bfhi(wk[k]) * rk);
        }
    }
}

DI void phase_od_pool(const Params& P) {
    char* ws = P.ws; const bf16_t* U = (const bf16_t*)(ws + OFF_HID + HOFF_U); bf16_t* PL = (bf16_t*)(ws + OFF_HID + HOFF_PL);
    const size_t gtid = (size_t)lbid() * NTHR + ltid(), gstride = (size_t)gridDim.x * NTHR;
    for (size_t i = gtid; i < (size_t)RT * 64; i += gstride) {
        const int row = (int)(i >> 6), c = (int)(i & 63) * 8, grp = c >> 7;
        const int w = 2 << grp, left = w >> 1, right = w - 1 - left;
        int base, n, t;
        if (row < RL) { base = row & ~8191; n = SEQ; t = row & 8191; } else { const int rc = row - RL; base = RL + (rc & ~255); n = CTX; t = rc & 255; }
        const int lo = max(t - left, 0), hi = min(t + right + 1, n);
        float acc[8] = {0.f, 0.f, 0.f, 0.f, 0.f, 0.f, 0.f, 0.f};
#pragma unroll 4
        for (int tt = lo; tt < hi; ++tt) {
            const u32x4 v = *(const u32x4*)(U + (size_t)(base + tt) * 512 + c);
            acc[0] += bflo(v.x); acc[1] += bfhi(v.x); acc[2] += bflo(v.y); acc[3] += bfhi(v.y); acc[4] += bflo(v.z); acc[5] += bfhi(v.z); acc[6] += bflo(v.w); acc[7] += bfhi(v.w);
        }
        const float ic = 1.f / (float)(hi - lo);
        const u32x4 s = *(const u32x4*)(U + (size_t)row * 512 + c);
        u32x4 o;
        o.x = pk2(acc[0] * ic - bflo(s.x), acc[1] * ic - bfhi(s.x)); o.y = pk2(acc[2] * ic - bflo(s.y), acc[3] * ic - bfhi(s.y));
        o.z = pk2(acc[4] * ic - bflo(s.z), acc[5] * ic - bfhi(s.z)); o.w = pk2(acc[6] * ic - bflo(s.w), acc[7] * ic - bfhi(s.w));
        *(u32x4*)(PL + (size_t)row * 512 + c) = o;
    }
}

constexpr int NPHASE = 25;

DI void run_phase(const Params& P, int ph, char* smem) {
    char* ws = P.ws; char* hid = ws + OFF_HID; char* ob = (char*)P.out;
    float* X = (float*)(ws + OFF_X); bf16_t* XM = (bf16_t*)(ws + OFF_XM); bf16_t* HID = (bf16_t*)hid;
    const float* MOD = (const float*)(ws + OFF_MOD);
    if (ph == 0) { phase_pro_a(P, smem); return; }
    if (ph == 1) { phase_pro_b(P); return; }
    int l, op;
    if (ph < 14) { l = 0; op = ph - 2; } else { l = 1; op = ph - 14; if (op >= 6) op += 1; }
    const float* modl = MOD + (size_t)l * 5 * 9216;
    switch (op) {
    case 0: case 9: {
        const int f = op == 0 ? 0 : 1;
        EpiSwiglu e{HID};
        gemm_phase(XM, 1024, (const bf16_t*)(ws + OFF_WGU + (l * 2 + f) * SZ_WGU), 5632, 5632, 1024, e, smem, !(l == 1 && f == 1));
    } break;
    case 1: case 10: {
        const int f = op == 1 ? 0 : 1;
        EpiY e{XM, modl + (f == 0 ? 2 : 8) * 1024, 0.5f};
        gemm_phase(HID, DFF, (const bf16_t*)(ws + OFF_WD + (l * 2 + f) * SZ_WD), 1024, 1024, DFF, e, smem, !(l == 1 && f == 1));
    } break;
    case 2: phase_ln(P, l, 0, l, 3, false, false, XM, l == 0); break;
    case 3: {
        if (l == 0) {
            EpiEvIn e{(bf16_t*)(hid + HOFF_QN), (bf16_t*)(hid + HOFF_QB), (bf16_t*)(ob + OOFF_KVN), (bf16_t*)(hid + HOFF_KA), (bf16_t*)(ob + OOFF_KB), (bf16_t*)(ob + OOFF_VB),
                      (const f32x2*)(ws + OFF_TAR), (const f32x2*)(ws + OFF_TAC), (const f32x2*)(ws + OFF_TBR), (const f32x2*)(ws + OFF_TBC)};
            gemm_phase(XM, 1024, (const bf16_t*)(ws + OFF_EVIN), 2048, 2048, 1024, e, smem);
        } else {
            EpiOdIn e{(bf16_t*)(hid + HOFF_U), (bf16_t*)(hid + HOFF_QD), (bf16_t*)(hid + HOFF_KD), (bf16_t*)(hid + HOFF_VD)};
            gemm_phase(XM, 1024, (const bf16_t*)(ws + OFF_ODIN), 2048, 2048, 1024, e, smem);
        }
    } break;
    case 4: if (l == 0) phase_ev_rms(P); else phase_od_pool(P); break;
    case 5: {
        if (l == 0) {
            EpiUQ e1{(bf16_t*)(hid + HOFF_QA), (const f32x2*)(ws + OFF_TAR), (const f32x2*)(ws + OFF_TAC)};
            gemm_phase((const bf16_t*)(hid + HOFF_QN), 256, (const bf16_t*)(ws + OFF_UQ), 768, 768, 256, e1, smem);
            EpiUKV e2{(bf16_t*)(hid + HOFF_KA), (bf16_t*)(hid + HOFF_VA)};
            gemm_phase((const bf16_t*)(ob + OOFF_KVN), 128, (const bf16_t*)(ws + OFF_UKV), 1024, 1024, 128, e2, smem);
        } else {
            odd_attention_phase(P, smem);
            EpiPool e{XM, P.in[22], 0};
            gemm_phase((const bf16_t*)(hid + HOFF_PL), 512, (const bf16_t*)(ws + OFF_POOL), 512, 512, 512, e, smem);
        }
    } break;
    case 6: even_attention_phase(P, smem); break;
    case 7: {
        EpiY e{HID, modl + 5 * 1024, 1.f};
        gemm_phase(XM, 1024, (const bf16_t*)(ws + (l == 0 ? OFF_EVOUT : OFF_ODOUT)), 1024, 1024, 1024, e, smem, l == 0);
    } break;
    case 8: phase_ln(P, l, 1, l, 6, false, l == 1, HID, false); break;
    case 11: if (l == 0) phase_ln(P, 0, 2, 1, 0, false, false, XM, false); else phase_ln(P, 1, 2, 1, 0, true, true, XM, false); break;
    default: break;
    }
}

DI void grid_barrier(unsigned* ctr, unsigned target) {
    __syncthreads();
    if (threadIdx.x == 0) {
        __builtin_amdgcn_fence(__ATOMIC_RELEASE, "agent");
        __hip_atomic_fetch_add(ctr, 1u, __ATOMIC_RELAXED, __HIP_MEMORY_SCOPE_AGENT);
        while (__hip_atomic_load(ctr, __ATOMIC_RELAXED, __HIP_MEMORY_SCOPE_AGENT) < target) __builtin_amdgcn_s_sleep(2);
        __builtin_amdgcn_fence(__ATOMIC_ACQUIRE, "agent");
    }
    __syncthreads();
}

__global__ void __launch_bounds__(NTHR, 2) mega(Params P, int ph_lo, int ph_hi) {
    extern __shared__ __attribute__((aligned(16))) char smem[];
    unsigned nsync = 0;
    for (int ph = ph_lo; ph < ph_hi; ++ph) {
        run_phase(P, ph, smem);
        if (ph + 1 < ph_hi) {
            if (ph == ph_lo) cg::this_grid().sync();
            else { ++nsync; grid_barrier((unsigned*)(P.ws + OFF_BAR), nsync * gridDim.x); }
        }
    }
}

extern "C" void kernel_launch(void* const* d_in, const int* in_sizes, int n_in, void* d_out, int out_size, void* d_ws, size_t ws_size, hipStream_t stream) {
    if (ws_size < WS_NEED) { fprintf(stderr, "workspace too small: %zu < %zu\n", ws_size, (size_t)WS_NEED); return; }
    Params P{};
    for (int i = 0; i < 24; ++i) P.in[i] = (const float*)d_in[i];
    P.out = (float*)d_out; P.ws = (char*)d_ws;
    static int grid_blocks = 0;
    if (!grid_blocks) {
        int dev = 0, cus = 0, per_cu = 0;
        hipGetDevice(&dev);
        hipDeviceGetAttribute(&cus, hipDeviceAttributeMultiprocessorCount, dev);
        hipFuncSetAttribute((const void*)mega, hipFuncAttributeMaxDynamicSharedMemorySize, SMEM_BYTES);
        hipOccupancyMaxActiveBlocksPerMultiprocessor(&per_cu, mega, NTHR, SMEM_BYTES);
        if (per_cu < 1) per_cu = 1;
        if (per_cu > 1) per_cu = 1;
        grid_blocks = cus * per_cu;
    }
#if COOP
    hipMemsetAsync((char*)d_ws + OFF_BAR, 0, 256, stream);
    int lo = 0, hi = NPHASE;
    void* args[] = {&P, &lo, &hi};
    hipError_t e = hipLaunchCooperativeKernel((void*)mega, dim3(grid_blocks), dim3(NTHR), args, SMEM_BYTES, stream);
    if (e != hipSuccess) fprintf(stderr, "cooperative launch failed: %s (grid %d)\n", hipGetErrorString(e), grid_blocks);
#else
    for (int ph = 0; ph < NPHASE; ++ph) mega<<<grid_blocks, NTHR, SMEM_BYTES, stream>>>(P, ph, ph + 1);
#endif
}
```
